# Optimizing an MI355X kernel written in HIP

```python
import jax
import jax.numpy as jnp
from jax import lax
import numpy as np

D_MODEL = 1024
BATCH = 8
SEQ = 4096
DEPTH = 4

GRID_W = 64
CTX_LEN = 256
NORM_EPS = 1e-6
ROPE_THETA = 10000.0

ATT_HEADS = 8
ATT_KV_HEADS = 2
ATT_HEAD_DIM = 64
Q_BLOCK = 128
ATT_W = ATT_HEADS * ATT_HEAD_DIM
ATT_KV_W = ATT_KV_HEADS * ATT_HEAD_DIM

RET_HEADS = 4
RET_HEAD_DIM = 128
RET_CHUNK = 128
RET_W = RET_HEADS * RET_HEAD_DIM

RWKV_HEADS = 8
RWKV_HEAD_DIM = 64
RWKV_W = RWKV_HEADS * RWKV_HEAD_DIM
RWKV_DECAY_LORA = 64
RWKV_AAA_LORA = 64
RWKV_GATE_LORA = 128
RWKV_GN_EPS = 64e-5
RWKV_SPLITS = (RWKV_W, RWKV_W, RWKV_W, RWKV_DECAY_LORA, RWKV_AAA_LORA, RWKV_GATE_LORA)
RWKV_COLS = 3 * RWKV_W + RWKV_DECAY_LORA + RWKV_AAA_LORA + RWKV_GATE_LORA

N_BRANCH = 3
BRANCH_W = 512
IN_SPLITS = (ATT_W, ATT_KV_W, ATT_KV_W, RET_W, RET_W, RET_W, RET_W, RWKV_COLS, N_BRANCH * D_MODEL)
IN_COLS = ATT_W + 2 * ATT_KV_W + 4 * RET_W + RWKV_COLS + N_BRANCH * D_MODEL

MOE_GROUPS = 4
MOE_EXPERTS_PER_GROUP = 8
MOE_EXPERTS = MOE_GROUPS * MOE_EXPERTS_PER_GROUP
MOE_TOPK = 2
MOE_HIDDEN = 512
MOE_BLOCK = 256

kernel_name = 'hybrid_prefix_dit_block'


def rms_norm(x, g):
    xf = x.astype(jnp.float32)
    y = xf * lax.rsqrt(jnp.mean(xf * xf, axis=-1, keepdims=True) + NORM_EPS)
    return (y * g.astype(jnp.float32)).astype(x.dtype)


def split_cols(u, sizes):
    bounds = []
    acc = 0
    for s in sizes[:-1]:
        acc += s
        bounds.append(acc)
    return jnp.split(u, bounds, axis=-1)


def split_heads(u, n_heads):
    b, n, w = u.shape
    return u.reshape(b, n, n_heads, w // n_heads).transpose(0, 2, 1, 3)


def merge_heads(u):
    b, h, n, d = u.shape
    return u.transpose(0, 2, 1, 3).reshape(b, n, h * d)


def axial_rope_tables(n_tokens, head_dim):
    rows = n_tokens // GRID_W
    row = jnp.broadcast_to(jnp.arange(rows, dtype=jnp.float32)[:, None], (rows, GRID_W)).reshape(-1)
    col = jnp.broadcast_to(jnp.arange(GRID_W, dtype=jnp.float32)[None, :], (rows, GRID_W)).reshape(-1)
    quarter = head_dim // 4
    inv_freq = ROPE_THETA ** (-jnp.arange(quarter, dtype=jnp.float32) / quarter)
    ang = jnp.stack([row[:, None] * inv_freq, col[:, None] * inv_freq], axis=1)
    return jnp.cos(ang), jnp.sin(ang)


def apply_axial_rope(x, cos, sin):
    shape = x.shape
    xr = x.astype(jnp.float32).reshape(*shape[:-1], 2, 2, shape[-1] // 4)
    x1, x2 = xr[..., 0, :], xr[..., 1, :]
    out = jnp.stack([x1 * cos - x2 * sin, x2 * cos + x1 * sin], axis=-2)
    return out.reshape(shape).astype(x.dtype)


def centred_shift(u, mu):
    prev = jnp.pad(u[:, :-1], ((0, 0), (1, 0), (0, 0)))
    nxt = jnp.pad(u[:, 1:], ((0, 0), (0, 1), (0, 0)))
    return u + (prev - u) * mu[0] + (nxt - u) * mu[1]


def gqa_softmax(q, k, v):
    s = jnp.einsum('bkgqd,bksd->bkgqs', q.astype(jnp.float32), k) * (q.shape[-1] ** -0.5)
    return jnp.einsum('bkgqs,bksd->bkgqd', jax.nn.softmax(s, axis=-1), v)


def attention_branch(q, k, v, qc, kc, vc, qn_g, kn_g, cos, sin, want_ctx):
    b, n, _ = q.shape
    n_ctx = qc.shape[1]
    grp = ATT_HEADS // ATT_KV_HEADS
    qh = apply_axial_rope(rms_norm(split_heads(q, ATT_HEADS), qn_g), cos, sin)
    kh = apply_axial_rope(rms_norm(split_heads(k, ATT_KV_HEADS), kn_g), cos, sin)
    kch = rms_norm(split_heads(kc, ATT_KV_HEADS), kn_g).astype(jnp.float32)
    vch = split_heads(vc, ATT_KV_HEADS).astype(jnp.float32)
    keys = jnp.concatenate([kch, kh.astype(jnp.float32)], axis=2)
    vals = jnp.concatenate([vch, split_heads(v, ATT_KV_HEADS).astype(jnp.float32)], axis=2)
    qb = qh.reshape(b, ATT_KV_HEADS, grp, n // Q_BLOCK, Q_BLOCK, ATT_HEAD_DIM).transpose(3, 0, 1, 2, 4, 5)
    ob = lax.map(lambda qi: gqa_softmax(qi, keys, vals), qb)
    out = ob.transpose(1, 2, 3, 0, 4, 5).reshape(b, ATT_HEADS, n, ATT_HEAD_DIM)
    y = merge_heads(out).astype(q.dtype)
    if not want_ctx:
        return y, None
    qch = rms_norm(split_heads(qc, ATT_HEADS), qn_g).reshape(b, ATT_KV_HEADS, grp, n_ctx, ATT_HEAD_DIM)
    oc = gqa_softmax(qch, kch, vch).reshape(b, ATT_HEADS, n_ctx, ATT_HEAD_DIM)
    return y, merge_heads(oc).astype(qc.dtype)


def chunk_retention(q, k, v, log_gamma, s0, want_out):
    bsz, nh, n, dk = k.shape
    dv = v.shape[-1]
    n_chunks = n // RET_CHUNK
    pos = jnp.arange(RET_CHUNK, dtype=jnp.float32)
    d_key = jnp.exp(log_gamma[:, None] * (RET_CHUNK - 1.0 - pos))[:, :, None]
    d_chunk = jnp.exp(log_gamma * RET_CHUNK)[:, None, None]
    if want_out:
        lag = pos[:, None] - pos[None, :]
        d_intra = jnp.where(lag >= 0, jnp.exp(log_gamma[:, None, None] * jnp.maximum(lag, 0.0)), 0.0)
        d_query = jnp.exp(log_gamma[:, None] * (pos + 1.0))[:, :, None]
    to_chunks = lambda u: u.reshape(bsz, nh, n_chunks, RET_CHUNK, u.shape[-1]).transpose(2, 0, 1, 3, 4)

    def step(s, blk):
        qc, kc, vc = blk
        s_next = d_chunk * s + jnp.einsum('bhjd,bhje->bhde', kc * d_key, vc)
        if not want_out:
            return s_next, None
        scores = jnp.einsum('bhid,bhjd->bhij', qc, kc) * d_intra
        y = jnp.einsum('bhij,bhje->bhie', scores, vc) + jnp.einsum('bhid,bhde->bhie', qc, s) * d_query
        return s_next, y

    xs = (to_chunks(q) if want_out else None, to_chunks(k), to_chunks(v))
    s_fin, ys = lax.scan(step, s0, xs)
    if not want_out:
        return s_fin, None
    return s_fin, ys.transpose(1, 2, 0, 3, 4).reshape(bsz, nh, n, dv)


def retention_branch(q, k, v, g, qc, kc, vc, gc, decay_logit, gn_g, cos, sin, want_ctx):
    f32 = jnp.float32
    scale = RET_HEAD_DIM ** -0.5
    log_gamma = jax.nn.log_sigmoid(decay_logit.astype(f32))
    ql = apply_axial_rope(split_heads(q, RET_HEADS), cos, sin).astype(f32)
    kl = apply_axial_rope(split_heads(k, RET_HEADS), cos, sin).astype(f32) * scale
    vl = split_heads(v, RET_HEADS).astype(f32)
    qcx = split_heads(qc, RET_HEADS).astype(f32) if want_ctx else None
    kcx = split_heads(kc, RET_HEADS).astype(f32) * scale
    vcx = split_heads(vc, RET_HEADS).astype(f32)
    s0 = jnp.zeros((kcx.shape[0], RET_HEADS, RET_HEAD_DIM, RET_HEAD_DIM), f32)
    flip = lambda u: None if u is None else jnp.flip(u, axis=2)
    s_cf, y_cf = chunk_retention(qcx, kcx, vcx, log_gamma[0], s0, want_ctx)
    s_cb, y_cb = chunk_retention(flip(qcx), flip(kcx), flip(vcx), log_gamma[1], s0, want_ctx)
    _, y_lf = chunk_retention(ql, kl, vl, log_gamma[0], s_cf, True)
    _, y_lb = chunk_retention(flip(ql), flip(kl), flip(vl), log_gamma[1], s_cb, True)

    def readout(y, gate):
        yn = rms_norm(y, gn_g.reshape(RET_HEADS, 1, RET_HEAD_DIM))
        return (jax.nn.silu(gate.astype(f32)) * merge_heads(yn)).astype(gate.dtype)

    y = readout(y_lf + flip(y_lb), g)
    if not want_ctx:
        return y, None
    return y, readout(y_cf + flip(y_cb), gc)


def rwkv7_scan(r, decay, k, v, a_in, b_in, s0, reverse, want_out):
    time_major = lambda u: None if u is None else jnp.swapaxes(u, 0, 1)

    def step(s, inp):
        rt, wt, kt, vt, at, bt = inp
        sa = jnp.einsum('bhij,bhj->bhi', s, at)
        s = s * wt[:, :, None, :] + sa[..., None] * bt[:, :, None, :] + vt[..., None] * kt[:, :, None, :]
        return s, (jnp.einsum('bhij,bhj->bhi', s, rt) if want_out else None)

    xs = tuple(time_major(u) for u in (r, decay, k, v, a_in, b_in))
    s_fin, ys = lax.scan(step, s0, xs, reverse=reverse)
    return s_fin, (jnp.swapaxes(ys, 0, 1) if want_out else None)


def rwkv7_branch(u, uc, mu, w0, w2, a0, a2, g2, k_k, k_a, r_k, ln_g, ln_b, want_ctx):
    f32 = jnp.float32

    def scan_inputs(t):
        bsz, n, _ = t.shape
        t = centred_shift(t.astype(f32), mu.astype(f32))
        r, k, v, xw, xa, xg = split_cols(t, RWKV_SPLITS)
        heads = lambda z: z.reshape(bsz, n, RWKV_HEADS, RWKV_HEAD_DIM)
        kk = heads(k * k_k)
        kk = kk * lax.rsqrt(jnp.maximum(jnp.sum(kk * kk, axis=-1, keepdims=True), 1e-12))
        dirs = []
        for d in range(2):
            w_log = -jax.nn.softplus(-(w0[d] + jnp.tanh(xw) @ w2[d])) - 0.5
            a = jax.nn.sigmoid(a0[d] + xa @ a2[d])
            dirs.append((heads(jnp.exp(-jnp.exp(w_log))),
                         heads(k * (1.0 + (a - 1.0) * k_a)),
                         kk * heads(a)))
        return heads(r), heads(v), kk, xg, dirs

    def readout(y, r, v, dirs, xg):
        bsz, n = y.shape[:2]
        mean = jnp.mean(y, axis=-1, keepdims=True)
        var = jnp.mean(jnp.square(y - mean), axis=-1, keepdims=True)
        yn = ((y - mean) * lax.rsqrt(var + RWKV_GN_EPS)).reshape(bsz, n, RWKV_W) * ln_g + ln_b
        bonus = jnp.sum(r * (dirs[0][1] + dirs[1][1]) * r_k, axis=-1, keepdims=True) * v
        return (yn + bonus.reshape(bsz, n, RWKV_W)) * (jax.nn.sigmoid(xg) @ g2)

    r, v, kk, xg, dirs = scan_inputs(u)
    rc, vc, kkc, xgc, dirs_c = scan_inputs(uc)
    s0 = jnp.zeros((u.shape[0], RWKV_HEADS, RWKV_HEAD_DIM, RWKV_HEAD_DIM), f32)
    y_lat, y_ctx = [], []
    for d in range(2):
        s_ctx, yc = rwkv7_scan(rc if want_ctx else None, dirs_c[d][0], dirs_c[d][1], vc, -kkc, dirs_c[d][2],
                               s0, d == 1, want_ctx)
        _, yl = rwkv7_scan(r, dirs[d][0], dirs[d][1], v, -kk, dirs[d][2], s_ctx, d == 1, True)
        y_lat.append(yl)
        y_ctx.append(yc)
    out = readout(y_lat[0] + y_lat[1], r, v, dirs, xg).astype(u.dtype)
    if not want_ctx:
        return out, None
    return out, readout(y_ctx[0] + y_ctx[1], rc, vc, dirs_c, xgc).astype(uc.dtype)


def merge_branches(y_att, y_ret, y_rwkv, gate_logits, w_branch, w_out):
    ys = jnp.stack([y_att, y_ret, y_rwkv], axis=-2)
    proj = jnp.einsum('blnw,nwd->blnd', ys, w_branch)
    gates = jax.nn.sigmoid(gate_logits.astype(jnp.float32)).reshape(proj.shape)
    return jnp.sum(gates * proj, axis=-2).astype(w_out.dtype) @ w_out


def hybrid_mixer(h, hc, w_in, att_qn_g, att_kn_g, ret_decay_logit, ret_gn_g, rwkv_mu, rwkv_w0, rwkv_w2,
                 rwkv_a0, rwkv_a2, rwkv_g2, rwkv_k_k, rwkv_k_a, rwkv_r_k, rwkv_ln_g, rwkv_ln_b,
                 w_branch, w_out, att_cos, att_sin, ret_cos, ret_sin, want_ctx):
    aq, ak, av, rq, rk, rv, rg, wu, gl = split_cols(h @ w_in, IN_SPLITS)
    aqc, akc, avc, rqc, rkc, rvc, rgc, wuc, glc = split_cols(hc @ w_in, IN_SPLITS)
    ya, yac = attention_branch(aq, ak, av, aqc, akc, avc, att_qn_g, att_kn_g, att_cos, att_sin, want_ctx)
    yr, yrc = retention_branch(rq, rk, rv, rg, rqc, rkc, rvc, rgc, ret_decay_logit, ret_gn_g,
                               ret_cos, ret_sin, want_ctx)
    yw, ywc = rwkv7_branch(wu, wuc, rwkv_mu, rwkv_w0, rwkv_w2, rwkv_a0, rwkv_a2, rwkv_g2, rwkv_k_k,
                           rwkv_k_a, rwkv_r_k, rwkv_ln_g, rwkv_ln_b, want_ctx)
    out = merge_branches(ya, yr, yw, gl, w_branch, w_out).astype(h.dtype)
    if not want_ctx:
        return out, None
    return out, merge_branches(yac, yrc, ywc, glc, w_branch, w_out).astype(hc.dtype)


def hier_moe(t, grp_w, grp_b, exp_w, exp_b, w_gate, w_up, w_down):
    n_tok, d = t.shape
    tf = t.astype(jnp.float32)
    grp_logits = tf @ grp_w.astype(jnp.float32) + grp_b.astype(jnp.float32)
    grp = jnp.argmax(grp_logits, axis=-1)
    p_grp = jnp.max(jax.nn.softmax(grp_logits, axis=-1), axis=-1, keepdims=True)
    exp_logits = (tf @ exp_w.astype(jnp.float32) + exp_b.astype(jnp.float32)).reshape(
        n_tok, MOE_GROUPS, MOE_EXPERTS_PER_GROUP)
    in_grp = exp_logits[jnp.arange(n_tok), grp]
    top_val, top_idx = lax.top_k(in_grp, MOE_TOPK)
    weights = (jax.nn.softmax(top_val, axis=-1) * p_grp).reshape(-1)
    expert = (grp[:, None] * MOE_EXPERTS_PER_GROUP + top_idx).reshape(-1)
    n_pair = n_tok * MOE_TOPK
    order = jnp.argsort(expert)
    e_sorted = expert[order]
    counts = jnp.bincount(expert, length=MOE_EXPERTS)
    padded = (counts + MOE_BLOCK - 1) // MOE_BLOCK * MOE_BLOCK
    pad_end = jnp.cumsum(padded)
    pad_start = pad_end - padded
    grp_start = jnp.cumsum(counts) - counts
    dest = pad_start[e_sorted] + jnp.arange(n_pair) - grp_start[e_sorted]
    n_blocks = -(-n_pair // MOE_BLOCK) + MOE_EXPERTS
    buf = jnp.zeros((n_blocks * MOE_BLOCK, d), t.dtype).at[dest].set(t[order // MOE_TOPK])
    block_expert = jnp.minimum(jnp.searchsorted(pad_end, jnp.arange(n_blocks) * MOE_BLOCK, side='right'),
                               MOE_EXPERTS - 1)

    def expert_block(args):
        xb, e = args
        return (jax.nn.silu(xb @ w_gate[e]) * (xb @ w_up[e])) @ w_down[e]

    yb = lax.map(expert_block, (buf.reshape(n_blocks, MOE_BLOCK, d), block_expert)).reshape(-1, d)
    y_pairs = yb[dest].astype(jnp.float32) * weights[order][:, None]
    y = jnp.zeros((n_tok, d), jnp.float32).at[order // MOE_TOPK].add(y_pairs)
    return y.astype(t.dtype)


def setup_inputs(seed: int = 0) -> dict:
    key = jax.random.key(seed)
    ks = iter(jax.random.split(key, 40))
    f32 = jnp.float32
    nrm = lambda shape, scale: jax.random.normal(next(ks), shape, f32) * scale
    L, D = DEPTH, D_MODEL
    x = nrm((BATCH, SEQ, D), 1.0)
    c = nrm((BATCH, D), 1.0)
    ctx = nrm((BATCH, CTX_LEN, D), 1.0)
    c_ctx = nrm((D,), 1.0)
    ada_w = nrm((L, D, 6 * D), 0.5 * D ** -0.5)
    ada_b = nrm((L, 6 * D), 0.02)
    norm1_g = 1.0 + nrm((L, D), 0.02)
    norm2_g = 1.0 + nrm((L, D), 0.02)
    w_in = nrm((L, D, IN_COLS), D ** -0.5)
    att_qn_g = 1.0 + nrm((L, ATT_HEAD_DIM), 0.02)
    att_kn_g = 1.0 + nrm((L, ATT_HEAD_DIM), 0.02)
    ret_base = jnp.log(2.0 ** (5.0 + jnp.arange(RET_HEADS, dtype=f32)) - 1.0)
    ret_decay_logit = ret_base[None, None, :] + nrm((L, 2, RET_HEADS), 0.1)
    ret_gn_g = 1.0 + nrm((L, RET_W), 0.02)
    rwkv_mu = jax.random.uniform(next(ks), (L, 2, RWKV_COLS), f32, 0.05, 0.45)
    rwkv_w0 = jnp.linspace(-6.5, -1.5, RWKV_W, dtype=f32)[None, None, :] + nrm((L, 2, RWKV_W), 0.1)
    rwkv_w2 = nrm((L, 2, RWKV_DECAY_LORA, RWKV_W), 0.1)
    rwkv_a0 = nrm((L, 2, RWKV_W), 0.1)
    rwkv_a2 = nrm((L, 2, RWKV_AAA_LORA, RWKV_W), 0.3 * RWKV_AAA_LORA ** -0.5)
    rwkv_g2 = nrm((L, RWKV_GATE_LORA, RWKV_W), RWKV_GATE_LORA ** -0.5)
    rwkv_k_k = 0.85 + nrm((L, RWKV_W), 0.02)
    rwkv_k_a = 1.0 + nrm((L, RWKV_W), 0.02)
    rwkv_r_k = nrm((L, RWKV_HEADS, RWKV_HEAD_DIM), 0.1)
    rwkv_ln_g = 1.0 + nrm((L, RWKV_W), 0.02)
    rwkv_ln_b = nrm((L, RWKV_W), 0.02)
    w_branch = nrm((L, N_BRANCH, BRANCH_W, D), BRANCH_W ** -0.5)
    w_out = nrm((L, D, D), D ** -0.5)
    router_grp_w = nrm((L, D, MOE_GROUPS), D ** -0.5)
    router_grp_b = nrm((L, MOE_GROUPS), 0.01)
    router_exp_w = nrm((L, D, MOE_EXPERTS), D ** -0.5)
    router_exp_b = nrm((L, MOE_EXPERTS), 0.01)
    moe_w_gate = nrm((L, MOE_EXPERTS, D, MOE_HIDDEN), D ** -0.5)
    moe_w_up = nrm((L, MOE_EXPERTS, D, MOE_HIDDEN), D ** -0.5)
    moe_w_down = nrm((L, MOE_EXPERTS, MOE_HIDDEN, D), MOE_HIDDEN ** -0.5)
    return {'x': x, 'c': c, 'ctx': ctx, 'c_ctx': c_ctx, 'ada_w': ada_w, 'ada_b': ada_b,
            'norm1_g': norm1_g, 'norm2_g': norm2_g, 'w_in': w_in, 'att_qn_g': att_qn_g, 'att_kn_g': att_kn_g,
            'ret_decay_logit': ret_decay_logit, 'ret_gn_g': ret_gn_g, 'rwkv_mu': rwkv_mu, 'rwkv_w0': rwkv_w0,
            'rwkv_w2': rwkv_w2, 'rwkv_a0': rwkv_a0, 'rwkv_a2': rwkv_a2, 'rwkv_g2': rwkv_g2,
            'rwkv_k_k': rwkv_k_k, 'rwkv_k_a': rwkv_k_a, 'rwkv_r_k': rwkv_r_k, 'rwkv_ln_g': rwkv_ln_g,
            'rwkv_ln_b': rwkv_ln_b, 'w_branch': w_branch, 'w_out': w_out, 'router_grp_w': router_grp_w,
            'router_grp_b': router_grp_b, 'router_exp_w': router_exp_w, 'router_exp_b': router_exp_b,
            'moe_w_gate': moe_w_gate, 'moe_w_up': moe_w_up, 'moe_w_down': moe_w_down}


def reference(x, c, ctx, c_ctx, ada_w, ada_b, norm1_g, norm2_g, w_in, att_qn_g, att_kn_g,
              ret_decay_logit, ret_gn_g, rwkv_mu, rwkv_w0, rwkv_w2, rwkv_a0, rwkv_a2, rwkv_g2,
              rwkv_k_k, rwkv_k_a, rwkv_r_k, rwkv_ln_g, rwkv_ln_b, w_branch, w_out,
              router_grp_w, router_grp_b, router_exp_w, router_exp_b, moe_w_gate, moe_w_up, moe_w_down):
    b, n_lat, d = x.shape
    att_cos, att_sin = axial_rope_tables(n_lat, ATT_HEAD_DIM)
    ret_cos, ret_sin = axial_rope_tables(n_lat, RET_HEAD_DIM)
    cond = jax.nn.silu(c)
    cond_ctx = jax.nn.silu(c_ctx)
    for layer in range(DEPTH):
        want_ctx = layer < DEPTH - 1
        sh1, sc1, g1, sh2, sc2, g2 = jnp.split((cond @ ada_w[layer] + ada_b[layer])[:, None, :], 6, axis=-1)
        sh1c, sc1c, g1c, sh2c, sc2c, g2c = jnp.split(cond_ctx @ ada_w[layer] + ada_b[layer], 6, axis=-1)
        h = rms_norm(x, norm1_g[layer]) * (1.0 + sc1) + sh1
        hc = rms_norm(ctx, norm1_g[layer]) * (1.0 + sc1c) + sh1c
        m, mc = hybrid_mixer(h, hc, w_in[layer], att_qn_g[layer], att_kn_g[layer], ret_decay_logit[layer],
                             ret_gn_g[layer], rwkv_mu[layer], rwkv_w0[layer], rwkv_w2[layer], rwkv_a0[layer],
                             rwkv_a2[layer], rwkv_g2[layer], rwkv_k_k[layer], rwkv_k_a[layer], rwkv_r_k[layer],
                             rwkv_ln_g[layer], rwkv_ln_b[layer], w_branch[layer], w_out[layer],
                             att_cos, att_sin, ret_cos, ret_sin, want_ctx)
        x = x + g1 * m
        h2 = rms_norm(x, norm2_g[layer]) * (1.0 + sc2) + sh2
        tokens = h2.reshape(-1, d)
        if want_ctx:
            ctx = ctx + g1c * mc
            h2c = rms_norm(ctx, norm2_g[layer]) * (1.0 + sc2c) + sh2c
            tokens = jnp.concatenate([tokens, h2c.reshape(-1, d)], axis=0)
        y = hier_moe(tokens, router_grp_w[layer], router_grp_b[layer], router_exp_w[layer], router_exp_b[layer],
                     moe_w_gate[layer], moe_w_up[layer], moe_w_down[layer])
        x = x + g2 * y[: b * n_lat].reshape(x.shape)
        if want_ctx:
            ctx = ctx + g2c * y[b * n_lat:].reshape(ctx.shape)
    return x
```

```cpp
#include <hip/hip_runtime.h>
#include <cstdio>
#include <cstdint>

#ifndef MK_FUSED
#define MK_FUSED 1
#endif

constexpr int D = 1024, NB = 8, NLAT = 4096, NCTX = 256, NP = NLAT + NCTX, T = NB * NP, DEPTH = 4;
constexpr int TP = T / 256;
constexpr int NPAIR_MAX = 2 * T;
constexpr int MOE_NBLK = NPAIR_MAX / 256 + 32;
constexpr int NTHREADS = 512, NWAVES = 8;

typedef unsigned short bf16_t;
typedef short bf16x8 __attribute__((ext_vector_type(8)));
typedef short bf16x4 __attribute__((ext_vector_type(4)));
typedef float f32x4 __attribute__((ext_vector_type(4)));
typedef float f32x2 __attribute__((ext_vector_type(2)));
typedef unsigned u32x4 __attribute__((ext_vector_type(4)));
typedef unsigned u32x2 __attribute__((ext_vector_type(2)));
#define LAS __attribute__((address_space(3)))

constexpr size_t AL(size_t x) { return (x + 255) & ~(size_t)255; }
constexpr size_t WS_CTL = 0, CTL_BYTES = 65536;
constexpr int CW_BAR = 0;
constexpr int CW_CNT = 4096;
constexpr size_t WS_MOD = AL(WS_CTL + CTL_BYTES);
constexpr size_t WS_ROPE = AL(WS_MOD + (size_t)DEPTH * 9 * 6144 * 4);
constexpr size_t WS_RWT = AL(WS_ROPE + (size_t)(2 * 64 * 16 + 2 * 64 * 32) * 4);
constexpr size_t WS_RW2 = AL(WS_RWT + (size_t)DEPTH * 36 * 1024 * 4);
constexpr size_t WS_RC = AL(WS_RW2 + (size_t)DEPTH * 64 * 3 * 4 * 16 * 4 * 4);
constexpr size_t WS_CTXRES = AL(WS_RC + (size_t)DEPTH * 9 * 48 * 4);
constexpr size_t WS_BTIN = AL(WS_CTXRES + (size_t)NB * NCTX * D * 4);
constexpr size_t WS_BTBR = AL(WS_BTIN + (size_t)7680 * 1024 * 2);
constexpr size_t WS_BTOUT = AL(WS_BTBR + (size_t)3 * 1024 * 512 * 2);
constexpr size_t WS_BTLORA = AL(WS_BTOUT + (size_t)1024 * 1024 * 2);
constexpr size_t WS_H = AL(WS_BTLORA + (size_t)2560 * 256 * 2);
constexpr size_t WS_M0 = AL(WS_H + (size_t)T * 1024 * 2);
constexpr size_t SZ512 = (size_t)T * 512 * 2;
constexpr size_t WS_AQ = WS_M0;
constexpr size_t WS_AKV = AL(WS_AQ + SZ512);
constexpr size_t WS_RQ = AL(WS_AKV + (size_t)T * 256 * 2);
constexpr size_t WS_RK = AL(WS_RQ + SZ512);
constexpr size_t WS_RV = AL(WS_RK + SZ512);
constexpr size_t WS_RG = AL(WS_RV + SZ512);
constexpr size_t WS_GL = AL(WS_RG + SZ512);
constexpr size_t WS_WU = AL(WS_GL + (size_t)T * 3072 * 2);
constexpr size_t WS_LW = AL(WS_WU + (size_t)T * 1792 * 2);
constexpr size_t WS_LA = AL(WS_LW + (size_t)T * 1024 * 2);
constexpr size_t WS_LG = AL(WS_LA + (size_t)T * 1024 * 2);
constexpr size_t WS_W1 = AL(WS_LG + SZ512);
constexpr size_t WS_END_MIX = AL(WS_W1 + 9 * SZ512);
constexpr size_t WS_YS = WS_LW;
constexpr size_t WS_SF = WS_WU + 3 * SZ512;
constexpr size_t WS_SB = AL(WS_SF + (size_t)NB * 4 * 34 * 16384 * 2);
static_assert(WS_SB + (size_t)NB * 4 * 34 * 16384 * 2 <= WS_LG, "retention states fit behind YCAT inside WU|LW|LA");
constexpr size_t WS_BT1 = WS_M0;
constexpr size_t WS_BT2 = AL(WS_BT1 + (size_t)32 * 1024 * 1024 * 2);
constexpr size_t WS_BUF = AL(WS_BT2 + (size_t)32 * 1024 * 512 * 2);
constexpr size_t WS_HB = AL(WS_BUF + (size_t)MOE_NBLK * 256 * 1024 * 2);
constexpr size_t WS_YB = AL(WS_HB + (size_t)MOE_NBLK * 256 * 512 * 2);
constexpr size_t WS_PAIR = AL(WS_YB + (size_t)MOE_NBLK * 256 * 1024 * 2);
constexpr size_t WS_RSROW = AL(WS_PAIR + (size_t)4 * NPAIR_MAX * 4);
constexpr size_t WS_END_MOE = AL(WS_RSROW + (size_t)T * 4);
static_assert(WS_END_MOE <= WS_END_MIX, "moe overlay inside the mixer region");
constexpr size_t WS_NEED = WS_END_MIX;
static_assert(WS_NEED <= 1220000000ull, "workspace budget (sum of inputs = 1220.39 MB)");

constexpr int RING_BYTES = 131072;
constexpr int LDS_BYTES = 147456;
constexpr int MISC_OFF = LDS_BYTES - 4096;

struct Params {
    const float* in[33];
    float* out;
    unsigned char* ws;
    float invA[16];
    float invR[32];
    int ph_lo, ph_hi, l_lo, l_hi;
    int fused, do_pro;
    int dry, pad2;
};
enum { I_X = 0, I_C, I_CTX, I_CCTX, I_ADAW, I_ADAB, I_N1G, I_N2G, I_WIN, I_QNG, I_KNG, I_RDL, I_RGN, I_MU, I_W0, I_W2, I_A0, I_A2, I_G2, I_KK, I_KA, I_RK, I_LNG, I_LNB,
       I_WBR, I_WOUT, I_RGW, I_RGB, I_REW, I_REB, I_MG, I_MUP, I_MD };

__device__ __forceinline__ float bf2f(unsigned v) { return __builtin_bit_cast(float, v << 16); }
__device__ __forceinline__ unsigned f2bf(float f) { return (unsigned)__builtin_bit_cast(unsigned short, (__bf16)f); }
typedef __bf16 hwbf16x2 __attribute__((ext_vector_type(2)));
__device__ __forceinline__ unsigned pk2(float lo, float hi) { const f32x2 v = {lo, hi}; return __builtin_bit_cast(unsigned, __builtin_convertvector(v, hwbf16x2)); }
__device__ __forceinline__ float lo16(unsigned w) { return __builtin_bit_cast(float, w << 16); }
__device__ __forceinline__ float hi16(unsigned w) { return __builtin_bit_cast(float, w & 0xffff0000u); }
__device__ __forceinline__ void unpack8(const u32x4 v, float (&x)[8]) { x[0] = lo16(v.x); x[1] = hi16(v.x); x[2] = lo16(v.y); x[3] = hi16(v.y); x[4] = lo16(v.z); x[5] = hi16(v.z); x[6] = lo16(v.w); x[7] = hi16(v.w); }
__device__ __forceinline__ u32x4 pack8(const float (&x)[8]) { u32x4 v; v.x = pk2(x[0], x[1]); v.y = pk2(x[2], x[3]); v.z = pk2(x[4], x[5]); v.w = pk2(x[6], x[7]); return v; }
__device__ __forceinline__ float frcp(float x) { return __builtin_amdgcn_rcpf(x); }
__device__ __forceinline__ float sigmoidf_(float x) { return frcp(1.f + __expf(-x)); }
__device__ __forceinline__ float siluf_(float x) { return x * frcp(1.f + __expf(-x)); }
__device__ __forceinline__ float shfl_xor_f(float v, int m) { return __shfl_xor(v, m, 64); }
__device__ __forceinline__ float* xrow(const Params& p, int row) {
    const int b = row / NP, q = row - b * NP;
    return q < NCTX ? (float*)(p.ws + WS_CTXRES) + (size_t)(b * NCTX + q) * D : p.out + (size_t)(b * NLAT + (q - NCTX)) * D;
}
__device__ __forceinline__ bf16x8 ld_frag(const LAS unsigned char* p) { return *(const LAS bf16x8*)p; }
__device__ __forceinline__ bf16x4 tr_read(const LAS unsigned char* p) { return __builtin_amdgcn_ds_read_tr16_b64_v4i16((LAS bf16x4*)p); }
__device__ __forceinline__ bf16x8 cat44(bf16x4 a, bf16x4 b) { bf16x8 r; r[0] = a[0]; r[1] = a[1]; r[2] = a[2]; r[3] = a[3]; r[4] = b[0]; r[5] = b[1]; r[6] = b[2]; r[7] = b[3]; return r; }
__device__ __forceinline__ bf16x8 pack_frag(const f32x4 a, const f32x4 b) {
    u32x4 w; w.x = pk2(a[0], a[1]); w.y = pk2(a[2], a[3]); w.z = pk2(b[0], b[1]); w.w = pk2(b[2], b[3]); return __builtin_bit_cast(bf16x8, w);
}
#define MFMA16(a, b, c) __builtin_amdgcn_mfma_f32_16x16x32_bf16((a), (b), (c), 0, 0, 0)

#define XB_TMO      128
#define XB_XCNT(j)  (256  + 64 * (j))
#define XB_XSUB(j)  (1280 + 64 * (j))
#define XB_XGEN(j)  (2304 + 64 * (j))
#define XB_TOP      3328
#define XB_TOPGEN   3392
#define XCD_BAR_WORDS 3456
#define XB_SPIN_CAP (1u << 18)
__device__ __forceinline__ unsigned xb_ld(unsigned* p)              { return __hip_atomic_load(p, __ATOMIC_RELAXED, __HIP_MEMORY_SCOPE_AGENT); }
__device__ __forceinline__ unsigned xb_add(unsigned* p, unsigned v) { return __hip_atomic_fetch_add(p, v, __ATOMIC_RELAXED, __HIP_MEMORY_SCOPE_AGENT); }
__device__ __forceinline__ unsigned xb_xcc_id() { return (unsigned)__builtin_amdgcn_s_getreg((3 << 11) | 20) & 0xFu; }
#define XB_SPIN(cond, bar) do { unsigned _sp = 0; while (cond) { __builtin_amdgcn_s_sleep(1); \
    if ((++_sp & 255u) == 0u) { if (xb_ld(&(bar)[XB_TMO])) break; if (_sp > XB_SPIN_CAP) { atomicAdd(&(bar)[XB_TMO], 1u); break; } } } } while (0)
struct XcdBarrier { unsigned* bar; unsigned x; volatile LAS unsigned* st; };
__device__ __forceinline__ XcdBarrier xcd_barrier_post(unsigned* bar, volatile LAS unsigned* st) {
    XcdBarrier b; b.bar = bar; b.x = xb_xcc_id(); b.st = st;
    if (threadIdx.x == 0) (void)xb_add(&bar[XB_XCNT(b.x)], 1u);
    return b;
}
__device__ __forceinline__ void xcd_barrier_complete(unsigned* bar, unsigned x, unsigned& nloc, unsigned& nx) {
    const unsigned G = gridDim.x * gridDim.y * gridDim.z;
    unsigned sum, cnt, mine, sp = 0u;
    for (;;) {
        sum = 0u; cnt = 0u; mine = 0u;
#pragma unroll
        for (unsigned j = 0; j < 16; ++j) { const unsigned c = xb_ld(&bar[XB_XCNT(j)]); sum += c; cnt += (c > 0u) ? 1u : 0u; mine = (j == x) ? c : mine; }
        if (sum == G) break;
        __builtin_amdgcn_s_sleep(1);
        if ((++sp & 255u) == 0u) { if (xb_ld(&bar[XB_TMO])) break; if (sp > XB_SPIN_CAP) { atomicAdd(&bar[XB_TMO], 1u); break; } }
    }
    nloc = mine > 0u ? mine : 1u; nx = cnt > 0u ? cnt : 1u;
}
__device__ __forceinline__ void xcd_barrier(const XcdBarrier& b) {
    asm volatile("s_waitcnt vmcnt(0)" ::: "memory");
    __syncthreads();
    if (threadIdx.x == 0) {
        unsigned* bar = b.bar;
        __builtin_amdgcn_s_waitcnt(0);
        unsigned nloc = b.st[0], nx = b.st[1];
        if (nloc == 0u) { xcd_barrier_complete(bar, b.x, nloc, nx); b.st[0] = nloc; b.st[1] = nx; }
        const unsigned old = xb_add(&bar[XB_XSUB(b.x)], 1u);
        const unsigned gen = old / nloc;
        if (old + 1u == (gen + 1u) * nloc) {
            __builtin_amdgcn_fence(__ATOMIC_RELEASE, "agent");
            asm volatile("s_waitcnt vmcnt(0)" ::: "memory");
            const unsigned og = xb_add(&bar[XB_TOP], 1u);
            const unsigned tg = og / nx;
            if (og + 1u == (tg + 1u) * nx) xb_add(&bar[XB_TOPGEN], 1u);
            else XB_SPIN(xb_ld(&bar[XB_TOPGEN]) == tg, bar);
            __builtin_amdgcn_fence(__ATOMIC_ACQUIRE, "agent");
            xb_add(&bar[XB_XGEN(b.x)], 1u);
            asm volatile("s_waitcnt vmcnt(0)" ::: "memory");
        } else {
            XB_SPIN(xb_ld(&bar[XB_XGEN(b.x)]) == gen, bar);
            __builtin_amdgcn_fence(__ATOMIC_ACQUIRE, "agent");
            asm volatile("s_waitcnt vmcnt(0)" ::: "memory");
        }
    }
    __syncthreads();
}
namespace pg8 {
#define PG8_LAS __attribute__((address_space(3)))
typedef unsigned short bf16_t;
typedef short bf16x8 __attribute__((ext_vector_type(8)));
typedef float f32x4 __attribute__((ext_vector_type(4)));
typedef unsigned u32x4 __attribute__((ext_vector_type(4)));
constexpr int BM = 256, BK = 64, HALF = 128, HTB = HALF * BK * 2  , STAGE_BYTES = 8 * HTB, NXCD = 8, WGM = 8;

__host__ __device__ __forceinline__ int lds_byte(int r, int c) { const int st = (r >> 4) * 2 + (c >> 5), rr = r & 15, cc = c & 31, ob = rr * 64 + cc * 2; return st * 1024 + (ob ^ (((ob >> 9) & 1) << 5)); }
__host__ __device__ __forceinline__ void stage_rc(int b, int& R, int& C) { const int st = b / 1024, sb = b % 1024, swz = sb ^ (((sb >> 9) & 1) << 5); R = (st >> 1) * 16 + swz / 64; C = (st & 1) * 32 + (swz % 64) / 2; }
__host__ __device__ __forceinline__ int perm32(int rho) { const int n = rho >> 4, i = rho & 15; return 8 * (i >> 2) + 4 * n + (i & 3); }

struct Unit { int pm, pn; size_t bofs; };
struct Gemm { const bf16_t* A; const bf16_t* Bt; int M, N, K; };

struct StaticOrder {
    int nM, nN, nwg, G, c;
    __host__ __device__ void init(int M, int N, int G_, int c_) { nM = M / BM; nN = N / BM; nwg = nM * nN; G = G_; c = c_; }
    __host__ __device__ bool next(int i, Unit& u) const {
        const long L = (long)i * G + c; if (L >= nwg) return false;
        int wgid = (int)L; { const int q = nwg / NXCD, r = nwg % NXCD, xcd = wgid % NXCD, off = wgid / NXCD; wgid = (xcd < r ? xcd * (q + 1) : r * (q + 1) + (xcd - r) * q) + off; }
        const int nig = WGM * nN, gid = wgid / nig, fm = gid * WGM, gsz = (nM - fm) < WGM ? (nM - fm) : WGM;
        u.pm = fm + ((wgid % nig) % gsz); u.pn = (wgid % nig) / gsz; u.bofs = 0; return true;
    }
    __device__ __forceinline__ void a_ready(const Unit&) const {}
    __device__ __forceinline__ void done(const Unit&) const {}
};

__device__ __forceinline__ unsigned cvt_pk_bf16(float lo, float hi) { unsigned r; asm volatile("v_cvt_pk_bf16_f32 %0, %1, %2" : "=v"(r) : "v"(lo), "v"(hi)); return r; }
template <class Epi, class Sched, bool ALIGN_EPI = false, bool SP2 = false>
__device__ __forceinline__ void gemm_phase(PG8_LAS unsigned char* lds, const Gemm g, const Sched& S, const Epi& E) {
    int tid_ = threadIdx.x; asm volatile("" : "+v"(tid_)); const int tid = tid_, wid = __builtin_amdgcn_readfirstlane(tid >> 6), lane = tid & 63, wr = wid >> 2, wc = wid & 3, fr = lane & 15, fq = lane >> 4;
    int K = g.K; asm volatile("" : "+s"(K)); const int nt = K / BK;
    unsigned voffA[2], voffB[2];
#pragma unroll
    for (int i = 0; i < 2; ++i) { int R, C; stage_rc(tid * 16 + i * 8192, R, C); const int Rb = Epi::PERM ? ((R & ~31) + perm32(R & 31)) : R;
        voffA[i] = (unsigned)(R * K + C) * 2u; voffB[i] = (unsigned)(Rb * K + C) * 2u; }
    const size_t kstep = (size_t)(BK * 2);
    const size_t hstep = (size_t)HALF * K * 2;
    const size_t tstep = 2 * hstep;
    const unsigned ldsw = (unsigned)wid * 1024u;
    const int aoff = lds_byte(wr * 64 + fr, fq * 8), boff = lds_byte(wc * 32 + fr, fq * 8);
#define PG8_SA(b, h) (((b) * 2 + (h)) * HTB)
#define PG8_SB(b, h) ((4 + (b) * 2 + (h)) * HTB)
#define PG8_STAGE(bufoff, gbase, voff) do { _Pragma("unroll") for (int _i = 0; _i < 2; ++_i) \
        __builtin_amdgcn_global_load_lds((const unsigned*)((const char*)(gbase) + (voff)[_i]), (PG8_LAS unsigned*)(lds + (bufoff) + ldsw + _i * 8192), 16, 0, 0); } while (0)
#define PG8_LDA(dst, b, h) do { _Pragma("unroll") for (int m = 0; m < 4; ++m) _Pragma("unroll") for (int k = 0; k < 2; ++k) dst[m][k] = *(const PG8_LAS bf16x8*)(lds + PG8_SA(b, h) + aoff + m * 2048 + k * 1024); } while (0)
#define PG8_LDB(dst, b, h) do { _Pragma("unroll") for (int n = 0; n < 2; ++n) _Pragma("unroll") for (int k = 0; k < 2; ++k) dst[n][k] = *(const PG8_LAS bf16x8*)(lds + PG8_SB(b, h) + boff + n * 2048 + k * 1024); } while (0)
#define PG8_MMA(ai, bj, At, Bt) do { __builtin_amdgcn_s_setprio(1); _Pragma("unroll") for (int m = 0; m < 4; ++m) _Pragma("unroll") for (int n = 0; n < 2; ++n) _Pragma("unroll") for (int k = 0; k < 2; ++k) \
        acc[ai][bj][m][n] = __builtin_amdgcn_mfma_f32_16x16x32_bf16(Bt[n][k], At[m][k], acc[ai][bj][m][n], 0, 0, 0); __builtin_amdgcn_s_setprio(0); } while (0)
#define PG8_WAIT_V(n) asm volatile("s_waitcnt vmcnt(" #n ")" ::: "memory")
#define PG8_WAIT_L(n) asm volatile("s_waitcnt lgkmcnt(" #n ")" ::: "memory")
#define PG8_BAR __builtin_amdgcn_s_barrier()
#define PG8_SCHED __builtin_amdgcn_sched_barrier(0)
    Unit cur, nxt; int ui = 0;
    if (!S.next(0, cur)) return;
    f32x4 acc[2][2][4][2];
#pragma unroll
    for (int a = 0; a < 2; ++a)
#pragma unroll
        for (int b = 0; b < 2; ++b)
#pragma unroll
            for (int m = 0; m < 4; ++m)
#pragma unroll
                for (int n = 0; n < 2; ++n) acc[a][b][m][n] = (f32x4){0.f, 0.f, 0.f, 0.f};
    bf16x8 At[4][2], B0[2][2], B1[2][2];
    const char* cA = (const char*)g.A + (size_t)cur.pm * tstep; const char* cB = (const char*)g.Bt + cur.bofs + (size_t)cur.pn * tstep;
    S.a_ready(cur);
    if constexpr (SP2) {
        PG8_STAGE(PG8_SB(0, 0), cB, voffB); PG8_STAGE(PG8_SB(0, 1), cB + hstep, voffB); PG8_STAGE(PG8_SA(0, 0), cA, voffA); PG8_STAGE(PG8_SA(0, 1), cA + hstep, voffA);
        if (wr == 1) PG8_BAR;
        PG8_WAIT_V(2); PG8_BAR;
        PG8_STAGE(PG8_SB(1, 0), cB + kstep, voffB); PG8_STAGE(PG8_SA(1, 0), cA + kstep, voffA); PG8_STAGE(PG8_SB(1, 1), cB + hstep + kstep, voffB);
        PG8_WAIT_V(6); PG8_BAR;
    } else {
        PG8_STAGE(PG8_SB(0, 0), cB, voffB); PG8_STAGE(PG8_SA(0, 0), cA, voffA); PG8_STAGE(PG8_SB(0, 1), cB + hstep, voffB); PG8_STAGE(PG8_SA(0, 1), cA + hstep, voffA);
        if (wr == 1) PG8_BAR;
        PG8_WAIT_V(4); PG8_BAR;
        PG8_STAGE(PG8_SB(1, 0), cB + kstep, voffB); PG8_STAGE(PG8_SA(1, 0), cA + kstep, voffA); PG8_STAGE(PG8_SB(1, 1), cB + hstep + kstep, voffB);
        PG8_WAIT_V(6); PG8_BAR;
    }
    for (;;) {
        const bool has_next = S.next(ui + 1, nxt);
        const char* nA = has_next ? (const char*)g.A + (size_t)nxt.pm * tstep : cA; const char* nB = has_next ? (const char*)g.Bt + nxt.bofs + (size_t)nxt.pn * tstep : cB;
        for (int t = 0; t < nt; t += 2) {
            const bool last = (t == nt - 2);
            if constexpr (Epi::KHOOK) { if (t == 8 || t == 16) E.khook(acc, cur, wr, wc, fr, fq, t >> 3); }
            const char* a1 = cA + (size_t)(t + 1) * kstep;
            const char* a2 = last ? nA : cA + (size_t)(t + 2) * kstep; const char* b2 = last ? nB : cB + (size_t)(t + 2) * kstep;
            const char* a3 = a2 + kstep; const char* b3 = b2 + kstep;
            if (last && has_next) S.a_ready(nxt);
            if constexpr (SP2) {
            PG8_LDB(B0, 0, 0); PG8_LDB(B1, 0, 1); PG8_SCHED; PG8_LDA(At, 0, 0); PG8_STAGE(PG8_SA(1, 1), a1 + hstep, voffA);
            PG8_WAIT_V(8); PG8_WAIT_L(0); PG8_BAR; PG8_MMA(0, 0, At, B0); PG8_MMA(0, 1, At, B1); PG8_BAR; PG8_SCHED;
            PG8_LDA(At, 0, 1); PG8_STAGE(PG8_SB(0, 0), b2, voffB); PG8_STAGE(PG8_SB(0, 1), b2 + hstep, voffB); PG8_STAGE(PG8_SA(0, 0), a2, voffA);
            PG8_WAIT_V(8); PG8_WAIT_L(0); PG8_BAR; PG8_MMA(1, 0, At, B0); PG8_MMA(1, 1, At, B1); PG8_BAR; PG8_SCHED;
            PG8_LDB(B0, 1, 0); PG8_LDB(B1, 1, 1); PG8_SCHED; PG8_LDA(At, 1, 0); PG8_STAGE(PG8_SA(0, 1), a2 + hstep, voffA);
            PG8_WAIT_V(8); PG8_WAIT_L(0); PG8_BAR; PG8_MMA(0, 0, At, B0); PG8_MMA(0, 1, At, B1); PG8_BAR; PG8_SCHED;
            PG8_LDA(At, 1, 1); PG8_STAGE(PG8_SB(1, 0), b3, voffB); PG8_STAGE(PG8_SB(1, 1), b3 + hstep, voffB); PG8_STAGE(PG8_SA(1, 0), a3, voffA);
            PG8_WAIT_V(8); PG8_WAIT_L(0); PG8_BAR; PG8_MMA(1, 0, At, B0); PG8_MMA(1, 1, At, B1); PG8_BAR; PG8_SCHED;
            } else {
            PG8_LDB(B0, 0, 0); PG8_SCHED; PG8_LDA(At, 0, 0); PG8_STAGE(PG8_SA(1, 1), a1 + hstep, voffA);
            PG8_WAIT_L(8); PG8_BAR; PG8_WAIT_L(0); PG8_MMA(0, 0, At, B0); PG8_BAR; PG8_SCHED;
            PG8_LDB(B1, 0, 1); PG8_STAGE(PG8_SB(0, 0), b2, voffB);
            PG8_BAR; PG8_WAIT_L(0); PG8_MMA(0, 1, At, B1); PG8_BAR;
            PG8_LDA(At, 0, 1); PG8_STAGE(PG8_SA(0, 0), a2, voffA);
            PG8_BAR; PG8_WAIT_L(0); PG8_MMA(1, 0, At, B0); PG8_BAR; PG8_SCHED;
            PG8_STAGE(PG8_SB(0, 1), b2 + hstep, voffB);
            PG8_WAIT_V(6); PG8_BAR; PG8_MMA(1, 1, At, B1); PG8_BAR;
            PG8_LDB(B0, 1, 0); PG8_SCHED; PG8_LDA(At, 1, 0); PG8_STAGE(PG8_SA(0, 1), a2 + hstep, voffA);
            PG8_WAIT_L(8); PG8_BAR; PG8_WAIT_L(0); PG8_MMA(0, 0, At, B0); PG8_BAR; PG8_SCHED;
            PG8_LDB(B1, 1, 1); PG8_STAGE(PG8_SB(1, 0), b3, voffB);
            PG8_BAR; PG8_WAIT_L(0); PG8_MMA(0, 1, At, B1); PG8_BAR;
            PG8_LDA(At, 1, 1); PG8_STAGE(PG8_SA(1, 0), a3, voffA);
            PG8_BAR; PG8_WAIT_L(0); PG8_MMA(1, 0, At, B0); PG8_BAR; PG8_SCHED;
            PG8_STAGE(PG8_SB(1, 1), b3 + hstep, voffB);
            PG8_WAIT_V(6); PG8_BAR; PG8_MMA(1, 1, At, B1); PG8_BAR;
            }
        }
        if constexpr (ALIGN_EPI) { if (wr == 0) PG8_BAR; }
        if constexpr (!Epi::AFTER_DRAIN) { E(acc, cur, wr, wc, fr, fq); S.done(cur); }
        if (!has_next) break;
#pragma unroll
        for (int a = 0; a < 2; ++a)
#pragma unroll
            for (int b = 0; b < 2; ++b)
#pragma unroll
                for (int m = 0; m < 4; ++m)
#pragma unroll
                    for (int n = 0; n < 2; ++n) acc[a][b][m][n] = (f32x4){0.f, 0.f, 0.f, 0.f};
        cur = nxt; cA = nA; cB = nB; ++ui;
        if constexpr (ALIGN_EPI) { if (wr == 1) PG8_BAR; }
    }
    PG8_WAIT_V(0);
    if constexpr (!ALIGN_EPI) { if (wr == 0) PG8_BAR; }
    PG8_BAR;
    if constexpr (Epi::AFTER_DRAIN) { E.fused(acc, cur, wr, wc, fr, fq, lds, wid, lane); S.done(cur); }
#undef PG8_SA
#undef PG8_SB
#undef PG8_STAGE
#undef PG8_LDA
#undef PG8_LDB
#undef PG8_MMA
#undef PG8_WAIT_V
#undef PG8_WAIT_L
#undef PG8_BAR
#undef PG8_SCHED
}
template <bool EXPNEG = false> __device__ __forceinline__ void store_bf16_tile(bf16_t* O, int pitch, int colt, const f32x4 (&acc)[2][2][4][2], const Unit& u, int wr, int wc, int fr, int fq) {
    const int row0 = u.pm * BM + wr * 64 + fr; const int col0 = colt + wc * 32 + 8 * fq;
#pragma unroll
    for (int ai = 0; ai < 2; ++ai)
#pragma unroll
        for (int m = 0; m < 4; ++m) { bf16_t* rowp = O + (size_t)(row0 + ai * HALF + m * 16) * pitch + col0;
#pragma unroll
            for (int bj = 0; bj < 2; ++bj) { f32x4 v0 = acc[ai][bj][m][0], v1 = acc[ai][bj][m][1];
                if (EXPNEG) {
#pragma unroll
                    for (int e = 0; e < 4; ++e) { v0[e] = __expf(-v0[e]); v1[e] = __expf(-v1[e]); } }
                u32x4 w; w.x = cvt_pk_bf16(v0[0], v0[1]); w.y = cvt_pk_bf16(v0[2], v0[3]); w.z = cvt_pk_bf16(v1[0], v1[1]); w.w = cvt_pk_bf16(v1[2], v1[3]);
                *(u32x4*)(rowp + bj * HALF) = w; } }
}
struct EpiInproj {
    static constexpr bool PERM = true, AFTER_DRAIN = false, KHOOK = false;
    unsigned char* ws;
    __device__ __forceinline__ void operator()(const f32x4 (&acc)[2][2][4][2], const Unit& u, int wr, int wc, int fr, int fq) const {
        const int pn = u.pn; size_t base; int pitch, colt;
        if (pn < 2)       { base = WS_AQ;  pitch = 512;  colt = pn * 256; }
        else if (pn == 2) { base = WS_AKV; pitch = 256;  colt = 0; }
        else if (pn < 5)  { base = WS_RQ;  pitch = 512;  colt = (pn - 3) * 256; }
        else if (pn < 7)  { base = WS_RK;  pitch = 512;  colt = (pn - 5) * 256; }
        else if (pn < 9)  { base = WS_RV;  pitch = 512;  colt = (pn - 7) * 256; }
        else if (pn < 11) { base = WS_RG;  pitch = 512;  colt = (pn - 9) * 256; }
        else if (pn < 18) { base = WS_WU;  pitch = 1792; colt = (pn - 11) * 256; }
        else              { store_bf16_tile<true>((bf16_t*)(ws + WS_GL), 3072, (pn - 18) * 256, acc, u, wr, wc, fr, fq); return; }
        store_bf16_tile((bf16_t*)(ws + base), pitch, colt, acc, u, wr, wc, fr, fq);
    }
};
struct EpiLora {
    static constexpr bool PERM = true, AFTER_DRAIN = false, KHOOK = false;
    unsigned char* ws;
    __device__ __forceinline__ void operator()(const f32x4 (&acc)[2][2][4][2], const Unit& u, int wr, int wc, int fr, int fq) const {
        const int pn = u.pn; size_t base; int pitch, colt;
        if (pn < 4)      { base = WS_LW; pitch = 1024; colt = pn * 256; }
        else if (pn < 8) { base = WS_LA; pitch = 1024; colt = (pn - 4) * 256; }
        else             { base = WS_LG; pitch = 512;  colt = (pn - 8) * 256; }
        store_bf16_tile((bf16_t*)(ws + base), pitch, colt, acc, u, wr, wc, fr, fq);
    }
};
struct EpiPlainBf16 {
    static constexpr bool PERM = true, AFTER_DRAIN = false, KHOOK = false;
    bf16_t* O; int pitch;
    __device__ __forceinline__ void operator()(const f32x4 (&acc)[2][2][4][2], const Unit& u, int wr, int wc, int fr, int fq) const {
        store_bf16_tile(O, pitch, u.pn * BM, acc, u, wr, wc, fr, fq);
    }
};
template <int MODE> struct EpiMerge {
    static constexpr bool PERM = false, AFTER_DRAIN = false, KHOOK = false;
    const bf16_t* GL; float* MRG; bf16_t* OB; int nb;
    __device__ __forceinline__ void operator()(const f32x4 (&acc)[2][2][4][2], const Unit& u, int wr, int wc, int fr, int fq) const {
        const int row0 = u.pm * BM + wr * 64 + fr, col0 = u.pn * BM + wc * 32 + 4 * fq;
#pragma unroll
        for (int ai = 0; ai < 2; ++ai)
#pragma unroll
            for (int m = 0; m < 4; ++m) { const size_t row = (size_t)(row0 + ai * HALF + m * 16); asm volatile("" ::: "memory");
#pragma unroll
                for (int bj = 0; bj < 2; ++bj)
#pragma unroll
                    for (int n = 0; n < 2; ++n) { const int col = col0 + bj * HALF + n * 16;
                        const u32x2 gw = *(const u32x2*)(GL + row * 3072 + nb * 1024 + col);
                        f32x4 g; g[0] = __builtin_amdgcn_rcpf(1.f + __expf(-lo16(gw.x))); g[1] = __builtin_amdgcn_rcpf(1.f + __expf(-hi16(gw.x))); g[2] = __builtin_amdgcn_rcpf(1.f + __expf(-lo16(gw.y))); g[3] = __builtin_amdgcn_rcpf(1.f + __expf(-hi16(gw.y)));
                        f32x4 v = acc[ai][bj][m][n] * g;
                        float* mp = MRG + row * 1024 + col;
                        if (MODE != 0) v = v + *(const f32x4*)mp;
                        if (MODE != 2) *(f32x4*)mp = v;
                        else { u32x2 w; w.x = cvt_pk_bf16(v[0], v[1]); w.y = cvt_pk_bf16(v[2], v[3]); *(u32x2*)(OB + row * 1024 + col) = w; } } }
    }
};
struct EpiMergeK {
    static constexpr bool PERM = false, AFTER_DRAIN = false, KHOOK = true;
    const bf16_t* GL; bf16_t* OB;
    __device__ __forceinline__ void khook(f32x4 (&acc)[2][2][4][2], const Unit& u, int wr, int wc, int fr, int fq, int seg  ) const {
        const int row0 = u.pm * BM + wr * 64 + fr, col0 = u.pn * BM + wc * 32 + 4 * fq;
#pragma unroll
        for (int ai = 0; ai < 2; ++ai) {
            u32x2 ga[4][2][2], gb[4][2][2];
            asm volatile("" ::: "memory");
#pragma unroll
            for (int m = 0; m < 4; ++m) { const bf16_t* gr = GL + (size_t)(row0 + ai * HALF + m * 16) * 3072 + (seg - 1) * 1024 + col0;
#pragma unroll
                for (int bj = 0; bj < 2; ++bj)
#pragma unroll
                    for (int n = 0; n < 2; ++n) { ga[m][bj][n] = *(const u32x2*)(gr + bj * HALF + n * 16); gb[m][bj][n] = *(const u32x2*)(gr + 1024 + bj * HALF + n * 16); } }
#pragma unroll
            for (int m = 0; m < 4; ++m)
#pragma unroll
                for (int bj = 0; bj < 2; ++bj)
#pragma unroll
                    for (int n = 0; n < 2; ++n) { const u32x2 a = ga[m][bj][n], b = gb[m][bj][n];
                        f32x4 r;
                        r[0] = (1.f + lo16(b.x)) * __builtin_amdgcn_rcpf(1.f + lo16(a.x)); r[1] = (1.f + hi16(b.x)) * __builtin_amdgcn_rcpf(1.f + hi16(a.x));
                        r[2] = (1.f + lo16(b.y)) * __builtin_amdgcn_rcpf(1.f + lo16(a.y)); r[3] = (1.f + hi16(b.y)) * __builtin_amdgcn_rcpf(1.f + hi16(a.y));
                        acc[ai][bj][m][n] = acc[ai][bj][m][n] * r; } }
    }
    __device__ __forceinline__ void operator()(const f32x4 (&acc)[2][2][4][2], const Unit& u, int wr, int wc, int fr, int fq) const {
        const int row0 = u.pm * BM + wr * 64 + fr, col0 = u.pn * BM + wc * 32 + 4 * fq;
#pragma unroll
        for (int ai = 0; ai < 2; ++ai) { asm volatile("" ::: "memory");
#pragma unroll
            for (int m = 0; m < 4; ++m) { const size_t row = (size_t)(row0 + ai * HALF + m * 16);
#pragma unroll
                for (int bj = 0; bj < 2; ++bj)
#pragma unroll
                    for (int n = 0; n < 2; ++n) { const int col = col0 + bj * HALF + n * 16;
                        const u32x2 gw = *(const u32x2*)(GL + row * 3072 + 2048 + col);
                        f32x4 g; g[0] = __builtin_amdgcn_rcpf(1.f + lo16(gw.x)); g[1] = __builtin_amdgcn_rcpf(1.f + hi16(gw.x)); g[2] = __builtin_amdgcn_rcpf(1.f + lo16(gw.y)); g[3] = __builtin_amdgcn_rcpf(1.f + hi16(gw.y));
                        const f32x4 v = acc[ai][bj][m][n] * g;
                        u32x2 w; w.x = cvt_pk_bf16(v[0], v[1]); w.y = cvt_pk_bf16(v[2], v[3]); *(u32x2*)(OB + row * 1024 + col) = w; } } }
    }
};
struct EpiOut {
    static constexpr bool PERM = false, AFTER_DRAIN = false, KHOOK = false;
    float* out; float* ctxres; const float* modl; int dry; const float* xin; const float* cin;
    __device__ __forceinline__ void operator()(const f32x4 (&acc)[2][2][4][2], const Unit& u, int wr, int wc, int fr, int fq) const {
        const int row0 = u.pm * BM + wr * 64 + fr, col0 = u.pn * BM + wc * 32 + 4 * fq;
        const int b = (u.pm * BM) / NP, q0 = u.pm * BM - b * NP;
        const bool isctx = q0 < NCTX;
        const float* g1 = modl + (size_t)(isctx ? 8 : b) * 6144 + 2048;
        float* xb = isctx ? ctxres + (size_t)(b * NCTX) * D : out + ((size_t)b * NLAT + (q0 - NCTX)) * D;
        const float* xs = isctx ? cin + (size_t)(b * NCTX) * D : xin + ((size_t)b * NLAT + (q0 - NCTX)) * D;
        f32x4 gv[2][2];
#pragma unroll
        for (int bj = 0; bj < 2; ++bj)
#pragma unroll
            for (int n = 0; n < 2; ++n) gv[bj][n] = *(const f32x4*)(g1 + col0 + bj * HALF + n * 16);
#pragma unroll
        for (int ai = 0; ai < 2; ++ai) { asm volatile("" ::: "memory");
#pragma unroll
            for (int m = 0; m < 4; ++m) { const size_t ro = (size_t)(wr * 64 + fr + ai * HALF + m * 16) * D + col0; float* rowp = xb + ro; const float* srcp = xs + ro;
#pragma unroll
                for (int bj = 0; bj < 2; ++bj)
#pragma unroll
                    for (int n = 0; n < 2; ++n) { float* xp = rowp + bj * HALF + n * 16; const f32x4 nv = *(const f32x4*)(srcp + bj * HALF + n * 16) + gv[bj][n] * acc[ai][bj][m][n]; if (!dry) *(f32x4*)xp = nv; } } }
    }
};
struct EpiSwiGLU {
    static constexpr bool PERM = false, AFTER_DRAIN = false, KHOOK = false;
    bf16_t* HB;
    __device__ __forceinline__ void operator()(const f32x4 (&acc)[2][2][4][2], const Unit& u, int wr, int wc, int fr, int fq) const {
        const int row0 = u.pm * BM + wr * 64 + fr, hh0 = u.pn * 128 + wc * 16 + 4 * fq;
#pragma unroll
        for (int ai = 0; ai < 2; ++ai)
#pragma unroll
            for (int m = 0; m < 4; ++m) { bf16_t* rowp = HB + (size_t)(row0 + ai * HALF + m * 16) * 512 + hh0;
#pragma unroll
                for (int bj = 0; bj < 2; ++bj) { const f32x4 g = acc[ai][bj][m][0], up = acc[ai][bj][m][1]; f32x4 h;
#pragma unroll
                    for (int i = 0; i < 4; ++i) h[i] = g[i] * __builtin_amdgcn_rcpf(1.f + __expf(-g[i])) * up[i];
                    u32x2 w; w.x = cvt_pk_bf16(h[0], h[1]); w.y = cvt_pk_bf16(h[2], h[3]); *(u32x2*)(rowp + bj * 64) = w; } }
    }
};
struct LatentOrder {
    StaticOrder S;
    __host__ __device__ void init(int N, int G_, int c_) { S.init(128 * BM, N, G_, c_); }
    __host__ __device__ bool next(int i, Unit& u) const { if (!S.next(i, u)) return false; u.pm = (u.pm >> 4) * 17 + 1 + (u.pm & 15); return true; }
    __device__ __forceinline__ void a_ready(const Unit&) const {}
    __device__ __forceinline__ void done(const Unit&) const {}
};
template <size_t ESTRIDE> struct MoeOrder {
    int G, c; const PG8_LAS int* tab;
    __device__ __forceinline__ bool next(int i, Unit& u) const {
        const long L = (long)i * G + c; if (L >= (long)tab[32 + MOE_NBLK] * 4) return false;
        u.pm = (int)(L >> 2); u.pn = (int)(L & 3); u.bofs = (size_t)tab[32 + u.pm] * ESTRIDE; return true; }
    __device__ __forceinline__ void a_ready(const Unit&) const {}
    __device__ __forceinline__ void done(const Unit&) const {}
};
}
#define PG8_SP2 true
#define PG8_ALIGN true
struct Frame {
    LAS unsigned char* lds; int tid, lane, wave, G, bid, gwave, nwave;
};
__device__ __forceinline__ bf16_t* WSB(const Params& p, size_t off) { return (bf16_t*)(p.ws + off); }
__device__ __forceinline__ float* WSF(const Params& p, size_t off) { return (float*)(p.ws + off); }

__device__ __forceinline__ void sincos_dd(double ang, float& c, float& s) {
    const double kf = __builtin_rint(ang * 0.63661977236758134308);
    const double r = (ang - kf * 1.57079632679489655800) - kf * 6.12323399573676603587e-17;
    const int k = ((int)kf) & 3;
    const double r2 = r * r;
    const double sp = r * (1.0 + r2 * (-1.0 / 6 + r2 * (1.0 / 120 + r2 * (-1.0 / 5040 + r2 * (1.0 / 362880 + r2 * (-1.0 / 39916800 + r2 * (1.0 / 6227020800.0)))))));
    const double cp = 1.0 + r2 * (-0.5 + r2 * (1.0 / 24 + r2 * (-1.0 / 720 + r2 * (1.0 / 40320 + r2 * (-1.0 / 3628800 + r2 * (1.0 / 479001600 + r2 * (-1.0 / 87178291200.0)))))));
    const double cc = (k == 0) ? cp : (k == 1) ? -sp : (k == 2) ? -cp : sp;
    const double ss = (k == 0) ? sp : (k == 1) ? cp : (k == 2) ? -sp : -cp;
    c = (float)cc; s = (float)ss;
}
__device__ __forceinline__ void p0_prologue(const Params& p, const Frame& F) {
    const int gt = F.bid * NTHREADS + F.tid, ngt = F.G * NTHREADS;
    { float* tab = WSF(p, WS_ROPE); const LAS Params* lpar = (const LAS Params*)(F.lds + (LDS_BYTES - 4096 + 2048));
      for (int i = gt; i < 64 * 16 + 64 * 32; i += ngt) {
          if (i < 1024) { const int pos = i >> 4, k = i & 15; float c, s; sincos_dd((double)pos * (double)lpar->invA[k], c, s); tab[i] = c; tab[1024 + i] = s; }
          else { const int j = i - 1024, pos = j >> 5, k = j & 31; float c, s; sincos_dd((double)pos * (double)lpar->invR[k], c, s); tab[2048 + j] = c; tab[2048 + 2048 + j] = s; } } }
    { float* rwt = WSF(p, WS_RWT);
      for (int i = gt; i < DEPTH * 36 * 1024; i += ngt) { const int l = i / (36 * 1024), r = i - l * 36 * 1024, o = r >> 10, k = r & 1023;
          rwt[i] = o < 4 ? p.in[I_RGW][((size_t)l * 1024 + k) * 4 + o] : p.in[I_REW][((size_t)l * 1024 + k) * 32 + (o - 4)]; } }
    { float* rw2 = WSF(p, WS_RW2);
      for (int i = gt; i < DEPTH * 64 * 3 * 4 * 16 * 4; i += ngt) { const int j = i & 3, n = (i >> 2) & 15, g = (i >> 6) & 3, r = i >> 8, nt = r % 3, r2 = r / 3, kq = r2 & 63, l = r2 >> 6;
          const int ng = 16 * nt + n, k = 4 * (4 * kq + j) + g;
          rw2[i] = ng < 4 ? p.in[I_RGW][((size_t)l * 1024 + k) * 4 + ng] : (ng < 36 ? p.in[I_REW][((size_t)l * 1024 + k) * 32 + (ng - 4)] : 0.f); } }
    { LAS float* cond = (LAS float*)F.lds;
      LAS float* red = (LAS float*)(F.lds + 9 * 1024 * 4);
      for (int i = F.tid; i < 9 * 1024; i += NTHREADS) { const float v = i < 8192 ? p.in[I_C][i] : p.in[I_CCTX][i - 8192]; cond[i] = siluf_(v); }
      __syncthreads();
      float* mod = WSF(p, WS_MOD);
      for (int task = F.bid; task < DEPTH * 96; task += F.G) {
          const int l = task / 96, col0 = (task - l * 96) * 64, c = F.tid & 63, ks = F.tid >> 6;
          const float* w = p.in[I_ADAW] + ((size_t)l * 1024 + ks * 128) * 6144 + col0 + c;
          float a[9];
#pragma unroll
          for (int r = 0; r < 9; ++r) a[r] = 0.f;
          for (int k = 0; k < 128; ++k) { const float wv = w[(size_t)k * 6144];
#pragma unroll
              for (int r = 0; r < 9; ++r) a[r] += cond[r * 1024 + ks * 128 + k] * wv; }
#pragma unroll
          for (int r = 0; r < 9; ++r) red[(ks * 9 + r) * 64 + c] = a[r];
          __syncthreads();
          for (int o = F.tid; o < 9 * 64; o += NTHREADS) { const int r = o >> 6, cc = o & 63; float s = 0.f;
#pragma unroll
              for (int k2 = 0; k2 < 8; ++k2) s += red[(k2 * 9 + r) * 64 + cc];
              mod[((size_t)l * 9 + r) * 6144 + col0 + cc] = s + p.in[I_ADAB][(size_t)l * 6144 + col0 + cc]; }
          __syncthreads();
      } }
}

__device__ __forceinline__ void cvt_tile(const float* src, int ld_src, bf16_t* dst, int ld_dst, int k0, int n0, LAS float* tile  , int tid) {
#pragma unroll
    for (int ps = 0; ps < 2; ++ps) { const int k = ps * 32 + (tid >> 4), n4 = (tid & 15) * 4;
        const f32x4 v = *(const f32x4*)(src + (size_t)(k0 + k) * ld_src + n0 + n4);
        tile[k * 65 + n4] = v[0]; tile[k * 65 + n4 + 1] = v[1]; tile[k * 65 + n4 + 2] = v[2]; tile[k * 65 + n4 + 3] = v[3]; }
    __syncthreads();
    { const int n = tid >> 3, k8 = (tid & 7) * 8; float x[8];
#pragma unroll
      for (int e = 0; e < 8; ++e) x[e] = tile[(k8 + e) * 65 + n];
      *(u32x4*)(dst + (size_t)(n0 + n) * ld_dst + k0 + k8) = pack8(x); }
    __syncthreads();
}

struct CvtTask { const float* src; bf16_t* dst; int ld_src, ld_dst, k0, n0, which; };
__device__ __forceinline__ void cvt_load(f32x4 (&v)[8], const CvtTask& c, int tid) {
#pragma unroll
    for (int ps = 0; ps < 8; ++ps) v[ps] = *(const f32x4*)(c.src + (size_t)(c.k0 + ps * 8 + (tid >> 6)) * c.ld_src + c.n0 + (tid & 63) * 4);
}
__device__ __forceinline__ void cvt_store(const f32x4 (&v)[8], const CvtTask& c, LAS float* tile  , int tid) {
#pragma unroll
    for (int ps = 0; ps < 8; ++ps) *(LAS f32x4*)(tile + (ps * 8 + (tid >> 6)) * 260 + (tid & 63) * 4) = v[ps];
    __syncthreads();
    { const int n = tid >> 1, kb = (tid & 1) * 32, nn = c.n0 + n; const int row = c.which < 0 ? nn : ((nn >> 4) << 5) + (c.which << 4) + (nn & 15);
      bf16_t* d = c.dst + (size_t)row * c.ld_dst + c.k0 + kb;
#pragma unroll
      for (int q = 0; q < 4; ++q) { float x[8];
#pragma unroll
          for (int e = 0; e < 8; ++e) x[e] = tile[(kb + q * 8 + e) * 260 + n];
          *(u32x4*)(d + q * 8) = pack8(x); } }
    __syncthreads();
}
constexpr int NT_MIX = 16 * 30 + 3 * 8 * 4 + 16 * 4;
__device__ __forceinline__ CvtTask cvt_task_mix(const Params& p, int l, int t) {
    CvtTask c; c.which = -1;
    if (t < 480) { const int kt = t / 30, nt = t - kt * 30; c.src = p.in[I_WIN] + (size_t)l * 1024 * 7680; c.ld_src = 7680; c.dst = WSB(p, WS_BTIN); c.ld_dst = 1024; c.k0 = kt * 64; c.n0 = nt * 256; }
    else if (t < 576) { const int u = t - 480, nb = u >> 5, r = u & 31, kt = r >> 2, nt = r & 3;
        c.src = p.in[I_WBR] + ((size_t)l * 3 + nb) * 512 * 1024; c.ld_src = 1024; c.dst = WSB(p, WS_BTBR) + nb * 512; c.ld_dst = 1536; c.k0 = kt * 64; c.n0 = nt * 256; }
    else { const int u = t - 576, kt = u >> 2, nt = u & 3; c.src = p.in[I_WOUT] + (size_t)l * 1024 * 1024; c.ld_src = 1024; c.dst = WSB(p, WS_BTOUT); c.ld_dst = 1024; c.k0 = kt * 64; c.n0 = nt * 256; }
    return c;
}
constexpr int NT_MOE = 32 * 2 * 16 * 2 + 32 * 8 * 4;
__device__ __forceinline__ CvtTask cvt_task_moe(const Params& p, int l, int t) {
    CvtTask c;
    if (t < 2048) { const int e = t >> 6, r = t & 63, which = r >> 5, kt = (r >> 1) & 15, nt = r & 1;
        c.src = (which ? p.in[I_MUP] : p.in[I_MG]) + ((size_t)l * 32 + e) * 1024 * 512; c.ld_src = 512; c.dst = WSB(p, WS_BT1) + (size_t)e * 1024 * 1024; c.ld_dst = 1024; c.k0 = kt * 64; c.n0 = nt * 256; c.which = which; }
    else { const int u = t - 2048, e = u >> 5, r = u & 31, kt = r >> 2, nt = r & 3;
        c.src = p.in[I_MD] + ((size_t)l * 32 + e) * 512 * 1024; c.ld_src = 1024; c.dst = WSB(p, WS_BT2) + (size_t)e * 1024 * 512; c.ld_dst = 512; c.k0 = kt * 64; c.n0 = nt * 256; c.which = -1; }
    return c;
}
template <bool MOE> __device__ __forceinline__ void cvt_run(const Params& p, const Frame& F, int l, LAS float* tile, int first_blk = 0) {
    const int NTASK = MOE ? NT_MOE : NT_MIX;
    if (F.bid < first_blk) return;
    const int stride = F.G - first_blk;
    int t = F.bid - first_blk; if (t >= NTASK) return;
    CvtTask cur = MOE ? cvt_task_moe(p, l, t) : cvt_task_mix(p, l, t);
    f32x4 v[8]; cvt_load(v, cur, F.tid);
    for (;;) {
        const int tn = t + stride; const bool more = tn < NTASK;
        CvtTask nx = cur; f32x4 vn[8];
        if (more) { nx = MOE ? cvt_task_moe(p, l, tn) : cvt_task_mix(p, l, tn); cvt_load(vn, nx, F.tid); }
        cvt_store(v, cur, tile, F.tid);
        if (!more) break;
#pragma unroll
        for (int i = 0; i < 8; ++i) v[i] = vn[i];
        cur = nx; t = tn;
    }
}

__device__ __forceinline__ void rmsnorm_mod_row(const float* x, const float* g, const float* sc, const float* sh, bf16_t* o, int lane, float* keep  ) {
    f32x4 v[4]; float ss = 0.f;
#pragma unroll
    for (int j = 0; j < 4; ++j) { v[j] = *(const f32x4*)(x + j * 256 + lane * 4); ss += v[j][0] * v[j][0] + v[j][1] * v[j][1] + v[j][2] * v[j][2] + v[j][3] * v[j][3]; }
#pragma unroll
    for (int m = 1; m < 64; m <<= 1) ss += shfl_xor_f(ss, m);
    const float rs = rsqrtf(ss * (1.f / 1024.f) + 1e-6f);
#pragma unroll
    for (int j = 0; j < 4; ++j) { const int c = j * 256 + lane * 4;
        const f32x4 gg = *(const f32x4*)(g + c), s1 = *(const f32x4*)(sc + c), s0 = *(const f32x4*)(sh + c);
        f32x4 y;
#pragma unroll
        for (int e = 0; e < 4; ++e) y[e] = v[j][e] * rs * gg[e] * (1.f + s1[e]) + s0[e];
        u32x2 w; w.x = pk2(y[0], y[1]); w.y = pk2(y[2], y[3]); *(u32x2*)(o + c) = w;
        if (keep) { keep[j * 4 + 0] = y[0]; keep[j * 4 + 1] = y[1]; keep[j * 4 + 2] = y[2]; keep[j * 4 + 3] = y[3]; } }
}
__device__ __forceinline__ void p1_weights(const Params& p, const Frame& F, int l) {
    LAS float* tile = (LAS float*)F.lds;
    cvt_run<false>(p, F, l, tile);
    if (F.bid < 9) { const float* sh2 = WSF(p, WS_MOD) + ((size_t)l * 9 + F.bid) * 6144 + 3072; const float* rwt = WSF(p, WS_RWT) + (size_t)l * 36 * 1024; float* rc = WSF(p, WS_RC) + ((size_t)l * 9 + F.bid) * 48;
        for (int n = F.wave; n < 48; n += NWAVES) { float a = 0.f;
            if (n < 36) {
#pragma unroll
                for (int j = 0; j < 4; ++j) { const f32x4 sv = *(const f32x4*)(sh2 + j * 256 + F.lane * 4), wv = *(const f32x4*)(rwt + n * 1024 + j * 256 + F.lane * 4); a += sv[0] * wv[0] + sv[1] * wv[1] + sv[2] * wv[2] + sv[3] * wv[3]; }
#pragma unroll
                for (int mk = 1; mk < 64; mk <<= 1) a += shfl_xor_f(a, mk);
                a += n < 4 ? p.in[I_RGB][l * 4 + n] : p.in[I_REB][l * 32 + n - 4]; }
            if (F.lane == 0) rc[n] = a; } }
    { bf16_t* bl = WSB(p, WS_BTLORA); const int gt = F.bid * NTHREADS + F.tid, ngt = F.G * NTHREADS;
      for (int i = gt; i < 2560 * 256; i += ngt) { const int k = i / 2560, row = i - k * 2560;
          float v = 0.f;
          if (row < 1024) { if (k < 64) { const int d = row >> 9, c = row & 511; v = p.in[I_W2][(((size_t)l * 2 + d) * 64 + k) * 512 + c]; } }
          else if (row < 2048) { if (k >= 64 && k < 128) { const int r2 = row - 1024, d = r2 >> 9, c = r2 & 511; v = p.in[I_A2][(((size_t)l * 2 + d) * 64 + (k - 64)) * 512 + c]; } }
          else { if (k >= 128) { const int c = row - 2048; v = p.in[I_G2][((size_t)l * 128 + (k - 128)) * 512 + c]; } }
          bl[(size_t)row * 256 + k] = (bf16_t)f2bf(v); } }
}
__device__ __forceinline__ void p1_cvt_norm1(const Params& p, const Frame& F, int l) {
    p1_weights(p, F, l);
    { const float* mod = WSF(p, WS_MOD) + (size_t)l * 9 * 6144; bf16_t* H = WSB(p, WS_H);
      for (int row = F.gwave; row < T; row += F.nwave) { const int b = row / NP, q = row - b * NP; const float* mr = mod + (size_t)(q < NCTX ? 8 : b) * 6144;
          const float* xin = q < NCTX ? p.in[I_CTX] + (size_t)(b * NCTX + q) * D : p.in[I_X] + (size_t)(b * NLAT + (q - NCTX)) * D;
          rmsnorm_mod_row(xin, p.in[I_N1G] + (size_t)l * 1024, mr + 1024, mr, H + (size_t)row * 1024, F.lane, nullptr); } }
}

__device__ __forceinline__ void p3_prep(const Params& p, const Frame& F, int l) {
    const float* tab = WSF(p, WS_ROPE);
    const float* cosA = tab, *sinA = tab + 1024, *cosR = tab + 2048, *sinR = tab + 4096;
    bf16_t* AQ = WSB(p, WS_AQ); bf16_t* AKV = WSB(p, WS_AKV); bf16_t* RQ = WSB(p, WS_RQ); bf16_t* RK = WSB(p, WS_RK);
    const bf16_t* WU = WSB(p, WS_WU); bf16_t* AL_ = WSB(p, WS_H);
    const int lane = F.lane;
    const float* qng = p.in[I_QNG] + l * 64, *kng = p.in[I_KNG] + l * 64;
    const float* mu0 = p.in[I_MU] + (size_t)l * 2 * 1792, *mu1 = mu0 + 1792;
    for (int row = F.gwave; row < T; row += F.nwave) {
        const int b = row / NP, q = row - b * NP; const bool lat = q >= NCTX; const int t = q - NCTX, prow = t >> 6, pcol = t & 63;
        const u32x4 raw_aq = *(const u32x4*)(AQ + (size_t)row * 512 + lane * 8), raw_ak = *(const u32x4*)(AKV + (size_t)row * 256 + (lane & 15) * 8);
        const u32x4 raw_rq = *(const u32x4*)(RQ + (size_t)row * 512 + lane * 8), raw_rk = *(const u32x4*)(RK + (size_t)row * 512 + lane * 8);
        const bool hasp = (q != 0) && (q != NCTX), hasn = (q != NCTX - 1) && (q != NP - 1);
        const int cw = 1536 + lane * 4;
        const u32x2 cu = *(const u32x2*)(WU + (size_t)row * 1792 + cw);
        u32x2 pu; pu.x = 0u; pu.y = 0u; u32x2 nu = pu;
        if (hasp) pu = *(const u32x2*)(WU + (size_t)(row - 1) * 1792 + cw);
        if (hasn) nu = *(const u32x2*)(WU + (size_t)(row + 1) * 1792 + cw);
        { const int sub = lane & 7, a = sub >> 2, half = (sub >> 1) & 1, ib = (sub & 1) * 8, pos = lat ? (a ? pcol : prow) : 0;
          float cA[8], sA[8];
          *(f32x4*)cA = *(const f32x4*)(cosA + pos * 16 + ib); *(f32x4*)(cA + 4) = *(const f32x4*)(cosA + pos * 16 + ib + 4);
          *(f32x4*)sA = *(const f32x4*)(sinA + pos * 16 + ib); *(f32x4*)(sA + 4) = *(const f32x4*)(sinA + pos * 16 + ib + 4);
          { float x[8]; unpack8(raw_aq, x);
            float ss = 0.f;
#pragma unroll
            for (int e = 0; e < 8; ++e) ss += x[e] * x[e];
            ss += shfl_xor_f(ss, 1); ss += shfl_xor_f(ss, 2); ss += shfl_xor_f(ss, 4);
            const float rs = rsqrtf(ss * (1.f / 64.f) + 1e-6f);
            float gq[8]; *(f32x4*)gq = *(const f32x4*)(qng + sub * 8); *(f32x4*)(gq + 4) = *(const f32x4*)(qng + sub * 8 + 4);
#pragma unroll
            for (int e = 0; e < 8; ++e) x[e] = x[e] * rs * gq[e];
            float y[8];
#pragma unroll
            for (int e = 0; e < 8; ++e) { const float o = shfl_xor_f(x[e], 2);
                if (lat) { const float c = cA[e], s = sA[e]; y[e] = half ? (x[e] * c + o * s) : (x[e] * c - o * s); } else y[e] = x[e];
                y[e] *= 0.18033688011112042f; }
            if (!p.dry) *(u32x4*)(AQ + (size_t)row * 512 + lane * 8) = pack8(y); }
          { const int lk = lane & 15; float x[8]; unpack8(raw_ak, x);
            float ss = 0.f;
#pragma unroll
            for (int e = 0; e < 8; ++e) ss += x[e] * x[e];
            ss += shfl_xor_f(ss, 1); ss += shfl_xor_f(ss, 2); ss += shfl_xor_f(ss, 4);
            const float rs = rsqrtf(ss * (1.f / 64.f) + 1e-6f);
            float gk[8]; *(f32x4*)gk = *(const f32x4*)(kng + sub * 8); *(f32x4*)(gk + 4) = *(const f32x4*)(kng + sub * 8 + 4);
#pragma unroll
            for (int e = 0; e < 8; ++e) x[e] = x[e] * rs * gk[e];
            float y[8];
#pragma unroll
            for (int e = 0; e < 8; ++e) { const float o = shfl_xor_f(x[e], 2);
                if (lat) { const float c = cA[e], s = sA[e]; y[e] = half ? (x[e] * c + o * s) : (x[e] * c - o * s); } else y[e] = x[e]; }
            if (lane < 16 && !p.dry) *(u32x4*)(AKV + (size_t)row * 256 + lk * 8) = pack8(y); } }
        { const int sub = lane & 15, a = sub >> 3, half = (sub >> 2) & 1, ib = (sub & 3) * 8, pos = lat ? (a ? pcol : prow) : 0;
          float cR[8], sR[8];
          *(f32x4*)cR = *(const f32x4*)(cosR + pos * 32 + ib); *(f32x4*)(cR + 4) = *(const f32x4*)(cosR + pos * 32 + ib + 4);
          *(f32x4*)sR = *(const f32x4*)(sinR + pos * 32 + ib); *(f32x4*)(sR + 4) = *(const f32x4*)(sinR + pos * 32 + ib + 4);
#pragma unroll
          for (int which = 0; which < 2; ++which) { bf16_t* buf = which ? RK : RQ;
            float x[8]; unpack8(which ? raw_rk : raw_rq, x); float y[8];
#pragma unroll
            for (int e = 0; e < 8; ++e) { const float o = shfl_xor_f(x[e], 4);
                if (lat) { const float c = cR[e], s = sR[e]; y[e] = half ? (x[e] * c + o * s) : (x[e] * c - o * s); } else y[e] = x[e];
                if (which) y[e] *= 0.08838834764831845f; }
            if (!p.dry) *(u32x4*)(buf + (size_t)row * 512 + lane * 8) = pack8(y); } }
        { const int c = cw;
          const float uc[4] = {lo16(cu.x), hi16(cu.x), lo16(cu.y), hi16(cu.y)}, up[4] = {lo16(pu.x), hi16(pu.x), lo16(pu.y), hi16(pu.y)}, un[4] = {lo16(nu.x), hi16(nu.x), lo16(nu.y), hi16(nu.y)};
          float y[4]; const f32x4 m0v = *(const f32x4*)(mu0 + c), m1v = *(const f32x4*)(mu1 + c);
#pragma unroll
          for (int e = 0; e < 4; ++e) { const float xs = uc[e] + (up[e] - uc[e]) * m0v[e] + (un[e] - uc[e]) * m1v[e];
              if (lane < 16) { const float ex = __expf(2.f * xs); y[e] = 1.f - 2.f * frcp(ex + 1.f); }
              else if (lane < 32) y[e] = xs;
              else y[e] = sigmoidf_(xs); }
          u32x2 w; w.x = pk2(y[0], y[1]); w.y = pk2(y[2], y[3]); *(u32x2*)(AL_ + (size_t)row * 256 + lane * 4) = w; }
    }
}

__device__ __forceinline__ void p5_rwkv_tok(const Params& p, const Frame& F, int l) {
    const bf16_t* WU = WSB(p, WS_WU); const bf16_t* LW = WSB(p, WS_LW); const bf16_t* LA = WSB(p, WS_LA);
    bf16_t* RS = WSB(p, WS_W1); bf16_t* VS = RS + (size_t)T * 512; bf16_t* KKS = VS + (size_t)T * 512;
    const int lane = F.lane, c0 = lane * 8;
    const float* mu0 = p.in[I_MU] + (size_t)l * 2 * 1792, *mu1 = mu0 + 1792;
    const float* k_k = p.in[I_KK] + l * 512, *k_a = p.in[I_KA] + l * 512;
    for (int row = F.gwave; row < T; row += F.nwave) {
        const int b = row / NP, q = row - b * NP;
        const bool hasp = (q != 0) && (q != NCTX), hasn = (q != NCTX - 1) && (q != NP - 1);
        float sh[3][8];
#pragma unroll
        for (int part = 0; part < 3; ++part) { const int c = part * 512 + c0;
            const u32x4 cu = *(const u32x4*)(WU + (size_t)row * 1792 + c);
            u32x4 pu; pu.x = pu.y = pu.z = pu.w = 0u; u32x4 nu = pu;
            if (hasp) pu = *(const u32x4*)(WU + (size_t)(row - 1) * 1792 + c);
            if (hasn) nu = *(const u32x4*)(WU + (size_t)(row + 1) * 1792 + c);
            float uc[8], up[8], un[8]; unpack8(cu, uc); unpack8(pu, up); unpack8(nu, un);
#pragma unroll
            for (int e = 0; e < 8; ++e) sh[part][e] = uc[e] + (up[e] - uc[e]) * mu0[c + e] + (un[e] - uc[e]) * mu1[c + e]; }
        float kk[8]; float ss = 0.f;
#pragma unroll
        for (int e = 0; e < 8; ++e) { kk[e] = sh[1][e] * k_k[c0 + e]; ss += kk[e] * kk[e]; }
        ss += shfl_xor_f(ss, 1); ss += shfl_xor_f(ss, 2); ss += shfl_xor_f(ss, 4);
        const float rn = rsqrtf(fmaxf(ss, 1e-12f));
#pragma unroll
        for (int e = 0; e < 8; ++e) kk[e] *= rn;
        u32x4 lw_raw[2], la_raw[2];
#pragma unroll
        for (int d = 0; d < 2; ++d) { lw_raw[d] = *(const u32x4*)(LW + (size_t)row * 1024 + d * 512 + c0); la_raw[d] = *(const u32x4*)(LA + (size_t)row * 1024 + d * 512 + c0); }
        *(u32x4*)(RS + (size_t)row * 512 + c0) = pack8(sh[0]);
        *(u32x4*)(VS + (size_t)row * 512 + c0) = pack8(sh[2]);
        *(u32x4*)(KKS + (size_t)row * 512 + c0) = pack8(kk);
#pragma unroll
        for (int d = 0; d < 2; ++d) {
            _Float16* LOGW = (_Float16*)(p.ws + WS_W1 + (size_t)(3 + 3 * d) * SZ512); bf16_t* KR = WSB(p, WS_W1 + (size_t)(4 + 3 * d) * SZ512); bf16_t* BB = WSB(p, WS_W1 + (size_t)(5 + 3 * d) * SZ512);
            const float* w0 = p.in[I_W0] + ((size_t)l * 2 + d) * 512, *a0 = p.in[I_A0] + ((size_t)l * 2 + d) * 512;
            float lw[8], la[8]; unpack8(lw_raw[d], lw); unpack8(la_raw[d], la);
            float kr[8], bb[8]; typedef _Float16 h8 __attribute__((ext_vector_type(8))); h8 lg;
#pragma unroll
            for (int e = 0; e < 8; ++e) { const float a = sigmoidf_(a0[c0 + e] + la[e]);
                lg[e] = (_Float16)(-0.6065306597126334f * sigmoidf_(w0[c0 + e] + lw[e]));
                kr[e] = sh[1][e] * (1.f + (a - 1.f) * k_a[c0 + e]); bb[e] = kk[e] * a; }
            *(h8*)(LOGW + (size_t)row * 512 + c0) = lg;
            *(u32x4*)(KR + (size_t)row * 512 + c0) = pack8(kr);
            *(u32x4*)(BB + (size_t)row * 512 + c0) = pack8(bb); }
    }
}
__device__ __forceinline__ float reduce8(float (&v)[8], int lane) {
    float a[4];
#pragma unroll
    for (int k = 0; k < 4; ++k) { const bool up = (lane & 32) != 0; const float send = up ? v[k] : v[k + 4], keep = up ? v[k + 4] : v[k]; a[k] = keep + __shfl_xor(send, 32, 64); }
    float b[2];
#pragma unroll
    for (int k = 0; k < 2; ++k) { const bool up = (lane & 16) != 0; const float send = up ? a[k] : a[k + 2], keep = up ? a[k + 2] : a[k]; b[k] = keep + __shfl_xor(send, 16, 64); }
    float c; { const bool up = (lane & 8) != 0; const float send = up ? b[0] : b[1], keep = up ? b[1] : b[0]; c = keep + __shfl_xor(send, 8, 64); }
    c += __shfl_xor(c, 4, 64); c += __shfl_xor(c, 2, 64); c += __shfl_xor(c, 1, 64);
    return c;
}
__device__ __forceinline__ void p6_rwkv_scan_naive(const Params& p, const Frame& F, int l) {
    (void)l;
    LAS float* L_r = (LAS float*)F.lds;
    LAS float* L_w = L_r + 4096; LAS float* L_k = L_w + 4096; LAS float* L_v = L_k + 4096; LAS float* L_a = L_v + 4096; LAS float* L_b = L_a + 4096; LAS float* L_y = L_b + 4096;
    const bf16_t* RS = WSB(p, WS_W1); const bf16_t* VS = RS + (size_t)T * 512; const bf16_t* KKS = VS + (size_t)T * 512;
    const int lane = F.lane, w = F.wave, tid = F.tid;
    for (int task = F.bid; task < NB * 8 * 2; task += F.G) {
        const int dir = task & 1, h = (task >> 1) & 7, b = task >> 4;
        const _Float16* LOGW = (const _Float16*)(p.ws + WS_W1 + (size_t)(3 + 3 * dir) * SZ512); const bf16_t* KR = WSB(p, WS_W1 + (size_t)(4 + 3 * dir) * SZ512); const bf16_t* BB = WSB(p, WS_W1 + (size_t)(5 + 3 * dir) * SZ512);
        bf16_t* YS = WSB(p, WS_YS) + (size_t)dir * T * 512;
        float S[8];
#pragma unroll
        for (int i = 0; i < 8; ++i) S[i] = 0.f;
        for (int s0 = 0; s0 < NP; s0 += 64) {
            { const int st = tid >> 3, c8 = (tid & 7) * 8, s = s0 + st; const int q = dir ? (s < NCTX ? NCTX - 1 - s : NP + NCTX - 1 - s) : s;
              const size_t off = ((size_t)(b * NP + q)) * 512 + h * 64 + c8;
              float x[8];
              unpack8(*(const u32x4*)(RS + off), x);
#pragma unroll
              for (int e = 0; e < 8; ++e) L_r[st * 64 + c8 + e] = x[e];
              unpack8(*(const u32x4*)(VS + off), x);
#pragma unroll
              for (int e = 0; e < 8; ++e) L_v[st * 64 + c8 + e] = x[e];
              unpack8(*(const u32x4*)(KKS + off), x);
#pragma unroll
              for (int e = 0; e < 8; ++e) L_a[st * 64 + c8 + e] = -x[e];
              unpack8(*(const u32x4*)(KR + off), x);
#pragma unroll
              for (int e = 0; e < 8; ++e) L_k[st * 64 + c8 + e] = x[e];
              unpack8(*(const u32x4*)(BB + off), x);
#pragma unroll
              for (int e = 0; e < 8; ++e) L_b[st * 64 + c8 + e] = x[e];
              typedef _Float16 h8 __attribute__((ext_vector_type(8))); const h8 lg = *(const h8*)(LOGW + off);
#pragma unroll
              for (int e = 0; e < 8; ++e) L_w[st * 64 + c8 + e] = __expf((float)lg[e]); }
            __syncthreads();
            for (int st = 0; st < 64; ++st) {
                const float rj = L_r[st * 64 + lane], wj = L_w[st * 64 + lane], kj = L_k[st * 64 + lane], aj = L_a[st * 64 + lane], bj = L_b[st * 64 + lane];
                float pa[8];
#pragma unroll
                for (int i = 0; i < 8; ++i) pa[i] = S[i] * aj;
                const float tot = reduce8(pa, lane);
                float py[8];
#pragma unroll
                for (int i = 0; i < 8; ++i) { const float sa = __shfl(tot, i * 8, 64); const float vi = L_v[st * 64 + w * 8 + i];
                    S[i] = S[i] * wj + sa * bj + vi * kj; py[i] = S[i] * rj; }
                const float ty = reduce8(py, lane);
                if ((lane & 7) == 0) L_y[st * 64 + w * 8 + (lane >> 3)] = ty;
            }
            __syncthreads();
            { const int st = tid >> 3, c8 = (tid & 7) * 8, s = s0 + st; const int q = dir ? (s < NCTX ? NCTX - 1 - s : NP + NCTX - 1 - s) : s;
              float y[8];
#pragma unroll
              for (int e = 0; e < 8; ++e) y[e] = L_y[st * 64 + c8 + e];
              *(u32x4*)(YS + ((size_t)(b * NP + q)) * 512 + h * 64 + c8) = pack8(y); }
            __syncthreads();
        }
    }
}

__device__ __forceinline__ void p7_rwkv_readout(const Params& p, const Frame& F, int l);
constexpr int RPITCH_TR = 288;
constexpr int RPITCH_ROW = 272;
__device__ __forceinline__ float log_gamma_of(const Params& p, int l, int dir, int h) {
    const float x = p.in[I_RDL][(l * 2 + dir) * 4 + h];
    return -log1pf(__expf(-x));
}
__device__ __forceinline__ void p8_ret_kv(const Params& p, const Frame& F, int l) {
    const bf16_t* RK = WSB(p, WS_RK); const bf16_t* RV = WSB(p, WS_RV);
    bf16_t* SF = WSB(p, WS_SF); bf16_t* SB = WSB(p, WS_SB);
    LAS unsigned char* Lv = F.lds; LAS unsigned char* Lkf = F.lds + 128 * RPITCH_TR; LAS unsigned char* Lkb = F.lds + 2 * 128 * RPITCH_TR;
    const int lane = F.lane, w = F.wave, tid = F.tid, g = lane >> 4, li = lane & 15, q4 = li >> 2, p4 = li & 3;
    for (int u = F.bid; u < NB * 4 * 34; u += F.G) {
        const int c = u % 34, bh = u / 34, h = bh & 3, b = bh >> 2;
        const float lgf = log_gamma_of(p, l, 0, h) * 1.4426950408889634f, lgb = log_gamma_of(p, l, 1, h) * 1.4426950408889634f;
#pragma unroll
        for (int it = 0; it < 4; ++it) { const int idx = it * NTHREADS + tid, j = idx >> 4, c8 = (idx & 15) * 8;
            const size_t off = ((size_t)(b * NP + c * 128 + j)) * 512 + h * 128 + c8;
            const u32x4 vv = *(const u32x4*)(RV + off); *(LAS u32x4*)(Lv + j * RPITCH_TR + c8 * 2) = vv;
            float x[8]; unpack8(*(const u32x4*)(RK + off), x);
            const float sf = exp2f(lgf * (float)(127 - j)), sb = exp2f(lgb * (float)j);
            float xf[8], xb[8];
#pragma unroll
            for (int e = 0; e < 8; ++e) { xf[e] = x[e] * sf; xb[e] = x[e] * sb; }
            *(LAS u32x4*)(Lkf + j * RPITCH_TR + c8 * 2) = pack8(xf); *(LAS u32x4*)(Lkb + j * RPITCH_TR + c8 * 2) = pack8(xb); }
        __syncthreads();
        const int dir = w >> 2, e0 = (w & 3) * 32;
        LAS unsigned char* Lk = dir ? Lkb : Lkf;
        f32x4 acc[2][8];
#pragma unroll
        for (int et = 0; et < 2; ++et)
#pragma unroll
            for (int dt = 0; dt < 8; ++dt) acc[et][dt] = (f32x4){0.f, 0.f, 0.f, 0.f};
        const LAS unsigned char* vbase = Lv; const LAS unsigned char* kbase = Lk;
#pragma unroll 1
        for (int ks = 0; ks < 4; ++ks) {
            const int r0 = 32 * ks + 8 * g;
            bf16x8 af[2];
#pragma unroll
            for (int et = 0; et < 2; ++et) { const int col = e0 + 16 * et + 4 * p4;
                af[et] = cat44(tr_read(vbase + (r0 + q4) * RPITCH_TR + col * 2), tr_read(vbase + (r0 + 4 + q4) * RPITCH_TR + col * 2)); }
#pragma unroll
            for (int dt = 0; dt < 8; ++dt) { const int col = 16 * dt + 4 * p4;
                const bf16x8 bfr = cat44(tr_read(kbase + (r0 + q4) * RPITCH_TR + col * 2), tr_read(kbase + (r0 + 4 + q4) * RPITCH_TR + col * 2));
#pragma unroll
                for (int et = 0; et < 2; ++et) acc[et][dt] = MFMA16(af[et], bfr, acc[et][dt]); }
        }
        bf16_t* dst = (dir ? SB : SF) + (size_t)u * 16384;
#pragma unroll
        for (int et = 0; et < 2; ++et)
#pragma unroll
            for (int dt = 0; dt < 8; ++dt)
#pragma unroll
                for (int r = 0; r < 4; ++r) dst[(size_t)(e0 + 16 * et + 4 * g + r) * 128 + 16 * dt + li] = (bf16_t)f2bf(acc[et][dt][r]);
        __syncthreads();
    }
}
__device__ __forceinline__ void p9_ret_scan(const Params& p, const Frame& F, int l) {
    unsigned* SF = (unsigned*)(p.ws + WS_SF); unsigned* SB = (unsigned*)(p.ws + WS_SB);
    const int gt = F.bid * NTHREADS + F.tid, ngt = F.G * NTHREADS;
    for (int i = gt; i < 2 * NB * 4 * 8192; i += ngt) {
        const int dir = i / (NB * 4 * 8192), r = i - dir * (NB * 4 * 8192), bh = r >> 13, el = r & 8191, h = bh & 3;
        const float gC = __expf(128.f * log_gamma_of(p, l, dir, h));
        unsigned* base = (dir ? SB : SF) + (size_t)bh * 34 * 8192 + el;
        float s0 = 0.f, s1 = 0.f;
        for (int k = 0; k < 34; ++k) { const int c = dir ? (k < 2 ? 1 - k : 35 - k) : k;
            const unsigned kv = base[(size_t)c * 8192]; if (!p.dry) base[(size_t)c * 8192] = pk2(s0, s1); s0 = gC * s0 + lo16(kv); s1 = gC * s1 + hi16(kv); }
    }
}
__device__ __forceinline__ void p10_ret_out(const Params& p, const Frame& F, int l, bool want_ctx) {
    const bf16_t* RQ = WSB(p, WS_RQ); const bf16_t* RK = WSB(p, WS_RK); const bf16_t* RV = WSB(p, WS_RV); const bf16_t* RG = WSB(p, WS_RG); bf16_t* YR = WSB(p, WS_WU) + 512;
    const bf16_t* SF = WSB(p, WS_SF); const bf16_t* SB = WSB(p, WS_SB);
    LAS unsigned char* Lq = F.lds; LAS unsigned char* Lk = Lq + 128 * RPITCH_ROW; LAS unsigned char* Lv = Lk + 128 * RPITCH_ROW; LAS unsigned char* Ls = Lv + 128 * RPITCH_TR;
    const int lane = F.lane, w = F.wave, tid = F.tid, g = lane >> 4, li = lane & 15, q4 = li >> 2, p4 = li & 3;
    const float* gn = p.in[I_RGN] + l * 512;
    for (int u = F.bid; u < NB * 4 * 34; u += F.G) {
        const int c = u % 34, bh = u / 34, h = bh & 3, b = bh >> 2;
        if (c < 2 && !want_ctx) continue;
        const float lgf = log_gamma_of(p, l, 0, h) * 1.4426950408889634f, lgb = log_gamma_of(p, l, 1, h) * 1.4426950408889634f;
        const size_t row0 = (size_t)(b * NP + c * 128);
#pragma unroll
        for (int it = 0; it < 4; ++it) { const int idx = it * NTHREADS + tid, j = idx >> 4, c8 = (idx & 15) * 8;
            const size_t off = (row0 + j) * 512 + h * 128 + c8;
            *(LAS u32x4*)(Lq + j * RPITCH_ROW + c8 * 2) = *(const u32x4*)(RQ + off);
            *(LAS u32x4*)(Lk + j * RPITCH_ROW + c8 * 2) = *(const u32x4*)(RK + off);
            *(LAS u32x4*)(Lv + j * RPITCH_TR + c8 * 2) = *(const u32x4*)(RV + off);
            *(LAS u32x4*)(Ls + j * RPITCH_ROW + c8 * 2) = *(const u32x4*)(SF + (size_t)u * 16384 + j * 128 + c8); }
        __syncthreads();
        const int il = 16 * w + li;
        bf16x8 qf[4];
#pragma unroll
        for (int ks = 0; ks < 4; ++ks) qf[ks] = ld_frag(Lq + il * RPITCH_ROW + (32 * ks + 8 * g) * 2);
        f32x4 sc[8];
#pragma unroll
        for (int jt = 0; jt < 8; ++jt) { sc[jt] = (f32x4){0.f, 0.f, 0.f, 0.f};
#pragma unroll
            for (int ks = 0; ks < 4; ++ks) sc[jt] = MFMA16(ld_frag(Lk + (16 * jt + li) * RPITCH_ROW + (32 * ks + 8 * g) * 2), qf[ks], sc[jt]); }
#pragma unroll
        for (int jt = 0; jt < 8; ++jt)
#pragma unroll
            for (int r = 0; r < 4; ++r) { const int j = 16 * jt + 4 * g + r, dl = il - j;
                const float f = dl > 0 ? __builtin_amdgcn_exp2f(lgf * (float)dl) : (dl < 0 ? __builtin_amdgcn_exp2f(lgb * (float)(-dl)) : 2.f);
                sc[jt][r] *= f; }
        f32x4 y[8];
#pragma unroll
        for (int et = 0; et < 8; ++et) y[et] = (f32x4){0.f, 0.f, 0.f, 0.f};
        const LAS unsigned char* vbase = Lv;
#pragma unroll
        for (int ks = 0; ks < 4; ++ks) {
            const bf16x8 pf = pack_frag(sc[2 * ks], sc[2 * ks + 1]);
#pragma unroll
            for (int et = 0; et < 8; ++et) { const int col = 16 * et + 4 * p4;
                const bf16x8 vf = cat44(tr_read(vbase + (32 * ks + 4 * g + q4) * RPITCH_TR + col * 2), tr_read(vbase + (32 * ks + 16 + 4 * g + q4) * RPITCH_TR + col * 2));
                y[et] = MFMA16(vf, pf, y[et]); }
        }
        { f32x4 z[8]; const float sf = exp2f(lgf * (float)(il + 1));
#pragma unroll
          for (int et = 0; et < 8; ++et) { z[et] = (f32x4){0.f, 0.f, 0.f, 0.f};
#pragma unroll
              for (int ks = 0; ks < 4; ++ks) z[et] = MFMA16(ld_frag(Ls + (16 * et + li) * RPITCH_ROW + (32 * ks + 8 * g) * 2), qf[ks], z[et]);
              y[et] = y[et] + z[et] * sf; } }
        __syncthreads();
#pragma unroll
        for (int it = 0; it < 4; ++it) { const int idx = it * NTHREADS + tid, j = idx >> 4, c8 = (idx & 15) * 8;
            *(LAS u32x4*)(Ls + j * RPITCH_ROW + c8 * 2) = *(const u32x4*)(SB + (size_t)u * 16384 + j * 128 + c8); }
        __syncthreads();
        { f32x4 z[8]; const float sb = exp2f(lgb * (float)(128 - il));
#pragma unroll
          for (int et = 0; et < 8; ++et) { z[et] = (f32x4){0.f, 0.f, 0.f, 0.f};
#pragma unroll
              for (int ks = 0; ks < 4; ++ks) z[et] = MFMA16(ld_frag(Ls + (16 * et + li) * RPITCH_ROW + (32 * ks + 8 * g) * 2), qf[ks], z[et]);
              y[et] = y[et] + z[et] * sb; } }
        float ss = 0.f;
#pragma unroll
        for (int et = 0; et < 8; ++et)
#pragma unroll
            for (int r = 0; r < 4; ++r) ss += y[et][r] * y[et][r];
        ss += shfl_xor_f(ss, 16); ss += shfl_xor_f(ss, 32);
        const float rs = rsqrtf(ss * (1.f / 128.f) + 1e-6f);
        const size_t orow = (row0 + il) * 512 + h * 128;
#pragma unroll
        for (int et = 0; et < 8; ++et) { const int e = 16 * et + 4 * g;
            const u32x2 gw = *(const u32x2*)(RG + orow + e); const f32x4 gg = *(const f32x4*)(gn + h * 128 + e);
            const float o0 = siluf_(lo16(gw.x)) * y[et][0] * rs * gg[0], o1 = siluf_(hi16(gw.x)) * y[et][1] * rs * gg[1], o2 = siluf_(lo16(gw.y)) * y[et][2] * rs * gg[2], o3 = siluf_(hi16(gw.y)) * y[et][3] * rs * gg[3];
            u32x2 ow; ow.x = pk2(o0, o1); ow.y = pk2(o2, o3); *(u32x2*)(YR + (row0 + il) * 1536 + h * 128 + e) = ow; }
        __syncthreads();
    }
}
constexpr int APITCH = 144;
__device__ __forceinline__ void p11_attention(const Params& p, const Frame& F, bool want_ctx) {
    const bf16_t* AQ = WSB(p, WS_AQ); const bf16_t* AKV = WSB(p, WS_AKV); bf16_t* YA = WSB(p, WS_WU);
    const int lane = F.lane, w = F.wave, tid = F.tid, g = lane >> 4, li = lane & 15, q4 = li >> 2, p4 = li & 3;
    LAS unsigned char* LK = F.lds; LAS unsigned char* LV = F.lds + 4 * 64 * APITCH;
    const int nunits = NB * 8 * 17;
    for (int u0 = F.bid; u0 < nunits; u0 += F.G) {
        int b, h, qb;
        int u = u0;
        if (F.G == 256 && u0 < NB * 8 * 16) { const int r = u0 >> 8, x = u0 & 7, j = (u0 & 255) >> 3, pair = x + 8 * (r >> 1), un = (r & 1) * 32 + j;
            u = (pair >> 1) * 128 + ((pair & 1) * 4 + (un >> 4)) * 16 + (un & 15); }
        if (u < NB * 8 * 16) { b = u >> 7; h = (u >> 4) & 7; qb = 1 + (u & 15); } else { const int v = u - NB * 8 * 16; b = v >> 3; h = v & 7; qb = 0; }
        if (qb == 0 && !want_ctx) continue;
        const int kvh = h >> 2, ntile = qb == 0 ? NCTX / 64 : NP / 64;
        const size_t rowbase = (size_t)b * NP + (size_t)qb * 256;
        bf16x8 qf[2][2];
#pragma unroll
        for (int it = 0; it < 2; ++it)
#pragma unroll
            for (int ks = 0; ks < 2; ++ks) qf[it][ks] = *(const bf16x8*)(AQ + (rowbase + 32 * w + 16 * it + li) * 512 + h * 64 + 32 * ks + 8 * g);
        f32x4 o[4][2]; float m[2], ls[2];
#pragma unroll
        for (int it = 0; it < 2; ++it) { m[it] = 0.f; ls[it] = 0.f;
#pragma unroll
            for (int et = 0; et < 4; ++et) o[et][it] = (f32x4){0.f, 0.f, 0.f, 0.f}; }
        const int sj = tid >> 3, sc8 = (tid & 7) * 8;
        const bf16_t* kvsrc = AKV + ((size_t)b * NP + sj) * 256 + kvh * 64 + sc8;
        u32x4 kreg[2], vreg[2];
#pragma unroll
        for (int sb = 0; sb < 2; ++sb) { kreg[sb] = *(const u32x4*)(kvsrc + (size_t)sb * 64 * 256); vreg[sb] = *(const u32x4*)(kvsrc + (size_t)sb * 64 * 256 + 128); }
        __syncthreads();
        for (int kp = 0; kp < ntile / 2; ++kp) {
            LAS unsigned char* lkb = LK + (kp & 1) * 128 * APITCH; LAS unsigned char* lvb = LV + (kp & 1) * 128 * APITCH;
#pragma unroll
            for (int sb = 0; sb < 2; ++sb) { *(LAS u32x4*)(lkb + (sb * 64 + sj) * APITCH + sc8 * 2) = kreg[sb]; *(LAS u32x4*)(lvb + (sb * 64 + sj) * APITCH + sc8 * 2) = vreg[sb]; }
            __syncthreads();
            if (kp + 1 < ntile / 2) {
#pragma unroll
                for (int sb = 0; sb < 2; ++sb) { const bf16_t* s2 = kvsrc + (size_t)(2 * kp + 2 + sb) * 64 * 256; kreg[sb] = *(const u32x4*)s2; vreg[sb] = *(const u32x4*)(s2 + 128); } }
#pragma unroll
            for (int sb = 0; sb < 2; ++sb) { const int kt = 2 * kp + sb; LAS unsigned char* lk = lkb + sb * 64 * APITCH; LAS unsigned char* lv = lvb + sb * 64 * APITCH;
            f32x4 sc[4][2];
            const float i0 = kt == 0 ? 0.f : -m[0], i1 = kt == 0 ? 0.f : -m[1];
#pragma unroll
            for (int jt = 0; jt < 4; ++jt) { sc[jt][0] = (f32x4){i0, i0, i0, i0}; sc[jt][1] = (f32x4){i1, i1, i1, i1};
#pragma unroll
                for (int ks = 0; ks < 2; ++ks) { const bf16x8 kf = ld_frag(lk + (16 * jt + li) * APITCH + (32 * ks + 8 * g) * 2);
                    sc[jt][0] = MFMA16(kf, qf[0][ks], sc[jt][0]); sc[jt][1] = MFMA16(kf, qf[1][ks], sc[jt][1]); } }
            float mx[2];
#pragma unroll
            for (int it = 0; it < 2; ++it) { float t = sc[0][it][0];
#pragma unroll
                for (int jt = 0; jt < 4; ++jt)
#pragma unroll
                    for (int r = 0; r < 4; ++r) t = fmaxf(t, sc[jt][it][r]);
                t = fmaxf(t, shfl_xor_f(t, 16)); t = fmaxf(t, shfl_xor_f(t, 32)); mx[it] = t; }
            bf16x8 pf[2][2];
            if (kt == 0 || __any(fmaxf(mx[0], mx[1]) > 8.f)) {
#pragma unroll
                for (int it = 0; it < 2; ++it) { const float d = kt == 0 ? mx[it] : fmaxf(mx[it], 0.f), alpha = kt == 0 ? 1.f : __builtin_amdgcn_exp2f(-d);
                    m[it] = kt == 0 ? d : m[it] + d; ls[it] *= alpha;
#pragma unroll
                    for (int et = 0; et < 4; ++et) o[et][it] = o[et][it] * alpha;
#pragma unroll
                    for (int jt = 0; jt < 4; ++jt)
#pragma unroll
                        for (int r = 0; r < 4; ++r) sc[jt][it][r] -= d; } }
#pragma unroll
            for (int it = 0; it < 2; ++it) { float rsum = 0.f;
#pragma unroll
                for (int jt = 0; jt < 4; ++jt)
#pragma unroll
                    for (int r = 0; r < 4; ++r) { const float e = __builtin_amdgcn_exp2f(sc[jt][it][r]); sc[jt][it][r] = e; rsum += e; }
                ls[it] += rsum;
                pf[it][0] = pack_frag(sc[0][it], sc[1][it]); pf[it][1] = pack_frag(sc[2][it], sc[3][it]); }
#pragma unroll
            for (int ks = 0; ks < 2; ++ks)
#pragma unroll
                for (int et = 0; et < 4; ++et) { const int col = 16 * et + 4 * p4;
                    const bf16x8 vf = cat44(tr_read(lv + (32 * ks + 4 * g + q4) * APITCH + col * 2), tr_read(lv + (32 * ks + 16 + 4 * g + q4) * APITCH + col * 2));
                    o[et][0] = MFMA16(vf, pf[0][ks], o[et][0]); o[et][1] = MFMA16(vf, pf[1][ks], o[et][1]); }
            }
        }
#pragma unroll
        for (int it = 0; it < 2; ++it) { float l = ls[it]; l += shfl_xor_f(l, 16); l += shfl_xor_f(l, 32); const float inv = 1.f / l;
            bf16_t* op = YA + (rowbase + 32 * w + 16 * it + li) * 1536 + h * 64 + 4 * g;
#pragma unroll
            for (int et = 0; et < 4; ++et) { u32x2 ow; ow.x = pk2(o[et][it][0] * inv, o[et][it][1] * inv); ow.y = pk2(o[et][it][2] * inv, o[et][it][3] * inv); *(u32x2*)(op + 16 * et) = ow; } }
    }
    __syncthreads();
}

__device__ __forceinline__ void p14_norm2_router(const Params& p, const Frame& F, int l, bool want_ctx) {
    LAS float* tile = (LAS float*)F.lds;
    (void)tile;
    const float* mod = WSF(p, WS_MOD) + (size_t)l * 9 * 6144; bf16_t* H2 = WSB(p, WS_H);
    const float* rw2 = WSF(p, WS_RW2) + (size_t)l * 64 * 3 * 4 * 16 * 4;
    const float* rcl = WSF(p, WS_RC) + (size_t)l * 9 * 48;
    const float* n2g = p.in[I_N2G] + (size_t)l * 1024;
    unsigned* cnt = (unsigned*)(p.ws + WS_CTL) + CW_CNT + l * 32;
    int* PE = (int*)(p.ws + WS_PAIR); int* PPOS = PE + NPAIR_MAX; float* PW = (float*)(PPOS + NPAIR_MAX);
    for (int gi = F.gwave; gi < T / 16; gi += F.nwave) {
        int lane = F.lane; asm volatile("" : "+v"(lane));
        const int g = lane >> 4, li = lane & 15, half = lane >> 5, lk = lane & 31;
        const int row0 = 16 * gi, b = row0 / NP, q = row0 - b * NP; const bool isctx = q < NCTX;
        if (isctx && !want_ctx) continue;
        const int mrow = isctx ? 8 : b; const float* mr = mod + (size_t)mrow * 6144;
        LAS float* At = (LAS float*)(F.lds + F.wave * 12288);
        LAS float* LGT = At + 16 * 4 * 36;
        const float* xr[8];
#pragma unroll
        for (int r = 0; r < 8; ++r) xr[r] = xrow(p, row0 + 8 * half + r);
        f32x4 acc[3]; float ss[8];
#pragma unroll
        for (int nt = 0; nt < 3; ++nt) acc[nt] = (f32x4){0.f, 0.f, 0.f, 0.f};
#pragma unroll
        for (int r = 0; r < 8; ++r) ss[r] = 0.f;
        f32x4 xv[8];
#pragma unroll
        for (int r = 0; r < 8; ++r) xv[r] = *(const f32x4*)(xr[r] + 4 * lk);
#pragma unroll 1
        for (int ck = 0; ck < 8; ++ck) { const int kc = ck * 128 + 4 * lk;
            const f32x4 gg = *(const f32x4*)(n2g + kc), s1 = *(const f32x4*)(mr + 4096 + kc);
            f32x4 gq; gq[0] = gg[0] * (1.f + s1[0]); gq[1] = gg[1] * (1.f + s1[1]); gq[2] = gg[2] * (1.f + s1[2]); gq[3] = gg[3] * (1.f + s1[3]);
            const float* wb = rw2 + ((size_t)(ck * 8) * 3 * 4 + g) * 64 + li * 4;
            f32x4 bc[3];
#pragma unroll
            for (int nt = 0; nt < 3; ++nt) bc[nt] = *(const f32x4*)(wb + nt * 256);
#pragma unroll
            for (int r = 0; r < 8; ++r) { ss[r] += xv[r][0] * xv[r][0] + xv[r][1] * xv[r][1] + xv[r][2] * xv[r][2] + xv[r][3] * xv[r][3];
#pragma unroll
                for (int e = 0; e < 4; ++e) At[((8 * half + r) * 4 + e) * 36 + lk] = xv[r][e] * gq[e]; }
            if (ck < 7) {
#pragma unroll
                for (int r = 0; r < 8; ++r) xv[r] = *(const f32x4*)(xr[r] + kc + 128); }
            asm volatile("" ::: "memory");
#pragma unroll
            for (int kq = 0; kq < 8; ++kq) { const f32x4 av = *(const LAS f32x4*)(At + (li * 4 + g) * 36 + 4 * kq);
                f32x4 bn[3];
                if (kq < 7) {
#pragma unroll
                    for (int nt = 0; nt < 3; ++nt) bn[nt] = *(const f32x4*)(wb + ((kq + 1) * 3 + nt) * 256); }
#pragma unroll
                for (int nt = 0; nt < 3; ++nt) {
#pragma unroll
                    for (int j = 0; j < 4; ++j) acc[nt] = __builtin_amdgcn_mfma_f32_16x16x4f32(av[j], bc[nt][j], acc[nt], 0, 0, 0); }
                if (kq < 7) {
#pragma unroll
                    for (int nt = 0; nt < 3; ++nt) bc[nt] = bn[nt]; } }
            asm volatile("" ::: "memory");
        }
#pragma unroll
        for (int r = 0; r < 8; ++r) {
#pragma unroll
            for (int mk = 1; mk < 32; mk <<= 1) ss[r] += shfl_xor_f(ss[r], mk);
            ss[r] = rsqrtf(ss[r] * (1.f / 1024.f) + 1e-6f); }
#pragma unroll
        for (int r2 = 0; r2 < 4; ++r2) { float rsA = ss[r2], rsB = ss[4 + r2]; asm volatile("" : "+v"(rsA), "+v"(rsB));
            const float rs = (g & 1) ? rsB : rsA;
#pragma unroll
            for (int nt = 0; nt < 3; ++nt) LGT[(4 * g + r2) * 48 + 16 * nt + li] = acc[nt][r2] * rs + rcl[mrow * 48 + 16 * nt + li]; }
        asm volatile("" ::: "memory");
        if (lane < 16 && !p.dry) {
            const int row = row0 + lane; const LAS float* lg = LGT + lane * 48;
            int grp = 0; float gm = lg[0];
            float gl4[4]; gl4[0] = gm;
#pragma unroll
            for (int i = 1; i < 4; ++i) { gl4[i] = lg[i]; if (gl4[i] > gm) { gm = gl4[i]; grp = i; } }
            float gs = 0.f;
#pragma unroll
            for (int i = 0; i < 4; ++i) gs += __expf(gl4[i] - gm);
            const float pg = frcp(gs);
            int i1 = 0, i2 = -1; float v1 = -3.0e38f, v2 = -3.0e38f;
#pragma unroll
            for (int i = 0; i < 8; ++i) { const float v = lg[4 + grp * 8 + i];
                if (v > v1) { v2 = v1; i2 = i1; v1 = v; i1 = i; } else if (v > v2) { v2 = v; i2 = i; } }
            const float e2 = __expf(v2 - v1), w1 = pg * frcp(1.f + e2), w2 = pg * e2 * frcp(1.f + e2);
            const int ex1 = grp * 8 + i1, ex2 = grp * 8 + i2;
            const unsigned p1 = atomicAdd(&cnt[ex1], 1u), p2 = atomicAdd(&cnt[ex2], 1u);
            PE[2 * row] = ex1; PE[2 * row + 1] = ex2; PPOS[2 * row] = (int)p1; PPOS[2 * row + 1] = (int)p2; PW[2 * row] = w1; PW[2 * row + 1] = w2;
        }
        if (!p.dry && lk == 0) { float* RSR = WSF(p, WS_RSROW);
#pragma unroll
            for (int r = 0; r < 8; ++r) RSR[row0 + 8 * half + r] = ss[r]; }
    }
}
struct MoeTab { LAS int* pad_start; LAS int* blk_e; LAS int* n_used; };
__device__ __forceinline__ MoeTab moe_tab(const Frame& F) { MoeTab t; LAS int* base = (LAS int*)(F.lds + MISC_OFF + 64); t.pad_start = base; t.blk_e = base + 32; t.n_used = base + 32 + MOE_NBLK; return t; }
__device__ __forceinline__ void moe_build_tab(const Params& p, const Frame& F, int l) {
    const MoeTab t = moe_tab(F);
    const unsigned* cnt = (const unsigned*)(p.ws + WS_CTL) + CW_CNT + l * 32;
    __syncthreads();
    if (F.tid == 0) { int acc = 0;
        for (int e = 0; e < 32; ++e) { const int c = (int)__hip_atomic_load(cnt + e, __ATOMIC_RELAXED, __HIP_MEMORY_SCOPE_AGENT), nb = (c + 255) >> 8; t.pad_start[e] = acc * 256;
            for (int k = 0; k < nb; ++k) t.blk_e[acc + k] = e;
            acc += nb; }
        *t.n_used = acc; }
    __syncthreads();
}
__device__ __forceinline__ void p15_scatter(const Params& p, const Frame& F, int l, bool want_ctx) {
    moe_build_tab(p, F, l);
    const MoeTab t = moe_tab(F);
    const int* PE = (const int*)(p.ws + WS_PAIR); const int* PPOS = PE + NPAIR_MAX; int* PD = (int*)(p.ws + WS_PAIR) + 3 * NPAIR_MAX;
    const float* RSR = WSF(p, WS_RSROW); bf16_t* BUF = WSB(p, WS_BUF);
    const float* mod = WSF(p, WS_MOD) + (size_t)l * 9 * 6144; const float* n2g = p.in[I_N2G] + (size_t)l * 1024;
    const int lane = F.lane;
    for (int row = F.gwave; row < T; row += F.nwave) {
        const int b = row / NP, q = row - b * NP; const bool isctx = q < NCTX;
        if (isctx && !want_ctx) continue;
        const float* mr = mod + (size_t)(isctx ? 8 : b) * 6144; const float* x = xrow(p, row);
        const float rs = RSR[row];
        const int d0 = t.pad_start[PE[2 * row]] + PPOS[2 * row], d1 = t.pad_start[PE[2 * row + 1]] + PPOS[2 * row + 1];
        if (lane == 0) { PD[2 * row] = d0; PD[2 * row + 1] = d1; }
        f32x4 xv[4];
#pragma unroll
        for (int j = 0; j < 4; ++j) xv[j] = *(const f32x4*)(x + j * 256 + lane * 4);
#pragma unroll
        for (int j = 0; j < 4; ++j) { const int c = j * 256 + lane * 4;
            const f32x4 gg = *(const f32x4*)(n2g + c), s1 = *(const f32x4*)(mr + 4096 + c), s0 = *(const f32x4*)(mr + 3072 + c); float y[4];
#pragma unroll
            for (int e = 0; e < 4; ++e) y[e] = xv[j][e] * rs * gg[e] * (1.f + s1[e]) + s0[e];
            u32x2 w; w.x = pk2(y[0], y[1]); w.y = pk2(y[2], y[3]);
            *(u32x2*)(BUF + (size_t)d0 * 1024 + c) = w; *(u32x2*)(BUF + (size_t)d1 * 1024 + c) = w; }
    }
}
__device__ __forceinline__ void p18_combine(const Params& p, const Frame& F, int l, bool want_ctx) {
    const int* PD = (const int*)(p.ws + WS_PAIR) + 3 * NPAIR_MAX; const float* PW = (const float*)(p.ws + WS_PAIR) + 2 * NPAIR_MAX;
    const bf16_t* YB = WSB(p, WS_YB);
    const float* mod = WSF(p, WS_MOD) + (size_t)l * 9 * 6144;
    const float* modn = mod + 9 * 6144;
    const float* n1g = p.in[I_N1G] + (size_t)(l + 1) * 1024;
    bf16_t* H = WSB(p, WS_H);
    const bool donorm = (l + 1 < DEPTH);
    const int lane = F.lane;
    for (int row = F.gwave; row < T; row += F.nwave) {
        const int b = row / NP, q = row - b * NP; const bool isctx = q < NCTX;
        if (isctx && !want_ctx) continue;
        const int mrow = isctx ? 8 : b;
        const float* g2 = mod + (size_t)mrow * 6144 + 5120;
        const int d0 = PD[2 * row], d1 = PD[2 * row + 1]; const float w0 = PW[2 * row], w1 = PW[2 * row + 1];
        float* x = xrow(p, row);
        f32x4 xv[4]; float ss = 0.f;
#pragma unroll
        for (int j = 0; j < 2; ++j) { const int c = j * 512 + lane * 8;
            float ya[8], yb[8]; unpack8(*(const u32x4*)(YB + (size_t)d0 * 1024 + c), ya); unpack8(*(const u32x4*)(YB + (size_t)d1 * 1024 + c), yb);
            f32x4 x0 = *(const f32x4*)(x + c), x1 = *(const f32x4*)(x + c + 4); const f32x4 ga = *(const f32x4*)(g2 + c), gb = *(const f32x4*)(g2 + c + 4);
#pragma unroll
            for (int e = 0; e < 4; ++e) { x0[e] += ga[e] * (w0 * ya[e] + w1 * yb[e]); x1[e] += gb[e] * (w0 * ya[4 + e] + w1 * yb[4 + e]); ss += x0[e] * x0[e] + x1[e] * x1[e]; }
            if (!p.dry) { *(f32x4*)(x + c) = x0; *(f32x4*)(x + c + 4) = x1; }
            xv[2 * j] = x0; xv[2 * j + 1] = x1; }
        if (donorm) {
#pragma unroll
            for (int m = 1; m < 64; m <<= 1) ss += shfl_xor_f(ss, m);
            const float rs = rsqrtf(ss * (1.f / 1024.f) + 1e-6f);
            const float* mr = modn + (size_t)mrow * 6144;
#pragma unroll
            for (int j = 0; j < 2; ++j) { const int c = j * 512 + lane * 8; float y[8];
#pragma unroll
                for (int hf = 0; hf < 2; ++hf) { const f32x4 gg = *(const f32x4*)(n1g + c + 4 * hf), s1 = *(const f32x4*)(mr + 1024 + c + 4 * hf), s0 = *(const f32x4*)(mr + c + 4 * hf);
#pragma unroll
                    for (int e = 0; e < 4; ++e) y[4 * hf + e] = xv[2 * j + hf][e] * rs * gg[e] * (1.f + s1[e]) + s0[e]; }
                if (!p.dry) *(u32x4*)(H + (size_t)row * 1024 + c) = pack8(y); } }
    }
}
constexpr size_t WS_REC = WS_WU; constexpr int REC_BYTES = 15360, RC_BYTES = 1792;
static_assert(WS_LW == WS_WU + (size_t)T * 1792 * 2 && WS_LA == WS_LW + (size_t)T * 1024 * 2 && WS_LG == WS_LA + (size_t)T * 1024 * 2, "WU|LW|LA contiguous");
static_assert(WS_REC + (size_t)NB * 8 * (NP / 16) * REC_BYTES <= WS_LG, "chunk records fit");
constexpr size_t WS_YCAT = WS_WU;
constexpr size_t WS_YS2 = WS_H;
constexpr int NCHUNK = NP / 16;
__device__ __forceinline__ int scan_pos(int s, int dir) { return dir ? (s < NCTX ? NCTX - 1 - s : NP + NCTX - 1 - s) : s; }
constexpr size_t WS_REC2 = WS_W1;
constexpr size_t WS_VS2 = AL(WS_REC2 + (size_t)NB * 8 * (NP / 16) * REC_BYTES);
constexpr size_t WS_BON = AL(WS_VS2 + SZ512);
static_assert(WS_BON + (size_t)2 * T * 8 * 4 <= WS_END_MIX, "records + V' + bonus fit in the W1 region");
struct BuildRaw { u32x4 wu[3][2], halo[3], lw[2], la[2]; };
template <int DIR> __device__ __forceinline__ void build_load(BuildRaw& R, const Params& p, int ch, int lane) {
    const bf16_t* WU = WSB(p, WS_WU); const bf16_t* LWg = WSB(p, WS_LW); const bf16_t* LAg = WSB(p, WS_LA);
    const int bh = ch / NCHUNK, tb = ch - bh * NCHUNK, b = bh >> 3, h = bh & 7;
    const int q0 = 16 * tb; const size_t row0 = (size_t)b * NP + q0;
    const int lt = lane >> 2, lc = (lane & 3) * 16;
    const bool hasp = (q0 != 0) && (q0 != NCTX), hasn = (q0 + 16 != NCTX) && (q0 + 16 != NP);
#pragma unroll
    for (int part = 0; part < 3; ++part) { const bf16_t* src = WU + (row0 + lt) * 1792 + part * 512 + h * 64 + lc;
        R.wu[part][0] = *(const u32x4*)src; R.wu[part][1] = *(const u32x4*)(src + 8);
        u32x4 hv; hv.x = hv.y = hv.z = hv.w = 0u;
        if (lane < 16) { const bool nx = lane >= 8; const bool ok = nx ? hasn : hasp;
            if (ok) hv = *(const u32x4*)(WU + (nx ? row0 + 16 : row0 - 1) * 1792 + part * 512 + h * 64 + (lane & 7) * 8); }
        R.halo[part] = hv; }
    const bf16_t* s1p = LWg + (row0 + lt) * 1024 + DIR * 512 + h * 64 + lc; const bf16_t* s2p = LAg + (row0 + lt) * 1024 + DIR * 512 + h * 64 + lc;
    R.lw[0] = *(const u32x4*)s1p; R.lw[1] = *(const u32x4*)(s1p + 8); R.la[0] = *(const u32x4*)s2p; R.la[1] = *(const u32x4*)(s2p + 8);
}
template <int DIR> __device__ __forceinline__ void p6c_rwkv_build(const Params& p, const Frame& F, int l) {
    constexpr int dir = DIR;
    unsigned char* REC = p.ws + WS_REC2; bf16_t* VSo = WSB(p, WS_VS2); float* BON = WSF(p, WS_BON) + (size_t)dir * T * 8;
    constexpr int TP_ = 144;
    BuildRaw cur, nxt;
    if (F.gwave < NB * 8 * NCHUNK) build_load<DIR>(cur, p, F.gwave, F.lane);
    for (int ch = F.gwave; ch < NB * 8 * NCHUNK; ch += F.nwave) {
        int lane = F.lane; asm volatile("" : "+v"(lane));
        const int g = lane >> 4, li = lane & 15;
        LAS unsigned char* wl = F.lds + F.wave * 17408;
        LAS unsigned char* Ta = wl; LAS unsigned char* Tr = wl + 2304; LAS unsigned char* Tb = wl + 4608; LAS unsigned char* Tk = wl + 6912;
        LAS float* M = (LAS float*)wl;
        LAS unsigned char* Sv = wl + 9216;
        const int pj = (lane & 32) + ((lane & 15) >> 2) * 8 + ((lane >> 4) & 1) * 4 + (lane & 3);
        const int bh = ch / NCHUNK, tb = ch - bh * NCHUNK, b = bh >> 3, h = bh & 7;
        const int q0 = 16 * tb; const size_t row0 = (size_t)b * NP + q0;
        const int cidx = dir ? (tb < 16 ? 15 - tb : 287 - tb) : tb;
        const int lt = lane >> 2, lc = (lane & 3) * 16;
#pragma unroll
        for (int part = 0; part < 3; ++part) {
            *(LAS u32x4*)(wl + part * 2304 + (lt + 1) * 128 + lc * 2) = cur.wu[part][0]; *(LAS u32x4*)(wl + part * 2304 + (lt + 1) * 128 + lc * 2 + 16) = cur.wu[part][1];
            if (lane < 16) *(LAS u32x4*)(wl + part * 2304 + (lane >= 8 ? 17 * 128 : 0) + (lane & 7) * 16) = cur.halo[part]; }
        const int cc = h * 64 + lane;
        float rr[16], kx[16], vx[16], kn[16];
        { const float* mu0 = p.in[I_MU] + (size_t)l * 2 * 1792, *mu1 = mu0 + 1792;
          const float kkc = p.in[I_KK][l * 512 + cc];
#pragma unroll
          for (int part = 0; part < 3; ++part) { const float m0 = mu0[part * 512 + cc], m1 = mu1[part * 512 + cc];
              float raw[18];
#pragma unroll
              for (int t = 0; t < 18; ++t) raw[t] = bf2f(*(const LAS bf16_t*)(wl + part * 2304 + t * 128 + lane * 2));
#pragma unroll
              for (int t = 0; t < 16; ++t) { const float u = raw[t + 1], sh = u + (raw[t] - u) * m0 + (raw[t + 2] - u) * m1;
                  if (part == 0) rr[t] = sh; else if (part == 1) kx[t] = sh; else vx[t] = sh; } }
          float s0[8], s1[8];
#pragma unroll
          for (int t = 0; t < 8; ++t) { kn[t] = kx[t] * kkc; kn[t + 8] = kx[t + 8] * kkc; s0[t] = kn[t] * kn[t]; s1[t] = kn[t + 8] * kn[t + 8]; }
          const float t0 = reduce8(s0, lane), t1 = reduce8(s1, lane);
#pragma unroll
          for (int t = 0; t < 8; ++t) { kn[t] *= rsqrtf(fmaxf(__shfl(t0, t * 8, 64), 1e-12f)); kn[t + 8] *= rsqrtf(fmaxf(__shfl(t1, t * 8, 64), 1e-12f)); }
          asm volatile("" ::: "memory");
          if (dir == 0) {
#pragma unroll
              for (int t = 0; t < 16; ++t) *(LAS bf16_t*)(Sv + t * 128 + lane * 2) = (bf16_t)f2bf(vx[t]);
              asm volatile("" ::: "memory");
              bf16_t* vo = VSo + (row0 + lt) * 512 + h * 64 + lc; *(u32x4*)vo = *(const LAS u32x4*)(Sv + lt * 128 + lc * 2); *(u32x4*)(vo + 8) = *(const LAS u32x4*)(Sv + lt * 128 + lc * 2 + 16); }
          *(LAS u32x4*)(wl + lt * 128 + lc * 2) = cur.lw[0]; *(LAS u32x4*)(wl + lt * 128 + lc * 2 + 16) = cur.lw[1];
          *(LAS u32x4*)(wl + 2048 + lt * 128 + lc * 2) = cur.la[0]; *(LAS u32x4*)(wl + 2048 + lt * 128 + lc * 2 + 16) = cur.la[1]; }
        { const int chn = ch + F.nwave; if (chn < NB * 8 * NCHUNK) build_load<DIR>(nxt, p, chn, lane); else nxt = cur; }
        float X[16], Q[16], v[16], bhh[16], khh[16]; float Lc = 0.f;
        { const float w0c = p.in[I_W0][((size_t)l * 2 + dir) * 512 + cc], a0c = p.in[I_A0][((size_t)l * 2 + dir) * 512 + cc], kac = p.in[I_KA][l * 512 + cc], rkc = p.in[I_RK][l * 512 + cc];
          float bs0[8], bs1[8];
#pragma unroll
          for (int t = 0; t < 16; ++t) {
              constexpr int dummy_ = 0; (void)dummy_;
              const int tt = dir ? 15 - t : t; const int o = tt * 128 + lane * 2;
              const float lwv = bf2f(*(const LAS bf16_t*)(wl + o)), lav = bf2f(*(const LAS bf16_t*)(wl + 2048 + o));
              const float r = rr[tt], kp = kx[tt], kkn = kn[tt]; v[t] = vx[tt];
              const float asig = sigmoidf_(a0c + lav), lw = -0.6065306597126334f * sigmoidf_(w0c + lwv);
              const float k = kp * (1.f + (asig - 1.f) * kac), bb = kkn * asig, a = -kkn;
              if (t < 8) bs0[t] = r * k * rkc; else bs1[t - 8] = r * k * rkc;
              const float Lx = Lc; Lc += lw;
              const float at = a * __expf(Lx), rt = r * __expf(Lc), en = __expf(-Lc);
              X[t] = at; Q[t] = rt; bhh[t] = bb * en; khh[t] = k * en;
          }
          const float u0 = reduce8(bs0, lane), u1 = reduce8(bs1, lane);
          if ((lane & 7) == 0) { const int t = lane >> 3; const int tk0 = dir ? 15 - t : t, tk1 = dir ? 7 - t : 8 + t; BON[(row0 + tk0) * 8 + h] = u0; BON[(row0 + tk1) * 8 + h] = u1; } }
        asm volatile("" ::: "memory");
#pragma unroll
        for (int t = 0; t < 16; ++t) {
            *(LAS bf16_t*)(Ta + t * TP_ + lane * 2) = (bf16_t)f2bf(X[t]); *(LAS bf16_t*)(Tr + t * TP_ + lane * 2) = (bf16_t)f2bf(Q[t]);
            *(LAS bf16_t*)(Tb + t * TP_ + lane * 2) = (bf16_t)f2bf(bhh[t]); *(LAS bf16_t*)(Tk + t * TP_ + lane * 2) = (bf16_t)f2bf(khh[t]);
        }
        const float gC = __expf(Lc);
#pragma unroll
        for (int t = 0; t < 16; ++t) { bhh[t] *= gC; khh[t] *= gC; }
        unsigned char* rec = REC + ((size_t)bh * NCHUNK + cidx) * REC_BYTES;
#pragma unroll
        for (int q4 = 0; q4 < 4; ++q4) *(float*)(rec + 8192 + q4 * RC_BYTES + 1536 + lane * 4) = gC;
#pragma unroll
        for (int gg = 0; gg < 4; ++gg) { u32x4 w; w.x = pk2(bhh[4 * gg], bhh[4 * gg + 1]); w.y = pk2(bhh[4 * gg + 2], bhh[4 * gg + 3]); w.z = pk2(khh[4 * gg], khh[4 * gg + 1]); w.w = pk2(khh[4 * gg + 2], khh[4 * gg + 3]);
            *(u32x4*)(rec + 4096 + (lane * 32 + gg * 8) * 2) = w; }
        f32x4 mab = {0.f, 0.f, 0.f, 0.f}, mak = mab, mrb = mab, mrk = mab;
#pragma unroll
        for (int ks = 0; ks < 2; ++ks) { const int o = li * TP_ + (32 * ks + 8 * g) * 2;
            const bf16x8 fa = ld_frag(Ta + o), fr = ld_frag(Tr + o), fb = ld_frag(Tb + o), fk = ld_frag(Tk + o);
            mab = MFMA16(fa, fb, mab); mak = MFMA16(fa, fk, mak); mrb = MFMA16(fr, fb, mrb); mrk = MFMA16(fr, fk, mrk); }
        asm volatile("" ::: "memory");
#pragma unroll
        for (int r = 0; r < 4; ++r) { const int t = 4 * g + r;
            M[t * 16 + li] = li < t ? mab[r] : 0.f; M[256 + t * 16 + li] = li < t ? mak[r] : 0.f;
            M[512 + t * 16 + li] = li <= t ? mrb[r] : 0.f; M[768 + t * 16 + li] = li <= t ? mrk[r] : 0.f; }
        f32x2 XU[16]; float Y0[16];
        XU[0] = (f32x2){X[0], 0.f};
#pragma unroll
        for (int t = 1; t < 16; ++t) { f32x2 xu = {X[t], 0.f}; float u2 = 0.f;
#pragma unroll
            for (int s4 = 0; s4 < 4; ++s4) { if (4 * s4 < t) { const f32x4 ab = *(const LAS f32x4*)(M + t * 16 + 4 * s4), ak = *(const LAS f32x4*)(M + 256 + t * 16 + 4 * s4);
#pragma unroll
                for (int e = 0; e < 4; ++e) { const int s = 4 * s4 + e; if (s < t) { xu = xu + XU[s] * ab[e]; u2 += ak[e] * v[s]; } } } }
            xu.y += u2;
            asm volatile("" : "+v"(xu) :: "memory");
            XU[t] = xu; }
#pragma unroll
        for (int t = 0; t < 16; ++t) { f32x2 qy = {Q[t], 0.f}; float y2 = 0.f;
#pragma unroll
            for (int s4 = 0; s4 < 4; ++s4) { if (4 * s4 <= t) { const f32x4 rb = *(const LAS f32x4*)(M + 512 + t * 16 + 4 * s4), rk = *(const LAS f32x4*)(M + 768 + t * 16 + 4 * s4);
#pragma unroll
                for (int e = 0; e < 4; ++e) { const int s = 4 * s4 + e; if (s <= t) { qy = qy + XU[s] * rb[e]; y2 += rk[e] * v[s]; } } } }
            qy.y += y2;
            asm volatile("" : "+v"(qy) :: "memory");
            Q[t] = qy.x; Y0[t] = qy.y; }
        float U0[16];
#pragma unroll
        for (int t = 0; t < 16; ++t) { X[t] = XU[t].x; U0[t] = XU[t].y; }
        asm volatile("" ::: "memory");
#pragma unroll
        for (int t = 0; t < 16; ++t) { *(LAS bf16_t*)(wl + 4096 + (t * 64 + pj) * 2) = (bf16_t)f2bf(X[t]); *(LAS bf16_t*)(wl + 6144 + (t * 64 + pj) * 2) = (bf16_t)f2bf(Q[t]); }
        asm volatile("" ::: "memory");
#pragma unroll
        for (int k = 0; k < 4; ++k) *(u32x4*)(rec + k * 1024 + lane * 16) = *(const LAS u32x4*)(wl + 4096 + k * 1024 + lane * 16);
        unsigned char* rc = rec + 8192 + g * RC_BYTES + li * 32;
#pragma unroll
        for (int hf = 0; hf < 2; ++hf) { u32x4 w;
            w.x = pk2(v[8 * hf], v[8 * hf + 1]); w.y = pk2(v[8 * hf + 2], v[8 * hf + 3]); w.z = pk2(v[8 * hf + 4], v[8 * hf + 5]); w.w = pk2(v[8 * hf + 6], v[8 * hf + 7]); *(u32x4*)(rc + hf * 16) = w;
            w.x = pk2(U0[8 * hf], U0[8 * hf + 1]); w.y = pk2(U0[8 * hf + 2], U0[8 * hf + 3]); w.z = pk2(U0[8 * hf + 4], U0[8 * hf + 5]); w.w = pk2(U0[8 * hf + 6], U0[8 * hf + 7]); *(u32x4*)(rc + 512 + hf * 16) = w;
            w.x = pk2(Y0[8 * hf], Y0[8 * hf + 1]); w.y = pk2(Y0[8 * hf + 2], Y0[8 * hf + 3]); w.z = pk2(Y0[8 * hf + 4], Y0[8 * hf + 5]); w.w = pk2(Y0[8 * hf + 6], Y0[8 * hf + 7]); *(u32x4*)(rc + 1024 + hf * 16) = w; }
        cur = nxt;
    }
}
constexpr int SC_SLOT = 10240, SC_NSLOT = 13, SC_DEPTH = 6;
__device__ __forceinline__ void scan_dma(const unsigned char* rec, int iq, LAS unsigned char* slot, int lane) {
    const unsigned char* g0 = rec + lane * 16;
#pragma unroll
    for (int k = 0; k < 8; ++k) __builtin_amdgcn_global_load_lds((const unsigned*)(g0 + k * 1024), (LAS unsigned*)(slot + k * 1024), 16, 0, 0);
    const unsigned char* g1 = rec + 8192 + iq * RC_BYTES + lane * 16;
    __builtin_amdgcn_global_load_lds((const unsigned*)g1, (LAS unsigned*)(slot + 8192), 16, 0, 0);
    if (lane < 48) __builtin_amdgcn_global_load_lds((const unsigned*)(g1 + 1024), (LAS unsigned*)(slot + 9216), 16, 0, 0);
}
__device__ __forceinline__ unsigned lds_ld(volatile LAS unsigned* q) { return *q; }
__device__ __forceinline__ void p6b_rwkv_scan(const Params& p, const Frame& F, int dir) {
    volatile LAS unsigned* ctl = (volatile LAS unsigned*)(F.lds + MISC_OFF + 1536);
    if (F.tid < 3) ctl[F.tid] = 0u;
    __syncthreads();
    if (F.wave > 2) return;
    const int lane = F.lane, g = lane >> 4, li = lane & 15;
    const int task = (F.G == 256) ? (F.bid & 7) * 32 + (F.bid >> 3) : F.bid;
    if (task >= NB * 8 * 4) return;
    const int bh = task >> 2, iq = task & 3, b = bh >> 3, h = bh & 7;
    const unsigned char* rec0 = p.ws + WS_REC2 + (size_t)bh * NCHUNK * REC_BYTES;
    if (F.wave != 0) {
        const int hh = F.wave - 1;
        if (p.dry == 1) return;
        asm volatile("s_waitcnt vmcnt(0)" ::: "memory");
#pragma unroll 1
        for (int n = 0; n < NCHUNK / 2; ++n) { const int k = 2 * n + hh;
            while ((int)lds_ld(ctl + 2) + SC_NSLOT <= k) __builtin_amdgcn_s_sleep(1);
            scan_dma(rec0 + (size_t)k * REC_BYTES, iq, F.lds + (k % SC_NSLOT) * SC_SLOT, lane);
            if (n >= 5) { asm volatile("s_waitcnt vmcnt(50)" ::: "memory"); if (lane == 0) ctl[hh] = (unsigned)(n - 4); } }
        asm volatile("s_waitcnt vmcnt(0)" ::: "memory");
        if (lane == 0) ctl[hh] = (unsigned)(NCHUNK / 2);
        return;
    }
    bf16_t* YS = WSB(p, WS_YS2) + (size_t)dir * T * 512;
    f32x4 st[4];
#pragma unroll
    for (int jt = 0; jt < 4; ++jt) st[jt] = (f32x4){0.f, 0.f, 0.f, 0.f};
    struct Ops { bf16x8 ah[2], qq[2], bk[4]; f32x4 gc[4]; u32x2 vt, u0, y0; };
#define SCAN_WAIT(c_) do { const unsigned need_ = (unsigned)((c_) >> 1) + 1u; volatile LAS unsigned* lw_ = ctl + ((c_) & 1); while (lds_ld(lw_) < need_) __builtin_amdgcn_s_sleep(1); asm volatile("" ::: "memory"); } while (0)
#define SCAN_WAIT2(c_) do { const unsigned n1_ = (unsigned)((c_) >> 1) + 1u, n0_ = ((c_) + 2 < NCHUNK) ? (unsigned)((c_) >> 1) + 2u : 0u; \
        for (;;) { const u32x2 fl_ = *(volatile LAS u32x2*)ctl; if (fl_.x >= n0_ && fl_.y >= n1_) break; __builtin_amdgcn_s_sleep(1); } asm volatile("" ::: "memory"); } while (0)
#define SCAN_LOAD(o_, c_) do { const LAS unsigned char* sl_ = F.lds + ((c_) % SC_NSLOT) * SC_SLOT; \
        _Pragma("unroll") for (int ks = 0; ks < 2; ++ks) { o_.ah[ks] = ld_frag(sl_ + (li * 64 + ks * 32 + g * 8) * 2); o_.qq[ks] = ld_frag(sl_ + 2048 + (li * 64 + ks * 32 + g * 8) * 2); } \
        _Pragma("unroll") for (int jt = 0; jt < 4; ++jt) { o_.bk[jt] = ld_frag(sl_ + 4096 + ((16 * jt + li) * 32 + g * 8) * 2); o_.gc[jt] = *(const LAS f32x4*)(sl_ + 8192 + 1536 + (16 * jt + 4 * g) * 4); } \
        o_.vt = *(const LAS u32x2*)(sl_ + 8192 + (li * 16 + 4 * g) * 2); o_.u0 = *(const LAS u32x2*)(sl_ + 8192 + 512 + (li * 16 + 4 * g) * 2); o_.y0 = *(const LAS u32x2*)(sl_ + 8192 + 1024 + (li * 16 + 4 * g) * 2); } while (0)
    const int pmode = p.dry;
    if (pmode == 2) { for (int c = 0; c < NCHUNK; ++c) { SCAN_WAIT(c); if (lane == 0) ctl[2] = (unsigned)(c + 1); } return; }
    Ops o0, o1;
    if (pmode != 1) SCAN_WAIT(0);
    SCAN_LOAD(o0, 0);
    const int rstep = dir ? -512 : 512;
#define SCAN_YPTR(c_) (YS + ((size_t)(b * NP + scan_pos(16 * (c_) + 4 * g, dir))) * 512 + h * 64 + 16 * iq + li)
#define SCAN_STEP(cur_, nxt_, c_) do { \
        const bf16x8 sb0 = pack_frag(st[0], st[1]), sb1 = pack_frag(st[2], st[3]); \
        f32x4 U = {lo16(cur_.u0.x), hi16(cur_.u0.x), lo16(cur_.u0.y), hi16(cur_.u0.y)}, Y = {lo16(cur_.y0.x), hi16(cur_.y0.x), lo16(cur_.y0.y), hi16(cur_.y0.y)}; \
        U = MFMA16(cur_.ah[0], sb0, U); Y = MFMA16(cur_.qq[0], sb0, Y); U = MFMA16(cur_.ah[1], sb1, U); Y = MFMA16(cur_.qq[1], sb1, Y); \
        asm volatile("" ::: "memory"); \
        if ((c_) + 1 < NCHUNK) { if (pmode != 1 && ((c_) & 1) == 0) SCAN_WAIT2(c_); SCAN_LOAD(nxt_, (c_) + 1); } \
        asm volatile("" ::: "memory"); \
        u32x4 uvw; uvw.x = pk2(U[0], U[1]); uvw.y = pk2(U[2], U[3]); uvw.z = cur_.vt.x; uvw.w = cur_.vt.y; \
        const bf16x8 uv = __builtin_bit_cast(bf16x8, uvw); \
        _Pragma("unroll") for (int jt = 0; jt < 4; ++jt) st[jt] = MFMA16(cur_.bk[jt], uv, st[jt] * cur_.gc[jt]); \
        if (pmode == 0) { bf16_t* yp = SCAN_YPTR(c_); _Pragma("unroll") for (int r = 0; r < 4; ++r) yp[r * rstep] = (bf16_t)f2bf(Y[r]); } \
        else if (Y[0] == 1.2345f) YS[0] = 0; \
        asm volatile("s_waitcnt lgkmcnt(0)" ::: "memory"); \
        if (lane == 0) ctl[2] = (unsigned)((c_) + 2); } while (0)
#pragma unroll 1
    for (int c = 0; c < NCHUNK; c += 2) { SCAN_STEP(o0, o1, c); SCAN_STEP(o1, o0, c + 1); }
#undef SCAN_STEP
#undef SCAN_YPTR
#undef SCAN_WAIT
#undef SCAN_WAIT2
#undef SCAN_LOAD
}

__device__ __forceinline__ void p7_rwkv_readout(const Params& p, const Frame& F, int l) {
    const bf16_t* VS = WSB(p, WS_VS2); const float* BON0 = WSF(p, WS_BON); const float* BON1 = BON0 + (size_t)T * 8;
    const bf16_t* YS0 = WSB(p, WS_H); const bf16_t* YS1 = YS0 + (size_t)T * 512;
    const bf16_t* LG = WSB(p, WS_LG); bf16_t* YW = WSB(p, WS_WU) + 1024;
    const int lane = F.lane, c0 = lane * 8;
    const float* ln_g = p.in[I_LNG] + l * 512, *ln_b = p.in[I_LNB] + l * 512;
    for (int row = F.gwave; row < T; row += F.nwave) {
        const size_t off = (size_t)row * 512 + c0;
        float y0[8], y1[8], v[8], g[8];
        unpack8(*(const u32x4*)(YS0 + off), y0); unpack8(*(const u32x4*)(YS1 + off), y1); unpack8(*(const u32x4*)(VS + off), v); unpack8(*(const u32x4*)(LG + off), g);
        const float bs = BON0[(size_t)row * 8 + (lane >> 3)] + BON1[(size_t)row * 8 + (lane >> 3)];
        float y[8], sm = 0.f;
#pragma unroll
        for (int e = 0; e < 8; ++e) { y[e] = y0[e] + y1[e]; sm += y[e]; }
        sm += shfl_xor_f(sm, 1); sm += shfl_xor_f(sm, 2); sm += shfl_xor_f(sm, 4);
        const float mean = sm * (1.f / 64.f); float vs = 0.f;
#pragma unroll
        for (int e = 0; e < 8; ++e) { const float d = y[e] - mean; vs += d * d; }
        vs += shfl_xor_f(vs, 1); vs += shfl_xor_f(vs, 2); vs += shfl_xor_f(vs, 4);
        const float rstd = rsqrtf(vs * (1.f / 64.f) + 64e-5f);
        float lg8[8], lb8[8]; *(f32x4*)lg8 = *(const f32x4*)(ln_g + c0); *(f32x4*)(lg8 + 4) = *(const f32x4*)(ln_g + c0 + 4); *(f32x4*)lb8 = *(const f32x4*)(ln_b + c0); *(f32x4*)(lb8 + 4) = *(const f32x4*)(ln_b + c0 + 4);
        float o[8];
#pragma unroll
        for (int e = 0; e < 8; ++e) o[e] = ((y[e] - mean) * rstd * lg8[e] + lb8[e] + bs * v[e]) * g[e];
        *(u32x4*)(YW + (size_t)row * 1536 + c0) = pack8(o);
    }
}
constexpr int NPHASE = 21;
constexpr int PARAMS_OFF = MISC_OFF + 2048;
__device__ __forceinline__ unsigned rfl(unsigned v) { return (unsigned)__builtin_amdgcn_readfirstlane((int)v); }
template <class Tp> __device__ __forceinline__ Tp* rfl_ptr(Tp* q) { const unsigned long long a = (unsigned long long)q; const unsigned lo = rfl((unsigned)a), hi = rfl((unsigned)(a >> 32)); return (Tp*)(((unsigned long long)hi << 32) | lo); }
__device__ __forceinline__ float rfl_f(float v) { return __builtin_bit_cast(float, rfl(__builtin_bit_cast(unsigned, v))); }
__device__ __forceinline__ Params load_params(LAS unsigned char* lds) {
    unsigned off = PARAMS_OFF; asm volatile("" : "+s"(off) :: "memory");
    const LAS Params* lp = (const LAS Params*)(lds + off);
    Params q;
#pragma unroll
    for (int i = 0; i < 33; ++i) q.in[i] = rfl_ptr(lp->in[i]);
    q.out = rfl_ptr(lp->out); q.ws = rfl_ptr(lp->ws);
#pragma unroll
    for (int i = 0; i < 16; ++i) q.invA[i] = rfl_f(lp->invA[i]);
#pragma unroll
    for (int i = 0; i < 32; ++i) q.invR[i] = rfl_f(lp->invR[i]);
    q.ph_lo = 0; q.ph_hi = 0; q.l_lo = 0; q.l_hi = 0; q.fused = 0; q.do_pro = 0; q.dry = (int)rfl((unsigned)lp->dry); q.pad2 = 0;
    return q;
}
__device__ __forceinline__ unsigned char* load_ws(LAS unsigned char* lds) {
    unsigned off = PARAMS_OFF; asm volatile("" : "+s"(off) :: "memory");
    const LAS Params* lp = (const LAS Params*)(lds + off);
    return rfl_ptr(lp->ws);
}
__device__ __forceinline__ Frame make_frame(LAS unsigned char* lds) {
    Frame F; int tid = threadIdx.x; asm volatile("" : "+v"(tid));
    int bid = blockIdx.x, G = gridDim.x; asm volatile("" : "+s"(bid), "+s"(G));
    F.lds = lds; F.tid = tid; F.lane = tid & 63; F.wave = __builtin_amdgcn_readfirstlane(tid >> 6);
    F.G = G; F.bid = bid; F.gwave = bid * NWAVES + F.wave; F.nwave = G * NWAVES;
    return F;
}
#define SEAM() do { if (fused) { XcdBarrier bar_; bar_.bar = (unsigned*)(load_ws(lds0) + WS_CTL) + CW_BAR; bar_.x = xb_xcc_id(); bar_.st = misc; xcd_barrier(bar_); } } while (0)
#ifndef MK_PHASES
#define MK_PHASES 0xFFFFFFFFu
#endif
#define IN(k) (((MK_PHASES >> (k)) & 1u) && ph_lo <= (k) && (k) < ph_hi)
#define EN(k) ((MK_PHASES >> (k)) & 1u)
#define LP() const Frame F = make_frame(lds0); const Params p = load_params(lds0)

__device__ __forceinline__ void layer_program(LAS unsigned char* const lds0, volatile LAS unsigned* misc, const int l, const int ph_lo, const int ph_hi, const int fused) {
        const bool want_ctx = l < DEPTH - 1;
        if (IN(0) && l == 0) { LP(); p1_cvt_norm1(p, F, l); SEAM(); }
        if (IN(1)) { LP();
            pg8::Gemm g{WSB(p, WS_H), WSB(p, WS_BTIN), T, 7680, 1024}; pg8::StaticOrder S; S.init(T, 7680, F.G, F.bid);
            pg8::EpiInproj E{p.ws};
            pg8::gemm_phase<pg8::EpiInproj, pg8::StaticOrder, PG8_ALIGN, PG8_SP2>(F.lds, g, S, E);
            SEAM(); }
        if (IN(2)) { LP(); p3_prep(p, F, l); SEAM(); }
        if (IN(3)) { LP();
            pg8::Gemm g{WSB(p, WS_H), WSB(p, WS_BTLORA), T, 2560, 256}; pg8::StaticOrder S; S.init(T, 2560, F.G, F.bid);
            pg8::EpiLora E{p.ws};
            pg8::gemm_phase<pg8::EpiLora, pg8::StaticOrder, PG8_ALIGN, PG8_SP2>(F.lds, g, S, E);
            SEAM(); }
        if (IN(5)) { LP(); p6c_rwkv_build<0>(p, F, l); SEAM(); }
        if (IN(6)) { LP(); p6b_rwkv_scan(p, F, 0); SEAM(); }
        if (IN(7)) { LP(); p6c_rwkv_build<1>(p, F, l); SEAM(); }
        if (IN(8)) { LP(); p6b_rwkv_scan(p, F, 1); SEAM(); }
        if (IN(9)) { LP(); p7_rwkv_readout(p, F, l); }
        if (IN(10)) { LP(); p8_ret_kv(p, F, l); SEAM(); }
        if (IN(11)) { LP(); p9_ret_scan(p, F, l); SEAM(); }
        if (IN(12)) { LP(); p10_ret_out(p, F, l, want_ctx); }
        if (IN(13)) { LP(); p11_attention(p, F, want_ctx); SEAM(); }
        if (IN(14)) { LP();
            pg8::Gemm g{WSB(p, WS_YCAT), WSB(p, WS_BTBR), T, 1024, 1536};
            pg8::EpiMergeK E{WSB(p, WS_GL), WSB(p, WS_H)};
            if (want_ctx) { pg8::StaticOrder S; S.init(T, 1024, F.G, F.bid); pg8::gemm_phase<pg8::EpiMergeK, pg8::StaticOrder, PG8_ALIGN, PG8_SP2>(F.lds, g, S, E); }
            else { pg8::LatentOrder S; S.init(1024, F.G, F.bid); pg8::gemm_phase<pg8::EpiMergeK, pg8::LatentOrder, PG8_ALIGN, PG8_SP2>(F.lds, g, S, E); }
            __syncthreads();
            cvt_run<true>(p, F, l, (LAS float*)F.lds, (want_ctx && F.G == 256) ? 32 : 0);
            SEAM(); }
        if (IN(15)) { LP();
            pg8::Gemm g{WSB(p, WS_H), WSB(p, WS_BTOUT), T, 1024, 1024};
            pg8::EpiOut E{p.out, WSF(p, WS_CTXRES), WSF(p, WS_MOD) + (size_t)l * 9 * 6144, p.dry, l == 0 ? p.in[I_X] : p.out, l == 0 ? p.in[I_CTX] : WSF(p, WS_CTXRES)};
            if (want_ctx) { pg8::StaticOrder S; S.init(T, 1024, F.G, F.bid); pg8::gemm_phase<pg8::EpiOut, pg8::StaticOrder, PG8_ALIGN, PG8_SP2>(F.lds, g, S, E); }
            else { pg8::LatentOrder S; S.init(1024, F.G, F.bid); pg8::gemm_phase<pg8::EpiOut, pg8::LatentOrder, PG8_ALIGN, PG8_SP2>(F.lds, g, S, E); }
            SEAM(); }
        if (IN(16)) { LP(); p14_norm2_router(p, F, l, want_ctx); SEAM(); }
        if (IN(17)) { LP(); p15_scatter(p, F, l, want_ctx); SEAM(); }
        if (IN(18)) { LP();
            moe_build_tab(p, F, l);
            pg8::Gemm g{WSB(p, WS_BUF), WSB(p, WS_BT1), MOE_NBLK * 256, 1024, 1024};
            typedef pg8::MoeOrder<(size_t)1024 * 1024 * 2> Ord; Ord S{F.G, F.bid, (const PG8_LAS int*)(F.lds + MISC_OFF + 64)};
            pg8::EpiSwiGLU E{WSB(p, WS_HB)};
            pg8::gemm_phase<pg8::EpiSwiGLU, Ord, PG8_ALIGN, PG8_SP2>(F.lds, g, S, E);
            SEAM(); }
        if (IN(19)) { LP();
            moe_build_tab(p, F, l);
            pg8::Gemm g{WSB(p, WS_HB), WSB(p, WS_BT2), MOE_NBLK * 256, 1024, 512};
            typedef pg8::MoeOrder<(size_t)1024 * 512 * 2> Ord; Ord S{F.G, F.bid, (const PG8_LAS int*)(F.lds + MISC_OFF + 64)};
            pg8::EpiPlainBf16 E{WSB(p, WS_YB), 1024};
            pg8::gemm_phase<pg8::EpiPlainBf16, Ord, PG8_ALIGN, PG8_SP2>(F.lds, g, S, E);
            SEAM(); }
        if (IN(20)) { LP(); p18_combine(p, F, l, want_ctx); if (l + 1 < DEPTH) p1_weights(p, F, l + 1); SEAM(); }
    }
__global__ void __launch_bounds__(NTHREADS, 2) mk_fwd(Params kp) {
    extern __shared__ __attribute__((aligned(16))) unsigned char lds_raw[];
    LAS unsigned char* const lds0 = (LAS unsigned char*)lds_raw;
    volatile LAS unsigned* misc = (volatile LAS unsigned*)(lds0 + MISC_OFF);
    if (threadIdx.x < 4) misc[threadIdx.x] = 0u;
    if (threadIdx.x == 0) { LAS Params* lp = (LAS Params*)(lds0 + PARAMS_OFF);
#pragma unroll
        for (int i = 0; i < 33; ++i) lp->in[i] = kp.in[i];
        lp->out = kp.out; lp->ws = kp.ws;
#pragma unroll
        for (int i = 0; i < 16; ++i) lp->invA[i] = kp.invA[i];
#pragma unroll
        for (int i = 0; i < 32; ++i) lp->invR[i] = kp.invR[i];
        lp->dry = kp.dry; }
    __syncthreads();
    const int ph_lo = kp.ph_lo, ph_hi = kp.ph_hi, fused = kp.fused;
    if (fused) (void)xcd_barrier_post((unsigned*)(kp.ws + WS_CTL) + CW_BAR, misc);
    if (((MK_PHASES >> 31) & 1u) && kp.do_pro) { LP(); p0_prologue(p, F); SEAM(); }

#if MK_FUSED
    layer_program(lds0, misc, 0, ph_lo, ph_hi, fused);
    layer_program(lds0, misc, 1, ph_lo, ph_hi, fused);
    layer_program(lds0, misc, 2, ph_lo, ph_hi, fused);
    layer_program(lds0, misc, 3, ph_lo, ph_hi, fused);
#else
    if (kp.l_lo < kp.l_hi) layer_program(lds0, misc, kp.l_lo, ph_lo, ph_hi, fused);
#endif
#undef IN
#undef SEAM
}

#ifndef MK_REP_MASK
#define MK_REP_MASK 0u
#define MK_REP_N 0
#endif
#ifndef MK_DRY_MODE
#define MK_DRY_MODE 1
#endif
extern "C" void kernel_launch(void* const* d_in, const int* in_sizes, int n_in, void* d_out, int out_size, void* d_ws, size_t ws_size, hipStream_t stream) {
    static int grid = 0;
    if (grid == 0) {
        if (n_in != 33 || in_sizes[0] != NB * NLAT * D || out_size != NB * NLAT * D || ws_size < WS_NEED) {
            fprintf(stderr, "kernel_launch: unexpected shapes/workspace: n_in %d in0 %d out %d ws %zu (need %zu)\n", n_in, n_in > 0 ? in_sizes[0] : -1, out_size, ws_size, (size_t)WS_NEED); grid = -1; return; }
        int dev = 0, cus = 0, per_cu = 0;
        if (hipGetDevice(&dev) != hipSuccess || hipDeviceGetAttribute(&cus, hipDeviceAttributeMultiprocessorCount, dev) != hipSuccess) { grid = -1; return; }
        if (hipFuncSetAttribute((const void*)mk_fwd, hipFuncAttributeMaxDynamicSharedMemorySize, LDS_BYTES) != hipSuccess) { fprintf(stderr, "kernel_launch: hipFuncSetAttribute failed\n"); grid = -1; return; }
        if (hipOccupancyMaxActiveBlocksPerMultiprocessor(&per_cu, (const void*)mk_fwd, NTHREADS, LDS_BYTES) != hipSuccess || per_cu < 1)
            fprintf(stderr, "kernel_launch: occupancy query reports %d workgroups per CU\n", per_cu);
        (void)hipGetLastError();
        grid = cus;
    }
    if (grid < 0) return;
    if (hipMemsetAsync((char*)d_ws + WS_CTL, 0, CTL_BYTES, stream) != hipSuccess) { fprintf(stderr, "kernel_launch: memset failed\n"); return; }
    Params a{};
    for (int i = 0; i < 33; ++i) a.in[i] = (const float*)d_in[i];
    a.out = (float*)d_out; a.ws = (unsigned char*)d_ws;
    for (int i = 0; i < 16; ++i) a.invA[i] = (float)pow(10000.0, -(double)i / 16.0);
    for (int i = 0; i < 32; ++i) a.invR[i] = (float)pow(10000.0, -(double)i / 32.0);
#if MK_FUSED
    a.ph_lo = 0; a.ph_hi = NPHASE; a.l_lo = 0; a.l_hi = DEPTH; a.fused = 1; a.do_pro = 1;
    hipLaunchKernelGGL(mk_fwd, dim3(grid), dim3(NTHREADS), LDS_BYTES, stream, a);
    if (hipPeekAtLastError() != hipSuccess) fprintf(stderr, "kernel_launch: launch failed\n");
#else
    a.fused = 0; a.do_pro = 1; a.l_lo = 0; a.l_hi = 0; a.ph_lo = 0; a.ph_hi = 0;
    hipLaunchKernelGGL(mk_fwd, dim3(grid), dim3(NTHREADS), LDS_BYTES, stream, a);
    a.do_pro = 0;
    for (int l = 0; l < DEPTH; ++l)
        for (int ph = 0; ph < NPHASE; ++ph) { a.l_lo = l; a.l_hi = l + 1; a.ph_lo = ph; a.ph_hi = ph + 1;
            const int reps = 1 + (((MK_REP_MASK >> ph) & 1u) ? MK_REP_N : 0);
            for (int r = 0; r < reps; ++r) { a.dry = r > 0 ? MK_DRY_MODE : 0; hipLaunchKernelGGL(mk_fwd, dim3(grid), dim3(NTHREADS), LDS_BYTES, stream, a); } a.dry = 0; }
    if (hipPeekAtLastError() != hipSuccess) fprintf(stderr, "kernel_launch: launch failed\n");
#endif
}
```

```cpp
#include <hip/hip_runtime.h>
#include <cstdio>
#include <cstdint>

#ifndef MK_FUSED
#define MK_FUSED 1
#endif

constexpr int D = 1024, NB = 8, NLAT = 4096, NCTX = 256, NP = NLAT + NCTX, T = NB * NP, DEPTH = 4;
constexpr int TP = T / 256;
constexpr int NPAIR_MAX = 2 * T;
constexpr int MOE_NBLK = NPAIR_MAX / 256 + 32;
constexpr int NTHREADS = 512, NWAVES = 8;

typedef unsigned short bf16_t;
typedef short bf16x8 __attribute__((ext_vector_type(8)));
typedef short bf16x4 __attribute__((ext_vector_type(4)));
typedef float f32x4 __attribute__((ext_vector_type(4)));
typedef float f32x2 __attribute__((ext_vector_type(2)));
typedef unsigned u32x4 __attribute__((ext_vector_type(4)));
typedef unsigned u32x2 __attribute__((ext_vector_type(2)));
#define LAS __attribute__((address_space(3)))

constexpr size_t AL(size_t x) { return (x + 255) & ~(size_t)255; }
constexpr size_t WS_CTL = 0, CTL_BYTES = 65536;
constexpr int CW_BAR = 0;
constexpr int CW_CNT = 4096;
constexpr size_t WS_MOD = AL(WS_CTL + CTL_BYTES);
constexpr size_t WS_ROPE = AL(WS_MOD + (size_t)DEPTH * 9 * 6144 * 4);
constexpr size_t WS_RWT = AL(WS_ROPE + (size_t)(2 * 64 * 16 + 2 * 64 * 32) * 4);
constexpr size_t WS_RW2 = AL(WS_RWT + (size_t)DEPTH * 36 * 1024 * 4);
constexpr size_t WS_RC = AL(WS_RW2 + (size_t)DEPTH * 64 * 3 * 4 * 16 * 4 * 4);
constexpr size_t WS_CTXRES = AL(WS_RC + (size_t)DEPTH * 9 * 48 * 4);
constexpr size_t WS_BTIN = AL(WS_CTXRES + (size_t)NB * NCTX * D * 4);
constexpr size_t WS_BTBR = AL(WS_BTIN + (size_t)7680 * 1024 * 2);
constexpr size_t WS_BTOUT = AL(WS_BTBR + (size_t)3 * 1024 * 512 * 2);
constexpr size_t WS_BTLORA = AL(WS_BTOUT + (size_t)1024 * 1024 * 2);
constexpr size_t WS_H = AL(WS_BTLORA + (size_t)2560 * 256 * 2);
constexpr size_t WS_M0 = AL(WS_H + (size_t)T * 1024 * 2);
constexpr size_t SZ512 = (size_t)T * 512 * 2;
constexpr size_t WS_AQ = WS_M0;
constexpr size_t WS_AKV = AL(WS_AQ + SZ512);
constexpr size_t WS_RQ = AL(WS_AKV + (size_t)T * 256 * 2);
constexpr size_t WS_RK = AL(WS_RQ + SZ512);
constexpr size_t WS_RV = AL(WS_RK + SZ512);
constexpr size_t WS_RG = AL(WS_RV + SZ512);
constexpr size_t WS_GL = AL(WS_RG + SZ512);
constexpr size_t WS_WU = AL(WS_GL + (size_t)T * 3072 * 2);
constexpr size_t WS_LW = AL(WS_WU + (size_t)T * 1792 * 2);
constexpr size_t WS_LA = AL(WS_LW + (size_t)T * 1024 * 2);
constexpr size_t WS_LG = AL(WS_LA + (size_t)T * 1024 * 2);
constexpr size_t WS_W1 = AL(WS_LG + SZ512);
constexpr size_t WS_END_MIX = AL(WS_W1 + 9 * SZ512);
constexpr size_t WS_YS = WS_LW;
constexpr size_t WS_SF = WS_WU + 3 * SZ512;
constexpr size_t WS_SB = AL(WS_SF + (size_t)NB * 4 * 34 * 16384 * 2);
static_assert(WS_SB + (size_t)NB * 4 * 34 * 16384 * 2 <= WS_LG, "retention states fit behind YCAT inside WU|LW|LA");
constexpr size_t WS_BT1 = WS_M0;
constexpr size_t WS_BT2 = AL(WS_BT1 + (size_t)32 * 1024 * 1024 * 2);
constexpr size_t WS_BUF = AL(WS_BT2 + (size_t)32 * 1024 * 512 * 2);
constexpr size_t WS_HB = AL(WS_BUF + (size_t)MOE_NBLK * 256 * 1024 * 2);
constexpr size_t WS_YB = AL(WS_HB + (size_t)MOE_NBLK * 256 * 512 * 2);
constexpr size_t WS_PAIR = AL(WS_YB + (size_t)MOE_NBLK * 256 * 1024 * 2);
constexpr size_t WS_RSROW = AL(WS_PAIR + (size_t)4 * NPAIR_MAX * 4);
constexpr size_t WS_END_MOE = AL(WS_RSROW + (size_t)T * 4);
static_assert(WS_END_MOE <= WS_END_MIX, "moe overlay inside the mixer region");
constexpr size_t WS_NEED = WS_END_MIX;
static_assert(WS_NEED <= 1220000000ull, "workspace budget (sum of inputs = 1220.39 MB)");

constexpr int RING_BYTES = 131072;
constexpr int LDS_BYTES = 147456;
constexpr int MISC_OFF = LDS_BYTES - 4096;

struct Params {
    const float* in[33];
    float* out;
    unsigned char* ws;
    float invA[16];
    float invR[32];
    int ph_lo, ph_hi, l_lo, l_hi;
    int fused, do_pro;
    int dry, pad2;
};
enum { I_X = 0, I_C, I_CTX, I_CCTX, I_ADAW, I_ADAB, I_N1G, I_N2G, I_WIN, I_QNG, I_KNG, I_RDL, I_RGN, I_MU, I_W0, I_W2, I_A0, I_A2, I_G2, I_KK, I_KA, I_RK, I_LNG, I_LNB,
       I_WBR, I_WOUT, I_RGW, I_RGB, I_REW, I_REB, I_MG, I_MUP, I_MD };

__device__ __forceinline__ float bf2f(unsigned v) { return __builtin_bit_cast(float, v << 16); }
__device__ __forceinline__ unsigned f2bf(float f) { return (unsigned)__builtin_bit_cast(unsigned short, (__bf16)f); }
typedef __bf16 hwbf16x2 __attribute__((ext_vector_type(2)));
__device__ __forceinline__ unsigned pk2(float lo, float hi) { const f32x2 v = {lo, hi}; return __builtin_bit_cast(unsigned, __builtin_convertvector(v, hwbf16x2)); }
__device__ __forceinline__ float lo16(unsigned w) { return __builtin_bit_cast(float, w << 16); }
__device__ __forceinline__ float hi16(unsigned w) { return __builtin_bit_cast(float, w & 0xffff0000u); }
__device__ __forceinline__ void unpack8(const u32x4 v, float (&x)[8]) { x[0] = lo16(v.x); x[1] = hi16(v.x); x[2] = lo16(v.y); x[3] = hi16(v.y); x[4] = lo16(v.z); x[5] = hi16(v.z); x[6] = lo16(v.w); x[7] = hi16(v.w); }
__device__ __forceinline__ u32x4 pack8(const float (&x)[8]) { u32x4 v; v.x = pk2(x[0], x[1]); v.y = pk2(x[2], x[3]); v.z = pk2(x[4], x[5]); v.w = pk2(x[6], x[7]); return v; }
__device__ __forceinline__ float frcp(float x) { return __builtin_amdgcn_rcpf(x); }
__device__ __forceinline__ float sigmoidf_(float x) { return frcp(1.f + __expf(-x)); }
__device__ __forceinline__ float siluf_(float x) { return x * frcp(1.f + __expf(-x)); }
__device__ __forceinline__ float shfl_xor_f(float v, int m) { return __shfl_xor(v, m, 64); }
__device__ __forceinline__ float* xrow(const Params& p, int row) {
    const int b = row / NP, q = row - b * NP;
    return q < NCTX ? (float*)(p.ws + WS_CTXRES) + (size_t)(b * NCTX + q) * D : p.out + (size_t)(b * NLAT + (q - NCTX)) * D;
}
__device__ __forceinline__ bf16x8 ld_frag(const LAS unsigned char* p) { return *(const LAS bf16x8*)p; }
__device__ __forceinline__ bf16x4 tr_read(const LAS unsigned char* p) { return __builtin_amdgcn_ds_read_tr16_b64_v4i16((LAS bf16x4*)p); }
__device__ __forceinline__ bf16x8 cat44(bf16x4 a, bf16x4 b) { bf16x8 r; r[0] = a[0]; r[1] = a[1]; r[2] = a[2]; r[3] = a[3]; r[4] = b[0]; r[5] = b[1]; r[6] = b[2]; r[7] = b[3]; return r; }
__device__ __forceinline__ bf16x8 pack_frag(const f32x4 a, const f32x4 b) {
    u32x4 w; w.x = pk2(a[0], a[1]); w.y = pk2(a[2], a[3]); w.z = pk2(b[0], b[1]); w.w = pk2(b[2], b[3]); return __builtin_bit_cast(bf16x8, w);
}
#define MFMA16(a, b, c) __builtin_amdgcn_mfma_f32_16x16x32_bf16((a), (b), (c), 0, 0, 0)

#define XB_TMO      128
#define XB_XCNT(j)  (256  + 64 * (j))
#define XB_XSUB(j)  (1280 + 64 * (j))
#define XB_XGEN(j)  (2304 + 64 * (j))
#define XB_TOP      3328
#define XB_TOPGEN   3392
#define XCD_BAR_WORDS 3456
#define XB_SPIN_CAP (1u << 18)
__device__ __forceinline__ unsigned xb_ld(unsigned* p)              { return __hip_atomic_load(p, __ATOMIC_RELAXED, __HIP_MEMORY_SCOPE_AGENT); }
__device__ __forceinline__ unsigned xb_add(unsigned* p, unsigned v) { return __hip_atomic_fetch_add(p, v, __ATOMIC_RELAXED, __HIP_MEMORY_SCOPE_AGENT); }
__device__ __forceinline__ unsigned xb_xcc_id() { return (unsigned)__builtin_amdgcn_s_getreg((3 << 11) | 20) & 0xFu; }
#define XB_SPIN(cond, bar) do { unsigned _sp = 0; while (cond) { __builtin_amdgcn_s_sleep(1); \
    if ((++_sp & 255u) == 0u) { if (xb_ld(&(bar)[XB_TMO])) break; if (_sp > XB_SPIN_CAP) { atomicAdd(&(bar)[XB_TMO], 1u); break; } } } } while (0)
struct XcdBarrier { unsigned* bar; unsigned x; volatile LAS unsigned* st; };
__device__ __forceinline__ XcdBarrier xcd_barrier_post(unsigned* bar, volatile LAS unsigned* st) {
    XcdBarrier b; b.bar = bar; b.x = xb_xcc_id(); b.st = st;
    if (threadIdx.x == 0) (void)xb_add(&bar[XB_XCNT(b.x)], 1u);
    return b;
}
__device__ __forceinline__ void xcd_barrier_complete(unsigned* bar, unsigned x, unsigned& nloc, unsigned& nx) {
    const unsigned G = gridDim.x * gridDim.y * gridDim.z;
    unsigned sum, cnt, mine, sp = 0u;
    for (;;) {
        sum = 0u; cnt = 0u; mine = 0u;
#pragma unroll
        for (unsigned j = 0; j < 16; ++j) { const unsigned c = xb_ld(&bar[XB_XCNT(j)]); sum += c; cnt += (c > 0u) ? 1u : 0u; mine = (j == x) ? c : mine; }
        if (sum == G) break;
        __builtin_amdgcn_s_sleep(1);
        if ((++sp & 255u) == 0u) { if (xb_ld(&bar[XB_TMO])) break; if (sp > XB_SPIN_CAP) { atomicAdd(&bar[XB_TMO], 1u); break; } }
    }
    nloc = mine > 0u ? mine : 1u; nx = cnt > 0u ? cnt : 1u;
}
__device__ __forceinline__ void xcd_barrier(const XcdBarrier& b) {
    asm volatile("s_waitcnt vmcnt(0)" ::: "memory");
    __syncthreads();
    if (threadIdx.x == 0) {
        unsigned* bar = b.bar;
        __builtin_amdgcn_s_waitcnt(0);
        unsigned nloc = b.st[0], nx = b.st[1];
        if (nloc == 0u) { xcd_barrier_complete(bar, b.x, nloc, nx); b.st[0] = nloc; b.st[1] = nx; }
        const unsigned old = xb_add(&bar[XB_XSUB(b.x)], 1u);
        const unsigned gen = old / nloc;
        if (old + 1u == (gen + 1u) * nloc) {
            __builtin_amdgcn_fence(__ATOMIC_RELEASE, "agent");
            asm volatile("s_waitcnt vmcnt(0)" ::: "memory");
            const unsigned og = xb_add(&bar[XB_TOP], 1u);
            const unsigned tg = og / nx;
            if (og + 1u == (tg + 1u) * nx) xb_add(&bar[XB_TOPGEN], 1u);
            else XB_SPIN(xb_ld(&bar[XB_TOPGEN]) == tg, bar);
            __builtin_amdgcn_fence(__ATOMIC_ACQUIRE, "agent");
            xb_add(&bar[XB_XGEN(b.x)], 1u);
            asm volatile("s_waitcnt vmcnt(0)" ::: "memory");
        } else {
            XB_SPIN(xb_ld(&bar[XB_XGEN(b.x)]) == gen, bar);
            __builtin_amdgcn_fence(__ATOMIC_ACQUIRE, "agent");
            asm volatile("s_waitcnt vmcnt(0)" ::: "memory");
        }
    }
    __syncthreads();
}
namespace pg8 {
#define PG8_LAS __attribute__((address_space(3)))
typedef unsigned short bf16_t;
typedef short bf16x8 __attribute__((ext_vector_type(8)));
typedef float f32x4 __attribute__((ext_vector_type(4)));
typedef unsigned u32x4 __attribute__((ext_vector_type(4)));
constexpr int BM = 256, BK = 64, HALF = 128, HTB = HALF * BK * 2  , STAGE_BYTES = 8 * HTB, NXCD = 8, WGM = 8;

__host__ __device__ __forceinline__ int lds_byte(int r, int c) { const int st = (r >> 4) * 2 + (c >> 5), rr = r & 15, cc = c & 31, ob = rr * 64 + cc * 2; return st * 1024 + (ob ^ (((ob >> 9) & 1) << 5)); }
__host__ __device__ __forceinline__ void stage_rc(int b, int& R, int& C) { const int st = b / 1024, sb = b % 1024, swz = sb ^ (((sb >> 9) & 1) << 5); R = (st >> 1) * 16 + swz / 64; C = (st & 1) * 32 + (swz % 64) / 2; }
__host__ __device__ __forceinline__ int perm32(int rho) { const int n = rho >> 4, i = rho & 15; return 8 * (i >> 2) + 4 * n + (i & 3); }

struct Unit { int pm, pn; size_t bofs; };
struct Gemm { const bf16_t* A; const bf16_t* Bt; int M, N, K; };

struct StaticOrder {
    int nM, nN, nwg, G, c;
    __host__ __device__ void init(int M, int N, int G_, int c_) { nM = M / BM; nN = N / BM; nwg = nM * nN; G = G_; c = c_; }
    __host__ __device__ bool next(int i, Unit& u) const {
        const long L = (long)i * G + c; if (L >= nwg) return false;
        int wgid = (int)L; { const int q = nwg / NXCD, r = nwg % NXCD, xcd = wgid % NXCD, off = wgid / NXCD; wgid = (xcd < r ? xcd * (q + 1) : r * (q + 1) + (xcd - r) * q) + off; }
        const int nig = WGM * nN, gid = wgid / nig, fm = gid * WGM, gsz = (nM - fm) < WGM ? (nM - fm) : WGM;
        u.pm = fm + ((wgid % nig) % gsz); u.pn = (wgid % nig) / gsz; u.bofs = 0; return true;
    }
    __device__ __forceinline__ void a_ready(const Unit&) const {}
    __device__ __forceinline__ void done(const Unit&) const {}
};

__device__ __forceinline__ unsigned cvt_pk_bf16(float lo, float hi) { unsigned r; asm volatile("v_cvt_pk_bf16_f32 %0, %1, %2" : "=v"(r) : "v"(lo), "v"(hi)); return r; }
template <class Epi, class Sched, bool ALIGN_EPI = false, bool SP2 = false>
__device__ __forceinline__ void gemm_phase(PG8_LAS unsigned char* lds, const Gemm g, const Sched& S, const Epi& E) {
    int tid_ = threadIdx.x; asm volatile("" : "+v"(tid_)); const int tid = tid_, wid = __builtin_amdgcn_readfirstlane(tid >> 6), lane = tid & 63, wr = wid >> 2, wc = wid & 3, fr = lane & 15, fq = lane >> 4;
    int K = g.K; asm volatile("" : "+s"(K)); const int nt = K / BK;
    unsigned voffA[2], voffB[2];
#pragma unroll
    for (int i = 0; i < 2; ++i) { int R, C; stage_rc(tid * 16 + i * 8192, R, C); const int Rb = Epi::PERM ? ((R & ~31) + perm32(R & 31)) : R;
        voffA[i] = (unsigned)(R * K + C) * 2u; voffB[i] = (unsigned)(Rb * K + C) * 2u; }
    const size_t kstep = (size_t)(BK * 2);
    const size_t hstep = (size_t)HALF * K * 2;
    const size_t tstep = 2 * hstep;
    const unsigned ldsw = (unsigned)wid * 1024u;
    const int aoff = lds_byte(wr * 64 + fr, fq * 8), boff = lds_byte(wc * 32 + fr, fq * 8);
#define PG8_SA(b, h) (((b) * 2 + (h)) * HTB)
#define PG8_SB(b, h) ((4 + (b) * 2 + (h)) * HTB)
#define PG8_STAGE(bufoff, gbase, voff) do { _Pragma("unroll") for (int _i = 0; _i < 2; ++_i) \
        __builtin_amdgcn_global_load_lds((const unsigned*)((const char*)(gbase) + (voff)[_i]), (PG8_LAS unsigned*)(lds + (bufoff) + ldsw + _i * 8192), 16, 0, 0); } while (0)
#define PG8_LDA(dst, b, h) do { _Pragma("unroll") for (int m = 0; m < 4; ++m) _Pragma("unroll") for (int k = 0; k < 2; ++k) dst[m][k] = *(const PG8_LAS bf16x8*)(lds + PG8_SA(b, h) + aoff + m * 2048 + k * 1024); } while (0)
#define PG8_LDB(dst, b, h) do { _Pragma("unroll") for (int n = 0; n < 2; ++n) _Pragma("unroll") for (int k = 0; k < 2; ++k) dst[n][k] = *(const PG8_LAS bf16x8*)(lds + PG8_SB(b, h) + boff + n * 2048 + k * 1024); } while (0)
#define PG8_MMA(ai, bj, At, Bt) do { __builtin_amdgcn_s_setprio(1); _Pragma("unroll") for (int m = 0; m < 4; ++m) _Pragma("unroll") for (int n = 0; n < 2; ++n) _Pragma("unroll") for (int k = 0; k < 2; ++k) \
        acc[ai][bj][m][n] = __builtin_amdgcn_mfma_f32_16x16x32_bf16(Bt[n][k], At[m][k], acc[ai][bj][m][n], 0, 0, 0); __builtin_amdgcn_s_setprio(0); } while (0)
#define PG8_WAIT_V(n) asm volatile("s_waitcnt vmcnt(" #n ")" ::: "memory")
#define PG8_WAIT_L(n) asm volatile("s_waitcnt lgkmcnt(" #n ")" ::: "memory")
#define PG8_BAR __builtin_amdgcn_s_barrier()
#define PG8_SCHED __builtin_amdgcn_sched_barrier(0)
    Unit cur, nxt; int ui = 0;
    if (!S.next(0, cur)) return;
    f32x4 acc[2][2][4][2];
#pragma unroll
    for (int a = 0; a < 2; ++a)
#pragma unroll
        for (int b = 0; b < 2; ++b)
#pragma unroll
            for (int m = 0; m < 4; ++m)
#pragma unroll
                for (int n = 0; n < 2; ++n) acc[a][b][m][n] = (f32x4){0.f, 0.f, 0.f, 0.f};
    bf16x8 At[4][2], B0[2][2], B1[2][2];
    const char* cA = (const char*)g.A + (size_t)cur.pm * tstep; const char* cB = (const char*)g.Bt + cur.bofs + (size_t)cur.pn * tstep;
    S.a_ready(cur);
    if constexpr (SP2) {
        PG8_STAGE(PG8_SB(0, 0), cB, voffB); PG8_STAGE(PG8_SB(0, 1), cB + hstep, voffB); PG8_STAGE(PG8_SA(0, 0), cA, voffA); PG8_STAGE(PG8_SA(0, 1), cA + hstep, voffA);
        if (wr == 1) PG8_BAR;
        PG8_WAIT_V(2); PG8_BAR;
        PG8_STAGE(PG8_SB(1, 0), cB + kstep, voffB); PG8_STAGE(PG8_SA(1, 0), cA + kstep, voffA); PG8_STAGE(PG8_SB(1, 1), cB + hstep + kstep, voffB);
        PG8_WAIT_V(6); PG8_BAR;
    } else {
        PG8_STAGE(PG8_SB(0, 0), cB, voffB); PG8_STAGE(PG8_SA(0, 0), cA, voffA); PG8_STAGE(PG8_SB(0, 1), cB + hstep, voffB); PG8_STAGE(PG8_SA(0, 1), cA + hstep, voffA);
        if (wr == 1) PG8_BAR;
        PG8_WAIT_V(4); PG8_BAR;
        PG8_STAGE(PG8_SB(1, 0), cB + kstep, voffB); PG8_STAGE(PG8_SA(1, 0), cA + kstep, voffA); PG8_STAGE(PG8_SB(1, 1), cB + hstep + kstep, voffB);
        PG8_WAIT_V(6); PG8_BAR;
    }
    for (;;) {
        const bool has_next = S.next(ui + 1, nxt);
        const char* nA = has_next ? (const char*)g.A + (size_t)nxt.pm * tstep : cA; const char* nB = has_next ? (const char*)g.Bt + nxt.bofs + (size_t)nxt.pn * tstep : cB;
        for (int t = 0; t < nt; t += 2) {
            const bool last = (t == nt - 2);
            if constexpr (Epi::KHOOK) { if (t == 8 || t == 16) E.khook(acc, cur, wr, wc, fr, fq, t >> 3); }
            const char* a1 = cA + (size_t)(t + 1) * kstep;
            const char* a2 = last ? nA : cA + (size_t)(t + 2) * kstep; const char* b2 = last ? nB : cB + (size_t)(t + 2) * kstep;
            const char* a3 = a2 + kstep; const char* b3 = b2 + kstep;
            if (last && has_next) S.a_ready(nxt);
            if constexpr (SP2) {
            PG8_LDB(B0, 0, 0); PG8_LDB(B1, 0, 1); PG8_SCHED; PG8_LDA(At, 0, 0); PG8_STAGE(PG8_SA(1, 1), a1 + hstep, voffA);
            PG8_WAIT_V(8); PG8_WAIT_L(0); PG8_BAR; PG8_MMA(0, 0, At, B0); PG8_MMA(0, 1, At, B1); PG8_BAR; PG8_SCHED;
            PG8_LDA(At, 0, 1); PG8_STAGE(PG8_SB(0, 0), b2, voffB); PG8_STAGE(PG8_SB(0, 1), b2 + hstep, voffB); PG8_STAGE(PG8_SA(0, 0), a2, voffA);
            PG8_WAIT_V(8); PG8_WAIT_L(0); PG8_BAR; PG8_MMA(1, 0, At, B0); PG8_MMA(1, 1, At, B1); PG8_BAR; PG8_SCHED;
            PG8_LDB(B0, 1, 0); PG8_LDB(B1, 1, 1); PG8_SCHED; PG8_LDA(At, 1, 0); PG8_STAGE(PG8_SA(0, 1), a2 + hstep, voffA);
            PG8_WAIT_V(8); PG8_WAIT_L(0); PG8_BAR; PG8_MMA(0, 0, At, B0); PG8_MMA(0, 1, At, B1); PG8_BAR; PG8_SCHED;
            PG8_LDA(At, 1, 1); PG8_STAGE(PG8_SB(1, 0), b3, voffB); PG8_STAGE(PG8_SB(1, 1), b3 + hstep, voffB); PG8_STAGE(PG8_SA(1, 0), a3, voffA);
            PG8_WAIT_V(8); PG8_WAIT_L(0); PG8_BAR; PG8_MMA(1, 0, At, B0); PG8_MMA(1, 1, At, B1); PG8_BAR; PG8_SCHED;
            } else {
            PG8_LDB(B0, 0, 0); PG8_SCHED; PG8_LDA(At, 0, 0); PG8_STAGE(PG8_SA(1, 1), a1 + hstep, voffA);
            PG8_WAIT_L(8); PG8_BAR; PG8_WAIT_L(0); PG8_MMA(0, 0, At, B0); PG8_BAR; PG8_SCHED;
            PG8_LDB(B1, 0, 1); PG8_STAGE(PG8_SB(0, 0), b2, voffB);
            PG8_BAR; PG8_WAIT_L(0); PG8_MMA(0, 1, At, B1); PG8_BAR;
            PG8_LDA(At, 0, 1); PG8_STAGE(PG8_SA(0, 0), a2, voffA);
            PG8_BAR; PG8_WAIT_L(0); PG8_MMA(1, 0, At, B0); PG8_BAR; PG8_SCHED;
            PG8_STAGE(PG8_SB(0, 1), b2 + hstep, voffB);
            PG8_WAIT_V(6); PG8_BAR; PG8_MMA(1, 1, At, B1); PG8_BAR;
            PG8_LDB(B0, 1, 0); PG8_SCHED; PG8_LDA(At, 1, 0); PG8_STAGE(PG8_SA(0, 1), a2 + hstep, voffA);
            PG8_WAIT_L(8); PG8_BAR; PG8_WAIT_L(0); PG8_MMA(0, 0, At, B0); PG8_BAR; PG8_SCHED;
            PG8_LDB(B1, 1, 1); PG8_STAGE(PG8_SB(1, 0), b3, voffB);
            PG8_BAR; PG8_WAIT_L(0); PG8_MMA(0, 1, At, B1); PG8_BAR;
            PG8_LDA(At, 1, 1); PG8_STAGE(PG8_SA(1, 0), a3, voffA);
            PG8_BAR; PG8_WAIT_L(0); PG8_MMA(1, 0, At, B0); PG8_BAR; PG8_SCHED;
            PG8_STAGE(PG8_SB(1, 1), b3 + hstep, voffB);
            PG8_WAIT_V(6); PG8_BAR; PG8_MMA(1, 1, At, B1); PG8_BAR;
            }
        }
        if constexpr (ALIGN_EPI) { if (wr == 0) PG8_BAR; }
        if constexpr (!Epi::AFTER_DRAIN) { E(acc, cur, wr, wc, fr, fq); S.done(cur); }
        if (!has_next) break;
#pragma unroll
        for (int a = 0; a < 2; ++a)
#pragma unroll
            for (int b = 0; b < 2; ++b)
#pragma unroll
                for (int m = 0; m < 4; ++m)
#pragma unroll
                    for (int n = 0; n < 2; ++n) acc[a][b][m][n] = (f32x4){0.f, 0.f, 0.f, 0.f};
        cur = nxt; cA = nA; cB = nB; ++ui;
        if constexpr (ALIGN_EPI) { if (wr == 1) PG8_BAR; }
    }
    PG8_WAIT_V(0);
    if constexpr (!ALIGN_EPI) { if (wr == 0) PG8_BAR; }
    PG8_BAR;
    if constexpr (Epi::AFTER_DRAIN) { E.fused(acc, cur, wr, wc, fr, fq, lds, wid, lane); S.done(cur); }
#undef PG8_SA
#undef PG8_SB
#undef PG8_STAGE
#undef PG8_LDA
#undef PG8_LDB
#undef PG8_MMA
#undef PG8_WAIT_V
#undef PG8_WAIT_L
#undef PG8_BAR
#undef PG8_SCHED
}
template <bool EXPNEG = false> __device__ __forceinline__ void store_bf16_tile(bf16_t* O, int pitch, int colt, const f32x4 (&acc)[2][2][4][2], const Unit& u, int wr, int wc, int fr, int fq) {
    const int row0 = u.pm * BM + wr * 64 + fr; const int col0 = colt + wc * 32 + 8 * fq;
#pragma unroll
    for (int ai = 0; ai < 2; ++ai)
#pragma unroll
        for (int m = 0; m < 4; ++m) { bf16_t* rowp = O + (size_t)(row0 + ai * HALF + m * 16) * pitch + col0;
#pragma unroll
            for (int bj = 0; bj < 2; ++bj) { f32x4 v0 = acc[ai][bj][m][0], v1 = acc[ai][bj][m][1];
                if (EXPNEG) {
#pragma unroll
                    for (int e = 0; e < 4; ++e) { v0[e] = __expf(-v0[e]); v1[e] = __expf(-v1[e]); } }
                u32x4 w; w.x = cvt_pk_bf16(v0[0], v0[1]); w.y = cvt_pk_bf16(v0[2], v0[3]); w.z = cvt_pk_bf16(v1[0], v1[1]); w.w = cvt_pk_bf16(v1[2], v1[3]);
                *(u32x4*)(rowp + bj * HALF) = w; } }
}
struct EpiInproj {
    static constexpr bool PERM = true, AFTER_DRAIN = false, KHOOK = false;
    unsigned char* ws;
    __device__ __forceinline__ void operator()(const f32x4 (&acc)[2][2][4][2], const Unit& u, int wr, int wc, int fr, int fq) const {
        const int pn = u.pn; size_t base; int pitch, colt;
        if (pn < 2)       { base = WS_AQ;  pitch = 512;  colt = pn * 256; }
        else if (pn == 2) { base = WS_AKV; pitch = 256;  colt = 0; }
        else if (pn < 5)  { base = WS_RQ;  pitch = 512;  colt = (pn - 3) * 256; }
        else if (pn < 7)  { base = WS_RK;  pitch = 512;  colt = (pn - 5) * 256; }
        else if (pn < 9)  { base = WS_RV;  pitch = 512;  colt = (pn - 7) * 256; }
        else if (pn < 11) { base = WS_RG;  pitch = 512;  colt = (pn - 9) * 256; }
        else if (pn < 18) { base = WS_WU;  pitch = 1792; colt = (pn - 11) * 256; }
        else              { store_bf16_tile<true>((bf16_t*)(ws + WS_GL), 3072, (pn - 18) * 256, acc, u, wr, wc, fr, fq); return; }
        store_bf16_tile((bf16_t*)(ws + base), pitch, colt, acc, u, wr, wc, fr, fq);
    }
};
struct EpiLora {
    static constexpr bool PERM = true, AFTER_DRAIN = false, KHOOK = false;
    unsigned char* ws;
    __device__ __forceinline__ void operator()(const f32x4 (&acc)[2][2][4][2], const Unit& u, int wr, int wc, int fr, int fq) const {
        const int pn = u.pn; size_t base; int pitch, colt;
        if (pn < 4)      { base = WS_LW; pitch = 1024; colt = pn * 256; }
        else if (pn < 8) { base = WS_LA; pitch = 1024; colt = (pn - 4) * 256; }
        else             { base = WS_LG; pitch = 512;  colt = (pn - 8) * 256; }
        store_bf16_tile((bf16_t*)(ws + base), pitch, colt, acc, u, wr, wc, fr, fq);
    }
};
struct EpiPlainBf16 {
    static constexpr bool PERM = true, AFTER_DRAIN = false, KHOOK = false;
    bf16_t* O; int pitch;
    __device__ __forceinline__ void operator()(const f32x4 (&acc)[2][2][4][2], const Unit& u, int wr, int wc, int fr, int fq) const {
        store_bf16_tile(O, pitch, u.pn * BM, acc, u, wr, wc, fr, fq);
    }
};
template <int MODE> struct EpiMerge {
    static constexpr bool PERM = false, AFTER_DRAIN = false, KHOOK = false;
    const bf16_t* GL; float* MRG; bf16_t* OB; int nb;
    __device__ __forceinline__ void operator()(const f32x4 (&acc)[2][2][4][2], const Unit& u, int wr, int wc, int fr, int fq) const {
        const int row0 = u.pm * BM + wr * 64 + fr, col0 = u.pn * BM + wc * 32 + 4 * fq;
#pragma unroll
        for (int ai = 0; ai < 2; ++ai)
#pragma unroll
            for (int m = 0; m < 4; ++m) { const size_t row = (size_t)(row0 + ai * HALF + m * 16); asm volatile("" ::: "memory");
#pragma unroll
                for (int bj = 0; bj < 2; ++bj)
#pragma unroll
                    for (int n = 0; n < 2; ++n) { const int col = col0 + bj * HALF + n * 16;
                        const u32x2 gw = *(const u32x2*)(GL + row * 3072 + nb * 1024 + col);
                        f32x4 g; g[0] = __builtin_amdgcn_rcpf(1.f + __expf(-lo16(gw.x))); g[1] = __builtin_amdgcn_rcpf(1.f + __expf(-hi16(gw.x))); g[2] = __builtin_amdgcn_rcpf(1.f + __expf(-lo16(gw.y))); g[3] = __builtin_amdgcn_rcpf(1.f + __expf(-hi16(gw.y)));
                        f32x4 v = acc[ai][bj][m][n] * g;
                        float* mp = MRG + row * 1024 + col;
                        if (MODE != 0) v = v + *(const f32x4*)mp;
                        if (MODE != 2) *(f32x4*)mp = v;
                        else { u32x2 w; w.x = cvt_pk_bf16(v[0], v[1]); w.y = cvt_pk_bf16(v[2], v[3]); *(u32x2*)(OB + row * 1024 + col) = w; } } }
    }
};
struct EpiMergeK {
    static constexpr bool PERM = false, AFTER_DRAIN = false, KHOOK = true;
    const bf16_t* GL; bf16_t* OB;
    __device__ __forceinline__ void khook(f32x4 (&acc)[2][2][4][2], const Unit& u, int wr, int wc, int fr, int fq, int seg  ) const {
        const int row0 = u.pm * BM + wr * 64 + fr, col0 = u.pn * BM + wc * 32 + 4 * fq;
#pragma unroll
        for (int ai = 0; ai < 2; ++ai) {
            u32x2 ga[4][2][2], gb[4][2][2];
            asm volatile("" ::: "memory");
#pragma unroll
            for (int m = 0; m < 4; ++m) { const bf16_t* gr = GL + (size_t)(row0 + ai * HALF + m * 16) * 3072 + (seg - 1) * 1024 + col0;
#pragma unroll
                for (int bj = 0; bj < 2; ++bj)
#pragma unroll
                    for (int n = 0; n < 2; ++n) { ga[m][bj][n] = *(const u32x2*)(gr + bj * HALF + n * 16); gb[m][bj][n] = *(const u32x2*)(gr + 1024 + bj * HALF + n * 16); } }
#pragma unroll
            for (int m = 0; m < 4; ++m)
#pragma unroll
                for (int bj = 0; bj < 2; ++bj)
#pragma unroll
                    for (int n = 0; n < 2; ++n) { const u32x2 a = ga[m][bj][n], b = gb[m][bj][n];
                        f32x4 r;
                        r[0] = (1.f + lo16(b.x)) * __builtin_amdgcn_rcpf(1.f + lo16(a.x)); r[1] = (1.f + hi16(b.x)) * __builtin_amdgcn_rcpf(1.f + hi16(a.x));
                        r[2] = (1.f + lo16(b.y)) * __builtin_amdgcn_rcpf(1.f + lo16(a.y)); r[3] = (1.f + hi16(b.y)) * __builtin_amdgcn_rcpf(1.f + hi16(a.y));
                        acc[ai][bj][m][n] = acc[ai][bj][m][n] * r; } }
    }
    __device__ __forceinline__ void operator()(const f32x4 (&acc)[2][2][4][2], const Unit& u, int wr, int wc, int fr, int fq) const {
        const int row0 = u.pm * BM + wr * 64 + fr, col0 = u.pn * BM + wc * 32 + 4 * fq;
#pragma unroll
        for (int ai = 0; ai < 2; ++ai) { asm volatile("" ::: "memory");
#pragma unroll
            for (int m = 0; m < 4; ++m) { const size_t row = (size_t)(row0 + ai * HALF + m * 16);
#pragma unroll
                for (int bj = 0; bj < 2; ++bj)
#pragma unroll
                    for (int n = 0; n < 2; ++n) { const int col = col0 + bj * HALF + n * 16;
                        const u32x2 gw = *(const u32x2*)(GL + row * 3072 + 2048 + col);
                        f32x4 g; g[0] = __builtin_amdgcn_rcpf(1.f + lo16(gw.x)); g[1] = __builtin_amdgcn_rcpf(1.f + hi16(gw.x)); g[2] = __builtin_amdgcn_rcpf(1.f + lo16(gw.y)); g[3] = __builtin_amdgcn_rcpf(1.f + hi16(gw.y));
                        const f32x4 v = acc[ai][bj][m][n] * g;
                        u32x2 w; w.x = cvt_pk_bf16(v[0], v[1]); w.y = cvt_pk_bf16(v[2], v[3]); *(u32x2*)(OB + row * 1024 + col) = w; } } }
    }
};
struct EpiOut {
    static constexpr bool PERM = false, AFTER_DRAIN = false, KHOOK = false;
    float* out; float* ctxres; const float* modl; int dry; const float* xin; const float* cin;
    __device__ __forceinline__ void operator()(const f32x4 (&acc)[2][2][4][2], const Unit& u, int wr, int wc, int fr, int fq) const {
        const int row0 = u.pm * BM + wr * 64 + fr, col0 = u.pn * BM + wc * 32 + 4 * fq;
        const int b = (u.pm * BM) / NP, q0 = u.pm * BM - b * NP;
        const bool isctx = q0 < NCTX;
        const float* g1 = modl + (size_t)(isctx ? 8 : b) * 6144 + 2048;
        float* xb = isctx ? ctxres + (size_t)(b * NCTX) * D : out + ((size_t)b * NLAT + (q0 - NCTX)) * D;
        const float* xs = isctx ? cin + (size_t)(b * NCTX) * D : xin + ((size_t)b * NLAT + (q0 - NCTX)) * D;
        f32x4 gv[2][2];
#pragma unroll
        for (int bj = 0; bj < 2; ++bj)
#pragma unroll
            for (int n = 0; n < 2; ++n) gv[bj][n] = *(const f32x4*)(g1 + col0 + bj * HALF + n * 16);
#pragma unroll
        for (int ai = 0; ai < 2; ++ai) { asm volatile("" ::: "memory");
#pragma unroll
            for (int m = 0; m < 4; ++m) { const size_t ro = (size_t)(wr * 64 + fr + ai * HALF + m * 16) * D + col0; float* rowp = xb + ro; const float* srcp = xs + ro;
#pragma unroll
                for (int bj = 0; bj < 2; ++bj)
#pragma unroll
                    for (int n = 0; n < 2; ++n) { float* xp = rowp + bj * HALF + n * 16; const f32x4 nv = *(const f32x4*)(srcp + bj * HALF + n * 16) + gv[bj][n] * acc[ai][bj][m][n]; if (!dry) *(f32x4*)xp = nv; } } }
    }
};
struct EpiSwiGLU {
    static constexpr bool PERM = false, AFTER_DRAIN = false, KHOOK = false;
    bf16_t* HB;
    __device__ __forceinline__ void operator()(const f32x4 (&acc)[2][2][4][2], const Unit& u, int wr, int wc, int fr, int fq) const {
        const int row0 = u.pm * BM + wr * 64 + fr, hh0 = u.pn * 128 + wc * 16 + 4 * fq;
#pragma unroll
        for (int ai = 0; ai < 2; ++ai)
#pragma unroll
            for (int m = 0; m < 4; ++m) { bf16_t* rowp = HB + (size_t)(row0 + ai * HALF + m * 16) * 512 + hh0;
#pragma unroll
                for (int bj = 0; bj < 2; ++bj) { const f32x4 g = acc[ai][bj][m][0], up = acc[ai][bj][m][1]; f32x4 h;
#pragma unroll
                    for (int i = 0; i < 4; ++i) h[i] = g[i] * __builtin_amdgcn_rcpf(1.f + __expf(-g[i])) * up[i];
                    u32x2 w; w.x = cvt_pk_bf16(h[0], h[1]); w.y = cvt_pk_bf16(h[2], h[3]); *(u32x2*)(rowp + bj * 64) = w; } }
    }
};
struct LatentOrder {
    StaticOrder S;
    __host__ __device__ void init(int N, int G_, int c_) { S.init(128 * BM, N, G_, c_); }
    __host__ __device__ bool next(int i, Unit& u) const { if (!S.next(i, u)) return false; u.pm = (u.pm >> 4) * 17 + 1 + (u.pm & 15); return true; }
    __device__ __forceinline__ void a_ready(const Unit&) const {}
    __device__ __forceinline__ void done(const Unit&) const {}
};
template <size_t ESTRIDE> struct MoeOrder {
    int G, c; const PG8_LAS int* tab;
    __device__ __forceinline__ bool next(int i, Unit& u) const {
        const long L = (long)i * G + c; if (L >= (long)tab[32 + MOE_NBLK] * 4) return false;
        u.pm = (int)(L >> 2); u.pn = (int)(L & 3); u.bofs = (size_t)tab[32 + u.pm] * ESTRIDE; return true; }
    __device__ __forceinline__ void a_ready(const Unit&) const {}
    __device__ __forceinline__ void done(const Unit&) const {}
};
}
#define PG8_SP2 true
#define PG8_ALIGN true
struct Frame {
    LAS unsigned char* lds; int tid, lane, wave, G, bid, gwave, nwave;
};
__device__ __forceinline__ bf16_t* WSB(const Params& p, size_t off) { return (bf16_t*)(p.ws + off); }
__device__ __forceinline__ float* WSF(const Params& p, size_t off) { return (float*)(p.ws + off); }

__device__ __forceinline__ void sincos_dd(double ang, float& c, float& s) {
    const double kf = __builtin_rint(ang * 0.63661977236758134308);
    const double r = (ang - kf * 1.57079632679489655800) - kf * 6.12323399573676603587e-17;
    const int k = ((int)kf) & 3;
    const double r2 = r * r;
    const double sp = r * (1.0 + r2 * (-1.0 / 6 + r2 * (1.0 / 120 + r2 * (-1.0 / 5040 + r2 * (1.0 / 362880 + r2 * (-1.0 / 39916800 + r2 * (1.0 / 6227020800.0)))))));
    const double cp = 1.0 + r2 * (-0.5 + r2 * (1.0 / 24 + r2 * (-1.0 / 720 + r2 * (1.0 / 40320 + r2 * (-1.0 / 3628800 + r2 * (1.0 / 479001600 + r2 * (-1.0 / 87178291200.0)))))));
    const double cc = (k == 0) ? cp : (k == 1) ? -sp : (k == 2) ? -cp : sp;
    const double ss = (k == 0) ? sp : (k == 1) ? cp : (k == 2) ? -sp : -cp;
    c = (float)cc; s = (float)ss;
}
__device__ __forceinline__ void p0_prologue(const Params& p, const Frame& F) {
    const int gt = F.bid * NTHREADS + F.tid, ngt = F.G * NTHREADS;
    { float* tab = WSF(p, WS_ROPE); const LAS Params* lpar = (const LAS Params*)(F.lds + (LDS_BYTES - 4096 + 2048));
      for (int i = gt; i < 64 * 16 + 64 * 32; i += ngt) {
          if (i < 1024) { const int pos = i >> 4, k = i & 15; float c, s; sincos_dd((double)pos * (double)lpar->invA[k], c, s); tab[i] = c; tab[1024 + i] = s; }
          else { const int j = i - 1024, pos = j >> 5, k = j & 31; float c, s; sincos_dd((double)pos * (double)lpar->invR[k], c, s); tab[2048 + j] = c; tab[2048 + 2048 + j] = s; } } }
    { float* rwt = WSF(p, WS_RWT);
      for (int i = gt; i < DEPTH * 36 * 1024; i += ngt) { const int l = i / (36 * 1024), r = i - l * 36 * 1024, o = r >> 10, k = r & 1023;
          rwt[i] = o < 4 ? p.in[I_RGW][((size_t)l * 1024 + k) * 4 + o] : p.in[I_REW][((size_t)l * 1024 + k) * 32 + (o - 4)]; } }
    { float* rw2 = WSF(p, WS_RW2);
      for (int i = gt; i < DEPTH * 64 * 3 * 4 * 16 * 4; i += ngt) { const int j = i & 3, n = (i >> 2) & 15, g = (i >> 6) & 3, r = i >> 8, nt = r % 3, r2 = r / 3, kq = r2 & 63, l = r2 >> 6;
          const int ng = 16 * nt + n, k = 4 * (4 * kq + j) + g;
          rw2[i] = ng < 4 ? p.in[I_RGW][((size_t)l * 1024 + k) * 4 + ng] : (ng < 36 ? p.in[I_REW][((size_t)l * 1024 + k) * 32 + (ng - 4)] : 0.f); } }
    { LAS float* cond = (LAS float*)F.lds;
      LAS float* red = (LAS float*)(F.lds + 9 * 1024 * 4);
      for (int i = F.tid; i < 9 * 1024; i += NTHREADS) { const float v = i < 8192 ? p.in[I_C][i] : p.in[I_CCTX][i - 8192]; cond[i] = siluf_(v); }
      __syncthreads();
      float* mod = WSF(p, WS_MOD);
      for (int task = F.bid; task < DEPTH * 96; task += F.G) {
          const int l = task / 96, col0 = (task - l * 96) * 64, c = F.tid & 63, ks = F.tid >> 6;
          const float* w = p.in[I_ADAW] + ((size_t)l * 1024 + ks * 128) * 6144 + col0 + c;
          float a[9];
#pragma unroll
          for (int r = 0; r < 9; ++r) a[r] = 0.f;
          for (int k = 0; k < 128; ++k) { const float wv = w[(size_t)k * 6144];
#pragma unroll
              for (int r = 0; r < 9; ++r) a[r] += cond[r * 1024 + ks * 128 + k] * wv; }
#pragma unroll
          for (int r = 0; r < 9; ++r) red[(ks * 9 + r) * 64 + c] = a[r];
          __syncthreads();
          for (int o = F.tid; o < 9 * 64; o += NTHREADS) { const int r = o >> 6, cc = o & 63; float s = 0.f;
#pragma unroll
              for (int k2 = 0; k2 < 8; ++k2) s += red[(k2 * 9 + r) * 64 + cc];
              mod[((size_t)l * 9 + r) * 6144 + col0 + cc] = s + p.in[I_ADAB][(size_t)l * 6144 + col0 + cc]; }
          __syncthreads();
      } }
}

__device__ __forceinline__ void cvt_tile(const float* src, int ld_src, bf16_t* dst, int ld_dst, int k0, int n0, LAS float* tile  , int tid) {
#pragma unroll
    for (int ps = 0; ps < 2; ++ps) { const int k = ps * 32 + (tid >> 4), n4 = (tid & 15) * 4;
        const f32x4 v = *(const f32x4*)(src + (size_t)(k0 + k) * ld_src + n0 + n4);
        tile[k * 65 + n4] = v[0]; tile[k * 65 + n4 + 1] = v[1]; tile[k * 65 + n4 + 2] = v[2]; tile[k * 65 + n4 + 3] = v[3]; }
    __syncthreads();
    { const int n = tid >> 3, k8 = (tid & 7) * 8; float x[8];
#pragma unroll
      for (int e = 0; e < 8; ++e) x[e] = tile[(k8 + e) * 65 + n];
      *(u32x4*)(dst + (size_t)(n0 + n) * ld_dst + k0 + k8) = pack8(x); }
    __syncthreads();
}

struct CvtTask { const float* src; bf16_t* dst; int ld_src, ld_dst, k0, n0, which; };
__device__ __forceinline__ void cvt_load(f32x4 (&v)[8], const CvtTask& c, int tid) {
#pragma unroll
    for (int ps = 0; ps < 8; ++ps) v[ps] = *(const f32x4*)(c.src + (size_t)(c.k0 + ps * 8 + (tid >> 6)) * c.ld_src + c.n0 + (tid & 63) * 4);
}
__device__ __forceinline__ void cvt_store(const f32x4 (&v)[8], const CvtTask& c, LAS float* tile  , int tid) {
#pragma unroll
    for (int ps = 0; ps < 8; ++ps) *(LAS f32x4*)(tile + (ps * 8 + (tid >> 6)) * 260 + (tid & 63) * 4) = v[ps];
    __syncthreads();
    { const int n = tid >> 1, kb = (tid & 1) * 32, nn = c.n0 + n; const int row = c.which < 0 ? nn : ((nn >> 4) << 5) + (c.which << 4) + (nn & 15);
      bf16_t* d = c.dst + (size_t)row * c.ld_dst + c.k0 + kb;
#pragma unroll
      for (int q = 0; q < 4; ++q) { float x[8];
#pragma unroll
          for (int e = 0; e < 8; ++e) x[e] = tile[(kb + q * 8 + e) * 260 + n];
          *(u32x4*)(d + q * 8) = pack8(x); } }
    __syncthreads();
}
constexpr int NT_MIX = 16 * 30 + 3 * 8 * 4 + 16 * 4;
__device__ __forceinline__ CvtTask cvt_task_mix(const Params& p, int l, int t) {
    CvtTask c; c.which = -1;
    if (t < 480) { const int kt = t / 30, nt = t - kt * 30; c.src = p.in[I_WIN] + (size_t)l * 1024 * 7680; c.ld_src = 7680; c.dst = WSB(p, WS_BTIN); c.ld_dst = 1024; c.k0 = kt * 64; c.n0 = nt * 256; }
    else if (t < 576) { const int u = t - 480, nb = u >> 5, r = u & 31, kt = r >> 2, nt = r & 3;
        c.src = p.in[I_WBR] + ((size_t)l * 3 + nb) * 512 * 1024; c.ld_src = 1024; c.dst = WSB(p, WS_BTBR) + nb * 512; c.ld_dst = 1536; c.k0 = kt * 64; c.n0 = nt * 256; }
    else { const int u = t - 576, kt = u >> 2, nt = u & 3; c.src = p.in[I_WOUT] + (size_t)l * 1024 * 1024; c.ld_src = 1024; c.dst = WSB(p, WS_BTOUT); c.ld_dst = 1024; c.k0 = kt * 64; c.n0 = nt * 256; }
    return c;
}
constexpr int NT_MOE = 32 * 2 * 16 * 2 + 32 * 8 * 4;
__device__ __forceinline__ CvtTask cvt_task_moe(const Params& p, int l, int t) {
    CvtTask c;
    if (t < 2048) { const int e = t >> 6, r = t & 63, which = r >> 5, kt = (r >> 1) & 15, nt = r & 1;
        c.src = (which ? p.in[I_MUP] : p.in[I_MG]) + ((size_t)l * 32 + e) * 1024 * 512; c.ld_src = 512; c.dst = WSB(p, WS_BT1) + (size_t)e * 1024 * 1024; c.ld_dst = 1024; c.k0 = kt * 64; c.n0 = nt * 256; c.which = which; }
    else { const int u = t - 2048, e = u >> 5, r = u & 31, kt = r >> 2, nt = r & 3;
        c.src = p.in[I_MD] + ((size_t)l * 32 + e) * 512 * 1024; c.ld_src = 1024; c.dst = WSB(p, WS_BT2) + (size_t)e * 1024 * 512; c.ld_dst = 512; c.k0 = kt * 64; c.n0 = nt * 256; c.which = -1; }
    return c;
}
template <bool MOE> __device__ __forceinline__ void cvt_run(const Params& p, const Frame& F, int l, LAS float* tile, int first_blk = 0) {
    const int NTASK = MOE ? NT_MOE : NT_MIX;
    if (F.bid < first_blk) return;
    const int stride = F.G - first_blk;
    int t = F.bid - first_blk; if (t >= NTASK) return;
    CvtTask cur = MOE ? cvt_task_moe(p, l, t) : cvt_task_mix(p, l, t);
    f32x4 v[8]; cvt_load(v, cur, F.tid);
    for (;;) {
        const int tn = t + stride; const bool more = tn < NTASK;
        CvtTask nx = cur; f32x4 vn[8];
        if (more) { nx = MOE ? cvt_task_moe(p, l, tn) : cvt_task_mix(p, l, tn); cvt_load(vn, nx, F.tid); }
        cvt_store(v, cur, tile, F.tid);
        if (!more) break;
#pragma unroll
        for (int i = 0; i < 8; ++i) v[i] = vn[i];
        cur = nx; t = tn;
    }
}

__device__ __forceinline__ void rmsnorm_mod_row(const float* x, const float* g, const float* sc, const float* sh, bf16_t* o, int lane, float* keep  ) {
    f32x4 v[4]; float ss = 0.f;
#pragma unroll
    for (int j = 0; j < 4; ++j) { v[j] = *(const f32x4*)(x + j * 256 + lane * 4); ss += v[j][0] * v[j][0] + v[j][1] * v[j][1] + v[j][2] * v[j][2] + v[j][3] * v[j][3]; }
#pragma unroll
    for (int m = 1; m < 64; m <<= 1) ss += shfl_xor_f(ss, m);
    const float rs = rsqrtf(ss * (1.f / 1024.f) + 1e-6f);
#pragma unroll
    for (int j = 0; j < 4; ++j) { const int c = j * 256 + lane * 4;
        const f32x4 gg = *(const f32x4*)(g + c), s1 = *(const f32x4*)(sc + c), s0 = *(const f32x4*)(sh + c);
        f32x4 y;
#pragma unroll
        for (int e = 0; e < 4; ++e) y[e] = v[j][e] * rs * gg[e] * (1.f + s1[e]) + s0[e];
        u32x2 w; w.x = pk2(y[0], y[1]); w.y = pk2(y[2], y[3]); *(u32x2*)(o + c) = w;
        if (keep) { keep[j * 4 + 0] = y[0]; keep[j * 4 + 1] = y[1]; keep[j * 4 + 2] = y[2]; keep[j * 4 + 3] = y[3]; } }
}
__device__ __forceinline__ void p1_weights(const Params& p, const Frame& F, int l) {
    LAS float* tile = (LAS float*)F.lds;
    cvt_run<false>(p, F, l, tile);
    if (F.bid < 9) { const float* sh2 = WSF(p, WS_MOD) + ((size_t)l * 9 + F.bid) * 6144 + 3072; const float* rwt = WSF(p, WS_RWT) + (size_t)l * 36 * 1024; float* rc = WSF(p, WS_RC) + ((size_t)l * 9 + F.bid) * 48;
        for (int n = F.wave; n < 48; n += NWAVES) { float a = 0.f;
            if (n < 36) {
#pragma unroll
                for (int j = 0; j < 4; ++j) { const f32x4 sv = *(const f32x4*)(sh2 + j * 256 + F.lane * 4), wv = *(const f32x4*)(rwt + n * 1024 + j * 256 + F.lane * 4); a += sv[0] * wv[0] + sv[1] * wv[1] + sv[2] * wv[2] + sv[3] * wv[3]; }
#pragma unroll
                for (int mk = 1; mk < 64; mk <<= 1) a += shfl_xor_f(a, mk);
                a += n < 4 ? p.in[I_RGB][l * 4 + n] : p.in[I_REB][l * 32 + n - 4]; }
            if (F.lane == 0) rc[n] = a; } }
    { bf16_t* bl = WSB(p, WS_BTLORA); const int gt = F.bid * NTHREADS + F.tid, ngt = F.G * NTHREADS;
      for (int i = gt; i < 2560 * 256; i += ngt) { const int k = i / 2560, row = i - k * 2560;
          float v = 0.f;
          if (row < 1024) { if (k < 64) { const int d = row >> 9, c = row & 511; v = p.in[I_W2][(((size_t)l * 2 + d) * 64 + k) * 512 + c]; } }
          else if (row < 2048) { if (k >= 64 && k < 128) { const int r2 = row - 1024, d = r2 >> 9, c = r2 & 511; v = p.in[I_A2][(((size_t)l * 2 + d) * 64 + (k - 64)) * 512 + c]; } }
          else { if (k >= 128) { const int c = row - 2048; v = p.in[I_G2][((size_t)l * 128 + (k - 128)) * 512 + c]; } }
          bl[(size_t)row * 256 + k] = (bf16_t)f2bf(v); } }
}
__device__ __forceinline__ void p1_cvt_norm1(const Params& p, const Frame& F, int l) {
    p1_weights(p, F, l);
    { const float* mod = WSF(p, WS_MOD) + (size_t)l * 9 * 6144; bf16_t* H = WSB(p, WS_H);
      for (int row = F.gwave; row < T; row += F.nwave) { const int b = row / NP, q = row - b * NP; const float* mr = mod + (size_t)(q < NCTX ? 8 : b) * 6144;
          const float* xin = q < NCTX ? p.in[I_CTX] + (size_t)(b * NCTX + q) * D : p.in[I_X] + (size_t)(b * NLAT + (q - NCTX)) * D;
          rmsnorm_mod_row(xin, p.in[I_N1G] + (size_t)l * 1024, mr + 1024, mr, H + (size_t)row * 1024, F.lane, nullptr); } }
}

__device__ __forceinline__ void p3_prep(const Params& p, const Frame& F, int l) {
    const float* tab = WSF(p, WS_ROPE);
    const float* cosA = tab, *sinA = tab + 1024, *cosR = tab + 2048, *sinR = tab + 4096;
    bf16_t* AQ = WSB(p, WS_AQ); bf16_t* AKV = WSB(p, WS_AKV); bf16_t* RQ = WSB(p, WS_RQ); bf16_t* RK = WSB(p, WS_RK);
    const bf16_t* WU = WSB(p, WS_WU); bf16_t* AL_ = WSB(p, WS_H);
    const int lane = F.lane;
    const float* qng = p.in[I_QNG] + l * 64, *kng = p.in[I_KNG] + l * 64;
    const float* mu0 = p.in[I_MU] + (size_t)l * 2 * 1792, *mu1 = mu0 + 1792;
    for (int row = F.gwave; row < T; row += F.nwave) {
        const int b = row / NP, q = row - b * NP; const bool lat = q >= NCTX; const int t = q - NCTX, prow = t >> 6, pcol = t & 63;
        const u32x4 raw_aq = *(const u32x4*)(AQ + (size_t)row * 512 + lane * 8), raw_ak = *(const u32x4*)(AKV + (size_t)row * 256 + (lane & 15) * 8);
        const u32x4 raw_rq = *(const u32x4*)(RQ + (size_t)row * 512 + lane * 8), raw_rk = *(const u32x4*)(RK + (size_t)row * 512 + lane * 8);
        const bool hasp = (q != 0) && (q != NCTX), hasn = (q != NCTX - 1) && (q != NP - 1);
        const int cw = 1536 + lane * 4;
        const u32x2 cu = *(const u32x2*)(WU + (size_t)row * 1792 + cw);
        u32x2 pu; pu.x = 0u; pu.y = 0u; u32x2 nu = pu;
        if (hasp) pu = *(const u32x2*)(WU + (size_t)(row - 1) * 1792 + cw);
        if (hasn) nu = *(const u32x2*)(WU + (size_t)(row + 1) * 1792 + cw);
        { const int sub = lane & 7, a = sub >> 2, half = (sub >> 1) & 1, ib = (sub & 1) * 8, pos = lat ? (a ? pcol : prow) : 0;
          float cA[8], sA[8];
          *(f32x4*)cA = *(const f32x4*)(cosA + pos * 16 + ib); *(f32x4*)(cA + 4) = *(const f32x4*)(cosA + pos * 16 + ib + 4);
          *(f32x4*)sA = *(const f32x4*)(sinA + pos * 16 + ib); *(f32x4*)(sA + 4) = *(const f32x4*)(sinA + pos * 16 + ib + 4);
          { float x[8]; unpack8(raw_aq, x);
            float ss = 0.f;
#pragma unroll
            for (int e = 0; e < 8; ++e) ss += x[e] * x[e];
            ss += shfl_xor_f(ss, 1); ss += shfl_xor_f(ss, 2); ss += shfl_xor_f(ss, 4);
            const float rs = rsqrtf(ss * (1.f / 64.f) + 1e-6f);
            float gq[8]; *(f32x4*)gq = *(const f32x4*)(qng + sub * 8); *(f32x4*)(gq + 4) = *(const f32x4*)(qng + sub * 8 + 4);
#pragma unroll
            for (int e = 0; e < 8; ++e) x[e] = x[e] * rs * gq[e];
            float y[8];
#pragma unroll
            for (int e = 0; e < 8; ++e) { const float o = shfl_xor_f(x[e], 2);
                if (lat) { const float c = cA[e], s = sA[e]; y[e] = half ? (x[e] * c + o * s) : (x[e] * c - o * s); } else y[e] = x[e];
                y[e] *= 0.18033688011112042f; }
            if (!p.dry) *(u32x4*)(AQ + (size_t)row * 512 + lane * 8) = pack8(y); }
          { const int lk = lane & 15; float x[8]; unpack8(raw_ak, x);
            float ss = 0.f;
#pragma unroll
            for (int e = 0; e < 8; ++e) ss += x[e] * x[e];
            ss += shfl_xor_f(ss, 1); ss += shfl_xor_f(ss, 2); ss += shfl_xor_f(ss, 4);
            const float rs = rsqrtf(ss * (1.f / 64.f) + 1e-6f);
            float gk[8]; *(f32x4*)gk = *(const f32x4*)(kng + sub * 8); *(f32x4*)(gk + 4) = *(const f32x4*)(kng + sub * 8 + 4);
#pragma unroll
            for (int e = 0; e < 8; ++e) x[e] = x[e] * rs * gk[e];
            float y[8];
#pragma unroll
            for (int e = 0; e < 8; ++e) { const float o = shfl_xor_f(x[e], 2);
                if (lat) { const float c = cA[e], s = sA[e]; y[e] = half ? (x[e] * c + o * s) : (x[e] * c - o * s); } else y[e] = x[e]; }
            if (lane < 16 && !p.dry) *(u32x4*)(AKV + (size_t)row * 256 + lk * 8) = pack8(y); } }
        { const int sub = lane & 15, a = sub >> 3, half = (sub >> 2) & 1, ib = (sub & 3) * 8, pos = lat ? (a ? pcol : prow) : 0;
          float cR[8], sR[8];
          *(f32x4*)cR = *(const f32x4*)(cosR + pos * 32 + ib); *(f32x4*)(cR + 4) = *(const f32x4*)(cosR + pos * 32 + ib + 4);
          *(f32x4*)sR = *(const f32x4*)(sinR + pos * 32 + ib); *(f32x4*)(sR + 4) = *(const f32x4*)(sinR + pos * 32 + ib + 4);
#pragma unroll
          for (int which = 0; which < 2; ++which) { bf16_t* buf = which ? RK : RQ;
            float x[8]; unpack8(which ? raw_rk : raw_rq, x); float y[8];
#pragma unroll
            for (int e = 0; e < 8; ++e) { const float o = shfl_xor_f(x[e], 4);
                if (lat) { const float c = cR[e], s = sR[e]; y[e] = half ? (x[e] * c + o * s) : (x[e] * c - o * s); } else y[e] = x[e];
                if (which) y[e] *= 0.08838834764831845f; }
            if (!p.dry) *(u32x4*)(buf + (size_t)row * 512 + lane * 8) = pack8(y); } }
        { const int c = cw;
          const float uc[4] = {lo16(cu.x), hi16(cu.x), lo16(cu.y), hi16(cu.y)}, up[4] = {lo16(pu.x), hi16(pu.x), lo16(pu.y), hi16(pu.y)}, un[4] = {lo16(nu.x), hi16(nu.x), lo16(nu.y), hi16(nu.y)};
          float y[4]; const f32x4 m0v = *(const f32x4*)(mu0 + c), m1v = *(const f32x4*)(mu1 + c);
#pragma unroll
          for (int e = 0; e < 4; ++e) { const float xs = uc[e] + (up[e] - uc[e]) * m0v[e] + (un[e] - uc[e]) * m1v[e];
              if (lane < 16) { const float ex = __expf(2.f * xs); y[e] = 1.f - 2.f * frcp(ex + 1.f); }
              else if (lane < 32) y[e] = xs;
              else y[e] = sigmoidf_(xs); }
          u32x2 w; w.x = pk2(y[0], y[1]); w.y = pk2(y[2], y[3]); *(u32x2*)(AL_ + (size_t)row * 256 + lane * 4) = w; }
    }
}

__device__ __forceinline__ void p5_rwkv_tok(const Params& p, const Frame& F, int l) {
    const bf16_t* WU = WSB(p, WS_WU); const bf16_t* LW = WSB(p, WS_LW); const bf16_t* LA = WSB(p, WS_LA);
    bf16_t* RS = WSB(p, WS_W1); bf16_t* VS = RS + (size_t)T * 512; bf16_t* KKS = VS + (size_t)T * 512;
    const int lane = F.lane, c0 = lane * 8;
    const float* mu0 = p.in[I_MU] + (size_t)l * 2 * 1792, *mu1 = mu0 + 1792;
    const float* k_k = p.in[I_KK] + l * 512, *k_a = p.in[I_KA] + l * 512;
    for (int row = F.gwave; row < T; row += F.nwave) {
        const int b = row / NP, q = row - b * NP;
        const bool hasp = (q != 0) && (q != NCTX), hasn = (q != NCTX - 1) && (q != NP - 1);
        float sh[3][8];
#pragma unroll
        for (int part = 0; part < 3; ++part) { const int c = part * 512 + c0;
            const u32x4 cu = *(const u32x4*)(WU + (size_t)row * 1792 + c);
            u32x4 pu; pu.x = pu.y = pu.z = pu.w = 0u; u32x4 nu = pu;
            if (hasp) pu = *(const u32x4*)(WU + (size_t)(row - 1) * 1792 + c);
            if (hasn) nu = *(const u32x4*)(WU + (size_t)(row + 1) * 1792 + c);
            float uc[8], up[8], un[8]; unpack8(cu, uc); unpack8(pu, up); unpack8(nu, un);
#pragma unroll
            for (int e = 0; e < 8; ++e) sh[part][e] = uc[e] + (up[e] - uc[e]) * mu0[c + e] + (un[e] - uc[e]) * mu1[c + e]; }
        float kk[8]; float ss = 0.f;
#pragma unroll
        for (int e = 0; e < 8; ++e) { kk[e] = sh[1][e] * k_k[c0 + e]; ss += kk[e] * kk[e]; }
        ss += shfl_xor_f(ss, 1); ss += shfl_xor_f(ss, 2); ss += shfl_xor_f(ss, 4);
        const float rn = rsqrtf(fmaxf(ss, 1e-12f));
#pragma unroll
        for (int e = 0; e < 8; ++e) kk[e] *= rn;
        u32x4 lw_raw[2], la_raw[2];
#pragma unroll
        for (int d = 0; d < 2; ++d) { lw_raw[d] = *(const u32x4*)(LW + (size_t)row * 1024 + d * 512 + c0); la_raw[d] = *(const u32x4*)(LA + (size_t)row * 1024 + d * 512 + c0); }
        *(u32x4*)(RS + (size_t)row * 512 + c0) = pack8(sh[0]);
        *(u32x4*)(VS + (size_t)row * 512 + c0) = pack8(sh[2]);
        *(u32x4*)(KKS + (size_t)row * 512 + c0) = pack8(kk);
#pragma unroll
        for (int d = 0; d < 2; ++d) {
            _Float16* LOGW = (_Float16*)(p.ws + WS_W1 + (size_t)(3 + 3 * d) * SZ512); bf16_t* KR = WSB(p, WS_W1 + (size_t)(4 + 3 * d) * SZ512); bf16_t* BB = WSB(p, WS_W1 + (size_t)(5 + 3 * d) * SZ512);
            const float* w0 = p.in[I_W0] + ((size_t)l * 2 + d) * 512, *a0 = p.in[I_A0] + ((size_t)l * 2 + d) * 512;
            float lw[8], la[8]; unpack8(lw_raw[d], lw); unpack8(la_raw[d], la);
            float kr[8], bb[8]; typedef _Float16 h8 __attribute__((ext_vector_type(8))); h8 lg;
#pragma unroll
            for (int e = 0; e < 8; ++e) { const float a = sigmoidf_(a0[c0 + e] + la[e]);
                lg[e] = (_Float16)(-0.6065306597126334f * sigmoidf_(w0[c0 + e] + lw[e]));
                kr[e] = sh[1][e] * (1.f + (a - 1.f) * k_a[c0 + e]); bb[e] = kk[e] * a; }
            *(h8*)(LOGW + (size_t)row * 512 + c0) = lg;
            *(u32x4*)(KR + (size_t)row * 512 + c0) = pack8(kr);
            *(u32x4*)(BB + (size_t)row * 512 + c0) = pack8(bb); }
    }
}
__device__ __forceinline__ float reduce8(float (&v)[8], int lane) {
    float a[4];
#pragma unroll
    for (int k = 0; k < 4; ++k) { const bool up = (lane & 32) != 0; const float send = up ? v[k] : v[k + 4], keep = up ? v[k + 4] : v[k]; a[k] = keep + __shfl_xor(send, 32, 64); }
    float b[2];
#pragma unroll
    for (int k = 0; k < 2; ++k) { const bool up = (lane & 16) != 0; const float send = up ? a[k] : a[k + 2], keep = up ? a[k + 2] : a[k]; b[k] = keep + __shfl_xor(send, 16, 64); }
    float c; { const bool up = (lane & 8) != 0; const float send = up ? b[0] : b[1], keep = up ? b[1] : b[0]; c = keep + __shfl_xor(send, 8, 64); }
    c += __shfl_xor(c, 4, 64); c += __shfl_xor(c, 2, 64); c += __shfl_xor(c, 1, 64);
    return c;
}
__device__ __forceinline__ void p6_rwkv_scan_naive(const Params& p, const Frame& F, int l) {
    (void)l;
    LAS float* L_r = (LAS float*)F.lds;
    LAS float* L_w = L_r + 4096; LAS float* L_k = L_w + 4096; LAS float* L_v = L_k + 4096; LAS float* L_a = L_v + 4096; LAS float* L_b = L_a + 4096; LAS float* L_y = L_b + 4096;
    const bf16_t* RS = WSB(p, WS_W1); const bf16_t* VS = RS + (size_t)T * 512; const bf16_t* KKS = VS + (size_t)T * 512;
    const int lane = F.lane, w = F.wave, tid = F.tid;
    for (int task = F.bid; task < NB * 8 * 2; task += F.G) {
        const int dir = task & 1, h = (task >> 1) & 7, b = task >> 4;
        const _Float16* LOGW = (const _Float16*)(p.ws + WS_W1 + (size_t)(3 + 3 * dir) * SZ512); const bf16_t* KR = WSB(p, WS_W1 + (size_t)(4 + 3 * dir) * SZ512); const bf16_t* BB = WSB(p, WS_W1 + (size_t)(5 + 3 * dir) * SZ512);
        bf16_t* YS = WSB(p, WS_YS) + (size_t)dir * T * 512;
        float S[8];
#pragma unroll
        for (int i = 0; i < 8; ++i) S[i] = 0.f;
        for (int s0 = 0; s0 < NP; s0 += 64) {
            { const int st = tid >> 3, c8 = (tid & 7) * 8, s = s0 + st; const int q = dir ? (s < NCTX ? NCTX - 1 - s : NP + NCTX - 1 - s) : s;
              const size_t off = ((size_t)(b * NP + q)) * 512 + h * 64 + c8;
              float x[8];
              unpack8(*(const u32x4*)(RS + off), x);
#pragma unroll
              for (int e = 0; e < 8; ++e) L_r[st * 64 + c8 + e] = x[e];
              unpack8(*(const u32x4*)(VS + off), x);
#pragma unroll
              for (int e = 0; e < 8; ++e) L_v[st * 64 + c8 + e] = x[e];
              unpack8(*(const u32x4*)(KKS + off), x);
#pragma unroll
              for (int e = 0; e < 8; ++e) L_a[st * 64 + c8 + e] = -x[e];
              unpack8(*(const u32x4*)(KR + off), x);
#pragma unroll
              for (int e = 0; e < 8; ++e) L_k[st * 64 + c8 + e] = x[e];
              unpack8(*(const u32x4*)(BB + off), x);
#pragma unroll
              for (int e = 0; e < 8; ++e) L_b[st * 64 + c8 + e] = x[e];
              typedef _Float16 h8 __attribute__((ext_vector_type(8))); const h8 lg = *(const h8*)(LOGW + off);
#pragma unroll
              for (int e = 0; e < 8; ++e) L_w[st * 64 + c8 + e] = __expf((float)lg[e]); }
            __syncthreads();
            for (int st = 0; st < 64; ++st) {
                const float rj = L_r[st * 64 + lane], wj = L_w[st * 64 + lane], kj = L_k[st * 64 + lane], aj = L_a[st * 64 + lane], bj = L_b[st * 64 + lane];
                float pa[8];
#pragma unroll
                for (int i = 0; i < 8; ++i) pa[i] = S[i] * aj;
                const float tot = reduce8(pa, lane);
                float py[8];
#pragma unroll
                for (int i = 0; i < 8; ++i) { const float sa = __shfl(tot, i * 8, 64); const float vi = L_v[st * 64 + w * 8 + i];
                    S[i] = S[i] * wj + sa * bj + vi * kj; py[i] = S[i] * rj; }
                const float ty = reduce8(py, lane);
                if ((lane & 7) == 0) L_y[st * 64 + w * 8 + (lane >> 3)] = ty;
            }
            __syncthreads();
            { const int st = tid >> 3, c8 = (tid & 7) * 8, s = s0 + st; const int q = dir ? (s < NCTX ? NCTX - 1 - s : NP + NCTX - 1 - s) : s;
              float y[8];
#pragma unroll
              for (int e = 0; e < 8; ++e) y[e] = L_y[st * 64 + c8 + e];
              *(u32x4*)(YS + ((size_t)(b * NP + q)) * 512 + h * 64 + c8) = pack8(y); }
            __syncthreads();
        }
    }
}

__device__ __forceinline__ void p7_rwkv_readout(const Params& p, const Frame& F, int l);
constexpr int RPITCH_TR = 288;
constexpr int RPITCH_ROW = 272;
__device__ __forceinline__ float log_gamma_of(const Params& p, int l, int dir, int h) {
    const float x = p.in[I_RDL][(l * 2 + dir) * 4 + h];
    return -log1pf(__expf(-x));
}
__device__ __forceinline__ void p8_ret_kv(const Params& p, const Frame& F, int l) {
    const bf16_t* RK = WSB(p, WS_RK); const bf16_t* RV = WSB(p, WS_RV);
    bf16_t* SF = WSB(p, WS_SF); bf16_t* SB = WSB(p, WS_SB);
    LAS unsigned char* Lv = F.lds; LAS unsigned char* Lkf = F.lds + 128 * RPITCH_TR; LAS unsigned char* Lkb = F.lds + 2 * 128 * RPITCH_TR;
    const int lane = F.lane, w = F.wave, tid = F.tid, g = lane >> 4, li = lane & 15, q4 = li >> 2, p4 = li & 3;
    for (int u = F.bid; u < NB * 4 * 34; u += F.G) {
        const int c = u % 34, bh = u / 34, h = bh & 3, b = bh >> 2;
        const float lgf = log_gamma_of(p, l, 0, h) * 1.4426950408889634f, lgb = log_gamma_of(p, l, 1, h) * 1.4426950408889634f;
#pragma unroll
        for (int it = 0; it < 4; ++it) { const int idx = it * NTHREADS + tid, j = idx >> 4, c8 = (idx & 15) * 8;
            const size_t off = ((size_t)(b * NP + c * 128 + j)) * 512 + h * 128 + c8;
            const u32x4 vv = *(const u32x4*)(RV + off); *(LAS u32x4*)(Lv + j * RPITCH_TR + c8 * 2) = vv;
            float x[8]; unpack8(*(const u32x4*)(RK + off), x);
            const float sf = exp2f(lgf * (float)(127 - j)), sb = exp2f(lgb * (float)j);
            float xf[8], xb[8];
#pragma unroll
            for (int e = 0; e < 8; ++e) { xf[e] = x[e] * sf; xb[e] = x[e] * sb; }
            *(LAS u32x4*)(Lkf + j * RPITCH_TR + c8 * 2) = pack8(xf); *(LAS u32x4*)(Lkb + j * RPITCH_TR + c8 * 2) = pack8(xb); }
        __syncthreads();
        const int dir = w >> 2, e0 = (w & 3) * 32;
        LAS unsigned char* Lk = dir ? Lkb : Lkf;
        f32x4 acc[2][8];
#pragma unroll
        for (int et = 0; et < 2; ++et)
#pragma unroll
            for (int dt = 0; dt < 8; ++dt) acc[et][dt] = (f32x4){0.f, 0.f, 0.f, 0.f};
        const LAS unsigned char* vbase = Lv; const LAS unsigned char* kbase = Lk;
#pragma unroll 1
        for (int ks = 0; ks < 4; ++ks) {
            const int r0 = 32 * ks + 8 * g;
            bf16x8 af[2];
#pragma unroll
            for (int et = 0; et < 2; ++et) { const int col = e0 + 16 * et + 4 * p4;
                af[et] = cat44(tr_read(vbase + (r0 + q4) * RPITCH_TR + col * 2), tr_read(vbase + (r0 + 4 + q4) * RPITCH_TR + col * 2)); }
#pragma unroll
            for (int dt = 0; dt < 8; ++dt) { const int col = 16 * dt + 4 * p4;
                const bf16x8 bfr = cat44(tr_read(kbase + (r0 + q4) * RPITCH_TR + col * 2), tr_read(kbase + (r0 + 4 + q4) * RPITCH_TR + col * 2));
#pragma unroll
                for (int et = 0; et < 2; ++et) acc[et][dt] = MFMA16(af[et], bfr, acc[et][dt]); }
        }
        bf16_t* dst = (dir ? SB : SF) + (size_t)u * 16384;
#pragma unroll
        for (int et = 0; et < 2; ++et)
#pragma unroll
            for (int dt = 0; dt < 8; ++dt)
#pragma unroll
                for (int r = 0; r < 4; ++r) dst[(size_t)(e0 + 16 * et + 4 * g + r) * 128 + 16 * dt + li] = (bf16_t)f2bf(acc[et][dt][r]);
        __syncthreads();
    }
}
__device__ __forceinline__ void p9_ret_scan(const Params& p, const Frame& F, int l) {
    unsigned* SF = (unsigned*)(p.ws + WS_SF); unsigned* SB = (unsigned*)(p.ws + WS_SB);
    const int gt = F.bid * NTHREADS + F.tid, ngt = F.G * NTHREADS;
    for (int i = gt; i < 2 * NB * 4 * 8192; i += ngt) {
        const int dir = i / (NB * 4 * 8192), r = i - dir * (NB * 4 * 8192), bh = r >> 13, el = r & 8191, h = bh & 3;
        const float gC = __expf(128.f * log_gamma_of(p, l, dir, h));
        unsigned* base = (dir ? SB : SF) + (size_t)bh * 34 * 8192 + el;
        float s0 = 0.f, s1 = 0.f;
        for (int k = 0; k < 34; ++k) { const int c = dir ? (k < 2 ? 1 - k : 35 - k) : k;
            const unsigned kv = base[(size_t)c * 8192]; if (!p.dry) base[(size_t)c * 8192] = pk2(s0, s1); s0 = gC * s0 + lo16(kv); s1 = gC * s1 + hi16(kv); }
    }
}
__device__ __forceinline__ void p10_ret_out(const Params& p, const Frame& F, int l, bool want_ctx) {
    const bf16_t* RQ = WSB(p, WS_RQ); const bf16_t* RK = WSB(p, WS_RK); const bf16_t* RV = WSB(p, WS_RV); const bf16_t* RG = WSB(p, WS_RG); bf16_t* YR = WSB(p, WS_WU) + 512;
    const bf16_t* SF = WSB(p, WS_SF); const bf16_t* SB = WSB(p, WS_SB);
    LAS unsigned char* Lq = F.lds; LAS unsigned char* Lk = Lq + 128 * RPITCH_ROW; LAS unsigned char* Lv = Lk + 128 * RPITCH_ROW; LAS unsigned char* Ls = Lv + 128 * RPITCH_TR;
    const int lane = F.lane, w = F.wave, tid = F.tid, g = lane >> 4, li = lane & 15, q4 = li >> 2, p4 = li & 3;
    const float* gn = p.in[I_RGN] + l * 512;
    for (int u = F.bid; u < NB * 4 * 34; u += F.G) {
        const int c = u % 34, bh = u / 34, h = bh & 3, b = bh >> 2;
        if (c < 2 && !want_ctx) continue;
        const float lgf = log_gamma_of(p, l, 0, h) * 1.4426950408889634f, lgb = log_gamma_of(p, l, 1, h) * 1.4426950408889634f;
        const size_t row0 = (size_t)(b * NP + c * 128);
#pragma unroll
        for (int it = 0; it < 4; ++it) { const int idx = it * NTHREADS + tid, j = idx >> 4, c8 = (idx & 15) * 8;
            const size_t off = (row0 + j) * 512 + h * 128 + c8;
            *(LAS u32x4*)(Lq + j * RPITCH_ROW + c8 * 2) = *(const u32x4*)(RQ + off);
            *(LAS u32x4*)(Lk + j * RPITCH_ROW + c8 * 2) = *(const u32x4*)(RK + off);
            *(LAS u32x4*)(Lv + j * RPITCH_TR + c8 * 2) = *(const u32x4*)(RV + off);
            *(LAS u32x4*)(Ls + j * RPITCH_ROW + c8 * 2) = *(const u32x4*)(SF + (size_t)u * 16384 + j * 128 + c8); }
        __syncthreads();
        const int il = 16 * w + li;
        bf16x8 qf[4];
#pragma unroll
        for (int ks = 0; ks < 4; ++ks) qf[ks] = ld_frag(Lq + il * RPITCH_ROW + (32 * ks + 8 * g) * 2);
        f32x4 sc[8];
#pragma unroll
        for (int jt = 0; jt < 8; ++jt) { sc[jt] = (f32x4){0.f, 0.f, 0.f, 0.f};
#pragma unroll
            for (int ks = 0; ks < 4; ++ks) sc[jt] = MFMA16(ld_frag(Lk + (16 * jt + li) * RPITCH_ROW + (32 * ks + 8 * g) * 2), qf[ks], sc[jt]); }
#pragma unroll
        for (int jt = 0; jt < 8; ++jt)
#pragma unroll
            for (int r = 0; r < 4; ++r) { const int j = 16 * jt + 4 * g + r, dl = il - j;
                const float f = dl > 0 ? __builtin_amdgcn_exp2f(lgf * (float)dl) : (dl < 0 ? __builtin_amdgcn_exp2f(lgb * (float)(-dl)) : 2.f);
                sc[jt][r] *= f; }
        f32x4 y[8];
#pragma unroll
        for (int et = 0; et < 8; ++et) y[et] = (f32x4){0.f, 0.f, 0.f, 0.f};
        const LAS unsigned char* vbase = Lv;
#pragma unroll
        for (int ks = 0; ks < 4; ++ks) {
            const bf16x8 pf = pack_frag(sc[2 * ks], sc[2 * ks + 1]);
#pragma unroll
            for (int et = 0; et < 8; ++et) { const int col = 16 * et + 4 * p4;
                const bf16x8 vf = cat44(tr_read(vbase + (32 * ks + 4 * g + q4) * RPITCH_TR + col * 2), tr_read(vbase + (32 * ks + 16 + 4 * g + q4) * RPITCH_TR + col * 2));
                y[et] = MFMA16(vf, pf, y[et]); }
        }
        { f32x4 z[8]; const float sf = exp2f(lgf * (float)(il + 1));
#pragma unroll
          for (int et = 0; et < 8; ++et) { z[et] = (f32x4){0.f, 0.f, 0.f, 0.f};
#pragma unroll
              for (int ks = 0; ks < 4; ++ks) z[et] = MFMA16(ld_frag(Ls + (16 * et + li) * RPITCH_ROW + (32 * ks + 8 * g) * 2), qf[ks], z[et]);
              y[et] = y[et] + z[et] * sf; } }
        __syncthreads();
#pragma unroll
        for (int it = 0; it < 4; ++it) { const int idx = it * NTHREADS + tid, j = idx >> 4, c8 = (idx & 15) * 8;
            *(LAS u32x4*)(Ls + j * RPITCH_ROW + c8 * 2) = *(const u32x4*)(SB + (size_t)u * 16384 + j * 128 + c8); }
        __syncthreads();
        { f32x4 z[8]; const float sb = exp2f(lgb * (float)(128 - il));
#pragma unroll
          for (int et = 0; et < 8; ++et) { z[et] = (f32x4){0.f, 0.f, 0.f, 0.f};
#pragma unroll
              for (int ks = 0; ks < 4; ++ks) z[et] = MFMA16(ld_frag(Ls + (16 * et + li) * RPITCH_ROW + (32 * ks + 8 * g) * 2), qf[ks], z[et]);
              y[et] = y[et] + z[et] * sb; } }
        float ss = 0.f;
#pragma unroll
        for (int et = 0; et < 8; ++et)
#pragma unroll
            for (int r = 0; r < 4; ++r) ss += y[et][r] * y[et][r];
        ss += shfl_xor_f(ss, 16); ss += shfl_xor_f(ss, 32);
        const float rs = rsqrtf(ss * (1.f / 128.f) + 1e-6f);
        const size_t orow = (row0 + il) * 512 + h * 128;
#pragma unroll
        for (int et = 0; et < 8; ++et) { const int e = 16 * et + 4 * g;
            const u32x2 gw = *(const u32x2*)(RG + orow + e); const f32x4 gg = *(const f32x4*)(gn + h * 128 + e);
            const float o0 = siluf_(lo16(gw.x)) * y[et][0] * rs * gg[0], o1 = siluf_(hi16(gw.x)) * y[et][1] * rs * gg[1], o2 = siluf_(lo16(gw.y)) * y[et][2] * rs * gg[2], o3 = siluf_(hi16(gw.y)) * y[et][3] * rs * gg[3];
            u32x2 ow; ow.x = pk2(o0, o1); ow.y = pk2(o2, o3); *(u32x2*)(YR + (row0 + il) * 1536 + h * 128 + e) = ow; }
        __syncthreads();
    }
}
constexpr int APITCH = 144;
__device__ __forceinline__ void p11_attention(const Params& p, const Frame& F, bool want_ctx) {
    const bf16_t* AQ = WSB(p, WS_AQ); const bf16_t* AKV = WSB(p, WS_AKV); bf16_t* YA = WSB(p, WS_WU);
    const int lane = F.lane, w = F.wave, tid = F.tid, g = lane >> 4, li = lane & 15, q4 = li >> 2, p4 = li & 3;
    LAS unsigned char* LK = F.lds; LAS unsigned char* LV = F.lds + 4 * 64 * APITCH;
    const int nunits = NB * 8 * 17;
    for (int u0 = F.bid; u0 < nunits; u0 += F.G) {
        int b, h, qb;
        int u = u0;
        if (F.G == 256 && u0 < NB * 8 * 16) { const int r = u0 >> 8, x = u0 & 7, j = (u0 & 255) >> 3, pair = x + 8 * (r >> 1), un = (r & 1) * 32 + j;
            u = (pair >> 1) * 128 + ((pair & 1) * 4 + (un >> 4)) * 16 + (un & 15); }
        if (u < NB * 8 * 16) { b = u >> 7; h = (u >> 4) & 7; qb = 1 + (u & 15); } else { const int v = u - NB * 8 * 16; b = v >> 3; h = v & 7; qb = 0; }
        if (qb == 0 && !want_ctx) continue;
        const int kvh = h >> 2, ntile = qb == 0 ? NCTX / 64 : NP / 64;
        const size_t rowbase = (size_t)b * NP + (size_t)qb * 256;
        bf16x8 qf[2][2];
#pragma unroll
        for (int it = 0; it < 2; ++it)
#pragma unroll
            for (int ks = 0; ks < 2; ++ks) qf[it][ks] = *(const bf16x8*)(AQ + (rowbase + 32 * w + 16 * it + li) * 512 + h * 64 + 32 * ks + 8 * g);
        f32x4 o[4][2]; float m[2]; f32x4 lsa[2], minit[2];
        const bf16x8 ones = {(short)0x3F80, (short)0x3F80, (short)0x3F80, (short)0x3F80, (short)0x3F80, (short)0x3F80, (short)0x3F80, (short)0x3F80};
#pragma unroll
        for (int it = 0; it < 2; ++it) { m[it] = 0.f; lsa[it] = (f32x4){0.f, 0.f, 0.f, 0.f}; minit[it] = (f32x4){0.f, 0.f, 0.f, 0.f};
#pragma unroll
            for (int et = 0; et < 4; ++et) o[et][it] = (f32x4){0.f, 0.f, 0.f, 0.f}; }
        const int sj = tid >> 3, sc8 = (tid & 7) * 8;
        const bf16_t* kvsrc = AKV + ((size_t)b * NP + sj) * 256 + kvh * 64 + sc8;
        u32x4 kreg[2], vreg[2];
#pragma unroll
        for (int sb = 0; sb < 2; ++sb) { kreg[sb] = *(const u32x4*)(kvsrc + (size_t)sb * 64 * 256); vreg[sb] = *(const u32x4*)(kvsrc + (size_t)sb * 64 * 256 + 128); }
        __syncthreads();
        for (int kp = 0; kp < ntile / 2; ++kp) {
            LAS unsigned char* lkb = LK + (kp & 1) * 128 * APITCH; LAS unsigned char* lvb = LV + (kp & 1) * 128 * APITCH;
#pragma unroll
            for (int sb = 0; sb < 2; ++sb) { *(LAS u32x4*)(lkb + (sb * 64 + sj) * APITCH + sc8 * 2) = kreg[sb]; *(LAS u32x4*)(lvb + (sb * 64 + sj) * APITCH + sc8 * 2) = vreg[sb]; }
            __syncthreads();
            if (kp + 1 < ntile / 2) {
#pragma unroll
                for (int sb = 0; sb < 2; ++sb) { const bf16_t* s2 = kvsrc + (size_t)(2 * kp + 2 + sb) * 64 * 256; kreg[sb] = *(const u32x4*)s2; vreg[sb] = *(const u32x4*)(s2 + 128); } }
#pragma unroll
            for (int sb = 0; sb < 2; ++sb) { const int kt = 2 * kp + sb; LAS unsigned char* lk = lkb + sb * 64 * APITCH; LAS unsigned char* lv = lvb + sb * 64 * APITCH;
            f32x4 sc[4][2];
#pragma unroll
            for (int jt = 0; jt < 4; ++jt) {
                const bf16x8 kf0 = ld_frag(lk + (16 * jt + li) * APITCH + (8 * g) * 2), kf1 = ld_frag(lk + (16 * jt + li) * APITCH + (32 + 8 * g) * 2);
                sc[jt][0] = MFMA16(kf0, qf[0][0], minit[0]); sc[jt][1] = MFMA16(kf0, qf[1][0], minit[1]);
                sc[jt][0] = MFMA16(kf1, qf[0][1], sc[jt][0]); sc[jt][1] = MFMA16(kf1, qf[1][1], sc[jt][1]); }
            bf16x8 pf[2][2];
            if ((kt & 7) == 0) {
                float mx[2];
#pragma unroll
                for (int it = 0; it < 2; ++it) { float t = sc[0][it][0];
#pragma unroll
                    for (int jt = 0; jt < 4; ++jt)
#pragma unroll
                        for (int r = 0; r < 4; ++r) t = fmaxf(t, sc[jt][it][r]);
                    t = fmaxf(t, shfl_xor_f(t, 16)); t = fmaxf(t, shfl_xor_f(t, 32)); mx[it] = t; }
                if (kt == 0 || __any(fmaxf(mx[0], mx[1]) > 8.f)) {
#pragma unroll
                    for (int it = 0; it < 2; ++it) { const float d = kt == 0 ? mx[it] : fmaxf(mx[it], 0.f), alpha = kt == 0 ? 1.f : __builtin_amdgcn_exp2f(-d);
                        m[it] = kt == 0 ? d : m[it] + d; lsa[it] = lsa[it] * alpha; minit[it] = (f32x4){-m[it], -m[it], -m[it], -m[it]};
#pragma unroll
                        for (int et = 0; et < 4; ++et) o[et][it] = o[et][it] * alpha;
#pragma unroll
                        for (int jt = 0; jt < 4; ++jt)
#pragma unroll
                            for (int r = 0; r < 4; ++r) sc[jt][it][r] -= d; } } }
#pragma unroll
            for (int it = 0; it < 2; ++it) {
#pragma unroll
                for (int jt = 0; jt < 4; ++jt)
#pragma unroll
                    for (int r = 0; r < 4; ++r) sc[jt][it][r] = __builtin_amdgcn_exp2f(sc[jt][it][r]);
                pf[it][0] = pack_frag(sc[0][it], sc[1][it]); pf[it][1] = pack_frag(sc[2][it], sc[3][it]);
                lsa[it] = MFMA16(ones, pf[it][0], lsa[it]); lsa[it] = MFMA16(ones, pf[it][1], lsa[it]); }
#pragma unroll
            for (int ks = 0; ks < 2; ++ks)
#pragma unroll
                for (int et = 0; et < 4; ++et) { const int col = 16 * et + 4 * p4;
                    const bf16x8 vf = cat44(tr_read(lv + (32 * ks + 4 * g + q4) * APITCH + col * 2), tr_read(lv + (32 * ks + 16 + 4 * g + q4) * APITCH + col * 2));
                    o[et][0] = MFMA16(vf, pf[0][ks], o[et][0]); o[et][1] = MFMA16(vf, pf[1][ks], o[et][1]); }
            }
        }
#pragma unroll
        for (int it = 0; it < 2; ++it) { const float inv = __builtin_amdgcn_rcpf(lsa[it][0]);
            bf16_t* op = YA + (rowbase + 32 * w + 16 * it + li) * 1536 + h * 64 + 4 * g;
#pragma unroll
            for (int et = 0; et < 4; ++et) { u32x2 ow; ow.x = pk2(o[et][it][0] * inv, o[et][it][1] * inv); ow.y = pk2(o[et][it][2] * inv, o[et][it][3] * inv); *(u32x2*)(op + 16 * et) = ow; } }
    }
    __syncthreads();
}

__device__ __forceinline__ void p14_norm2_router(const Params& p, const Frame& F, int l, bool want_ctx) {
    LAS float* tile = (LAS float*)F.lds;
    (void)tile;
    const float* mod = WSF(p, WS_MOD) + (size_t)l * 9 * 6144; bf16_t* H2 = WSB(p, WS_H);
    const float* rw2 = WSF(p, WS_RW2) + (size_t)l * 64 * 3 * 4 * 16 * 4;
    const float* rcl = WSF(p, WS_RC) + (size_t)l * 9 * 48;
    const float* n2g = p.in[I_N2G] + (size_t)l * 1024;
    unsigned* cnt = (unsigned*)(p.ws + WS_CTL) + CW_CNT + l * 32;
    int* PE = (int*)(p.ws + WS_PAIR); int* PPOS = PE + NPAIR_MAX; float* PW = (float*)(PPOS + NPAIR_MAX);
    for (int gi = F.gwave; gi < T / 16; gi += F.nwave) {
        int lane = F.lane; asm volatile("" : "+v"(lane));
        const int g = lane >> 4, li = lane & 15, half = lane >> 5, lk = lane & 31;
        const int row0 = 16 * gi, b = row0 / NP, q = row0 - b * NP; const bool isctx = q < NCTX;
        if (isctx && !want_ctx) continue;
        const int mrow = isctx ? 8 : b; const float* mr = mod + (size_t)mrow * 6144;
        LAS float* At = (LAS float*)(F.lds + F.wave * 12288);
        LAS float* LGT = At + 16 * 4 * 36;
        const float* xr[8];
#pragma unroll
        for (int r = 0; r < 8; ++r) xr[r] = xrow(p, row0 + 8 * half + r);
        f32x4 acc[3]; float ss[8];
#pragma unroll
        for (int nt = 0; nt < 3; ++nt) acc[nt] = (f32x4){0.f, 0.f, 0.f, 0.f};
#pragma unroll
        for (int r = 0; r < 8; ++r) ss[r] = 0.f;
        f32x4 xv[8];
#pragma unroll
        for (int r = 0; r < 8; ++r) xv[r] = *(const f32x4*)(xr[r] + 4 * lk);
#pragma unroll 1
        for (int ck = 0; ck < 8; ++ck) { const int kc = ck * 128 + 4 * lk;
            const f32x4 gg = *(const f32x4*)(n2g + kc), s1 = *(const f32x4*)(mr + 4096 + kc);
            f32x4 gq; gq[0] = gg[0] * (1.f + s1[0]); gq[1] = gg[1] * (1.f + s1[1]); gq[2] = gg[2] * (1.f + s1[2]); gq[3] = gg[3] * (1.f + s1[3]);
            const float* wb = rw2 + ((size_t)(ck * 8) * 3 * 4 + g) * 64 + li * 4;
            f32x4 bc[3];
#pragma unroll
            for (int nt = 0; nt < 3; ++nt) bc[nt] = *(const f32x4*)(wb + nt * 256);
#pragma unroll
            for (int r = 0; r < 8; ++r) { ss[r] += xv[r][0] * xv[r][0] + xv[r][1] * xv[r][1] + xv[r][2] * xv[r][2] + xv[r][3] * xv[r][3];
#pragma unroll
                for (int e = 0; e < 4; ++e) At[((8 * half + r) * 4 + e) * 36 + lk] = xv[r][e] * gq[e]; }
            if (ck < 7) {
#pragma unroll
                for (int r = 0; r < 8; ++r) xv[r] = *(const f32x4*)(xr[r] + kc + 128); }
            asm volatile("" ::: "memory");
#pragma unroll
            for (int kq = 0; kq < 8; ++kq) { const f32x4 av = *(const LAS f32x4*)(At + (li * 4 + g) * 36 + 4 * kq);
                f32x4 bn[3];
                if (kq < 7) {
#pragma unroll
                    for (int nt = 0; nt < 3; ++nt) bn[nt] = *(const f32x4*)(wb + ((kq + 1) * 3 + nt) * 256); }
#pragma unroll
                for (int nt = 0; nt < 3; ++nt) {
#pragma unroll
                    for (int j = 0; j < 4; ++j) acc[nt] = __builtin_amdgcn_mfma_f32_16x16x4f32(av[j], bc[nt][j], acc[nt], 0, 0, 0); }
                if (kq < 7) {
#pragma unroll
                    for (int nt = 0; nt < 3; ++nt) bc[nt] = bn[nt]; } }
            asm volatile("" ::: "memory");
        }
#pragma unroll
        for (int r = 0; r < 8; ++r) {
#pragma unroll
            for (int mk = 1; mk < 32; mk <<= 1) ss[r] += shfl_xor_f(ss[r], mk);
            ss[r] = rsqrtf(ss[r] * (1.f / 1024.f) + 1e-6f); }
#pragma unroll
        for (int r2 = 0; r2 < 4; ++r2) { float rsA = ss[r2], rsB = ss[4 + r2]; asm volatile("" : "+v"(rsA), "+v"(rsB));
            const float rs = (g & 1) ? rsB : rsA;
#pragma unroll
            for (int nt = 0; nt < 3; ++nt) LGT[(4 * g + r2) * 48 + 16 * nt + li] = acc[nt][r2] * rs + rcl[mrow * 48 + 16 * nt + li]; }
        asm volatile("" ::: "memory");
        if (lane < 16 && !p.dry) {
            const int row = row0 + lane; const LAS float* lg = LGT + lane * 48;
            int grp = 0; float gm = lg[0];
            float gl4[4]; gl4[0] = gm;
#pragma unroll
            for (int i = 1; i < 4; ++i) { gl4[i] = lg[i]; if (gl4[i] > gm) { gm = gl4[i]; grp = i; } }
            float gs = 0.f;
#pragma unroll
            for (int i = 0; i < 4; ++i) gs += __expf(gl4[i] - gm);
            const float pg = frcp(gs);
            int i1 = 0, i2 = -1; float v1 = -3.0e38f, v2 = -3.0e38f;
#pragma unroll
            for (int i = 0; i < 8; ++i) { const float v = lg[4 + grp * 8 + i];
                if (v > v1) { v2 = v1; i2 = i1; v1 = v; i1 = i; } else if (v > v2) { v2 = v; i2 = i; } }
            const float e2 = __expf(v2 - v1), w1 = pg * frcp(1.f + e2), w2 = pg * e2 * frcp(1.f + e2);
            const int ex1 = grp * 8 + i1, ex2 = grp * 8 + i2;
            const unsigned p1 = atomicAdd(&cnt[ex1], 1u), p2 = atomicAdd(&cnt[ex2], 1u);
            PE[2 * row] = ex1; PE[2 * row + 1] = ex2; PPOS[2 * row] = (int)p1; PPOS[2 * row + 1] = (int)p2; PW[2 * row] = w1; PW[2 * row + 1] = w2;
        }
        if (!p.dry && lk == 0) { float* RSR = WSF(p, WS_RSROW);
#pragma unroll
            for (int r = 0; r < 8; ++r) RSR[row0 + 8 * half + r] = ss[r]; }
    }
}
struct MoeTab { LAS int* pad_start; LAS int* blk_e; LAS int* n_used; };
__device__ __forceinline__ MoeTab moe_tab(const Frame& F) { MoeTab t; LAS int* base = (LAS int*)(F.lds + MISC_OFF + 64); t.pad_start = base; t.blk_e = base + 32; t.n_used = base + 32 + MOE_NBLK; return t; }
__device__ __forceinline__ void moe_build_tab(const Params& p, const Frame& F, int l) {
    const MoeTab t = moe_tab(F);
    const unsigned* cnt = (const unsigned*)(p.ws + WS_CTL) + CW_CNT + l * 32;
    __syncthreads();
    if (F.tid == 0) { int acc = 0;
        for (int e = 0; e < 32; ++e) { const int c = (int)__hip_atomic_load(cnt + e, __ATOMIC_RELAXED, __HIP_MEMORY_SCOPE_AGENT), nb = (c + 255) >> 8; t.pad_start[e] = acc * 256;
            for (int k = 0; k < nb; ++k) t.blk_e[acc + k] = e;
            acc += nb; }
        *t.n_used = acc; }
    __syncthreads();
}
__device__ __forceinline__ void p15_scatter(const Params& p, const Frame& F, int l, bool want_ctx) {
    moe_build_tab(p, F, l);
    const MoeTab t = moe_tab(F);
    const int* PE = (const int*)(p.ws + WS_PAIR); const int* PPOS = PE + NPAIR_MAX; int* PD = (int*)(p.ws + WS_PAIR) + 3 * NPAIR_MAX;
    const float* RSR = WSF(p, WS_RSROW); bf16_t* BUF = WSB(p, WS_BUF);
    const float* mod = WSF(p, WS_MOD) + (size_t)l * 9 * 6144; const float* n2g = p.in[I_N2G] + (size_t)l * 1024;
    const int lane = F.lane;
    for (int row = F.gwave; row < T; row += F.nwave) {
        const int b = row / NP, q = row - b * NP; const bool isctx = q < NCTX;
        if (isctx && !want_ctx) continue;
        const float* mr = mod + (size_t)(isctx ? 8 : b) * 6144; const float* x = xrow(p, row);
        const float rs = RSR[row];
        const int d0 = t.pad_start[PE[2 * row]] + PPOS[2 * row], d1 = t.pad_start[PE[2 * row + 1]] + PPOS[2 * row + 1];
        if (lane == 0) { PD[2 * row] = d0; PD[2 * row + 1] = d1; }
        f32x4 xv[4];
#pragma unroll
        for (int j = 0; j < 4; ++j) xv[j] = *(const f32x4*)(x + j * 256 + lane * 4);
#pragma unroll
        for (int j = 0; j < 4; ++j) { const int c = j * 256 + lane * 4;
            const f32x4 gg = *(const f32x4*)(n2g + c), s1 = *(const f32x4*)(mr + 4096 + c), s0 = *(const f32x4*)(mr + 3072 + c); float y[4];
#pragma unroll
            for (int e = 0; e < 4; ++e) y[e] = xv[j][e] * rs * gg[e] * (1.f + s1[e]) + s0[e];
            u32x2 w; w.x = pk2(y[0], y[1]); w.y = pk2(y[2], y[3]);
            *(u32x2*)(BUF + (size_t)d0 * 1024 + c) = w; *(u32x2*)(BUF + (size_t)d1 * 1024 + c) = w; }
    }
}
__device__ __forceinline__ void p18_combine(const Params& p, const Frame& F, int l, bool want_ctx) {
    const int* PD = (const int*)(p.ws + WS_PAIR) + 3 * NPAIR_MAX; const float* PW = (const float*)(p.ws + WS_PAIR) + 2 * NPAIR_MAX;
    const bf16_t* YB = WSB(p, WS_YB);
    const float* mod = WSF(p, WS_MOD) + (size_t)l * 9 * 6144;
    const float* modn = mod + 9 * 6144;
    const float* n1g = p.in[I_N1G] + (size_t)(l + 1) * 1024;
    bf16_t* H = WSB(p, WS_H);
    const bool donorm = (l + 1 < DEPTH);
    const int lane = F.lane;
    for (int row = F.gwave; row < T; row += F.nwave) {
        const int b = row / NP, q = row - b * NP; const bool isctx = q < NCTX;
        if (isctx && !want_ctx) continue;
        const int mrow = isctx ? 8 : b;
        const float* g2 = mod + (size_t)mrow * 6144 + 5120;
        const int d0 = PD[2 * row], d1 = PD[2 * row + 1]; const float w0 = PW[2 * row], w1 = PW[2 * row + 1];
        float* x = xrow(p, row);
        f32x4 xv[4]; float ss = 0.f;
#pragma unroll
        for (int j = 0; j < 2; ++j) { const int c = j * 512 + lane * 8;
            float ya[8], yb[8]; unpack8(*(const u32x4*)(YB + (size_t)d0 * 1024 + c), ya); unpack8(*(const u32x4*)(YB + (size_t)d1 * 1024 + c), yb);
            f32x4 x0 = *(const f32x4*)(x + c), x1 = *(const f32x4*)(x + c + 4); const f32x4 ga = *(const f32x4*)(g2 + c), gb = *(const f32x4*)(g2 + c + 4);
#pragma unroll
            for (int e = 0; e < 4; ++e) { x0[e] += ga[e] * (w0 * ya[e] + w1 * yb[e]); x1[e] += gb[e] * (w0 * ya[4 + e] + w1 * yb[4 + e]); ss += x0[e] * x0[e] + x1[e] * x1[e]; }
            if (!p.dry) { *(f32x4*)(x + c) = x0; *(f32x4*)(x + c + 4) = x1; }
            xv[2 * j] = x0; xv[2 * j + 1] = x1; }
        if (donorm) {
#pragma unroll
            for (int m = 1; m < 64; m <<= 1) ss += shfl_xor_f(ss, m);
            const float rs = rsqrtf(ss * (1.f / 1024.f) + 1e-6f);
            const float* mr = modn + (size_t)mrow * 6144;
#pragma unroll
            for (int j = 0; j < 2; ++j) { const int c = j * 512 + lane * 8; float y[8];
#pragma unroll
                for (int hf = 0; hf < 2; ++hf) { const f32x4 gg = *(const f32x4*)(n1g + c + 4 * hf), s1 = *(const f32x4*)(mr + 1024 + c + 4 * hf), s0 = *(const f32x4*)(mr + c + 4 * hf);
#pragma unroll
                    for (int e = 0; e < 4; ++e) y[4 * hf + e] = xv[2 * j + hf][e] * rs * gg[e] * (1.f + s1[e]) + s0[e]; }
                if (!p.dry) *(u32x4*)(H + (size_t)row * 1024 + c) = pack8(y); } }
    }
}
constexpr size_t WS_REC = WS_WU; constexpr int REC_BYTES = 15360, RC_BYTES = 1792;
static_assert(WS_LW == WS_WU + (size_t)T * 1792 * 2 && WS_LA == WS_LW + (size_t)T * 1024 * 2 && WS_LG == WS_LA + (size_t)T * 1024 * 2, "WU|LW|LA contiguous");
static_assert(WS_REC + (size_t)NB * 8 * (NP / 16) * REC_BYTES <= WS_LG, "chunk records fit");
constexpr size_t WS_YCAT = WS_WU;
constexpr size_t WS_YS2 = WS_H;
constexpr int NCHUNK = NP / 16;
__device__ __forceinline__ int scan_pos(int s, int dir) { return dir ? (s < NCTX ? NCTX - 1 - s : NP + NCTX - 1 - s) : s; }
constexpr size_t WS_REC2 = WS_W1;
constexpr size_t WS_VS2 = AL(WS_REC2 + (size_t)NB * 8 * (NP / 16) * REC_BYTES);
constexpr size_t WS_BON = AL(WS_VS2 + SZ512);
static_assert(WS_BON + (size_t)2 * T * 8 * 4 <= WS_END_MIX, "records + V' + bonus fit in the W1 region");
struct BuildRaw { u32x4 wu[3][2], halo[3], lw[2], la[2]; };
template <int DIR> __device__ __forceinline__ void build_load(BuildRaw& R, const Params& p, int ch, int lane) {
    const bf16_t* WU = WSB(p, WS_WU); const bf16_t* LWg = WSB(p, WS_LW); const bf16_t* LAg = WSB(p, WS_LA);
    const int bh = ch / NCHUNK, tb = ch - bh * NCHUNK, b = bh >> 3, h = bh & 7;
    const int q0 = 16 * tb; const size_t row0 = (size_t)b * NP + q0;
    const int lt = lane >> 2, lc = (lane & 3) * 16;
    const bool hasp = (q0 != 0) && (q0 != NCTX), hasn = (q0 + 16 != NCTX) && (q0 + 16 != NP);
#pragma unroll
    for (int part = 0; part < 3; ++part) { const bf16_t* src = WU + (row0 + lt) * 1792 + part * 512 + h * 64 + lc;
        R.wu[part][0] = *(const u32x4*)src; R.wu[part][1] = *(const u32x4*)(src + 8);
        u32x4 hv; hv.x = hv.y = hv.z = hv.w = 0u;
        if (lane < 16) { const bool nx = lane >= 8; const bool ok = nx ? hasn : hasp;
            if (ok) hv = *(const u32x4*)(WU + (nx ? row0 + 16 : row0 - 1) * 1792 + part * 512 + h * 64 + (lane & 7) * 8); }
        R.halo[part] = hv; }
    const bf16_t* s1p = LWg + (row0 + lt) * 1024 + DIR * 512 + h * 64 + lc; const bf16_t* s2p = LAg + (row0 + lt) * 1024 + DIR * 512 + h * 64 + lc;
    R.lw[0] = *(const u32x4*)s1p; R.lw[1] = *(const u32x4*)(s1p + 8); R.la[0] = *(const u32x4*)s2p; R.la[1] = *(const u32x4*)(s2p + 8);
}
template <int DIR> __device__ __forceinline__ void p6c_rwkv_build(const Params& p, const Frame& F, int l) {
    constexpr int dir = DIR;
    unsigned char* REC = p.ws + WS_REC2; bf16_t* VSo = WSB(p, WS_VS2); float* BON = WSF(p, WS_BON) + (size_t)dir * T * 8;
    constexpr int TP_ = 144;
    BuildRaw cur, nxt;
    if (F.gwave < NB * 8 * NCHUNK) build_load<DIR>(cur, p, F.gwave, F.lane);
    for (int ch = F.gwave; ch < NB * 8 * NCHUNK; ch += F.nwave) {
        int lane = F.lane; asm volatile("" : "+v"(lane));
        const int g = lane >> 4, li = lane & 15;
        LAS unsigned char* wl = F.lds + F.wave * 17408;
        LAS unsigned char* Ta = wl; LAS unsigned char* Tr = wl + 2304; LAS unsigned char* Tb = wl + 4608; LAS unsigned char* Tk = wl + 6912;
        LAS float* M = (LAS float*)wl;
        LAS unsigned char* Sv = wl + 9216;
        const int pj = (lane & 32) + ((lane & 15) >> 2) * 8 + ((lane >> 4) & 1) * 4 + (lane & 3);
        const int bh = ch / NCHUNK, tb = ch - bh * NCHUNK, b = bh >> 3, h = bh & 7;
        const int q0 = 16 * tb; const size_t row0 = (size_t)b * NP + q0;
        const int cidx = dir ? (tb < 16 ? 15 - tb : 287 - tb) : tb;
        const int lt = lane >> 2, lc = (lane & 3) * 16;
#pragma unroll
        for (int part = 0; part < 3; ++part) {
            *(LAS u32x4*)(wl + part * 2304 + (lt + 1) * 128 + lc * 2) = cur.wu[part][0]; *(LAS u32x4*)(wl + part * 2304 + (lt + 1) * 128 + lc * 2 + 16) = cur.wu[part][1];
            if (lane < 16) *(LAS u32x4*)(wl + part * 2304 + (lane >= 8 ? 17 * 128 : 0) + (lane & 7) * 16) = cur.halo[part]; }
        const int cc = h * 64 + lane;
        float rr[16], kx[16], vx[16], kn[16];
        { const float* mu0 = p.in[I_MU] + (size_t)l * 2 * 1792, *mu1 = mu0 + 1792;
          const float kkc = p.in[I_KK][l * 512 + cc];
#pragma unroll
          for (int part = 0; part < 3; ++part) { const float m0 = mu0[part * 512 + cc], m1 = mu1[part * 512 + cc];
              float raw[18];
#pragma unroll
              for (int t = 0; t < 18; ++t) raw[t] = bf2f(*(const LAS bf16_t*)(wl + part * 2304 + t * 128 + lane * 2));
#pragma unroll
              for (int t = 0; t < 16; ++t) { const float u = raw[t + 1], sh = u + (raw[t] - u) * m0 + (raw[t + 2] - u) * m1;
                  if (part == 0) rr[t] = sh; else if (part == 1) kx[t] = sh; else vx[t] = sh; } }
          float s0[8], s1[8];
#pragma unroll
          for (int t = 0; t < 8; ++t) { kn[t] = kx[t] * kkc; kn[t + 8] = kx[t + 8] * kkc; s0[t] = kn[t] * kn[t]; s1[t] = kn[t + 8] * kn[t + 8]; }
          const float t0 = reduce8(s0, lane), t1 = reduce8(s1, lane);
#pragma unroll
          for (int t = 0; t < 8; ++t) { kn[t] *= rsqrtf(fmaxf(__shfl(t0, t * 8, 64), 1e-12f)); kn[t + 8] *= rsqrtf(fmaxf(__shfl(t1, t * 8, 64), 1e-12f)); }
          asm volatile("" ::: "memory");
          if (dir == 0) {
#pragma unroll
              for (int t = 0; t < 16; ++t) *(LAS bf16_t*)(Sv + t * 128 + lane * 2) = (bf16_t)f2bf(vx[t]);
              asm volatile("" ::: "memory");
              bf16_t* vo = VSo + (row0 + lt) * 512 + h * 64 + lc; *(u32x4*)vo = *(const LAS u32x4*)(Sv + lt * 128 + lc * 2); *(u32x4*)(vo + 8) = *(const LAS u32x4*)(Sv + lt * 128 + lc * 2 + 16); }
          *(LAS u32x4*)(wl + lt * 128 + lc * 2) = cur.lw[0]; *(LAS u32x4*)(wl + lt * 128 + lc * 2 + 16) = cur.lw[1];
          *(LAS u32x4*)(wl + 2048 + lt * 128 + lc * 2) = cur.la[0]; *(LAS u32x4*)(wl + 2048 + lt * 128 + lc * 2 + 16) = cur.la[1]; }
        { const int chn = ch + F.nwave; if (chn < NB * 8 * NCHUNK) build_load<DIR>(nxt, p, chn, lane); else nxt = cur; }
        float X[16], Q[16], v[16], bhh[16], khh[16]; float Lc = 0.f;
        { const float w0c = p.in[I_W0][((size_t)l * 2 + dir) * 512 + cc], a0c = p.in[I_A0][((size_t)l * 2 + dir) * 512 + cc], kac = p.in[I_KA][l * 512 + cc], rkc = p.in[I_RK][l * 512 + cc];
          float bs0[8], bs1[8];
#pragma unroll
          for (int t = 0; t < 16; ++t) {
              constexpr int dummy_ = 0; (void)dummy_;
              const int tt = dir ? 15 - t : t; const int o = tt * 128 + lane * 2;
              const float lwv = bf2f(*(const LAS bf16_t*)(wl + o)), lav = bf2f(*(const LAS bf16_t*)(wl + 2048 + o));
              const float r = rr[tt], kp = kx[tt], kkn = kn[tt]; v[t] = vx[tt];
              const float asig = sigmoidf_(a0c + lav), lw = -0.6065306597126334f * sigmoidf_(w0c + lwv);
              const float k = kp * (1.f + (asig - 1.f) * kac), bb = kkn * asig, a = -kkn;
              if (t < 8) bs0[t] = r * k * rkc; else bs1[t - 8] = r * k * rkc;
              const float Lx = Lc; Lc += lw;
              const float at = a * __expf(Lx), rt = r * __expf(Lc), en = __expf(-Lc);
              X[t] = at; Q[t] = rt; bhh[t] = bb * en; khh[t] = k * en;
          }
          const float u0 = reduce8(bs0, lane), u1 = reduce8(bs1, lane);
          if ((lane & 7) == 0) { const int t = lane >> 3; const int tk0 = dir ? 15 - t : t, tk1 = dir ? 7 - t : 8 + t; BON[(row0 + tk0) * 8 + h] = u0; BON[(row0 + tk1) * 8 + h] = u1; } }
        asm volatile("" ::: "memory");
#pragma unroll
        for (int t = 0; t < 16; ++t) {
            *(LAS bf16_t*)(Ta + t * TP_ + lane * 2) = (bf16_t)f2bf(X[t]); *(LAS bf16_t*)(Tr + t * TP_ + lane * 2) = (bf16_t)f2bf(Q[t]);
            *(LAS bf16_t*)(Tb + t * TP_ + lane * 2) = (bf16_t)f2bf(bhh[t]); *(LAS bf16_t*)(Tk + t * TP_ + lane * 2) = (bf16_t)f2bf(khh[t]);
        }
        const float gC = __expf(Lc);
#pragma unroll
        for (int t = 0; t < 16; ++t) { bhh[t] *= gC; khh[t] *= gC; }
        unsigned char* rec = REC + ((size_t)bh * NCHUNK + cidx) * REC_BYTES;
#pragma unroll
        for (int q4 = 0; q4 < 4; ++q4) *(float*)(rec + 8192 + q4 * RC_BYTES + 1536 + lane * 4) = gC;
#pragma unroll
        for (int gg = 0; gg < 4; ++gg) { u32x4 w; w.x = pk2(bhh[4 * gg], bhh[4 * gg + 1]); w.y = pk2(bhh[4 * gg + 2], bhh[4 * gg + 3]); w.z = pk2(khh[4 * gg], khh[4 * gg + 1]); w.w = pk2(khh[4 * gg + 2], khh[4 * gg + 3]);
            *(u32x4*)(rec + 4096 + (lane * 32 + gg * 8) * 2) = w; }
        f32x4 mab = {0.f, 0.f, 0.f, 0.f}, mak = mab, mrb = mab, mrk = mab;
#pragma unroll
        for (int ks = 0; ks < 2; ++ks) { const int o = li * TP_ + (32 * ks + 8 * g) * 2;
            const bf16x8 fa = ld_frag(Ta + o), fr = ld_frag(Tr + o), fb = ld_frag(Tb + o), fk = ld_frag(Tk + o);
            mab = MFMA16(fa, fb, mab); mak = MFMA16(fa, fk, mak); mrb = MFMA16(fr, fb, mrb); mrk = MFMA16(fr, fk, mrk); }
        asm volatile("" ::: "memory");
#pragma unroll
        for (int r = 0; r < 4; ++r) { const int t = 4 * g + r;
            M[t * 16 + li] = li < t ? mab[r] : 0.f; M[256 + t * 16 + li] = li < t ? mak[r] : 0.f;
            M[512 + t * 16 + li] = li <= t ? mrb[r] : 0.f; M[768 + t * 16 + li] = li <= t ? mrk[r] : 0.f; }
        f32x2 XU[16]; float Y0[16];
        XU[0] = (f32x2){X[0], 0.f};
#pragma unroll
        for (int t = 1; t < 16; ++t) { f32x2 xu = {X[t], 0.f}; float u2 = 0.f;
#pragma unroll
            for (int s4 = 0; s4 < 4; ++s4) { if (4 * s4 < t) { const f32x4 ab = *(const LAS f32x4*)(M + t * 16 + 4 * s4), ak = *(const LAS f32x4*)(M + 256 + t * 16 + 4 * s4);
#pragma unroll
                for (int e = 0; e < 4; ++e) { const int s = 4 * s4 + e; if (s < t) { xu = xu + XU[s] * ab[e]; u2 += ak[e] * v[s]; } } } }
            xu.y += u2;
            asm volatile("" : "+v"(xu) :: "memory");
            XU[t] = xu; }
#pragma unroll
        for (int t = 0; t < 16; ++t) { f32x2 qy = {Q[t], 0.f}; float y2 = 0.f;
#pragma unroll
            for (int s4 = 0; s4 < 4; ++s4) { if (4 * s4 <= t) { const f32x4 rb = *(const LAS f32x4*)(M + 512 + t * 16 + 4 * s4), rk = *(const LAS f32x4*)(M + 768 + t * 16 + 4 * s4);
#pragma unroll
                for (int e = 0; e < 4; ++e) { const int s = 4 * s4 + e; if (s <= t) { qy = qy + XU[s] * rb[e]; y2 += rk[e] * v[s]; } } } }
            qy.y += y2;
            asm volatile("" : "+v"(qy) :: "memory");
            Q[t] = qy.x; Y0[t] = qy.y; }
        float U0[16];
#pragma unroll
        for (int t = 0; t < 16; ++t) { X[t] = XU[t].x; U0[t] = XU[t].y; }
        asm volatile("" ::: "memory");
#pragma unroll
        for (int t = 0; t < 16; ++t) { *(LAS bf16_t*)(wl + 4096 + (t * 64 + pj) * 2) = (bf16_t)f2bf(X[t]); *(LAS bf16_t*)(wl + 6144 + (t * 64 + pj) * 2) = (bf16_t)f2bf(Q[t]); }
        asm volatile("" ::: "memory");
#pragma unroll
        for (int k = 0; k < 4; ++k) *(u32x4*)(rec + k * 1024 + lane * 16) = *(const LAS u32x4*)(wl + 4096 + k * 1024 + lane * 16);
        unsigned char* rc = rec + 8192 + g * RC_BYTES + li * 32;
#pragma unroll
        for (int hf = 0; hf < 2; ++hf) { u32x4 w;
            w.x = pk2(v[8 * hf], v[8 * hf + 1]); w.y = pk2(v[8 * hf + 2], v[8 * hf + 3]); w.z = pk2(v[8 * hf + 4], v[8 * hf + 5]); w.w = pk2(v[8 * hf + 6], v[8 * hf + 7]); *(u32x4*)(rc + hf * 16) = w;
            w.x = pk2(U0[8 * hf], U0[8 * hf + 1]); w.y = pk2(U0[8 * hf + 2], U0[8 * hf + 3]); w.z = pk2(U0[8 * hf + 4], U0[8 * hf + 5]); w.w = pk2(U0[8 * hf + 6], U0[8 * hf + 7]); *(u32x4*)(rc + 512 + hf * 16) = w;
            w.x = pk2(Y0[8 * hf], Y0[8 * hf + 1]); w.y = pk2(Y0[8 * hf + 2], Y0[8 * hf + 3]); w.z = pk2(Y0[8 * hf + 4], Y0[8 * hf + 5]); w.w = pk2(Y0[8 * hf + 6], Y0[8 * hf + 7]); *(u32x4*)(rc + 1024 + hf * 16) = w; }
        cur = nxt;
    }
}
constexpr int SC_SLOT = 10240, SC_NSLOT = 13, SC_DEPTH = 6;
__device__ __forceinline__ void scan_dma(const unsigned char* rec, int iq, LAS unsigned char* slot, int lane) {
    const unsigned char* g0 = rec + lane * 16;
#pragma unroll
    for (int k = 0; k < 8; ++k) __builtin_amdgcn_global_load_lds((const unsigned*)(g0 + k * 1024), (LAS unsigned*)(slot + k * 1024), 16, 0, 0);
    const unsigned char* g1 = rec + 8192 + iq * RC_BYTES + lane * 16;
    __builtin_amdgcn_global_load_lds((const unsigned*)g1, (LAS unsigned*)(slot + 8192), 16, 0, 0);
    if (lane < 48) __builtin_amdgcn_global_load_lds((const unsigned*)(g1 + 1024), (LAS unsigned*)(slot + 9216), 16, 0, 0);
}
__device__ __forceinline__ unsigned lds_ld(volatile LAS unsigned* q) { return *q; }
__device__ __forceinline__ void p6b_rwkv_scan(const Params& p, const Frame& F, int dir) {
    volatile LAS unsigned* ctl = (volatile LAS unsigned*)(F.lds + MISC_OFF + 1536);
    if (F.tid < 3) ctl[F.tid] = 0u;
    __syncthreads();
    if (F.wave > 2) return;
    const int lane = F.lane, g = lane >> 4, li = lane & 15;
    const int task = (F.G == 256) ? (F.bid & 7) * 32 + (F.bid >> 3) : F.bid;
    if (task >= NB * 8 * 4) return;
    const int bh = task >> 2, iq = task & 3, b = bh >> 3, h = bh & 7;
    const unsigned char* rec0 = p.ws + WS_REC2 + (size_t)bh * NCHUNK * REC_BYTES;
    if (F.wave != 0) {
        const int hh = F.wave - 1;
        if (p.dry == 1) return;
        asm volatile("s_waitcnt vmcnt(0)" ::: "memory");
#pragma unroll 1
        for (int n = 0; n < NCHUNK / 2; ++n) { const int k = 2 * n + hh;
            while ((int)lds_ld(ctl + 2) + SC_NSLOT <= k) __builtin_amdgcn_s_sleep(1);
            scan_dma(rec0 + (size_t)k * REC_BYTES, iq, F.lds + (k % SC_NSLOT) * SC_SLOT, lane);
            if (n >= 5) { asm volatile("s_waitcnt vmcnt(50)" ::: "memory"); if (lane == 0) ctl[hh] = (unsigned)(n - 4); } }
        asm volatile("s_waitcnt vmcnt(0)" ::: "memory");
        if (lane == 0) ctl[hh] = (unsigned)(NCHUNK / 2);
        return;
    }
    bf16_t* YS = WSB(p, WS_YS2) + (size_t)dir * T * 512;
    f32x4 st[4];
#pragma unroll
    for (int jt = 0; jt < 4; ++jt) st[jt] = (f32x4){0.f, 0.f, 0.f, 0.f};
    struct Ops { bf16x8 ah[2], qq[2], bk[4]; f32x4 gc[4]; u32x2 vt, u0, y0; };
#define SCAN_WAIT(c_) do { const unsigned need_ = (unsigned)((c_) >> 1) + 1u; volatile LAS unsigned* lw_ = ctl + ((c_) & 1); while (lds_ld(lw_) < need_) __builtin_amdgcn_s_sleep(1); asm volatile("" ::: "memory"); } while (0)
#define SCAN_WAIT2(c_) do { const unsigned n1_ = (unsigned)((c_) >> 1) + 1u, n0_ = ((c_) + 2 < NCHUNK) ? (unsigned)((c_) >> 1) + 2u : 0u; \
        for (;;) { const u32x2 fl_ = *(volatile LAS u32x2*)ctl; if (fl_.x >= n0_ && fl_.y >= n1_) break; __builtin_amdgcn_s_sleep(1); } asm volatile("" ::: "memory"); } while (0)
#define SCAN_LOAD(o_, c_) do { const LAS unsigned char* sl_ = F.lds + ((c_) % SC_NSLOT) * SC_SLOT; \
        _Pragma("unroll") for (int ks = 0; ks < 2; ++ks) { o_.ah[ks] = ld_frag(sl_ + (li * 64 + ks * 32 + g * 8) * 2); o_.qq[ks] = ld_frag(sl_ + 2048 + (li * 64 + ks * 32 + g * 8) * 2); } \
        _Pragma("unroll") for (int jt = 0; jt < 4; ++jt) { o_.bk[jt] = ld_frag(sl_ + 4096 + ((16 * jt + li) * 32 + g * 8) * 2); o_.gc[jt] = *(const LAS f32x4*)(sl_ + 8192 + 1536 + (16 * jt + 4 * g) * 4); } \
        o_.vt = *(const LAS u32x2*)(sl_ + 8192 + (li * 16 + 4 * g) * 2); o_.u0 = *(const LAS u32x2*)(sl_ + 8192 + 512 + (li * 16 + 4 * g) * 2); o_.y0 = *(const LAS u32x2*)(sl_ + 8192 + 1024 + (li * 16 + 4 * g) * 2); } while (0)
    const int pmode = p.dry;
    if (pmode == 2) { for (int c = 0; c < NCHUNK; ++c) { SCAN_WAIT(c); if (lane == 0) ctl[2] = (unsigned)(c + 1); } return; }
    Ops o0, o1;
    if (pmode != 1) SCAN_WAIT(0);
    SCAN_LOAD(o0, 0);
    const int rstep = dir ? -512 : 512;
#define SCAN_YPTR(c_) (YS + ((size_t)(b * NP + scan_pos(16 * (c_) + 4 * g, dir))) * 512 + h * 64 + 16 * iq + li)
#define SCAN_STEP(cur_, nxt_, c_) do { \
        const bf16x8 sb0 = pack_frag(st[0], st[1]), sb1 = pack_frag(st[2], st[3]); \
        f32x4 U = {lo16(cur_.u0.x), hi16(cur_.u0.x), lo16(cur_.u0.y), hi16(cur_.u0.y)}, Y = {lo16(cur_.y0.x), hi16(cur_.y0.x), lo16(cur_.y0.y), hi16(cur_.y0.y)}; \
        U = MFMA16(cur_.ah[0], sb0, U); Y = MFMA16(cur_.qq[0], sb0, Y); U = MFMA16(cur_.ah[1], sb1, U); Y = MFMA16(cur_.qq[1], sb1, Y); \
        asm volatile("" ::: "memory"); \
        if ((c_) + 1 < NCHUNK) { if (pmode != 1 && ((c_) & 1) == 0) SCAN_WAIT2(c_); SCAN_LOAD(nxt_, (c_) + 1); } \
        asm volatile("" ::: "memory"); \
        u32x4 uvw; uvw.x = pk2(U[0], U[1]); uvw.y = pk2(U[2], U[3]); uvw.z = cur_.vt.x; uvw.w = cur_.vt.y; \
        const bf16x8 uv = __builtin_bit_cast(bf16x8, uvw); \
        _Pragma("unroll") for (int jt = 0; jt < 4; ++jt) st[jt] = MFMA16(cur_.bk[jt], uv, st[jt] * cur_.gc[jt]); \
        if (pmode == 0) { bf16_t* yp = SCAN_YPTR(c_); _Pragma("unroll") for (int r = 0; r < 4; ++r) yp[r * rstep] = (bf16_t)f2bf(Y[r]); } \
        else if (Y[0] == 1.2345f) YS[0] = 0; \
        asm volatile("s_waitcnt lgkmcnt(0)" ::: "memory"); \
        if (lane == 0) ctl[2] = (unsigned)((c_) + 2); } while (0)
#pragma unroll 1
    for (int c = 0; c < NCHUNK; c += 2) { SCAN_STEP(o0, o1, c); SCAN_STEP(o1, o0, c + 1); }
#undef SCAN_STEP
#undef SCAN_YPTR
#undef SCAN_WAIT
#undef SCAN_WAIT2
#undef SCAN_LOAD
}

__device__ __forceinline__ void p7_rwkv_readout(const Params& p, const Frame& F, int l) {
    const bf16_t* VS = WSB(p, WS_VS2); const float* BON0 = WSF(p, WS_BON); const float* BON1 = BON0 + (size_t)T * 8;
    const bf16_t* YS0 = WSB(p, WS_H); const bf16_t* YS1 = YS0 + (size_t)T * 512;
    const bf16_t* LG = WSB(p, WS_LG); bf16_t* YW = WSB(p, WS_WU) + 1024;
    const int lane = F.lane, c0 = lane * 8;
    const float* ln_g = p.in[I_LNG] + l * 512, *ln_b = p.in[I_LNB] + l * 512;
    for (int row = F.gwave; row < T; row += F.nwave) {
        const size_t off = (size_t)row * 512 + c0;
        float y0[8], y1[8], v[8], g[8];
        unpack8(*(const u32x4*)(YS0 + off), y0); unpack8(*(const u32x4*)(YS1 + off), y1); unpack8(*(const u32x4*)(VS + off), v); unpack8(*(const u32x4*)(LG + off), g);
        const float bs = BON0[(size_t)row * 8 + (lane >> 3)] + BON1[(size_t)row * 8 + (lane >> 3)];
        float y[8], sm = 0.f;
#pragma unroll
        for (int e = 0; e < 8; ++e) { y[e] = y0[e] + y1[e]; sm += y[e]; }
        sm += shfl_xor_f(sm, 1); sm += shfl_xor_f(sm, 2); sm += shfl_xor_f(sm, 4);
        const float mean = sm * (1.f / 64.f); float vs = 0.f;
#pragma unroll
        for (int e = 0; e < 8; ++e) { const float d = y[e] - mean; vs += d * d; }
        vs += shfl_xor_f(vs, 1); vs += shfl_xor_f(vs, 2); vs += shfl_xor_f(vs, 4);
        const float rstd = rsqrtf(vs * (1.f / 64.f) + 64e-5f);
        float lg8[8], lb8[8]; *(f32x4*)lg8 = *(const f32x4*)(ln_g + c0); *(f32x4*)(lg8 + 4) = *(const f32x4*)(ln_g + c0 + 4); *(f32x4*)lb8 = *(const f32x4*)(ln_b + c0); *(f32x4*)(lb8 + 4) = *(const f32x4*)(ln_b + c0 + 4);
        float o[8];
#pragma unroll
        for (int e = 0; e < 8; ++e) o[e] = ((y[e] - mean) * rstd * lg8[e] + lb8[e] + bs * v[e]) * g[e];
        *(u32x4*)(YW + (size_t)row * 1536 + c0) = pack8(o);
    }
}
constexpr int NPHASE = 21;
constexpr int PARAMS_OFF = MISC_OFF + 2048;
__device__ __forceinline__ unsigned rfl(unsigned v) { return (unsigned)__builtin_amdgcn_readfirstlane((int)v); }
template <class Tp> __device__ __forceinline__ Tp* rfl_ptr(Tp* q) { const unsigned long long a = (unsigned long long)q; const unsigned lo = rfl((unsigned)a), hi = rfl((unsigned)(a >> 32)); return (Tp*)(((unsigned long long)hi << 32) | lo); }
__device__ __forceinline__ float rfl_f(float v) { return __builtin_bit_cast(float, rfl(__builtin_bit_cast(unsigned, v))); }
__device__ __forceinline__ Params load_params(LAS unsigned char* lds) {
    unsigned off = PARAMS_OFF; asm volatile("" : "+s"(off) :: "memory");
    const LAS Params* lp = (const LAS Params*)(lds + off);
    Params q;
#pragma unroll
    for (int i = 0; i < 33; ++i) q.in[i] = rfl_ptr(lp->in[i]);
    q.out = rfl_ptr(lp->out); q.ws = rfl_ptr(lp->ws);
#pragma unroll
    for (int i = 0; i < 16; ++i) q.invA[i] = rfl_f(lp->invA[i]);
#pragma unroll
    for (int i = 0; i < 32; ++i) q.invR[i] = rfl_f(lp->invR[i]);
    q.ph_lo = 0; q.ph_hi = 0; q.l_lo = 0; q.l_hi = 0; q.fused = 0; q.do_pro = 0; q.dry = (int)rfl((unsigned)lp->dry); q.pad2 = 0;
    return q;
}
__device__ __forceinline__ unsigned char* load_ws(LAS unsigned char* lds) {
    unsigned off = PARAMS_OFF; asm volatile("" : "+s"(off) :: "memory");
    const LAS Params* lp = (const LAS Params*)(lds + off);
    return rfl_ptr(lp->ws);
}
__device__ __forceinline__ Frame make_frame(LAS unsigned char* lds) {
    Frame F; int tid = threadIdx.x; asm volatile("" : "+v"(tid));
    int bid = blockIdx.x, G = gridDim.x; asm volatile("" : "+s"(bid), "+s"(G));
    F.lds = lds; F.tid = tid; F.lane = tid & 63; F.wave = __builtin_amdgcn_readfirstlane(tid >> 6);
    F.G = G; F.bid = bid; F.gwave = bid * NWAVES + F.wave; F.nwave = G * NWAVES;
    return F;
}
#define SEAM() do { if (fused) { XcdBarrier bar_; bar_.bar = (unsigned*)(load_ws(lds0) + WS_CTL) + CW_BAR; bar_.x = xb_xcc_id(); bar_.st = misc; xcd_barrier(bar_); } } while (0)
#ifndef MK_PHASES
#define MK_PHASES 0xFFFFFFFFu
#endif
#define IN(k) (((MK_PHASES >> (k)) & 1u) && ph_lo <= (k) && (k) < ph_hi)
#define EN(k) ((MK_PHASES >> (k)) & 1u)
#define LP() const Frame F = make_frame(lds0); const Params p = load_params(lds0)

__device__ __forceinline__ void layer_program(LAS unsigned char* const lds0, volatile LAS unsigned* misc, const int l, const int ph_lo, const int ph_hi, const int fused) {
        const bool want_ctx = l < DEPTH - 1;
        if (IN(0) && l == 0) { LP(); p1_cvt_norm1(p, F, l); SEAM(); }
        if (IN(1)) { LP();
            pg8::Gemm g{WSB(p, WS_H), WSB(p, WS_BTIN), T, 7680, 1024}; pg8::StaticOrder S; S.init(T, 7680, F.G, F.bid);
            pg8::EpiInproj E{p.ws};
            pg8::gemm_phase<pg8::EpiInproj, pg8::StaticOrder, PG8_ALIGN, PG8_SP2>(F.lds, g, S, E);
            SEAM(); }
        if (IN(2)) { LP(); p3_prep(p, F, l); SEAM(); }
        if (IN(3)) { LP();
            pg8::Gemm g{WSB(p, WS_H), WSB(p, WS_BTLORA), T, 2560, 256}; pg8::StaticOrder S; S.init(T, 2560, F.G, F.bid);
            pg8::EpiLora E{p.ws};
            pg8::gemm_phase<pg8::EpiLora, pg8::StaticOrder, PG8_ALIGN, PG8_SP2>(F.lds, g, S, E);
            SEAM(); }
        if (IN(5)) { LP(); p6c_rwkv_build<0>(p, F, l); SEAM(); }
        if (IN(6)) { LP(); p6b_rwkv_scan(p, F, 0); SEAM(); }
        if (IN(7)) { LP(); p6c_rwkv_build<1>(p, F, l); SEAM(); }
        if (IN(8)) { LP(); p6b_rwkv_scan(p, F, 1); SEAM(); }
        if (IN(9)) { LP(); p7_rwkv_readout(p, F, l); }
        if (IN(10)) { LP(); p8_ret_kv(p, F, l); SEAM(); }
        if (IN(11)) { LP(); p9_ret_scan(p, F, l); SEAM(); }
        if (IN(12)) { LP(); p10_ret_out(p, F, l, want_ctx); }
        if (IN(13)) { LP(); p11_attention(p, F, want_ctx); SEAM(); }
        if (IN(14)) { LP();
            pg8::Gemm g{WSB(p, WS_YCAT), WSB(p, WS_BTBR), T, 1024, 1536};
            pg8::EpiMergeK E{WSB(p, WS_GL), WSB(p, WS_H)};
            if (want_ctx) { pg8::StaticOrder S; S.init(T, 1024, F.G, F.bid); pg8::gemm_phase<pg8::EpiMergeK, pg8::StaticOrder, PG8_ALIGN, PG8_SP2>(F.lds, g, S, E); }
            else { pg8::LatentOrder S; S.init(1024, F.G, F.bid); pg8::gemm_phase<pg8::EpiMergeK, pg8::LatentOrder, PG8_ALIGN, PG8_SP2>(F.lds, g, S, E); }
            __syncthreads();
            cvt_run<true>(p, F, l, (LAS float*)F.lds, (want_ctx && F.G == 256) ? 32 : 0);
            SEAM(); }
        if (IN(15)) { LP();
            pg8::Gemm g{WSB(p, WS_H), WSB(p, WS_BTOUT), T, 1024, 1024};
            pg8::EpiOut E{p.out, WSF(p, WS_CTXRES), WSF(p, WS_MOD) + (size_t)l * 9 * 6144, p.dry, l == 0 ? p.in[I_X] : p.out, l == 0 ? p.in[I_CTX] : WSF(p, WS_CTXRES)};
            if (want_ctx) { pg8::StaticOrder S; S.init(T, 1024, F.G, F.bid); pg8::gemm_phase<pg8::EpiOut, pg8::StaticOrder, PG8_ALIGN, PG8_SP2>(F.lds, g, S, E); }
            else { pg8::LatentOrder S; S.init(1024, F.G, F.bid); pg8::gemm_phase<pg8::EpiOut, pg8::LatentOrder, PG8_ALIGN, PG8_SP2>(F.lds, g, S, E); }
            SEAM(); }
        if (IN(16)) { LP(); p14_norm2_router(p, F, l, want_ctx); SEAM(); }
        if (IN(17)) { LP(); p15_scatter(p, F, l, want_ctx); SEAM(); }
        if (IN(18)) { LP();
            moe_build_tab(p, F, l);
            pg8::Gemm g{WSB(p, WS_BUF), WSB(p, WS_BT1), MOE_NBLK * 256, 1024, 1024};
            typedef pg8::MoeOrder<(size_t)1024 * 1024 * 2> Ord; Ord S{F.G, F.bid, (const PG8_LAS int*)(F.lds + MISC_OFF + 64)};
            pg8::EpiSwiGLU E{WSB(p, WS_HB)};
            pg8::gemm_phase<pg8::EpiSwiGLU, Ord, PG8_ALIGN, PG8_SP2>(F.lds, g, S, E);
            SEAM(); }
        if (IN(19)) { LP();
            moe_build_tab(p, F, l);
            pg8::Gemm g{WSB(p, WS_HB), WSB(p, WS_BT2), MOE_NBLK * 256, 1024, 512};
            typedef pg8::MoeOrder<(size_t)1024 * 512 * 2> Ord; Ord S{F.G, F.bid, (const PG8_LAS int*)(F.lds + MISC_OFF + 64)};
            pg8::EpiPlainBf16 E{WSB(p, WS_YB), 1024};
            pg8::gemm_phase<pg8::EpiPlainBf16, Ord, PG8_ALIGN, PG8_SP2>(F.lds, g, S, E);
            SEAM(); }
        if (IN(20)) { LP(); p18_combine(p, F, l, want_ctx); if (l + 1 < DEPTH) p1_weights(p, F, l + 1); SEAM(); }
    }
__global__ void __launch_bounds__(NTHREADS, 2) mk_fwd(Params kp) {
    extern __shared__ __attribute__((aligned(16))) unsigned char lds_raw[];
    LAS unsigned char* const lds0 = (LAS unsigned char*)lds_raw;
    volatile LAS unsigned* misc = (volatile LAS unsigned*)(lds0 + MISC_OFF);
    if (threadIdx.x < 4) misc[threadIdx.x] = 0u;
    if (threadIdx.x == 0) { LAS Params* lp = (LAS Params*)(lds0 + PARAMS_OFF);
#pragma unroll
        for (int i = 0; i < 33; ++i) lp->in[i] = kp.in[i];
        lp->out = kp.out; lp->ws = kp.ws;
#pragma unroll
        for (int i = 0; i < 16; ++i) lp->invA[i] = kp.invA[i];
#pragma unroll
        for (int i = 0; i < 32; ++i) lp->invR[i] = kp.invR[i];
        lp->dry = kp.dry; }
    __syncthreads();
    const int ph_lo = kp.ph_lo, ph_hi = kp.ph_hi, fused = kp.fused;
    if (fused) (void)xcd_barrier_post((unsigned*)(kp.ws + WS_CTL) + CW_BAR, misc);
    if (((MK_PHASES >> 31) & 1u) && kp.do_pro) { LP(); p0_prologue(p, F); SEAM(); }

#if MK_FUSED
    layer_program(lds0, misc, 0, ph_lo, ph_hi, fused);
    layer_program(lds0, misc, 1, ph_lo, ph_hi, fused);
    layer_program(lds0, misc, 2, ph_lo, ph_hi, fused);
    layer_program(lds0, misc, 3, ph_lo, ph_hi, fused);
#else
    if (kp.l_lo < kp.l_hi) layer_program(lds0, misc, kp.l_lo, ph_lo, ph_hi, fused);
#endif
#undef IN
#undef SEAM
}

#ifndef MK_REP_MASK
#define MK_REP_MASK 0u
#define MK_REP_N 0
#endif
#ifndef MK_DRY_MODE
#define MK_DRY_MODE 1
#endif
extern "C" void kernel_launch(void* const* d_in, const int* in_sizes, int n_in, void* d_out, int out_size, void* d_ws, size_t ws_size, hipStream_t stream) {
    static int grid = 0;
    if (grid == 0) {
        if (n_in != 33 || in_sizes[0] != NB * NLAT * D || out_size != NB * NLAT * D || ws_size < WS_NEED) {
            fprintf(stderr, "kernel_launch: unexpected shapes/workspace: n_in %d in0 %d out %d ws %zu (need %zu)\n", n_in, n_in > 0 ? in_sizes[0] : -1, out_size, ws_size, (size_t)WS_NEED); grid = -1; return; }
        int dev = 0, cus = 0, per_cu = 0;
        if (hipGetDevice(&dev) != hipSuccess || hipDeviceGetAttribute(&cus, hipDeviceAttributeMultiprocessorCount, dev) != hipSuccess) { grid = -1; return; }
        if (hipFuncSetAttribute((const void*)mk_fwd, hipFuncAttributeMaxDynamicSharedMemorySize, LDS_BYTES) != hipSuccess) { fprintf(stderr, "kernel_launch: hipFuncSetAttribute failed\n"); grid = -1; return; }
        if (hipOccupancyMaxActiveBlocksPerMultiprocessor(&per_cu, (const void*)mk_fwd, NTHREADS, LDS_BYTES) != hipSuccess || per_cu < 1)
            fprintf(stderr, "kernel_launch: occupancy query reports %d workgroups per CU\n", per_cu);
        (void)hipGetLastError();
        grid = cus;
    }
    if (grid < 0) return;
    if (hipMemsetAsync((char*)d_ws + WS_CTL, 0, CTL_BYTES, stream) != hipSuccess) { fprintf(stderr, "kernel_launch: memset failed\n"); return; }
    Params a{};
    for (int i = 0; i < 33; ++i) a.in[i] = (const float*)d_in[i];
    a.out = (float*)d_out; a.ws = (unsigned char*)d_ws;
    for (int i = 0; i < 16; ++i) a.invA[i] = (float)pow(10000.0, -(double)i / 16.0);
    for (int i = 0; i < 32; ++i) a.invR[i] = (float)pow(10000.0, -(double)i / 32.0);
#if MK_FUSED
    a.ph_lo = 0; a.ph_hi = NPHASE; a.l_lo = 0; a.l_hi = DEPTH; a.fused = 1; a.do_pro = 1;
    hipLaunchKernelGGL(mk_fwd, dim3(grid), dim3(NTHREADS), LDS_BYTES, stream, a);
    if (hipPeekAtLastError() != hipSuccess) fprintf(stderr, "kernel_launch: launch failed\n");
#else
    a.fused = 0; a.do_pro = 1; a.l_lo = 0; a.l_hi = 0; a.ph_lo = 0; a.ph_hi = 0;
    hipLaunchKernelGGL(mk_fwd, dim3(grid), dim3(NTHREADS), LDS_BYTES, stream, a);
    a.do_pro = 0;
    for (int l = 0; l < DEPTH; ++l)
        for (int ph = 0; ph < NPHASE; ++ph) { a.l_lo = l; a.l_hi = l + 1; a.ph_lo = ph; a.ph_hi = ph + 1;
            const int reps = 1 + (((MK_REP_MASK >> ph) & 1u) ? MK_REP_N : 0);
            for (int r = 0; r < reps; ++r) { a.dry = r > 0 ? MK_DRY_MODE : 0; hipLaunchKernelGGL(mk_fwd, dim3(grid), dim3(NTHREADS), LDS_BYTES, stream, a); } a.dry = 0; }
    if (hipPeekAtLastError() != hipSuccess) fprintf(stderr, "kernel_launch: launch failed\n");
#endif
}
```

```cpp
#include <hip/hip_runtime.h>
#include <cstdio>
#include <cstdint>

#ifndef MK_FUSED
#define MK_FUSED 1
#endif

constexpr int D = 1024, NB = 8, NLAT = 4096, NCTX = 256, NP = NLAT + NCTX, T = NB * NP, DEPTH = 4;
constexpr int TP = T / 256;
constexpr int NPAIR_MAX = 2 * T;
constexpr int MOE_NBLK = NPAIR_MAX / 256 + 32;
constexpr int NTHREADS = 512, NWAVES = 8;

typedef unsigned short bf16_t;
typedef short bf16x8 __attribute__((ext_vector_type(8)));
typedef short bf16x4 __attribute__((ext_vector_type(4)));
typedef float f32x4 __attribute__((ext_vector_type(4)));
typedef float f32x2 __attribute__((ext_vector_type(2)));
typedef unsigned u32x4 __attribute__((ext_vector_type(4)));
typedef unsigned u32x2 __attribute__((ext_vector_type(2)));
#define LAS __attribute__((address_space(3)))

constexpr size_t AL(size_t x) { return (x + 255) & ~(size_t)255; }
constexpr size_t WS_CTL = 0, CTL_BYTES = 65536;
constexpr int CW_BAR = 0;
constexpr int CW_CNT = 4096;
constexpr size_t WS_MOD = AL(WS_CTL + CTL_BYTES);
constexpr size_t WS_ROPE = AL(WS_MOD + (size_t)DEPTH * 9 * 6144 * 4);
constexpr size_t WS_RWT = AL(WS_ROPE + (size_t)(2 * 64 * 16 + 2 * 64 * 32) * 4);
constexpr size_t WS_RW2 = AL(WS_RWT + (size_t)DEPTH * 36 * 1024 * 4);
constexpr size_t WS_RC = AL(WS_RW2 + (size_t)DEPTH * 64 * 3 * 4 * 16 * 4 * 4);
constexpr size_t WS_CTXRES = AL(WS_RC + (size_t)DEPTH * 9 * 48 * 4);
constexpr size_t WS_BTIN = AL(WS_CTXRES + (size_t)NB * NCTX * D * 4);
constexpr size_t WS_BTBR = AL(WS_BTIN + (size_t)7680 * 1024 * 2);
constexpr size_t WS_BTOUT = AL(WS_BTBR + (size_t)3 * 1024 * 512 * 2);
constexpr size_t WS_BTLORA = AL(WS_BTOUT + (size_t)1024 * 1024 * 2);
constexpr size_t WS_H = AL(WS_BTLORA + (size_t)2560 * 256 * 2);
constexpr size_t WS_M0 = AL(WS_H + (size_t)T * 1024 * 2);
constexpr size_t SZ512 = (size_t)T * 512 * 2;
constexpr size_t WS_AQ = WS_M0;
constexpr size_t WS_AKV = AL(WS_AQ + SZ512);
constexpr size_t WS_RQ = AL(WS_AKV + (size_t)T * 256 * 2);
constexpr size_t WS_RK = AL(WS_RQ + SZ512);
constexpr size_t WS_RV = AL(WS_RK + SZ512);
constexpr size_t WS_RG = AL(WS_RV + SZ512);
constexpr size_t WS_GL = AL(WS_RG + SZ512);
constexpr size_t WS_WU = AL(WS_GL + (size_t)T * 3072 * 2);
constexpr size_t WS_LW = AL(WS_WU + (size_t)T * 1792 * 2);
constexpr size_t WS_LA = AL(WS_LW + (size_t)T * 1024 * 2);
constexpr size_t WS_LG = AL(WS_LA + (size_t)T * 1024 * 2);
constexpr size_t WS_W1 = AL(WS_LG + SZ512);
constexpr size_t WS_END_MIX = AL(WS_W1 + 9 * SZ512);
constexpr size_t WS_YS = WS_LW;
constexpr size_t WS_SF = WS_WU + 3 * SZ512;
constexpr size_t WS_SB = AL(WS_SF + (size_t)NB * 4 * 34 * 16384 * 2);
static_assert(WS_SB + (size_t)NB * 4 * 34 * 16384 * 2 <= WS_LG, "retention states fit behind YCAT inside WU|LW|LA");
constexpr size_t WS_BT1 = WS_M0;
constexpr size_t WS_BT2 = AL(WS_BT1 + (size_t)32 * 1024 * 1024 * 2);
constexpr size_t WS_BUF = AL(WS_BT2 + (size_t)32 * 1024 * 512 * 2);
constexpr size_t WS_HB = AL(WS_BUF + (size_t)MOE_NBLK * 256 * 1024 * 2);
constexpr size_t WS_YB = AL(WS_HB + (size_t)MOE_NBLK * 256 * 512 * 2);
constexpr size_t WS_PAIR = AL(WS_YB + (size_t)MOE_NBLK * 256 * 1024 * 2);
constexpr size_t WS_RSROW = AL(WS_PAIR + (size_t)4 * NPAIR_MAX * 4);
constexpr size_t WS_END_MOE = AL(WS_RSROW + (size_t)T * 4);
static_assert(WS_END_MOE <= WS_END_MIX, "moe overlay inside the mixer region");
constexpr size_t WS_NEED = WS_END_MIX;
static_assert(WS_NEED <= 1220000000ull, "workspace budget (sum of inputs = 1220.39 MB)");

constexpr int RING_BYTES = 131072;
constexpr int LDS_BYTES = 147456;
constexpr int MISC_OFF = LDS_BYTES - 4096;

struct Params {
    const float* in[33];
    float* out;
    unsigned char* ws;
    float invA[16];
    float invR[32];
    int ph_lo, ph_hi, l_lo, l_hi;
    int fused, do_pro;
    int dry, pad2;
};
enum { I_X = 0, I_C, I_CTX, I_CCTX, I_ADAW, I_ADAB, I_N1G, I_N2G, I_WIN, I_QNG, I_KNG, I_RDL, I_RGN, I_MU, I_W0, I_W2, I_A0, I_A2, I_G2, I_KK, I_KA, I_RK, I_LNG, I_LNB,
       I_WBR, I_WOUT, I_RGW, I_RGB, I_REW, I_REB, I_MG, I_MUP, I_MD };

__device__ __forceinline__ float bf2f(unsigned v) { return __builtin_bit_cast(float, v << 16); }
__device__ __forceinline__ unsigned f2bf(float f) { return (unsigned)__builtin_bit_cast(unsigned short, (__bf16)f); }
typedef __bf16 hwbf16x2 __attribute__((ext_vector_type(2)));
__device__ __forceinline__ unsigned pk2(float lo, float hi) { const f32x2 v = {lo, hi}; return __builtin_bit_cast(unsigned, __builtin_convertvector(v, hwbf16x2)); }
__device__ __forceinline__ float lo16(unsigned w) { return __builtin_bit_cast(float, w << 16); }
__device__ __forceinline__ float hi16(unsigned w) { return __builtin_bit_cast(float, w & 0xffff0000u); }
__device__ __forceinline__ void unpack8(const u32x4 v, float (&x)[8]) { x[0] = lo16(v.x); x[1] = hi16(v.x); x[2] = lo16(v.y); x[3] = hi16(v.y); x[4] = lo16(v.z); x[5] = hi16(v.z); x[6] = lo16(v.w); x[7] = hi16(v.w); }
__device__ __forceinline__ u32x4 pack8(const float (&x)[8]) { u32x4 v; v.x = pk2(x[0], x[1]); v.y = pk2(x[2], x[3]); v.z = pk2(x[4], x[5]); v.w = pk2(x[6], x[7]); return v; }
__device__ __forceinline__ float frcp(float x) { return __builtin_amdgcn_rcpf(x); }
__device__ __forceinline__ float sigmoidf_(float x) { return frcp(1.f + __expf(-x)); }
__device__ __forceinline__ float siluf_(float x) { return x * frcp(1.f + __expf(-x)); }
__device__ __forceinline__ float shfl_xor_f(float v, int m) { return __shfl_xor(v, m, 64); }
__device__ __forceinline__ float* xrow(const Params& p, int row) {
    const int b = row / NP, q = row - b * NP;
    return q < NCTX ? (float*)(p.ws + WS_CTXRES) + (size_t)(b * NCTX + q) * D : p.out + (size_t)(b * NLAT + (q - NCTX)) * D;
}
__device__ __forceinline__ bf16x8 ld_frag(const LAS unsigned char* p) { return *(const LAS bf16x8*)p; }
__device__ __forceinline__ bf16x4 tr_read(const LAS unsigned char* p) { return __builtin_amdgcn_ds_read_tr16_b64_v4i16((LAS bf16x4*)p); }
__device__ __forceinline__ bf16x8 cat44(bf16x4 a, bf16x4 b) { bf16x8 r; r[0] = a[0]; r[1] = a[1]; r[2] = a[2]; r[3] = a[3]; r[4] = b[0]; r[5] = b[1]; r[6] = b[2]; r[7] = b[3]; return r; }
__device__ __forceinline__ bf16x8 pack_frag(const f32x4 a, const f32x4 b) {
    u32x4 w; w.x = pk2(a[0], a[1]); w.y = pk2(a[2], a[3]); w.z = pk2(b[0], b[1]); w.w = pk2(b[2], b[3]); return __builtin_bit_cast(bf16x8, w);
}
#define MFMA16(a, b, c) __builtin_amdgcn_mfma_f32_16x16x32_bf16((a), (b), (c), 0, 0, 0)

#define XB_TMO      128
#define XB_XCNT(j)  (256  + 64 * (j))
#define XB_XSUB(j)  (1280 + 64 * (j))
#define XB_XGEN(j)  (2304 + 64 * (j))
#define XB_TOP      3328
#define XB_TOPGEN   3392
#define XCD_BAR_WORDS 3456
#define XB_SPIN_CAP (1u << 18)
__device__ __forceinline__ unsigned xb_ld(unsigned* p)              { return __hip_atomic_load(p, __ATOMIC_RELAXED, __HIP_MEMORY_SCOPE_AGENT); }
__device__ __forceinline__ unsigned xb_add(unsigned* p, unsigned v) { return __hip_atomic_fetch_add(p, v, __ATOMIC_RELAXED, __HIP_MEMORY_SCOPE_AGENT); }
__device__ __forceinline__ unsigned xb_xcc_id() { return (unsigned)__builtin_amdgcn_s_getreg((3 << 11) | 20) & 0xFu; }
#define XB_SPIN(cond, bar) do { unsigned _sp = 0; while (cond) { __builtin_amdgcn_s_sleep(1); \
    if ((++_sp & 255u) == 0u) { if (xb_ld(&(bar)[XB_TMO])) break; if (_sp > XB_SPIN_CAP) { atomicAdd(&(bar)[XB_TMO], 1u); break; } } } } while (0)
struct XcdBarrier { unsigned* bar; unsigned x; volatile LAS unsigned* st; };
__device__ __forceinline__ XcdBarrier xcd_barrier_post(unsigned* bar, volatile LAS unsigned* st) {
    XcdBarrier b; b.bar = bar; b.x = xb_xcc_id(); b.st = st;
    if (threadIdx.x == 0) (void)xb_add(&bar[XB_XCNT(b.x)], 1u);
    return b;
}
__device__ __forceinline__ void xcd_barrier_complete(unsigned* bar, unsigned x, unsigned& nloc, unsigned& nx) {
    const unsigned G = gridDim.x * gridDim.y * gridDim.z;
    unsigned sum, cnt, mine, sp = 0u;
    for (;;) {
        sum = 0u; cnt = 0u; mine = 0u;
#pragma unroll
        for (unsigned j = 0; j < 16; ++j) { const unsigned c = xb_ld(&bar[XB_XCNT(j)]); sum += c; cnt += (c > 0u) ? 1u : 0u; mine = (j == x) ? c : mine; }
        if (sum == G) break;
        __builtin_amdgcn_s_sleep(1);
        if ((++sp & 255u) == 0u) { if (xb_ld(&bar[XB_TMO])) break; if (sp > XB_SPIN_CAP) { atomicAdd(&bar[XB_TMO], 1u); break; } }
    }
    nloc = mine > 0u ? mine : 1u; nx = cnt > 0u ? cnt : 1u;
}
__device__ __forceinline__ void xcd_barrier(const XcdBarrier& b) {
    asm volatile("s_waitcnt vmcnt(0)" ::: "memory");
    __syncthreads();
    if (threadIdx.x == 0) {
        unsigned* bar = b.bar;
        __builtin_amdgcn_s_waitcnt(0);
        unsigned nloc = b.st[0], nx = b.st[1];
        if (nloc == 0u) { xcd_barrier_complete(bar, b.x, nloc, nx); b.st[0] = nloc; b.st[1] = nx; }
        const unsigned old = xb_add(&bar[XB_XSUB(b.x)], 1u);
        const unsigned gen = old / nloc;
        if (old + 1u == (gen + 1u) * nloc) {
            __builtin_amdgcn_fence(__ATOMIC_RELEASE, "agent");
            asm volatile("s_waitcnt vmcnt(0)" ::: "memory");
            const unsigned og = xb_add(&bar[XB_TOP], 1u);
            const unsigned tg = og / nx;
            if (og + 1u == (tg + 1u) * nx) xb_add(&bar[XB_TOPGEN], 1u);
            else XB_SPIN(xb_ld(&bar[XB_TOPGEN]) == tg, bar);
            __builtin_amdgcn_fence(__ATOMIC_ACQUIRE, "agent");
            xb_add(&bar[XB_XGEN(b.x)], 1u);
            asm volatile("s_waitcnt vmcnt(0)" ::: "memory");
        } else {
            XB_SPIN(xb_ld(&bar[XB_XGEN(b.x)]) == gen, bar);
            __builtin_amdgcn_fence(__ATOMIC_ACQUIRE, "agent");
            asm volatile("s_waitcnt vmcnt(0)" ::: "memory");
        }
    }
    __syncthreads();
}
namespace pg8 {
#define PG8_LAS __attribute__((address_space(3)))
typedef unsigned short bf16_t;
typedef short bf16x8 __attribute__((ext_vector_type(8)));
typedef float f32x4 __attribute__((ext_vector_type(4)));
typedef unsigned u32x4 __attribute__((ext_vector_type(4)));
constexpr int BM = 256, BK = 64, HALF = 128, HTB = HALF * BK * 2  , STAGE_BYTES = 8 * HTB, NXCD = 8, WGM = 8;

__host__ __device__ __forceinline__ int lds_byte(int r, int c) { const int st = (r >> 4) * 2 + (c >> 5), rr = r & 15, cc = c & 31, ob = rr * 64 + cc * 2; return st * 1024 + (ob ^ (((ob >> 9) & 1) << 5)); }
__host__ __device__ __forceinline__ void stage_rc(int b, int& R, int& C) { const int st = b / 1024, sb = b % 1024, swz = sb ^ (((sb >> 9) & 1) << 5); R = (st >> 1) * 16 + swz / 64; C = (st & 1) * 32 + (swz % 64) / 2; }
__host__ __device__ __forceinline__ int perm32(int rho) { const int n = rho >> 4, i = rho & 15; return 8 * (i >> 2) + 4 * n + (i & 3); }

struct Unit { int pm, pn; size_t bofs; };
struct Gemm { const bf16_t* A; const bf16_t* Bt; int M, N, K; };

struct StaticOrder {
    int nM, nN, nwg, G, c;
    __host__ __device__ void init(int M, int N, int G_, int c_) { nM = M / BM; nN = N / BM; nwg = nM * nN; G = G_; c = c_; }
    __host__ __device__ bool next(int i, Unit& u) const {
        const long L = (long)i * G + c; if (L >= nwg) return false;
        int wgid = (int)L; { const int q = nwg / NXCD, r = nwg % NXCD, xcd = wgid % NXCD, off = wgid / NXCD; wgid = (xcd < r ? xcd * (q + 1) : r * (q + 1) + (xcd - r) * q) + off; }
        const int nig = WGM * nN, gid = wgid / nig, fm = gid * WGM, gsz = (nM - fm) < WGM ? (nM - fm) : WGM;
        u.pm = fm + ((wgid % nig) % gsz); u.pn = (wgid % nig) / gsz; u.bofs = 0; return true;
    }
    __device__ __forceinline__ void a_ready(const Unit&) const {}
    __device__ __forceinline__ void done(const Unit&) const {}
};

__device__ __forceinline__ unsigned cvt_pk_bf16(float lo, float hi) { unsigned r; asm volatile("v_cvt_pk_bf16_f32 %0, %1, %2" : "=v"(r) : "v"(lo), "v"(hi)); return r; }
template <class Epi, class Sched, bool ALIGN_EPI = false, bool SP2 = false>
__device__ __forceinline__ void gemm_phase(PG8_LAS unsigned char* lds, const Gemm g, const Sched& S, const Epi& E) {
    int tid_ = threadIdx.x; asm volatile("" : "+v"(tid_)); const int tid = tid_, wid = __builtin_amdgcn_readfirstlane(tid >> 6), lane = tid & 63, wr = wid >> 2, wc = wid & 3, fr = lane & 15, fq = lane >> 4;
    int K = g.K; asm volatile("" : "+s"(K)); const int nt = K / BK;
    unsigned voffA[2], voffB[2];
#pragma unroll
    for (int i = 0; i < 2; ++i) { int R, C; stage_rc(tid * 16 + i * 8192, R, C); const int Rb = Epi::PERM ? ((R & ~31) + perm32(R & 31)) : R;
        voffA[i] = (unsigned)(R * K + C) * 2u; voffB[i] = (unsigned)(Rb * K + C) * 2u; }
    const size_t kstep = (size_t)(BK * 2);
    const size_t hstep = (size_t)HALF * K * 2;
    const size_t tstep = 2 * hstep;
    const unsigned ldsw = (unsigned)wid * 1024u;
    const int aoff = lds_byte(wr * 64 + fr, fq * 8), boff = lds_byte(wc * 32 + fr, fq * 8);
#define PG8_SA(b, h) (((b) * 2 + (h)) * HTB)
#define PG8_SB(b, h) ((4 + (b) * 2 + (h)) * HTB)
#define PG8_STAGE(bufoff, gbase, voff) do { _Pragma("unroll") for (int _i = 0; _i < 2; ++_i) \
        __builtin_amdgcn_global_load_lds((const unsigned*)((const char*)(gbase) + (voff)[_i]), (PG8_LAS unsigned*)(lds + (bufoff) + ldsw + _i * 8192), 16, 0, 0); } while (0)
#define PG8_LDA(dst, b, h) do { _Pragma("unroll") for (int m = 0; m < 4; ++m) _Pragma("unroll") for (int k = 0; k < 2; ++k) dst[m][k] = *(const PG8_LAS bf16x8*)(lds + PG8_SA(b, h) + aoff + m * 2048 + k * 1024); } while (0)
#define PG8_LDB(dst, b, h) do { _Pragma("unroll") for (int n = 0; n < 2; ++n) _Pragma("unroll") for (int k = 0; k < 2; ++k) dst[n][k] = *(const PG8_LAS bf16x8*)(lds + PG8_SB(b, h) + boff + n * 2048 + k * 1024); } while (0)
#define PG8_MMA(ai, bj, At, Bt) do { __builtin_amdgcn_s_setprio(1); _Pragma("unroll") for (int m = 0; m < 4; ++m) _Pragma("unroll") for (int n = 0; n < 2; ++n) _Pragma("unroll") for (int k = 0; k < 2; ++k) \
        acc[ai][bj][m][n] = __builtin_amdgcn_mfma_f32_16x16x32_bf16(Bt[n][k], At[m][k], acc[ai][bj][m][n], 0, 0, 0); __builtin_amdgcn_s_setprio(0); } while (0)
#define PG8_WAIT_V(n) asm volatile("s_waitcnt vmcnt(" #n ")" ::: "memory")
#define PG8_WAIT_L(n) asm volatile("s_waitcnt lgkmcnt(" #n ")" ::: "memory")
#define PG8_BAR __builtin_amdgcn_s_barrier()
#define PG8_SCHED __builtin_amdgcn_sched_barrier(0)
    Unit cur, nxt; int ui = 0;
    if (!S.next(0, cur)) return;
    f32x4 acc[2][2][4][2];
#pragma unroll
    for (int a = 0; a < 2; ++a)
#pragma unroll
        for (int b = 0; b < 2; ++b)
#pragma unroll
            for (int m = 0; m < 4; ++m)
#pragma unroll
                for (int n = 0; n < 2; ++n) acc[a][b][m][n] = (f32x4){0.f, 0.f, 0.f, 0.f};
    bf16x8 At[4][2], B0[2][2], B1[2][2];
    const char* cA = (const char*)g.A + (size_t)cur.pm * tstep; const char* cB = (const char*)g.Bt + cur.bofs + (size_t)cur.pn * tstep;
    S.a_ready(cur);
    if constexpr (SP2) {
        PG8_STAGE(PG8_SB(0, 0), cB, voffB); PG8_STAGE(PG8_SB(0, 1), cB + hstep, voffB); PG8_STAGE(PG8_SA(0, 0), cA, voffA); PG8_STAGE(PG8_SA(0, 1), cA + hstep, voffA);
        if (wr == 1) PG8_BAR;
        PG8_WAIT_V(2); PG8_BAR;
        PG8_STAGE(PG8_SB(1, 0), cB + kstep, voffB); PG8_STAGE(PG8_SA(1, 0), cA + kstep, voffA); PG8_STAGE(PG8_SB(1, 1), cB + hstep + kstep, voffB);
        PG8_WAIT_V(6); PG8_BAR;
    } else {
        PG8_STAGE(PG8_SB(0, 0), cB, voffB); PG8_STAGE(PG8_SA(0, 0), cA, voffA); PG8_STAGE(PG8_SB(0, 1), cB + hstep, voffB); PG8_STAGE(PG8_SA(0, 1), cA + hstep, voffA);
        if (wr == 1) PG8_BAR;
        PG8_WAIT_V(4); PG8_BAR;
        PG8_STAGE(PG8_SB(1, 0), cB + kstep, voffB); PG8_STAGE(PG8_SA(1, 0), cA + kstep, voffA); PG8_STAGE(PG8_SB(1, 1), cB + hstep + kstep, voffB);
        PG8_WAIT_V(6); PG8_BAR;
    }
    for (;;) {
        const bool has_next = S.next(ui + 1, nxt);
        const char* nA = has_next ? (const char*)g.A + (size_t)nxt.pm * tstep : cA; const char* nB = has_next ? (const char*)g.Bt + nxt.bofs + (size_t)nxt.pn * tstep : cB;
        for (int t = 0; t < nt; t += 2) {
            const bool last = (t == nt - 2);
            if constexpr (Epi::KHOOK) { if (t == 8 || t == 16) E.khook(acc, cur, wr, wc, fr, fq, t >> 3); }
            const char* a1 = cA + (size_t)(t + 1) * kstep;
            const char* a2 = last ? nA : cA + (size_t)(t + 2) * kstep; const char* b2 = last ? nB : cB + (size_t)(t + 2) * kstep;
            const char* a3 = a2 + kstep; const char* b3 = b2 + kstep;
            if (last && has_next) S.a_ready(nxt);
            if constexpr (SP2) {
            PG8_LDB(B0, 0, 0); PG8_LDB(B1, 0, 1); PG8_SCHED; PG8_LDA(At, 0, 0); PG8_STAGE(PG8_SA(1, 1), a1 + hstep, voffA);
            PG8_WAIT_V(8); PG8_WAIT_L(0); PG8_BAR; PG8_MMA(0, 0, At, B0); PG8_MMA(0, 1, At, B1); PG8_BAR; PG8_SCHED;
            PG8_LDA(At, 0, 1); PG8_STAGE(PG8_SB(0, 0), b2, voffB); PG8_STAGE(PG8_SB(0, 1), b2 + hstep, voffB); PG8_STAGE(PG8_SA(0, 0), a2, voffA);
            PG8_WAIT_V(8); PG8_WAIT_L(0); PG8_BAR; PG8_MMA(1, 0, At, B0); PG8_MMA(1, 1, At, B1); PG8_BAR; PG8_SCHED;
            PG8_LDB(B0, 1, 0); PG8_LDB(B1, 1, 1); PG8_SCHED; PG8_LDA(At, 1, 0); PG8_STAGE(PG8_SA(0, 1), a2 + hstep, voffA);
            PG8_WAIT_V(8); PG8_WAIT_L(0); PG8_BAR; PG8_MMA(0, 0, At, B0); PG8_MMA(0, 1, At, B1); PG8_BAR; PG8_SCHED;
            PG8_LDA(At, 1, 1); PG8_STAGE(PG8_SB(1, 0), b3, voffB); PG8_STAGE(PG8_SB(1, 1), b3 + hstep, voffB); PG8_STAGE(PG8_SA(1, 0), a3, voffA);
            PG8_WAIT_V(8); PG8_WAIT_L(0); PG8_BAR; PG8_MMA(1, 0, At, B0); PG8_MMA(1, 1, At, B1); PG8_BAR; PG8_SCHED;
            } else {
            PG8_LDB(B0, 0, 0); PG8_SCHED; PG8_LDA(At, 0, 0); PG8_STAGE(PG8_SA(1, 1), a1 + hstep, voffA);
            PG8_WAIT_L(8); PG8_BAR; PG8_WAIT_L(0); PG8_MMA(0, 0, At, B0); PG8_BAR; PG8_SCHED;
            PG8_LDB(B1, 0, 1); PG8_STAGE(PG8_SB(0, 0), b2, voffB);
            PG8_BAR; PG8_WAIT_L(0); PG8_MMA(0, 1, At, B1); PG8_BAR;
            PG8_LDA(At, 0, 1); PG8_STAGE(PG8_SA(0, 0), a2, voffA);
            PG8_BAR; PG8_WAIT_L(0); PG8_MMA(1, 0, At, B0); PG8_BAR; PG8_SCHED;
            PG8_STAGE(PG8_SB(0, 1), b2 + hstep, voffB);
            PG8_WAIT_V(6); PG8_BAR; PG8_MMA(1, 1, At, B1); PG8_BAR;
            PG8_LDB(B0, 1, 0); PG8_SCHED; PG8_LDA(At, 1, 0); PG8_STAGE(PG8_SA(0, 1), a2 + hstep, voffA);
            PG8_WAIT_L(8); PG8_BAR; PG8_WAIT_L(0); PG8_MMA(0, 0, At, B0); PG8_BAR; PG8_SCHED;
            PG8_LDB(B1, 1, 1); PG8_STAGE(PG8_SB(1, 0), b3, voffB);
            PG8_BAR; PG8_WAIT_L(0); PG8_MMA(0, 1, At, B1); PG8_BAR;
            PG8_LDA(At, 1, 1); PG8_STAGE(PG8_SA(1, 0), a3, voffA);
            PG8_BAR; PG8_WAIT_L(0); PG8_MMA(1, 0, At, B0); PG8_BAR; PG8_SCHED;
            PG8_STAGE(PG8_SB(1, 1), b3 + hstep, voffB);
            PG8_WAIT_V(6); PG8_BAR; PG8_MMA(1, 1, At, B1); PG8_BAR;
            }
        }
        if constexpr (ALIGN_EPI) { if (wr == 0) PG8_BAR; }
        if constexpr (!Epi::AFTER_DRAIN) { E(acc, cur, wr, wc, fr, fq); S.done(cur); }
        if (!has_next) break;
#pragma unroll
        for (int a = 0; a < 2; ++a)
#pragma unroll
            for (int b = 0; b < 2; ++b)
#pragma unroll
                for (int m = 0; m < 4; ++m)
#pragma unroll
                    for (int n = 0; n < 2; ++n) acc[a][b][m][n] = (f32x4){0.f, 0.f, 0.f, 0.f};
        cur = nxt; cA = nA; cB = nB; ++ui;
        if constexpr (ALIGN_EPI) { if (wr == 1) PG8_BAR; }
    }
    PG8_WAIT_V(0);
    if constexpr (!ALIGN_EPI) { if (wr == 0) PG8_BAR; }
    PG8_BAR;
    if constexpr (Epi::AFTER_DRAIN) { E.fused(acc, cur, wr, wc, fr, fq, lds, wid, lane); S.done(cur); }
#undef PG8_SA
#undef PG8_SB
#undef PG8_STAGE
#undef PG8_LDA
#undef PG8_LDB
#undef PG8_MMA
#undef PG8_WAIT_V
#undef PG8_WAIT_L
#undef PG8_BAR
#undef PG8_SCHED
}
template <bool EXPNEG = false> __device__ __forceinline__ void store_bf16_tile(bf16_t* O, int pitch, int colt, const f32x4 (&acc)[2][2][4][2], const Unit& u, int wr, int wc, int fr, int fq) {
    const int row0 = u.pm * BM + wr * 64 + fr; const int col0 = colt + wc * 32 + 8 * fq;
#pragma unroll
    for (int ai = 0; ai < 2; ++ai)
#pragma unroll
        for (int m = 0; m < 4; ++m) { bf16_t* rowp = O + (size_t)(row0 + ai * HALF + m * 16) * pitch + col0;
#pragma unroll
            for (int bj = 0; bj < 2; ++bj) { f32x4 v0 = acc[ai][bj][m][0], v1 = acc[ai][bj][m][1];
                if (EXPNEG) {
#pragma unroll
                    for (int e = 0; e < 4; ++e) { v0[e] = __expf(-v0[e]); v1[e] = __expf(-v1[e]); } }
                u32x4 w; w.x = cvt_pk_bf16(v0[0], v0[1]); w.y = cvt_pk_bf16(v0[2], v0[3]); w.z = cvt_pk_bf16(v1[0], v1[1]); w.w = cvt_pk_bf16(v1[2], v1[3]);
                *(u32x4*)(rowp + bj * HALF) = w; } }
}
struct EpiInproj {
    static constexpr bool PERM = true, AFTER_DRAIN = false, KHOOK = false;
    unsigned char* ws;
    __device__ __forceinline__ void operator()(const f32x4 (&acc)[2][2][4][2], const Unit& u, int wr, int wc, int fr, int fq) const {
        const int pn = u.pn; size_t base; int pitch, colt;
        if (pn < 2)       { base = WS_AQ;  pitch = 512;  colt = pn * 256; }
        else if (pn == 2) { base = WS_AKV; pitch = 256;  colt = 0; }
        else if (pn < 5)  { base = WS_RQ;  pitch = 512;  colt = (pn - 3) * 256; }
        else if (pn < 7)  { base = WS_RK;  pitch = 512;  colt = (pn - 5) * 256; }
        else if (pn < 9)  { base = WS_RV;  pitch = 512;  colt = (pn - 7) * 256; }
        else if (pn < 11) { base = WS_RG;  pitch = 512;  colt = (pn - 9) * 256; }
        else if (pn < 18) { base = WS_WU;  pitch = 1792; colt = (pn - 11) * 256; }
        else              { store_bf16_tile<true>((bf16_t*)(ws + WS_GL), 3072, (pn - 18) * 256, acc, u, wr, wc, fr, fq); return; }
        store_bf16_tile((bf16_t*)(ws + base), pitch, colt, acc, u, wr, wc, fr, fq);
    }
};
struct EpiLora {
    static constexpr bool PERM = true, AFTER_DRAIN = false, KHOOK = false;
    unsigned char* ws;
    __device__ __forceinline__ void operator()(const f32x4 (&acc)[2][2][4][2], const Unit& u, int wr, int wc, int fr, int fq) const {
        const int pn = u.pn; size_t base; int pitch, colt;
        if (pn < 4)      { base = WS_LW; pitch = 1024; colt = pn * 256; }
        else if (pn < 8) { base = WS_LA; pitch = 1024; colt = (pn - 4) * 256; }
        else             { base = WS_LG; pitch = 512;  colt = (pn - 8) * 256; }
        store_bf16_tile((bf16_t*)(ws + base), pitch, colt, acc, u, wr, wc, fr, fq);
    }
};
struct EpiPlainBf16 {
    static constexpr bool PERM = true, AFTER_DRAIN = false, KHOOK = false;
    bf16_t* O; int pitch;
    __device__ __forceinline__ void operator()(const f32x4 (&acc)[2][2][4][2], const Unit& u, int wr, int wc, int fr, int fq) const {
        store_bf16_tile(O, pitch, u.pn * BM, acc, u, wr, wc, fr, fq);
    }
};
template <int MODE> struct EpiMerge {
    static constexpr bool PERM = false, AFTER_DRAIN = false, KHOOK = false;
    const bf16_t* GL; float* MRG; bf16_t* OB; int nb;
    __device__ __forceinline__ void operator()(const f32x4 (&acc)[2][2][4][2], const Unit& u, int wr, int wc, int fr, int fq) const {
        const int row0 = u.pm * BM + wr * 64 + fr, col0 = u.pn * BM + wc * 32 + 4 * fq;
#pragma unroll
        for (int ai = 0; ai < 2; ++ai)
#pragma unroll
            for (int m = 0; m < 4; ++m) { const size_t row = (size_t)(row0 + ai * HALF + m * 16); asm volatile("" ::: "memory");
#pragma unroll
                for (int bj = 0; bj < 2; ++bj)
#pragma unroll
                    for (int n = 0; n < 2; ++n) { const int col = col0 + bj * HALF + n * 16;
                        const u32x2 gw = *(const u32x2*)(GL + row * 3072 + nb * 1024 + col);
                        f32x4 g; g[0] = __builtin_amdgcn_rcpf(1.f + __expf(-lo16(gw.x))); g[1] = __builtin_amdgcn_rcpf(1.f + __expf(-hi16(gw.x))); g[2] = __builtin_amdgcn_rcpf(1.f + __expf(-lo16(gw.y))); g[3] = __builtin_amdgcn_rcpf(1.f + __expf(-hi16(gw.y)));
                        f32x4 v = acc[ai][bj][m][n] * g;
                        float* mp = MRG + row * 1024 + col;
                        if (MODE != 0) v = v + *(const f32x4*)mp;
                        if (MODE != 2) *(f32x4*)mp = v;
                        else { u32x2 w; w.x = cvt_pk_bf16(v[0], v[1]); w.y = cvt_pk_bf16(v[2], v[3]); *(u32x2*)(OB + row * 1024 + col) = w; } } }
    }
};
struct EpiMergeK {
    static constexpr bool PERM = false, AFTER_DRAIN = false, KHOOK = true;
    const bf16_t* GL; bf16_t* OB;
    __device__ __forceinline__ void khook(f32x4 (&acc)[2][2][4][2], const Unit& u, int wr, int wc, int fr, int fq, int seg  ) const {
        const int row0 = u.pm * BM + wr * 64 + fr, col0 = u.pn * BM + wc * 32 + 4 * fq;
#pragma unroll
        for (int ai = 0; ai < 2; ++ai) {
            u32x2 ga[4][2][2], gb[4][2][2];
            asm volatile("" ::: "memory");
#pragma unroll
            for (int m = 0; m < 4; ++m) { const bf16_t* gr = GL + (size_t)(row0 + ai * HALF + m * 16) * 3072 + (seg - 1) * 1024 + col0;
#pragma unroll
                for (int bj = 0; bj < 2; ++bj)
#pragma unroll
                    for (int n = 0; n < 2; ++n) { ga[m][bj][n] = *(const u32x2*)(gr + bj * HALF + n * 16); gb[m][bj][n] = *(const u32x2*)(gr + 1024 + bj * HALF + n * 16); } }
#pragma unroll
            for (int m = 0; m < 4; ++m)
#pragma unroll
                for (int bj = 0; bj < 2; ++bj)
#pragma unroll
                    for (int n = 0; n < 2; ++n) { const u32x2 a = ga[m][bj][n], b = gb[m][bj][n];
                        f32x4 r;
                        r[0] = (1.f + lo16(b.x)) * __builtin_amdgcn_rcpf(1.f + lo16(a.x)); r[1] = (1.f + hi16(b.x)) * __builtin_amdgcn_rcpf(1.f + hi16(a.x));
                        r[2] = (1.f + lo16(b.y)) * __builtin_amdgcn_rcpf(1.f + lo16(a.y)); r[3] = (1.f + hi16(b.y)) * __builtin_amdgcn_rcpf(1.f + hi16(a.y));
                        acc[ai][bj][m][n] = acc[ai][bj][m][n] * r; } }
    }
    __device__ __forceinline__ void operator()(const f32x4 (&acc)[2][2][4][2], const Unit& u, int wr, int wc, int fr, int fq) const {
        const int row0 = u.pm * BM + wr * 64 + fr, col0 = u.pn * BM + wc * 32 + 4 * fq;
#pragma unroll
        for (int ai = 0; ai < 2; ++ai) { asm volatile("" ::: "memory");
#pragma unroll
            for (int m = 0; m < 4; ++m) { const size_t row = (size_t)(row0 + ai * HALF + m * 16);
#pragma unroll
                for (int bj = 0; bj < 2; ++bj)
#pragma unroll
                    for (int n = 0; n < 2; ++n) { const int col = col0 + bj * HALF + n * 16;
                        const u32x2 gw = *(const u32x2*)(GL + row * 3072 + 2048 + col);
                        f32x4 g; g[0] = __builtin_amdgcn_rcpf(1.f + lo16(gw.x)); g[1] = __builtin_amdgcn_rcpf(1.f + hi16(gw.x)); g[2] = __builtin_amdgcn_rcpf(1.f + lo16(gw.y)); g[3] = __builtin_amdgcn_rcpf(1.f + hi16(gw.y));
                        const f32x4 v = acc[ai][bj][m][n] * g;
                        u32x2 w; w.x = cvt_pk_bf16(v[0], v[1]); w.y = cvt_pk_bf16(v[2], v[3]); *(u32x2*)(OB + row * 1024 + col) = w; } } }
    }
};
struct EpiOut {
    static constexpr bool PERM = false, AFTER_DRAIN = false, KHOOK = false;
    float* out; float* ctxres; const float* modl; int dry; const float* xin; const float* cin;
    __device__ __forceinline__ void operator()(const f32x4 (&acc)[2][2][4][2], const Unit& u, int wr, int wc, int fr, int fq) const {
        const int row0 = u.pm * BM + wr * 64 + fr, col0 = u.pn * BM + wc * 32 + 4 * fq;
        const int b = (u.pm * BM) / NP, q0 = u.pm * BM - b * NP;
        const bool isctx = q0 < NCTX;
        const float* g1 = modl + (size_t)(isctx ? 8 : b) * 6144 + 2048;
        float* xb = isctx ? ctxres + (size_t)(b * NCTX) * D : out + ((size_t)b * NLAT + (q0 - NCTX)) * D;
        const float* xs = isctx ? cin + (size_t)(b * NCTX) * D : xin + ((size_t)b * NLAT + (q0 - NCTX)) * D;
        f32x4 gv[2][2];
#pragma unroll
        for (int bj = 0; bj < 2; ++bj)
#pragma unroll
            for (int n = 0; n < 2; ++n) gv[bj][n] = *(const f32x4*)(g1 + col0 + bj * HALF + n * 16);
#pragma unroll
        for (int ai = 0; ai < 2; ++ai) { asm volatile("" ::: "memory");
#pragma unroll
            for (int m = 0; m < 4; ++m) { const size_t ro = (size_t)(wr * 64 + fr + ai * HALF + m * 16) * D + col0; float* rowp = xb + ro; const float* srcp = xs + ro;
#pragma unroll
                for (int bj = 0; bj < 2; ++bj)
#pragma unroll
                    for (int n = 0; n < 2; ++n) { float* xp = rowp + bj * HALF + n * 16; const f32x4 nv = *(const f32x4*)(srcp + bj * HALF + n * 16) + gv[bj][n] * acc[ai][bj][m][n]; if (!dry) *(f32x4*)xp = nv; } } }
    }
};
struct EpiSwiGLU {
    static constexpr bool PERM = false, AFTER_DRAIN = false, KHOOK = false;
    bf16_t* HB;
    __device__ __forceinline__ void operator()(const f32x4 (&acc)[2][2][4][2], const Unit& u, int wr, int wc, int fr, int fq) const {
        const int row0 = u.pm * BM + wr * 64 + fr, hh0 = u.pn * 128 + wc * 16 + 4 * fq;
#pragma unroll
        for (int ai = 0; ai < 2; ++ai)
#pragma unroll
            for (int m = 0; m < 4; ++m) { bf16_t* rowp = HB + (size_t)(row0 + ai * HALF + m * 16) * 512 + hh0;
#pragma unroll
                for (int bj = 0; bj < 2; ++bj) { const f32x4 g = acc[ai][bj][m][0], up = acc[ai][bj][m][1]; f32x4 h;
#pragma unroll
                    for (int i = 0; i < 4; ++i) h[i] = g[i] * __builtin_amdgcn_rcpf(1.f + __expf(-g[i])) * up[i];
                    u32x2 w; w.x = cvt_pk_bf16(h[0], h[1]); w.y = cvt_pk_bf16(h[2], h[3]); *(u32x2*)(rowp + bj * 64) = w; } }
    }
};
struct LatentOrder {
    StaticOrder S;
    __host__ __device__ void init(int N, int G_, int c_) { S.init(128 * BM, N, G_, c_); }
    __host__ __device__ bool next(int i, Unit& u) const { if (!S.next(i, u)) return false; u.pm = (u.pm >> 4) * 17 + 1 + (u.pm & 15); return true; }
    __device__ __forceinline__ void a_ready(const Unit&) const {}
    __device__ __forceinline__ void done(const Unit&) const {}
};
template <size_t ESTRIDE> struct MoeOrder {
    int G, c; const PG8_LAS int* tab;
    __device__ __forceinline__ bool next(int i, Unit& u) const {
        const long L = (long)i * G + c; if (L >= (long)tab[32 + MOE_NBLK] * 4) return false;
        u.pm = (int)(L >> 2); u.pn = (int)(L & 3); u.bofs = (size_t)tab[32 + u.pm] * ESTRIDE; return true; }
    __device__ __forceinline__ void a_ready(const Unit&) const {}
    __device__ __forceinline__ void done(const Unit&) const {}
};
}
#define PG8_SP2 true
#define PG8_ALIGN true
struct Frame {
    LAS unsigned char* lds; int tid, lane, wave, G, bid, gwave, nwave;
};
__device__ __forceinline__ bf16_t* WSB(const Params& p, size_t off) { return (bf16_t*)(p.ws + off); }
__device__ __forceinline__ float* WSF(const Params& p, size_t off) { return (float*)(p.ws + off); }

__device__ __forceinline__ void sincos_dd(double ang, float& c, float& s) {
    const double kf = __builtin_rint(ang * 0.63661977236758134308);
    const double r = (ang - kf * 1.57079632679489655800) - kf * 6.12323399573676603587e-17;
    const int k = ((int)kf) & 3;
    const double r2 = r * r;
    const double sp = r * (1.0 + r2 * (-1.0 / 6 + r2 * (1.0 / 120 + r2 * (-1.0 / 5040 + r2 * (1.0 / 362880 + r2 * (-1.0 / 39916800 + r2 * (1.0 / 6227020800.0)))))));
    const double cp = 1.0 + r2 * (-0.5 + r2 * (1.0 / 24 + r2 * (-1.0 / 720 + r2 * (1.0 / 40320 + r2 * (-1.0 / 3628800 + r2 * (1.0 / 479001600 + r2 * (-1.0 / 87178291200.0)))))));
    const double cc = (k == 0) ? cp : (k == 1) ? -sp : (k == 2) ? -cp : sp;
    const double ss = (k == 0) ? sp : (k == 1) ? cp : (k == 2) ? -sp : -cp;
    c = (float)cc; s = (float)ss;
}
__device__ __forceinline__ void p0_prologue(const Params& p, const Frame& F) {
    const int gt = F.bid * NTHREADS + F.tid, ngt = F.G * NTHREADS;
    { float* tab = WSF(p, WS_ROPE); const LAS Params* lpar = (const LAS Params*)(F.lds + (LDS_BYTES - 4096 + 2048));
      for (int i = gt; i < 64 * 16 + 64 * 32; i += ngt) {
          if (i < 1024) { const int pos = i >> 4, k = i & 15; float c, s; sincos_dd((double)pos * (double)lpar->invA[k], c, s); tab[i] = c; tab[1024 + i] = s; }
          else { const int j = i - 1024, pos = j >> 5, k = j & 31; float c, s; sincos_dd((double)pos * (double)lpar->invR[k], c, s); tab[2048 + j] = c; tab[2048 + 2048 + j] = s; } } }
    { float* rwt = WSF(p, WS_RWT);
      for (int i = gt; i < DEPTH * 36 * 1024; i += ngt) { const int l = i / (36 * 1024), r = i - l * 36 * 1024, o = r >> 10, k = r & 1023;
          rwt[i] = o < 4 ? p.in[I_RGW][((size_t)l * 1024 + k) * 4 + o] : p.in[I_REW][((size_t)l * 1024 + k) * 32 + (o - 4)]; } }
    { float* rw2 = WSF(p, WS_RW2);
      for (int i = gt; i < DEPTH * 64 * 3 * 4 * 16 * 4; i += ngt) { const int j = i & 3, n = (i >> 2) & 15, g = (i >> 6) & 3, r = i >> 8, nt = r % 3, r2 = r / 3, kq = r2 & 63, l = r2 >> 6;
          const int ng = 16 * nt + n, k = 4 * (4 * kq + j) + g;
          rw2[i] = ng < 4 ? p.in[I_RGW][((size_t)l * 1024 + k) * 4 + ng] : (ng < 36 ? p.in[I_REW][((size_t)l * 1024 + k) * 32 + (ng - 4)] : 0.f); } }
    { LAS float* cond = (LAS float*)F.lds;
      LAS float* red = (LAS float*)(F.lds + 9 * 1024 * 4);
      for (int i = F.tid; i < 9 * 1024; i += NTHREADS) { const float v = i < 8192 ? p.in[I_C][i] : p.in[I_CCTX][i - 8192]; cond[i] = siluf_(v); }
      __syncthreads();
      float* mod = WSF(p, WS_MOD);
      for (int task = F.bid; task < DEPTH * 96; task += F.G) {
          const int l = task / 96, col0 = (task - l * 96) * 64, c = F.tid & 63, ks = F.tid >> 6;
          const float* w = p.in[I_ADAW] + ((size_t)l * 1024 + ks * 128) * 6144 + col0 + c;
          float a[9];
#pragma unroll
          for (int r = 0; r < 9; ++r) a[r] = 0.f;
          for (int k = 0; k < 128; ++k) { const float wv = w[(size_t)k * 6144];
#pragma unroll
              for (int r = 0; r < 9; ++r) a[r] += cond[r * 1024 + ks * 128 + k] * wv; }
#pragma unroll
          for (int r = 0; r < 9; ++r) red[(ks * 9 + r) * 64 + c] = a[r];
          __syncthreads();
          for (int o = F.tid; o < 9 * 64; o += NTHREADS) { const int r = o >> 6, cc = o & 63; float s = 0.f;
#pragma unroll
              for (int k2 = 0; k2 < 8; ++k2) s += red[(k2 * 9 + r) * 64 + cc];
              mod[((size_t)l * 9 + r) * 6144 + col0 + cc] = s + p.in[I_ADAB][(size_t)l * 6144 + col0 + cc]; }
          __syncthreads();
      } }
}

__device__ __forceinline__ void cvt_tile(const float* src, int ld_src, bf16_t* dst, int ld_dst, int k0, int n0, LAS float* tile  , int tid) {
#pragma unroll
    for (int ps = 0; ps < 2; ++ps) { const int k = ps * 32 + (tid >> 4), n4 = (tid & 15) * 4;
        const f32x4 v = *(const f32x4*)(src + (size_t)(k0 + k) * ld_src + n0 + n4);
        tile[k * 65 + n4] = v[0]; tile[k * 65 + n4 + 1] = v[1]; tile[k * 65 + n4 + 2] = v[2]; tile[k * 65 + n4 + 3] = v[3]; }
    __syncthreads();
    { const int n = tid >> 3, k8 = (tid & 7) * 8; float x[8];
#pragma unroll
      for (int e = 0; e < 8; ++e) x[e] = tile[(k8 + e) * 65 + n];
      *(u32x4*)(dst + (size_t)(n0 + n) * ld_dst + k0 + k8) = pack8(x); }
    __syncthreads();
}

struct CvtTask { const float* src; bf16_t* dst; int ld_src, ld_dst, k0, n0, which; };
__device__ __forceinline__ void cvt_load(f32x4 (&v)[8], const CvtTask& c, int tid) {
#pragma unroll
    for (int ps = 0; ps < 8; ++ps) v[ps] = *(const f32x4*)(c.src + (size_t)(c.k0 + ps * 8 + (tid >> 6)) * c.ld_src + c.n0 + (tid & 63) * 4);
}
__device__ __forceinline__ void cvt_store(const f32x4 (&v)[8], const CvtTask& c, LAS float* tile  , int tid) {
#pragma unroll
    for (int ps = 0; ps < 8; ++ps) *(LAS f32x4*)(tile + (ps * 8 + (tid >> 6)) * 260 + (tid & 63) * 4) = v[ps];
    __syncthreads();
    { const int n = tid >> 1, kb = (tid & 1) * 32, nn = c.n0 + n; const int row = c.which < 0 ? nn : ((nn >> 4) << 5) + (c.which << 4) + (nn & 15);
      bf16_t* d = c.dst + (size_t)row * c.ld_dst + c.k0 + kb;
#pragma unroll
      for (int q = 0; q < 4; ++q) { float x[8];
#pragma unroll
          for (int e = 0; e < 8; ++e) x[e] = tile[(kb + q * 8 + e) * 260 + n];
          *(u32x4*)(d + q * 8) = pack8(x); } }
    __syncthreads();
}
constexpr int NT_MIX = 16 * 30 + 3 * 8 * 4 + 16 * 4;
__device__ __forceinline__ CvtTask cvt_task_mix(const Params& p, int l, int t) {
    CvtTask c; c.which = -1;
    if (t < 480) { const int kt = t / 30, nt = t - kt * 30; c.src = p.in[I_WIN] + (size_t)l * 1024 * 7680; c.ld_src = 7680; c.dst = WSB(p, WS_BTIN); c.ld_dst = 1024; c.k0 = kt * 64; c.n0 = nt * 256; }
    else if (t < 576) { const int u = t - 480, nb = u >> 5, r = u & 31, kt = r >> 2, nt = r & 3;
        c.src = p.in[I_WBR] + ((size_t)l * 3 + nb) * 512 * 1024; c.ld_src = 1024; c.dst = WSB(p, WS_BTBR) + nb * 512; c.ld_dst = 1536; c.k0 = kt * 64; c.n0 = nt * 256; }
    else { const int u = t - 576, kt = u >> 2, nt = u & 3; c.src = p.in[I_WOUT] + (size_t)l * 1024 * 1024; c.ld_src = 1024; c.dst = WSB(p, WS_BTOUT); c.ld_dst = 1024; c.k0 = kt * 64; c.n0 = nt * 256; }
    return c;
}
constexpr int NT_MOE = 32 * 2 * 16 * 2 + 32 * 8 * 4;
__device__ __forceinline__ CvtTask cvt_task_moe(const Params& p, int l, int t) {
    CvtTask c;
    if (t < 2048) { const int e = t >> 6, r = t & 63, which = r >> 5, kt = (r >> 1) & 15, nt = r & 1;
        c.src = (which ? p.in[I_MUP] : p.in[I_MG]) + ((size_t)l * 32 + e) * 1024 * 512; c.ld_src = 512; c.dst = WSB(p, WS_BT1) + (size_t)e * 1024 * 1024; c.ld_dst = 1024; c.k0 = kt * 64; c.n0 = nt * 256; c.which = which; }
    else { const int u = t - 2048, e = u >> 5, r = u & 31, kt = r >> 2, nt = r & 3;
        c.src = p.in[I_MD] + ((size_t)l * 32 + e) * 512 * 1024; c.ld_src = 1024; c.dst = WSB(p, WS_BT2) + (size_t)e * 1024 * 512; c.ld_dst = 512; c.k0 = kt * 64; c.n0 = nt * 256; c.which = -1; }
    return c;
}
template <bool MOE> __device__ __forceinline__ void cvt_run(const Params& p, const Frame& F, int l, LAS float* tile, int first_blk = 0, int t_lo = 0, int t_hi = -1) {
    const int NTASK = t_hi >= 0 ? t_hi : (MOE ? NT_MOE : NT_MIX);
    if (F.bid < first_blk) return;
    const int stride = F.G - first_blk;
    int t = t_lo + F.bid - first_blk; if (t >= NTASK) return;
    CvtTask cur = MOE ? cvt_task_moe(p, l, t) : cvt_task_mix(p, l, t);
    f32x4 v[8]; cvt_load(v, cur, F.tid);
    for (;;) {
        const int tn = t + stride; const bool more = tn < NTASK;
        CvtTask nx = cur; f32x4 vn[8];
        if (more) { nx = MOE ? cvt_task_moe(p, l, tn) : cvt_task_mix(p, l, tn); cvt_load(vn, nx, F.tid); }
        cvt_store(v, cur, tile, F.tid);
        if (!more) break;
#pragma unroll
        for (int i = 0; i < 8; ++i) v[i] = vn[i];
        cur = nx; t = tn;
    }
}

__device__ __forceinline__ void rmsnorm_mod_row(const float* x, const float* g, const float* sc, const float* sh, bf16_t* o, int lane, float* keep  ) {
    f32x4 v[4]; float ss = 0.f;
#pragma unroll
    for (int j = 0; j < 4; ++j) { v[j] = *(const f32x4*)(x + j * 256 + lane * 4); ss += v[j][0] * v[j][0] + v[j][1] * v[j][1] + v[j][2] * v[j][2] + v[j][3] * v[j][3]; }
#pragma unroll
    for (int m = 1; m < 64; m <<= 1) ss += shfl_xor_f(ss, m);
    const float rs = rsqrtf(ss * (1.f / 1024.f) + 1e-6f);
#pragma unroll
    for (int j = 0; j < 4; ++j) { const int c = j * 256 + lane * 4;
        const f32x4 gg = *(const f32x4*)(g + c), s1 = *(const f32x4*)(sc + c), s0 = *(const f32x4*)(sh + c);
        f32x4 y;
#pragma unroll
        for (int e = 0; e < 4; ++e) y[e] = v[j][e] * rs * gg[e] * (1.f + s1[e]) + s0[e];
        u32x2 w; w.x = pk2(y[0], y[1]); w.y = pk2(y[2], y[3]); *(u32x2*)(o + c) = w;
        if (keep) { keep[j * 4 + 0] = y[0]; keep[j * 4 + 1] = y[1]; keep[j * 4 + 2] = y[2]; keep[j * 4 + 3] = y[3]; } }
}
__device__ __forceinline__ void p1_weights(const Params& p, const Frame& F, int l, bool early_done = false) {
    LAS float* tile = (LAS float*)F.lds;
    cvt_run<false>(p, F, l, tile, 0, early_done ? 576 : 0);
    if (F.bid < 9) { const float* sh2 = WSF(p, WS_MOD) + ((size_t)l * 9 + F.bid) * 6144 + 3072; const float* rwt = WSF(p, WS_RWT) + (size_t)l * 36 * 1024; float* rc = WSF(p, WS_RC) + ((size_t)l * 9 + F.bid) * 48;
        for (int n = F.wave; n < 48; n += NWAVES) { float a = 0.f;
            if (n < 36) {
#pragma unroll
                for (int j = 0; j < 4; ++j) { const f32x4 sv = *(const f32x4*)(sh2 + j * 256 + F.lane * 4), wv = *(const f32x4*)(rwt + n * 1024 + j * 256 + F.lane * 4); a += sv[0] * wv[0] + sv[1] * wv[1] + sv[2] * wv[2] + sv[3] * wv[3]; }
#pragma unroll
                for (int mk = 1; mk < 64; mk <<= 1) a += shfl_xor_f(a, mk);
                a += n < 4 ? p.in[I_RGB][l * 4 + n] : p.in[I_REB][l * 32 + n - 4]; }
            if (F.lane == 0) rc[n] = a; } }
    { bf16_t* bl = WSB(p, WS_BTLORA); const int gt = F.bid * NTHREADS + F.tid, ngt = F.G * NTHREADS;
      for (int i = gt; i < 2560 * 256; i += ngt) { const int k = i / 2560, row = i - k * 2560;
          float v = 0.f;
          if (row < 1024) { if (k < 64) { const int d = row >> 9, c = row & 511; v = p.in[I_W2][(((size_t)l * 2 + d) * 64 + k) * 512 + c]; } }
          else if (row < 2048) { if (k >= 64 && k < 128) { const int r2 = row - 1024, d = r2 >> 9, c = r2 & 511; v = p.in[I_A2][(((size_t)l * 2 + d) * 64 + (k - 64)) * 512 + c]; } }
          else { if (k >= 128) { const int c = row - 2048; v = p.in[I_G2][((size_t)l * 128 + (k - 128)) * 512 + c]; } }
          bl[(size_t)row * 256 + k] = (bf16_t)f2bf(v); } }
}
__device__ __forceinline__ void p1_cvt_norm1(const Params& p, const Frame& F, int l) {
    p1_weights(p, F, l);
    { const float* mod = WSF(p, WS_MOD) + (size_t)l * 9 * 6144; bf16_t* H = WSB(p, WS_H);
      for (int row = F.gwave; row < T; row += F.nwave) { const int b = row / NP, q = row - b * NP; const float* mr = mod + (size_t)(q < NCTX ? 8 : b) * 6144;
          const float* xin = q < NCTX ? p.in[I_CTX] + (size_t)(b * NCTX + q) * D : p.in[I_X] + (size_t)(b * NLAT + (q - NCTX)) * D;
          rmsnorm_mod_row(xin, p.in[I_N1G] + (size_t)l * 1024, mr + 1024, mr, H + (size_t)row * 1024, F.lane, nullptr); } }
}

__device__ __forceinline__ void p3_prep(const Params& p, const Frame& F, int l) {
    const float* tab = WSF(p, WS_ROPE);
    const float* cosA = tab, *sinA = tab + 1024, *cosR = tab + 2048, *sinR = tab + 4096;
    bf16_t* AQ = WSB(p, WS_AQ); bf16_t* AKV = WSB(p, WS_AKV); bf16_t* RQ = WSB(p, WS_RQ); bf16_t* RK = WSB(p, WS_RK);
    const bf16_t* WU = WSB(p, WS_WU); bf16_t* AL_ = WSB(p, WS_H);
    const int lane = F.lane;
    const float* qng = p.in[I_QNG] + l * 64, *kng = p.in[I_KNG] + l * 64;
    const float* mu0 = p.in[I_MU] + (size_t)l * 2 * 1792, *mu1 = mu0 + 1792;
    for (int row = F.gwave; row < T; row += F.nwave) {
        const int b = row / NP, q = row - b * NP; const bool lat = q >= NCTX; const int t = q - NCTX, prow = t >> 6, pcol = t & 63;
        const u32x4 raw_aq = *(const u32x4*)(AQ + (size_t)row * 512 + lane * 8), raw_ak = *(const u32x4*)(AKV + (size_t)row * 256 + (lane & 15) * 8);
        const u32x4 raw_rq = *(const u32x4*)(RQ + (size_t)row * 512 + lane * 8), raw_rk = *(const u32x4*)(RK + (size_t)row * 512 + lane * 8);
        const bool hasp = (q != 0) && (q != NCTX), hasn = (q != NCTX - 1) && (q != NP - 1);
        const int cw = 1536 + lane * 4;
        const u32x2 cu = *(const u32x2*)(WU + (size_t)row * 1792 + cw);
        u32x2 pu; pu.x = 0u; pu.y = 0u; u32x2 nu = pu;
        if (hasp) pu = *(const u32x2*)(WU + (size_t)(row - 1) * 1792 + cw);
        if (hasn) nu = *(const u32x2*)(WU + (size_t)(row + 1) * 1792 + cw);
        { const int sub = lane & 7, a = sub >> 2, half = (sub >> 1) & 1, ib = (sub & 1) * 8, pos = lat ? (a ? pcol : prow) : 0;
          float cA[8], sA[8];
          *(f32x4*)cA = *(const f32x4*)(cosA + pos * 16 + ib); *(f32x4*)(cA + 4) = *(const f32x4*)(cosA + pos * 16 + ib + 4);
          *(f32x4*)sA = *(const f32x4*)(sinA + pos * 16 + ib); *(f32x4*)(sA + 4) = *(const f32x4*)(sinA + pos * 16 + ib + 4);
          { float x[8]; unpack8(raw_aq, x);
            float ss = 0.f;
#pragma unroll
            for (int e = 0; e < 8; ++e) ss += x[e] * x[e];
            ss += shfl_xor_f(ss, 1); ss += shfl_xor_f(ss, 2); ss += shfl_xor_f(ss, 4);
            const float rs = rsqrtf(ss * (1.f / 64.f) + 1e-6f);
            float gq[8]; *(f32x4*)gq = *(const f32x4*)(qng + sub * 8); *(f32x4*)(gq + 4) = *(const f32x4*)(qng + sub * 8 + 4);
#pragma unroll
            for (int e = 0; e < 8; ++e) x[e] = x[e] * rs * gq[e];
            float y[8];
#pragma unroll
            for (int e = 0; e < 8; ++e) { const float o = shfl_xor_f(x[e], 2);
                if (lat) { const float c = cA[e], s = sA[e]; y[e] = half ? (x[e] * c + o * s) : (x[e] * c - o * s); } else y[e] = x[e];
                y[e] *= 0.18033688011112042f; }
            if (!p.dry) *(u32x4*)(AQ + (size_t)row * 512 + lane * 8) = pack8(y); }
          { const int lk = lane & 15; float x[8]; unpack8(raw_ak, x);
            float ss = 0.f;
#pragma unroll
            for (int e = 0; e < 8; ++e) ss += x[e] * x[e];
            ss += shfl_xor_f(ss, 1); ss += shfl_xor_f(ss, 2); ss += shfl_xor_f(ss, 4);
            const float rs = rsqrtf(ss * (1.f / 64.f) + 1e-6f);
            float gk[8]; *(f32x4*)gk = *(const f32x4*)(kng + sub * 8); *(f32x4*)(gk + 4) = *(const f32x4*)(kng + sub * 8 + 4);
#pragma unroll
            for (int e = 0; e < 8; ++e) x[e] = x[e] * rs * gk[e];
            float y[8];
#pragma unroll
            for (int e = 0; e < 8; ++e) { const float o = shfl_xor_f(x[e], 2);
                if (lat) { const float c = cA[e], s = sA[e]; y[e] = half ? (x[e] * c + o * s) : (x[e] * c - o * s); } else y[e] = x[e]; }
            if (lane < 16 && !p.dry) *(u32x4*)(AKV + (size_t)row * 256 + lk * 8) = pack8(y); } }
        { const int sub = lane & 15, a = sub >> 3, half = (sub >> 2) & 1, ib = (sub & 3) * 8, pos = lat ? (a ? pcol : prow) : 0;
          float cR[8], sR[8];
          *(f32x4*)cR = *(const f32x4*)(cosR + pos * 32 + ib); *(f32x4*)(cR + 4) = *(const f32x4*)(cosR + pos * 32 + ib + 4);
          *(f32x4*)sR = *(const f32x4*)(sinR + pos * 32 + ib); *(f32x4*)(sR + 4) = *(const f32x4*)(sinR + pos * 32 + ib + 4);
#pragma unroll
          for (int which = 0; which < 2; ++which) { bf16_t* buf = which ? RK : RQ;
            float x[8]; unpack8(which ? raw_rk : raw_rq, x); float y[8];
#pragma unroll
            for (int e = 0; e < 8; ++e) { const float o = shfl_xor_f(x[e], 4);
                if (lat) { const float c = cR[e], s = sR[e]; y[e] = half ? (x[e] * c + o * s) : (x[e] * c - o * s); } else y[e] = x[e];
                if (which) y[e] *= 0.08838834764831845f; }
            if (!p.dry) *(u32x4*)(buf + (size_t)row * 512 + lane * 8) = pack8(y); } }
        { const int c = cw;
          const float uc[4] = {lo16(cu.x), hi16(cu.x), lo16(cu.y), hi16(cu.y)}, up[4] = {lo16(pu.x), hi16(pu.x), lo16(pu.y), hi16(pu.y)}, un[4] = {lo16(nu.x), hi16(nu.x), lo16(nu.y), hi16(nu.y)};
          float y[4]; const f32x4 m0v = *(const f32x4*)(mu0 + c), m1v = *(const f32x4*)(mu1 + c);
#pragma unroll
          for (int e = 0; e < 4; ++e) { const float xs = uc[e] + (up[e] - uc[e]) * m0v[e] + (un[e] - uc[e]) * m1v[e];
              if (lane < 16) { const float ex = __expf(2.f * xs); y[e] = 1.f - 2.f * frcp(ex + 1.f); }
              else if (lane < 32) y[e] = xs;
              else y[e] = sigmoidf_(xs); }
          u32x2 w; w.x = pk2(y[0], y[1]); w.y = pk2(y[2], y[3]); *(u32x2*)(AL_ + (size_t)row * 256 + lane * 4) = w; }
    }
}

__device__ __forceinline__ void p5_rwkv_tok(const Params& p, const Frame& F, int l) {
    const bf16_t* WU = WSB(p, WS_WU); const bf16_t* LW = WSB(p, WS_LW); const bf16_t* LA = WSB(p, WS_LA);
    bf16_t* RS = WSB(p, WS_W1); bf16_t* VS = RS + (size_t)T * 512; bf16_t* KKS = VS + (size_t)T * 512;
    const int lane = F.lane, c0 = lane * 8;
    const float* mu0 = p.in[I_MU] + (size_t)l * 2 * 1792, *mu1 = mu0 + 1792;
    const float* k_k = p.in[I_KK] + l * 512, *k_a = p.in[I_KA] + l * 512;
    for (int row = F.gwave; row < T; row += F.nwave) {
        const int b = row / NP, q = row - b * NP;
        const bool hasp = (q != 0) && (q != NCTX), hasn = (q != NCTX - 1) && (q != NP - 1);
        float sh[3][8];
#pragma unroll
        for (int part = 0; part < 3; ++part) { const int c = part * 512 + c0;
            const u32x4 cu = *(const u32x4*)(WU + (size_t)row * 1792 + c);
            u32x4 pu; pu.x = pu.y = pu.z = pu.w = 0u; u32x4 nu = pu;
            if (hasp) pu = *(const u32x4*)(WU + (size_t)(row - 1) * 1792 + c);
            if (hasn) nu = *(const u32x4*)(WU + (size_t)(row + 1) * 1792 + c);
            float uc[8], up[8], un[8]; unpack8(cu, uc); unpack8(pu, up); unpack8(nu, un);
#pragma unroll
            for (int e = 0; e < 8; ++e) sh[part][e] = uc[e] + (up[e] - uc[e]) * mu0[c + e] + (un[e] - uc[e]) * mu1[c + e]; }
        float kk[8]; float ss = 0.f;
#pragma unroll
        for (int e = 0; e < 8; ++e) { kk[e] = sh[1][e] * k_k[c0 + e]; ss += kk[e] * kk[e]; }
        ss += shfl_xor_f(ss, 1); ss += shfl_xor_f(ss, 2); ss += shfl_xor_f(ss, 4);
        const float rn = rsqrtf(fmaxf(ss, 1e-12f));
#pragma unroll
        for (int e = 0; e < 8; ++e) kk[e] *= rn;
        u32x4 lw_raw[2], la_raw[2];
#pragma unroll
        for (int d = 0; d < 2; ++d) { lw_raw[d] = *(const u32x4*)(LW + (size_t)row * 1024 + d * 512 + c0); la_raw[d] = *(const u32x4*)(LA + (size_t)row * 1024 + d * 512 + c0); }
        *(u32x4*)(RS + (size_t)row * 512 + c0) = pack8(sh[0]);
        *(u32x4*)(VS + (size_t)row * 512 + c0) = pack8(sh[2]);
        *(u32x4*)(KKS + (size_t)row * 512 + c0) = pack8(kk);
#pragma unroll
        for (int d = 0; d < 2; ++d) {
            _Float16* LOGW = (_Float16*)(p.ws + WS_W1 + (size_t)(3 + 3 * d) * SZ512); bf16_t* KR = WSB(p, WS_W1 + (size_t)(4 + 3 * d) * SZ512); bf16_t* BB = WSB(p, WS_W1 + (size_t)(5 + 3 * d) * SZ512);
            const float* w0 = p.in[I_W0] + ((size_t)l * 2 + d) * 512, *a0 = p.in[I_A0] + ((size_t)l * 2 + d) * 512;
            float lw[8], la[8]; unpack8(lw_raw[d], lw); unpack8(la_raw[d], la);
            float kr[8], bb[8]; typedef _Float16 h8 __attribute__((ext_vector_type(8))); h8 lg;
#pragma unroll
            for (int e = 0; e < 8; ++e) { const float a = sigmoidf_(a0[c0 + e] + la[e]);
                lg[e] = (_Float16)(-0.6065306597126334f * sigmoidf_(w0[c0 + e] + lw[e]));
                kr[e] = sh[1][e] * (1.f + (a - 1.f) * k_a[c0 + e]); bb[e] = kk[e] * a; }
            *(h8*)(LOGW + (size_t)row * 512 + c0) = lg;
            *(u32x4*)(KR + (size_t)row * 512 + c0) = pack8(kr);
            *(u32x4*)(BB + (size_t)row * 512 + c0) = pack8(bb); }
    }
}
__device__ __forceinline__ float reduce8(float (&v)[8], int lane) {
    float a[4];
#pragma unroll
    for (int k = 0; k < 4; ++k) { const bool up = (lane & 32) != 0; const float send = up ? v[k] : v[k + 4], keep = up ? v[k + 4] : v[k]; a[k] = keep + __shfl_xor(send, 32, 64); }
    float b[2];
#pragma unroll
    for (int k = 0; k < 2; ++k) { const bool up = (lane & 16) != 0; const float send = up ? a[k] : a[k + 2], keep = up ? a[k + 2] : a[k]; b[k] = keep + __shfl_xor(send, 16, 64); }
    float c; { const bool up = (lane & 8) != 0; const float send = up ? b[0] : b[1], keep = up ? b[1] : b[0]; c = keep + __shfl_xor(send, 8, 64); }
    c += __shfl_xor(c, 4, 64); c += __shfl_xor(c, 2, 64); c += __shfl_xor(c, 1, 64);
    return c;
}
__device__ __forceinline__ void p6_rwkv_scan_naive(const Params& p, const Frame& F, int l) {
    (void)l;
    LAS float* L_r = (LAS float*)F.lds;
    LAS float* L_w = L_r + 4096; LAS float* L_k = L_w + 4096; LAS float* L_v = L_k + 4096; LAS float* L_a = L_v + 4096; LAS float* L_b = L_a + 4096; LAS float* L_y = L_b + 4096;
    const bf16_t* RS = WSB(p, WS_W1); const bf16_t* VS = RS + (size_t)T * 512; const bf16_t* KKS = VS + (size_t)T * 512;
    const int lane = F.lane, w = F.wave, tid = F.tid;
    for (int task = F.bid; task < NB * 8 * 2; task += F.G) {
        const int dir = task & 1, h = (task >> 1) & 7, b = task >> 4;
        const _Float16* LOGW = (const _Float16*)(p.ws + WS_W1 + (size_t)(3 + 3 * dir) * SZ512); const bf16_t* KR = WSB(p, WS_W1 + (size_t)(4 + 3 * dir) * SZ512); const bf16_t* BB = WSB(p, WS_W1 + (size_t)(5 + 3 * dir) * SZ512);
        bf16_t* YS = WSB(p, WS_YS) + (size_t)dir * T * 512;
        float S[8];
#pragma unroll
        for (int i = 0; i < 8; ++i) S[i] = 0.f;
        for (int s0 = 0; s0 < NP; s0 += 64) {
            { const int st = tid >> 3, c8 = (tid & 7) * 8, s = s0 + st; const int q = dir ? (s < NCTX ? NCTX - 1 - s : NP + NCTX - 1 - s) : s;
              const size_t off = ((size_t)(b * NP + q)) * 512 + h * 64 + c8;
              float x[8];
              unpack8(*(const u32x4*)(RS + off), x);
#pragma unroll
              for (int e = 0; e < 8; ++e) L_r[st * 64 + c8 + e] = x[e];
              unpack8(*(const u32x4*)(VS + off), x);
#pragma unroll
              for (int e = 0; e < 8; ++e) L_v[st * 64 + c8 + e] = x[e];
              unpack8(*(const u32x4*)(KKS + off), x);
#pragma unroll
              for (int e = 0; e < 8; ++e) L_a[st * 64 + c8 + e] = -x[e];
              unpack8(*(const u32x4*)(KR + off), x);
#pragma unroll
              for (int e = 0; e < 8; ++e) L_k[st * 64 + c8 + e] = x[e];
              unpack8(*(const u32x4*)(BB + off), x);
#pragma unroll
              for (int e = 0; e < 8; ++e) L_b[st * 64 + c8 + e] = x[e];
              typedef _Float16 h8 __attribute__((ext_vector_type(8))); const h8 lg = *(const h8*)(LOGW + off);
#pragma unroll
              for (int e = 0; e < 8; ++e) L_w[st * 64 + c8 + e] = __expf((float)lg[e]); }
            __syncthreads();
            for (int st = 0; st < 64; ++st) {
                const float rj = L_r[st * 64 + lane], wj = L_w[st * 64 + lane], kj = L_k[st * 64 + lane], aj = L_a[st * 64 + lane], bj = L_b[st * 64 + lane];
                float pa[8];
#pragma unroll
                for (int i = 0; i < 8; ++i) pa[i] = S[i] * aj;
                const float tot = reduce8(pa, lane);
                float py[8];
#pragma unroll
                for (int i = 0; i < 8; ++i) { const float sa = __shfl(tot, i * 8, 64); const float vi = L_v[st * 64 + w * 8 + i];
                    S[i] = S[i] * wj + sa * bj + vi * kj; py[i] = S[i] * rj; }
                const float ty = reduce8(py, lane);
                if ((lane & 7) == 0) L_y[st * 64 + w * 8 + (lane >> 3)] = ty;
            }
            __syncthreads();
            { const int st = tid >> 3, c8 = (tid & 7) * 8, s = s0 + st; const int q = dir ? (s < NCTX ? NCTX - 1 - s : NP + NCTX - 1 - s) : s;
              float y[8];
#pragma unroll
              for (int e = 0; e < 8; ++e) y[e] = L_y[st * 64 + c8 + e];
              *(u32x4*)(YS + ((size_t)(b * NP + q)) * 512 + h * 64 + c8) = pack8(y); }
            __syncthreads();
        }
    }
}

__device__ __forceinline__ void p7_rwkv_readout(const Params& p, const Frame& F, int l);
constexpr int RPITCH_TR = 288;
constexpr int RPITCH_ROW = 272;
__device__ __forceinline__ float log_gamma_of(const Params& p, int l, int dir, int h) {
    const float x = p.in[I_RDL][(l * 2 + dir) * 4 + h];
    return -log1pf(__expf(-x));
}
__device__ __forceinline__ void p8_ret_kv(const Params& p, const Frame& F, int l) {
    const bf16_t* RK = WSB(p, WS_RK); const bf16_t* RV = WSB(p, WS_RV);
    bf16_t* SF = WSB(p, WS_SF); bf16_t* SB = WSB(p, WS_SB);
    LAS unsigned char* Lv = F.lds; LAS unsigned char* Lkf = F.lds + 128 * RPITCH_TR; LAS unsigned char* Lkb = F.lds + 2 * 128 * RPITCH_TR;
    const int lane = F.lane, w = F.wave, tid = F.tid, g = lane >> 4, li = lane & 15, q4 = li >> 2, p4 = li & 3;
    for (int u = F.bid; u < NB * 4 * 34; u += F.G) {
        const int c = u % 34, bh = u / 34, h = bh & 3, b = bh >> 2;
        const float lgf = log_gamma_of(p, l, 0, h) * 1.4426950408889634f, lgb = log_gamma_of(p, l, 1, h) * 1.4426950408889634f;
#pragma unroll
        for (int it = 0; it < 4; ++it) { const int idx = it * NTHREADS + tid, j = idx >> 4, c8 = (idx & 15) * 8;
            const size_t off = ((size_t)(b * NP + c * 128 + j)) * 512 + h * 128 + c8;
            const u32x4 vv = *(const u32x4*)(RV + off); *(LAS u32x4*)(Lv + j * RPITCH_TR + c8 * 2) = vv;
            float x[8]; unpack8(*(const u32x4*)(RK + off), x);
            const float sf = exp2f(lgf * (float)(127 - j)), sb = exp2f(lgb * (float)j);
            float xf[8], xb[8];
#pragma unroll
            for (int e = 0; e < 8; ++e) { xf[e] = x[e] * sf; xb[e] = x[e] * sb; }
            *(LAS u32x4*)(Lkf + j * RPITCH_TR + c8 * 2) = pack8(xf); *(LAS u32x4*)(Lkb + j * RPITCH_TR + c8 * 2) = pack8(xb); }
        __syncthreads();
        const int dir = w >> 2, e0 = (w & 3) * 32;
        LAS unsigned char* Lk = dir ? Lkb : Lkf;
        f32x4 acc[2][8];
#pragma unroll
        for (int et = 0; et < 2; ++et)
#pragma unroll
            for (int dt = 0; dt < 8; ++dt) acc[et][dt] = (f32x4){0.f, 0.f, 0.f, 0.f};
        const LAS unsigned char* vbase = Lv; const LAS unsigned char* kbase = Lk;
#pragma unroll 1
        for (int ks = 0; ks < 4; ++ks) {
            const int r0 = 32 * ks + 8 * g;
            bf16x8 af[2];
#pragma unroll
            for (int et = 0; et < 2; ++et) { const int col = e0 + 16 * et + 4 * p4;
                af[et] = cat44(tr_read(vbase + (r0 + q4) * RPITCH_TR + col * 2), tr_read(vbase + (r0 + 4 + q4) * RPITCH_TR + col * 2)); }
#pragma unroll
            for (int dt = 0; dt < 8; ++dt) { const int col = 16 * dt + 4 * p4;
                const bf16x8 bfr = cat44(tr_read(kbase + (r0 + q4) * RPITCH_TR + col * 2), tr_read(kbase + (r0 + 4 + q4) * RPITCH_TR + col * 2));
#pragma unroll
                for (int et = 0; et < 2; ++et) acc[et][dt] = MFMA16(af[et], bfr, acc[et][dt]); }
        }
        bf16_t* dst = (dir ? SB : SF) + (size_t)u * 16384;
#pragma unroll
        for (int et = 0; et < 2; ++et)
#pragma unroll
            for (int dt = 0; dt < 8; ++dt)
#pragma unroll
                for (int r = 0; r < 4; ++r) dst[(size_t)(e0 + 16 * et + 4 * g + r) * 128 + 16 * dt + li] = (bf16_t)f2bf(acc[et][dt][r]);
        __syncthreads();
    }
}
__device__ __forceinline__ void p9_ret_scan(const Params& p, const Frame& F, int l) {
    unsigned* SF = (unsigned*)(p.ws + WS_SF); unsigned* SB = (unsigned*)(p.ws + WS_SB);
    const int gt = F.bid * NTHREADS + F.tid, ngt = F.G * NTHREADS;
    for (int i = gt; i < 2 * NB * 4 * 8192; i += ngt) {
        const int dir = i / (NB * 4 * 8192), r = i - dir * (NB * 4 * 8192), bh = r >> 13, el = r & 8191, h = bh & 3;
        const float gC = __expf(128.f * log_gamma_of(p, l, dir, h));
        unsigned* base = (dir ? SB : SF) + (size_t)bh * 34 * 8192 + el;
        float s0 = 0.f, s1 = 0.f;
        for (int k = 0; k < 34; ++k) { const int c = dir ? (k < 2 ? 1 - k : 35 - k) : k;
            const unsigned kv = base[(size_t)c * 8192]; if (!p.dry) base[(size_t)c * 8192] = pk2(s0, s1); s0 = gC * s0 + lo16(kv); s1 = gC * s1 + hi16(kv); }
    }
}
__device__ __forceinline__ void p10_ret_out(const Params& p, const Frame& F, int l, bool want_ctx) {
    const bf16_t* RQ = WSB(p, WS_RQ); const bf16_t* RK = WSB(p, WS_RK); const bf16_t* RV = WSB(p, WS_RV); const bf16_t* RG = WSB(p, WS_RG); bf16_t* YR = WSB(p, WS_WU) + 512;
    const bf16_t* SF = WSB(p, WS_SF); const bf16_t* SB = WSB(p, WS_SB);
    LAS unsigned char* Lq = F.lds; LAS unsigned char* Lk = Lq + 128 * RPITCH_ROW; LAS unsigned char* Lv = Lk + 128 * RPITCH_ROW; LAS unsigned char* Ls = Lv + 128 * RPITCH_TR;
    const int lane = F.lane, w = F.wave, tid = F.tid, g = lane >> 4, li = lane & 15, q4 = li >> 2, p4 = li & 3;
    const float* gn = p.in[I_RGN] + l * 512;
    for (int u = F.bid; u < NB * 4 * 34; u += F.G) {
        const int c = u % 34, bh = u / 34, h = bh & 3, b = bh >> 2;
        if (c < 2 && !want_ctx) continue;
        const float lgf = log_gamma_of(p, l, 0, h) * 1.4426950408889634f, lgb = log_gamma_of(p, l, 1, h) * 1.4426950408889634f;
        const size_t row0 = (size_t)(b * NP + c * 128);
#pragma unroll
        for (int it = 0; it < 4; ++it) { const int idx = it * NTHREADS + tid, j = idx >> 4, c8 = (idx & 15) * 8;
            const size_t off = (row0 + j) * 512 + h * 128 + c8;
            *(LAS u32x4*)(Lq + j * RPITCH_ROW + c8 * 2) = *(const u32x4*)(RQ + off);
            *(LAS u32x4*)(Lk + j * RPITCH_ROW + c8 * 2) = *(const u32x4*)(RK + off);
            *(LAS u32x4*)(Lv + j * RPITCH_TR + c8 * 2) = *(const u32x4*)(RV + off);
            *(LAS u32x4*)(Ls + j * RPITCH_ROW + c8 * 2) = *(const u32x4*)(SF + (size_t)u * 16384 + j * 128 + c8); }
        __syncthreads();
        const int il = 16 * w + li;
        bf16x8 qf[4];
#pragma unroll
        for (int ks = 0; ks < 4; ++ks) qf[ks] = ld_frag(Lq + il * RPITCH_ROW + (32 * ks + 8 * g) * 2);
        f32x4 sc[8];
#pragma unroll
        for (int jt = 0; jt < 8; ++jt) { sc[jt] = (f32x4){0.f, 0.f, 0.f, 0.f};
#pragma unroll
            for (int ks = 0; ks < 4; ++ks) sc[jt] = MFMA16(ld_frag(Lk + (16 * jt + li) * RPITCH_ROW + (32 * ks + 8 * g) * 2), qf[ks], sc[jt]); }
#pragma unroll
        for (int jt = 0; jt < 8; ++jt)
#pragma unroll
            for (int r = 0; r < 4; ++r) { const int j = 16 * jt + 4 * g + r, dl = il - j;
                const float f = dl > 0 ? __builtin_amdgcn_exp2f(lgf * (float)dl) : (dl < 0 ? __builtin_amdgcn_exp2f(lgb * (float)(-dl)) : 2.f);
                sc[jt][r] *= f; }
        f32x4 y[8];
#pragma unroll
        for (int et = 0; et < 8; ++et) y[et] = (f32x4){0.f, 0.f, 0.f, 0.f};
        const LAS unsigned char* vbase = Lv;
#pragma unroll
        for (int ks = 0; ks < 4; ++ks) {
            const bf16x8 pf = pack_frag(sc[2 * ks], sc[2 * ks + 1]);
#pragma unroll
            for (int et = 0; et < 8; ++et) { const int col = 16 * et + 4 * p4;
                const bf16x8 vf = cat44(tr_read(vbase + (32 * ks + 4 * g + q4) * RPITCH_TR + col * 2), tr_read(vbase + (32 * ks + 16 + 4 * g + q4) * RPITCH_TR + col * 2));
                y[et] = MFMA16(vf, pf, y[et]); }
        }
        { f32x4 z[8]; const float sf = exp2f(lgf * (float)(il + 1));
#pragma unroll
          for (int et = 0; et < 8; ++et) { z[et] = (f32x4){0.f, 0.f, 0.f, 0.f};
#pragma unroll
              for (int ks = 0; ks < 4; ++ks) z[et] = MFMA16(ld_frag(Ls + (16 * et + li) * RPITCH_ROW + (32 * ks + 8 * g) * 2), qf[ks], z[et]);
              y[et] = y[et] + z[et] * sf; } }
        __syncthreads();
#pragma unroll
        for (int it = 0; it < 4; ++it) { const int idx = it * NTHREADS + tid, j = idx >> 4, c8 = (idx & 15) * 8;
            *(LAS u32x4*)(Ls + j * RPITCH_ROW + c8 * 2) = *(const u32x4*)(SB + (size_t)u * 16384 + j * 128 + c8); }
        __syncthreads();
        { f32x4 z[8]; const float sb = exp2f(lgb * (float)(128 - il));
#pragma unroll
          for (int et = 0; et < 8; ++et) { z[et] = (f32x4){0.f, 0.f, 0.f, 0.f};
#pragma unroll
              for (int ks = 0; ks < 4; ++ks) z[et] = MFMA16(ld_frag(Ls + (16 * et + li) * RPITCH_ROW + (32 * ks + 8 * g) * 2), qf[ks], z[et]);
              y[et] = y[et] + z[et] * sb; } }
        float ss = 0.f;
#pragma unroll
        for (int et = 0; et < 8; ++et)
#pragma unroll
            for (int r = 0; r < 4; ++r) ss += y[et][r] * y[et][r];
        ss += shfl_xor_f(ss, 16); ss += shfl_xor_f(ss, 32);
        const float rs = rsqrtf(ss * (1.f / 128.f) + 1e-6f);
        const size_t orow = (row0 + il) * 512 + h * 128;
#pragma unroll
        for (int et = 0; et < 8; ++et) { const int e = 16 * et + 4 * g;
            const u32x2 gw = *(const u32x2*)(RG + orow + e); const f32x4 gg = *(const f32x4*)(gn + h * 128 + e);
            const float o0 = siluf_(lo16(gw.x)) * y[et][0] * rs * gg[0], o1 = siluf_(hi16(gw.x)) * y[et][1] * rs * gg[1], o2 = siluf_(lo16(gw.y)) * y[et][2] * rs * gg[2], o3 = siluf_(hi16(gw.y)) * y[et][3] * rs * gg[3];
            u32x2 ow; ow.x = pk2(o0, o1); ow.y = pk2(o2, o3); *(u32x2*)(YR + (row0 + il) * 1536 + h * 128 + e) = ow; }
        __syncthreads();
    }
}
constexpr int APITCH = 144;
__device__ __forceinline__ void p11_attention(const Params& p, const Frame& F, bool want_ctx) {
    const bf16_t* AQ = WSB(p, WS_AQ); const bf16_t* AKV = WSB(p, WS_AKV); bf16_t* YA = WSB(p, WS_WU);
    const int lane = F.lane, w = F.wave, tid = F.tid, g = lane >> 4, li = lane & 15, q4 = li >> 2, p4 = li & 3;
    LAS unsigned char* LK = F.lds; LAS unsigned char* LV = F.lds + 4 * 64 * APITCH;
    const int nunits = NB * 8 * 17;
    for (int u0 = F.bid; u0 < nunits; u0 += F.G) {
        int b, h, qb;
        int u = u0;
        if (F.G == 256 && u0 < NB * 8 * 16) { const int r = u0 >> 8, x = u0 & 7, j = (u0 & 255) >> 3, pair = x + 8 * (r >> 1), un = (r & 1) * 32 + j;
            u = (pair >> 1) * 128 + ((pair & 1) * 4 + (un >> 4)) * 16 + (un & 15); }
        if (u < NB * 8 * 16) { b = u >> 7; h = (u >> 4) & 7; qb = 1 + (u & 15); } else { const int v = u - NB * 8 * 16; b = v >> 3; h = v & 7; qb = 0; }
        if (qb == 0 && !want_ctx) continue;
        const int kvh = h >> 2, ntile = qb == 0 ? NCTX / 64 : NP / 64;
        const size_t rowbase = (size_t)b * NP + (size_t)qb * 256;
        bf16x8 qf[2][2];
#pragma unroll
        for (int it = 0; it < 2; ++it)
#pragma unroll
            for (int ks = 0; ks < 2; ++ks) qf[it][ks] = *(const bf16x8*)(AQ + (rowbase + 32 * w + 16 * it + li) * 512 + h * 64 + 32 * ks + 8 * g);
        f32x4 o[4][2]; float m[2]; f32x4 lsa[2], minit[2];
        const bf16x8 ones = {(short)0x3F80, (short)0x3F80, (short)0x3F80, (short)0x3F80, (short)0x3F80, (short)0x3F80, (short)0x3F80, (short)0x3F80};
#pragma unroll
        for (int it = 0; it < 2; ++it) { m[it] = 0.f; lsa[it] = (f32x4){0.f, 0.f, 0.f, 0.f}; minit[it] = (f32x4){0.f, 0.f, 0.f, 0.f};
#pragma unroll
            for (int et = 0; et < 4; ++et) o[et][it] = (f32x4){0.f, 0.f, 0.f, 0.f}; }
        const int sj = tid >> 3, sc8 = (tid & 7) * 8;
        const bf16_t* kvsrc = AKV + ((size_t)b * NP + sj) * 256 + kvh * 64 + sc8;
        u32x4 kreg[2], vreg[2];
#pragma unroll
        for (int sb = 0; sb < 2; ++sb) { kreg[sb] = *(const u32x4*)(kvsrc + (size_t)sb * 64 * 256); vreg[sb] = *(const u32x4*)(kvsrc + (size_t)sb * 64 * 256 + 128); }
        __syncthreads();
        for (int kp = 0; kp < ntile / 2; ++kp) {
            LAS unsigned char* lkb = LK + (kp & 1) * 128 * APITCH; LAS unsigned char* lvb = LV + (kp & 1) * 128 * APITCH;
#pragma unroll
            for (int sb = 0; sb < 2; ++sb) { *(LAS u32x4*)(lkb + (sb * 64 + sj) * APITCH + sc8 * 2) = kreg[sb]; *(LAS u32x4*)(lvb + (sb * 64 + sj) * APITCH + sc8 * 2) = vreg[sb]; }
            __syncthreads();
            if (kp + 1 < ntile / 2) {
#pragma unroll
                for (int sb = 0; sb < 2; ++sb) { const bf16_t* s2 = kvsrc + (size_t)(2 * kp + 2 + sb) * 64 * 256; kreg[sb] = *(const u32x4*)s2; vreg[sb] = *(const u32x4*)(s2 + 128); } }
#pragma unroll
            for (int sb = 0; sb < 2; ++sb) { const int kt = 2 * kp + sb; LAS unsigned char* lk = lkb + sb * 64 * APITCH; LAS unsigned char* lv = lvb + sb * 64 * APITCH;
            f32x4 sc[4][2];
#pragma unroll
            for (int jt = 0; jt < 4; ++jt) {
                const bf16x8 kf0 = ld_frag(lk + (16 * jt + li) * APITCH + (8 * g) * 2), kf1 = ld_frag(lk + (16 * jt + li) * APITCH + (32 + 8 * g) * 2);
                sc[jt][0] = MFMA16(kf0, qf[0][0], minit[0]); sc[jt][1] = MFMA16(kf0, qf[1][0], minit[1]);
                sc[jt][0] = MFMA16(kf1, qf[0][1], sc[jt][0]); sc[jt][1] = MFMA16(kf1, qf[1][1], sc[jt][1]); }
            bf16x8 pf[2][2];
            if ((kt & 7) == 0) {
                float mx[2];
#pragma unroll
                for (int it = 0; it < 2; ++it) { float t = sc[0][it][0];
#pragma unroll
                    for (int jt = 0; jt < 4; ++jt)
#pragma unroll
                        for (int r = 0; r < 4; ++r) t = fmaxf(t, sc[jt][it][r]);
                    t = fmaxf(t, shfl_xor_f(t, 16)); t = fmaxf(t, shfl_xor_f(t, 32)); mx[it] = t; }
                if (kt == 0 || __any(fmaxf(mx[0], mx[1]) > 8.f)) {
#pragma unroll
                    for (int it = 0; it < 2; ++it) { const float d = kt == 0 ? mx[it] : fmaxf(mx[it], 0.f), alpha = kt == 0 ? 1.f : __builtin_amdgcn_exp2f(-d);
                        m[it] = kt == 0 ? d : m[it] + d; lsa[it] = lsa[it] * alpha; minit[it] = (f32x4){-m[it], -m[it], -m[it], -m[it]};
#pragma unroll
                        for (int et = 0; et < 4; ++et) o[et][it] = o[et][it] * alpha;
#pragma unroll
                        for (int jt = 0; jt < 4; ++jt)
#pragma unroll
                            for (int r = 0; r < 4; ++r) sc[jt][it][r] -= d; } } }
#pragma unroll
            for (int it = 0; it < 2; ++it) {
#pragma unroll
                for (int jt = 0; jt < 4; ++jt)
#pragma unroll
                    for (int r = 0; r < 4; ++r) sc[jt][it][r] = __builtin_amdgcn_exp2f(sc[jt][it][r]);
                pf[it][0] = pack_frag(sc[0][it], sc[1][it]); pf[it][1] = pack_frag(sc[2][it], sc[3][it]);
                lsa[it] = MFMA16(ones, pf[it][0], lsa[it]); lsa[it] = MFMA16(ones, pf[it][1], lsa[it]); }
#pragma unroll
            for (int ks = 0; ks < 2; ++ks)
#pragma unroll
                for (int et = 0; et < 4; ++et) { const int col = 16 * et + 4 * p4;
                    const bf16x8 vf = cat44(tr_read(lv + (32 * ks + 4 * g + q4) * APITCH + col * 2), tr_read(lv + (32 * ks + 16 + 4 * g + q4) * APITCH + col * 2));
                    o[et][0] = MFMA16(vf, pf[0][ks], o[et][0]); o[et][1] = MFMA16(vf, pf[1][ks], o[et][1]); }
            }
        }
#pragma unroll
        for (int it = 0; it < 2; ++it) { const float inv = __builtin_amdgcn_rcpf(lsa[it][0]);
            bf16_t* op = YA + (rowbase + 32 * w + 16 * it + li) * 1536 + h * 64 + 4 * g;
#pragma unroll
            for (int et = 0; et < 4; ++et) { u32x2 ow; ow.x = pk2(o[et][it][0] * inv, o[et][it][1] * inv); ow.y = pk2(o[et][it][2] * inv, o[et][it][3] * inv); *(u32x2*)(op + 16 * et) = ow; } }
    }
    __syncthreads();
}

__device__ __forceinline__ void p14_norm2_router(const Params& p, const Frame& F, int l, bool want_ctx) {
    LAS float* tile = (LAS float*)F.lds;
    (void)tile;
    const float* mod = WSF(p, WS_MOD) + (size_t)l * 9 * 6144; bf16_t* H2 = WSB(p, WS_H);
    const float* rw2 = WSF(p, WS_RW2) + (size_t)l * 64 * 3 * 4 * 16 * 4;
    const float* rcl = WSF(p, WS_RC) + (size_t)l * 9 * 48;
    const float* n2g = p.in[I_N2G] + (size_t)l * 1024;
    unsigned* cnt = (unsigned*)(p.ws + WS_CTL) + CW_CNT + l * 32;
    int* PE = (int*)(p.ws + WS_PAIR); int* PPOS = PE + NPAIR_MAX; float* PW = (float*)(PPOS + NPAIR_MAX);
    for (int gi = F.gwave; gi < T / 16; gi += F.nwave) {
        int lane = F.lane; asm volatile("" : "+v"(lane));
        const int g = lane >> 4, li = lane & 15, half = lane >> 5, lk = lane & 31;
        const int row0 = 16 * gi, b = row0 / NP, q = row0 - b * NP; const bool isctx = q < NCTX;
        if (isctx && !want_ctx) continue;
        const int mrow = isctx ? 8 : b; const float* mr = mod + (size_t)mrow * 6144;
        LAS float* At = (LAS float*)(F.lds + F.wave * 12288);
        LAS float* LGT = At + 16 * 4 * 36;
        const float* xr[8];
#pragma unroll
        for (int r = 0; r < 8; ++r) xr[r] = xrow(p, row0 + 8 * half + r);
        f32x4 acc[3]; float ss[8];
#pragma unroll
        for (int nt = 0; nt < 3; ++nt) acc[nt] = (f32x4){0.f, 0.f, 0.f, 0.f};
#pragma unroll
        for (int r = 0; r < 8; ++r) ss[r] = 0.f;
        f32x4 xv[8];
#pragma unroll
        for (int r = 0; r < 8; ++r) xv[r] = *(const f32x4*)(xr[r] + 4 * lk);
#pragma unroll 1
        for (int ck = 0; ck < 8; ++ck) { const int kc = ck * 128 + 4 * lk;
            const f32x4 gg = *(const f32x4*)(n2g + kc), s1 = *(const f32x4*)(mr + 4096 + kc);
            f32x4 gq; gq[0] = gg[0] * (1.f + s1[0]); gq[1] = gg[1] * (1.f + s1[1]); gq[2] = gg[2] * (1.f + s1[2]); gq[3] = gg[3] * (1.f + s1[3]);
            const float* wb = rw2 + ((size_t)(ck * 8) * 3 * 4 + g) * 64 + li * 4;
            f32x4 bc[3];
#pragma unroll
            for (int nt = 0; nt < 3; ++nt) bc[nt] = *(const f32x4*)(wb + nt * 256);
#pragma unroll
            for (int r = 0; r < 8; ++r) { ss[r] += xv[r][0] * xv[r][0] + xv[r][1] * xv[r][1] + xv[r][2] * xv[r][2] + xv[r][3] * xv[r][3];
#pragma unroll
                for (int e = 0; e < 4; ++e) At[((8 * half + r) * 4 + e) * 36 + lk] = xv[r][e] * gq[e]; }
            if (ck < 7) {
#pragma unroll
                for (int r = 0; r < 8; ++r) xv[r] = *(const f32x4*)(xr[r] + kc + 128); }
            asm volatile("" ::: "memory");
#pragma unroll
            for (int kq = 0; kq < 8; ++kq) { const f32x4 av = *(const LAS f32x4*)(At + (li * 4 + g) * 36 + 4 * kq);
                f32x4 bn[3];
                if (kq < 7) {
#pragma unroll
                    for (int nt = 0; nt < 3; ++nt) bn[nt] = *(const f32x4*)(wb + ((kq + 1) * 3 + nt) * 256); }
#pragma unroll
                for (int nt = 0; nt < 3; ++nt) {
#pragma unroll
                    for (int j = 0; j < 4; ++j) acc[nt] = __builtin_amdgcn_mfma_f32_16x16x4f32(av[j], bc[nt][j], acc[nt], 0, 0, 0); }
                if (kq < 7) {
#pragma unroll
                    for (int nt = 0; nt < 3; ++nt) bc[nt] = bn[nt]; } }
            asm volatile("" ::: "memory");
        }
#pragma unroll
        for (int r = 0; r < 8; ++r) {
#pragma unroll
            for (int mk = 1; mk < 32; mk <<= 1) ss[r] += shfl_xor_f(ss[r], mk);
            ss[r] = rsqrtf(ss[r] * (1.f / 1024.f) + 1e-6f); }
#pragma unroll
        for (int r2 = 0; r2 < 4; ++r2) { float rsA = ss[r2], rsB = ss[4 + r2]; asm volatile("" : "+v"(rsA), "+v"(rsB));
            const float rs = (g & 1) ? rsB : rsA;
#pragma unroll
            for (int nt = 0; nt < 3; ++nt) LGT[(4 * g + r2) * 48 + 16 * nt + li] = acc[nt][r2] * rs + rcl[mrow * 48 + 16 * nt + li]; }
        asm volatile("" ::: "memory");
        if (lane < 16 && !p.dry) {
            const int row = row0 + lane; const LAS float* lg = LGT + lane * 48;
            int grp = 0; float gm = lg[0];
            float gl4[4]; gl4[0] = gm;
#pragma unroll
            for (int i = 1; i < 4; ++i) { gl4[i] = lg[i]; if (gl4[i] > gm) { gm = gl4[i]; grp = i; } }
            float gs = 0.f;
#pragma unroll
            for (int i = 0; i < 4; ++i) gs += __expf(gl4[i] - gm);
            const float pg = frcp(gs);
            int i1 = 0, i2 = -1; float v1 = -3.0e38f, v2 = -3.0e38f;
#pragma unroll
            for (int i = 0; i < 8; ++i) { const float v = lg[4 + grp * 8 + i];
                if (v > v1) { v2 = v1; i2 = i1; v1 = v; i1 = i; } else if (v > v2) { v2 = v; i2 = i; } }
            const float e2 = __expf(v2 - v1), w1 = pg * frcp(1.f + e2), w2 = pg * e2 * frcp(1.f + e2);
            const int ex1 = grp * 8 + i1, ex2 = grp * 8 + i2;
            const unsigned p1 = atomicAdd(&cnt[ex1], 1u), p2 = atomicAdd(&cnt[ex2], 1u);
            PE[2 * row] = ex1; PE[2 * row + 1] = ex2; PPOS[2 * row] = (int)p1; PPOS[2 * row + 1] = (int)p2; PW[2 * row] = w1; PW[2 * row + 1] = w2;
        }
        if (!p.dry && lk == 0) { float* RSR = WSF(p, WS_RSROW);
#pragma unroll
            for (int r = 0; r < 8; ++r) RSR[row0 + 8 * half + r] = ss[r]; }
    }
}
struct MoeTab { LAS int* pad_start; LAS int* blk_e; LAS int* n_used; };
__device__ __forceinline__ MoeTab moe_tab(const Frame& F) { MoeTab t; LAS int* base = (LAS int*)(F.lds + MISC_OFF + 64); t.pad_start = base; t.blk_e = base + 32; t.n_used = base + 32 + MOE_NBLK; return t; }
__device__ __forceinline__ void moe_build_tab(const Params& p, const Frame& F, int l) {
    const MoeTab t = moe_tab(F);
    const unsigned* cnt = (const unsigned*)(p.ws + WS_CTL) + CW_CNT + l * 32;
    __syncthreads();
    if (F.tid == 0) { int acc = 0;
        for (int e = 0; e < 32; ++e) { const int c = (int)__hip_atomic_load(cnt + e, __ATOMIC_RELAXED, __HIP_MEMORY_SCOPE_AGENT), nb = (c + 255) >> 8; t.pad_start[e] = acc * 256;
            for (int k = 0; k < nb; ++k) t.blk_e[acc + k] = e;
            acc += nb; }
        *t.n_used = acc; }
    __syncthreads();
}
__device__ __forceinline__ void p15_scatter(const Params& p, const Frame& F, int l, bool want_ctx) {
    moe_build_tab(p, F, l);
    const MoeTab t = moe_tab(F);
    const int* PE = (const int*)(p.ws + WS_PAIR); const int* PPOS = PE + NPAIR_MAX; int* PD = (int*)(p.ws + WS_PAIR) + 3 * NPAIR_MAX;
    const float* RSR = WSF(p, WS_RSROW); bf16_t* BUF = WSB(p, WS_BUF);
    const float* mod = WSF(p, WS_MOD) + (size_t)l * 9 * 6144; const float* n2g = p.in[I_N2G] + (size_t)l * 1024;
    const int lane = F.lane;
    for (int row = F.gwave; row < T; row += F.nwave) {
        const int b = row / NP, q = row - b * NP; const bool isctx = q < NCTX;
        if (isctx && !want_ctx) continue;
        const float* mr = mod + (size_t)(isctx ? 8 : b) * 6144; const float* x = xrow(p, row);
        const float rs = RSR[row];
        const int d0 = t.pad_start[PE[2 * row]] + PPOS[2 * row], d1 = t.pad_start[PE[2 * row + 1]] + PPOS[2 * row + 1];
        if (lane == 0) { PD[2 * row] = d0; PD[2 * row + 1] = d1; }
        f32x4 xv[4];
#pragma unroll
        for (int j = 0; j < 4; ++j) xv[j] = *(const f32x4*)(x + j * 256 + lane * 4);
#pragma unroll
        for (int j = 0; j < 4; ++j) { const int c = j * 256 + lane * 4;
            const f32x4 gg = *(const f32x4*)(n2g + c), s1 = *(const f32x4*)(mr + 4096 + c), s0 = *(const f32x4*)(mr + 3072 + c); float y[4];
#pragma unroll
            for (int e = 0; e < 4; ++e) y[e] = xv[j][e] * rs * gg[e] * (1.f + s1[e]) + s0[e];
            u32x2 w; w.x = pk2(y[0], y[1]); w.y = pk2(y[2], y[3]);
            *(u32x2*)(BUF + (size_t)d0 * 1024 + c) = w; *(u32x2*)(BUF + (size_t)d1 * 1024 + c) = w; }
    }
}
__device__ __forceinline__ void p18_combine(const Params& p, const Frame& F, int l, bool want_ctx) {
    const int* PD = (const int*)(p.ws + WS_PAIR) + 3 * NPAIR_MAX; const float* PW = (const float*)(p.ws + WS_PAIR) + 2 * NPAIR_MAX;
    const bf16_t* YB = WSB(p, WS_YB);
    const float* mod = WSF(p, WS_MOD) + (size_t)l * 9 * 6144;
    const float* modn = mod + 9 * 6144;
    const float* n1g = p.in[I_N1G] + (size_t)(l + 1) * 1024;
    bf16_t* H = WSB(p, WS_H);
    const bool donorm = (l + 1 < DEPTH);
    const int lane = F.lane;
    for (int row = F.gwave; row < T; row += F.nwave) {
        const int b = row / NP, q = row - b * NP; const bool isctx = q < NCTX;
        if (isctx && !want_ctx) continue;
        const int mrow = isctx ? 8 : b;
        const float* g2 = mod + (size_t)mrow * 6144 + 5120;
        const int d0 = PD[2 * row], d1 = PD[2 * row + 1]; const float w0 = PW[2 * row], w1 = PW[2 * row + 1];
        float* x = xrow(p, row);
        f32x4 xv[4]; float ss = 0.f;
#pragma unroll
        for (int j = 0; j < 2; ++j) { const int c = j * 512 + lane * 8;
            float ya[8], yb[8]; unpack8(*(const u32x4*)(YB + (size_t)d0 * 1024 + c), ya); unpack8(*(const u32x4*)(YB + (size_t)d1 * 1024 + c), yb);
            f32x4 x0 = *(const f32x4*)(x + c), x1 = *(const f32x4*)(x + c + 4); const f32x4 ga = *(const f32x4*)(g2 + c), gb = *(const f32x4*)(g2 + c + 4);
#pragma unroll
            for (int e = 0; e < 4; ++e) { x0[e] += ga[e] * (w0 * ya[e] + w1 * yb[e]); x1[e] += gb[e] * (w0 * ya[4 + e] + w1 * yb[4 + e]); ss += x0[e] * x0[e] + x1[e] * x1[e]; }
            if (!p.dry) { *(f32x4*)(x + c) = x0; *(f32x4*)(x + c + 4) = x1; }
            xv[2 * j] = x0; xv[2 * j + 1] = x1; }
        if (donorm) {
#pragma unroll
            for (int m = 1; m < 64; m <<= 1) ss += shfl_xor_f(ss, m);
            const float rs = rsqrtf(ss * (1.f / 1024.f) + 1e-6f);
            const float* mr = modn + (size_t)mrow * 6144;
#pragma unroll
            for (int j = 0; j < 2; ++j) { const int c = j * 512 + lane * 8; float y[8];
#pragma unroll
                for (int hf = 0; hf < 2; ++hf) { const f32x4 gg = *(const f32x4*)(n1g + c + 4 * hf), s1 = *(const f32x4*)(mr + 1024 + c + 4 * hf), s0 = *(const f32x4*)(mr + c + 4 * hf);
#pragma unroll
                    for (int e = 0; e < 4; ++e) y[4 * hf + e] = xv[2 * j + hf][e] * rs * gg[e] * (1.f + s1[e]) + s0[e]; }
                if (!p.dry) *(u32x4*)(H + (size_t)row * 1024 + c) = pack8(y); } }
    }
}
constexpr size_t WS_REC = WS_WU; constexpr int REC_BYTES = 15360, RC_BYTES = 1792;
static_assert(WS_LW == WS_WU + (size_t)T * 1792 * 2 && WS_LA == WS_LW + (size_t)T * 1024 * 2 && WS_LG == WS_LA + (size_t)T * 1024 * 2, "WU|LW|LA contiguous");
static_assert(WS_REC + (size_t)NB * 8 * (NP / 16) * REC_BYTES <= WS_LG, "chunk records fit");
constexpr size_t WS_YCAT = WS_WU;
constexpr size_t WS_YS2 = WS_H;
constexpr int NCHUNK = NP / 16;
__device__ __forceinline__ int scan_pos(int s, int dir) { return dir ? (s < NCTX ? NCTX - 1 - s : NP + NCTX - 1 - s) : s; }
constexpr size_t WS_REC2 = WS_W1;
constexpr size_t WS_VS2 = AL(WS_REC2 + (size_t)NB * 8 * (NP / 16) * REC_BYTES);
constexpr size_t WS_BON = AL(WS_VS2 + SZ512);
static_assert(WS_BON + (size_t)2 * T * 8 * 4 <= WS_END_MIX, "records + V' + bonus fit in the W1 region");
struct BuildRaw { u32x4 wu[3][2], halo[3], lw[2], la[2]; };
template <int DIR> __device__ __forceinline__ void build_load(BuildRaw& R, const Params& p, int ch, int lane) {
    const bf16_t* WU = WSB(p, WS_WU); const bf16_t* LWg = WSB(p, WS_LW); const bf16_t* LAg = WSB(p, WS_LA);
    const int bh = ch / NCHUNK, tb = ch - bh * NCHUNK, b = bh >> 3, h = bh & 7;
    const int q0 = 16 * tb; const size_t row0 = (size_t)b * NP + q0;
    const int lt = lane >> 2, lc = (lane & 3) * 16;
    const bool hasp = (q0 != 0) && (q0 != NCTX), hasn = (q0 + 16 != NCTX) && (q0 + 16 != NP);
#pragma unroll
    for (int part = 0; part < 3; ++part) { const bf16_t* src = WU + (row0 + lt) * 1792 + part * 512 + h * 64 + lc;
        R.wu[part][0] = *(const u32x4*)src; R.wu[part][1] = *(const u32x4*)(src + 8);
        u32x4 hv; hv.x = hv.y = hv.z = hv.w = 0u;
        if (lane < 16) { const bool nx = lane >= 8; const bool ok = nx ? hasn : hasp;
            if (ok) hv = *(const u32x4*)(WU + (nx ? row0 + 16 : row0 - 1) * 1792 + part * 512 + h * 64 + (lane & 7) * 8); }
        R.halo[part] = hv; }
    const bf16_t* s1p = LWg + (row0 + lt) * 1024 + DIR * 512 + h * 64 + lc; const bf16_t* s2p = LAg + (row0 + lt) * 1024 + DIR * 512 + h * 64 + lc;
    R.lw[0] = *(const u32x4*)s1p; R.lw[1] = *(const u32x4*)(s1p + 8); R.la[0] = *(const u32x4*)s2p; R.la[1] = *(const u32x4*)(s2p + 8);
}
template <int DIR> __device__ __forceinline__ void p6c_rwkv_build(const Params& p, const Frame& F, int l) {
    constexpr int dir = DIR;
    unsigned char* REC = p.ws + WS_REC2; bf16_t* VSo = WSB(p, WS_VS2); float* BON = WSF(p, WS_BON) + (size_t)dir * T * 8;
    constexpr int TP_ = 144;
    BuildRaw cur, nxt;
    if (F.gwave < NB * 8 * NCHUNK) build_load<DIR>(cur, p, F.gwave, F.lane);
    for (int ch = F.gwave; ch < NB * 8 * NCHUNK; ch += F.nwave) {
        int lane = F.lane; asm volatile("" : "+v"(lane));
        const int g = lane >> 4, li = lane & 15;
        LAS unsigned char* wl = F.lds + F.wave * 17408;
        LAS unsigned char* Ta = wl; LAS unsigned char* Tr = wl + 2304; LAS unsigned char* Tb = wl + 4608; LAS unsigned char* Tk = wl + 6912;
        LAS float* M = (LAS float*)wl;
        LAS unsigned char* Sv = wl + 9216;
        const int pj = (lane & 32) + ((lane & 15) >> 2) * 8 + ((lane >> 4) & 1) * 4 + (lane & 3);
        const int bh = ch / NCHUNK, tb = ch - bh * NCHUNK, b = bh >> 3, h = bh & 7;
        const int q0 = 16 * tb; const size_t row0 = (size_t)b * NP + q0;
        const int cidx = dir ? (tb < 16 ? 15 - tb : 287 - tb) : tb;
        const int lt = lane >> 2, lc = (lane & 3) * 16;
#pragma unroll
        for (int part = 0; part < 3; ++part) {
            *(LAS u32x4*)(wl + part * 2304 + (lt + 1) * 128 + lc * 2) = cur.wu[part][0]; *(LAS u32x4*)(wl + part * 2304 + (lt + 1) * 128 + lc * 2 + 16) = cur.wu[part][1];
            if (lane < 16) *(LAS u32x4*)(wl + part * 2304 + (lane >= 8 ? 17 * 128 : 0) + (lane & 7) * 16) = cur.halo[part]; }
        const int cc = h * 64 + lane;
        float rr[16], kx[16], vx[16], kn[16];
        { const float* mu0 = p.in[I_MU] + (size_t)l * 2 * 1792, *mu1 = mu0 + 1792;
          const float kkc = p.in[I_KK][l * 512 + cc];
#pragma unroll
          for (int part = 0; part < 3; ++part) { const float m0 = mu0[part * 512 + cc], m1 = mu1[part * 512 + cc];
              float raw[18];
#pragma unroll
              for (int t = 0; t < 18; ++t) raw[t] = bf2f(*(const LAS bf16_t*)(wl + part * 2304 + t * 128 + lane * 2));
#pragma unroll
              for (int t = 0; t < 16; ++t) { const float u = raw[t + 1], sh = u + (raw[t] - u) * m0 + (raw[t + 2] - u) * m1;
                  if (part == 0) rr[t] = sh; else if (part == 1) kx[t] = sh; else vx[t] = sh; } }
          float s0[8], s1[8];
#pragma unroll
          for (int t = 0; t < 8; ++t) { kn[t] = kx[t] * kkc; kn[t + 8] = kx[t + 8] * kkc; s0[t] = kn[t] * kn[t]; s1[t] = kn[t + 8] * kn[t + 8]; }
          const float t0 = reduce8(s0, lane), t1 = reduce8(s1, lane);
#pragma unroll
          for (int t = 0; t < 8; ++t) { kn[t] *= rsqrtf(fmaxf(__shfl(t0, t * 8, 64), 1e-12f)); kn[t + 8] *= rsqrtf(fmaxf(__shfl(t1, t * 8, 64), 1e-12f)); }
          asm volatile("" ::: "memory");
          if (dir == 0) {
#pragma unroll
              for (int t = 0; t < 16; ++t) *(LAS bf16_t*)(Sv + t * 128 + lane * 2) = (bf16_t)f2bf(vx[t]);
              asm volatile("" ::: "memory");
              bf16_t* vo = VSo + (row0 + lt) * 512 + h * 64 + lc; *(u32x4*)vo = *(const LAS u32x4*)(Sv + lt * 128 + lc * 2); *(u32x4*)(vo + 8) = *(const LAS u32x4*)(Sv + lt * 128 + lc * 2 + 16); }
          *(LAS u32x4*)(wl + lt * 128 + lc * 2) = cur.lw[0]; *(LAS u32x4*)(wl + lt * 128 + lc * 2 + 16) = cur.lw[1];
          *(LAS u32x4*)(wl + 2048 + lt * 128 + lc * 2) = cur.la[0]; *(LAS u32x4*)(wl + 2048 + lt * 128 + lc * 2 + 16) = cur.la[1]; }
        { const int chn = ch + F.nwave; if (chn < NB * 8 * NCHUNK) build_load<DIR>(nxt, p, chn, lane); else nxt = cur; }
        float X[16], Q[16], v[16], bhh[16], khh[16]; float Lc = 0.f;
        { const float w0c = p.in[I_W0][((size_t)l * 2 + dir) * 512 + cc], a0c = p.in[I_A0][((size_t)l * 2 + dir) * 512 + cc], kac = p.in[I_KA][l * 512 + cc], rkc = p.in[I_RK][l * 512 + cc];
          float bs0[8], bs1[8];
#pragma unroll
          for (int t = 0; t < 16; ++t) {
              constexpr int dummy_ = 0; (void)dummy_;
              const int tt = dir ? 15 - t : t; const int o = tt * 128 + lane * 2;
              const float lwv = bf2f(*(const LAS bf16_t*)(wl + o)), lav = bf2f(*(const LAS bf16_t*)(wl + 2048 + o));
              const float r = rr[tt], kp = kx[tt], kkn = kn[tt]; v[t] = vx[tt];
              const float asig = sigmoidf_(a0c + lav), lw = -0.6065306597126334f * sigmoidf_(w0c + lwv);
              const float k = kp * (1.f + (asig - 1.f) * kac), bb = kkn * asig, a = -kkn;
              if (t < 8) bs0[t] = r * k * rkc; else bs1[t - 8] = r * k * rkc;
              const float Lx = Lc; Lc += lw;
              const float at = a * __expf(Lx), rt = r * __expf(Lc), en = __expf(-Lc);
              X[t] = at; Q[t] = rt; bhh[t] = bb * en; khh[t] = k * en;
          }
          const float u0 = reduce8(bs0, lane), u1 = reduce8(bs1, lane);
          if ((lane & 7) == 0) { const int t = lane >> 3; const int tk0 = dir ? 15 - t : t, tk1 = dir ? 7 - t : 8 + t; BON[(row0 + tk0) * 8 + h] = u0; BON[(row0 + tk1) * 8 + h] = u1; } }
        asm volatile("" ::: "memory");
#pragma unroll
        for (int t = 0; t < 16; ++t) {
            *(LAS bf16_t*)(Ta + t * TP_ + lane * 2) = (bf16_t)f2bf(X[t]); *(LAS bf16_t*)(Tr + t * TP_ + lane * 2) = (bf16_t)f2bf(Q[t]);
            *(LAS bf16_t*)(Tb + t * TP_ + lane * 2) = (bf16_t)f2bf(bhh[t]); *(LAS bf16_t*)(Tk + t * TP_ + lane * 2) = (bf16_t)f2bf(khh[t]);
        }
        const float gC = __expf(Lc);
#pragma unroll
        for (int t = 0; t < 16; ++t) { bhh[t] *= gC; khh[t] *= gC; }
        unsigned char* rec = REC + ((size_t)bh * NCHUNK + cidx) * REC_BYTES;
#pragma unroll
        for (int q4 = 0; q4 < 4; ++q4) *(float*)(rec + 8192 + q4 * RC_BYTES + 1536 + lane * 4) = gC;
#pragma unroll
        for (int gg = 0; gg < 4; ++gg) { u32x4 w; w.x = pk2(bhh[4 * gg], bhh[4 * gg + 1]); w.y = pk2(bhh[4 * gg + 2], bhh[4 * gg + 3]); w.z = pk2(khh[4 * gg], khh[4 * gg + 1]); w.w = pk2(khh[4 * gg + 2], khh[4 * gg + 3]);
            *(u32x4*)(rec + 4096 + (lane * 32 + gg * 8) * 2) = w; }
        f32x4 mab = {0.f, 0.f, 0.f, 0.f}, mak = mab, mrb = mab, mrk = mab;
#pragma unroll
        for (int ks = 0; ks < 2; ++ks) { const int o = li * TP_ + (32 * ks + 8 * g) * 2;
            const bf16x8 fa = ld_frag(Ta + o), fr = ld_frag(Tr + o), fb = ld_frag(Tb + o), fk = ld_frag(Tk + o);
            mab = MFMA16(fa, fb, mab); mak = MFMA16(fa, fk, mak); mrb = MFMA16(fr, fb, mrb); mrk = MFMA16(fr, fk, mrk); }
        asm volatile("" ::: "memory");
#pragma unroll
        for (int r = 0; r < 4; ++r) { const int t = 4 * g + r;
            M[t * 16 + li] = li < t ? mab[r] : 0.f; M[256 + t * 16 + li] = li < t ? mak[r] : 0.f;
            M[512 + t * 16 + li] = li <= t ? mrb[r] : 0.f; M[768 + t * 16 + li] = li <= t ? mrk[r] : 0.f; }
        f32x2 XU[16]; float Y0[16];
        XU[0] = (f32x2){X[0], 0.f};
#pragma unroll
        for (int t = 1; t < 16; ++t) { f32x2 xu = {X[t], 0.f}; float u2 = 0.f;
#pragma unroll
            for (int s4 = 0; s4 < 4; ++s4) { if (4 * s4 < t) { const f32x4 ab = *(const LAS f32x4*)(M + t * 16 + 4 * s4), ak = *(const LAS f32x4*)(M + 256 + t * 16 + 4 * s4);
#pragma unroll
                for (int e = 0; e < 4; ++e) { const int s = 4 * s4 + e; if (s < t) { xu = xu + XU[s] * ab[e]; u2 += ak[e] * v[s]; } } } }
            xu.y += u2;
            asm volatile("" : "+v"(xu) :: "memory");
            XU[t] = xu; }
#pragma unroll
        for (int t = 0; t < 16; ++t) { f32x2 qy = {Q[t], 0.f}; float y2 = 0.f;
#pragma unroll
            for (int s4 = 0; s4 < 4; ++s4) { if (4 * s4 <= t) { const f32x4 rb = *(const LAS f32x4*)(M + 512 + t * 16 + 4 * s4), rk = *(const LAS f32x4*)(M + 768 + t * 16 + 4 * s4);
#pragma unroll
                for (int e = 0; e < 4; ++e) { const int s = 4 * s4 + e; if (s <= t) { qy = qy + XU[s] * rb[e]; y2 += rk[e] * v[s]; } } } }
            qy.y += y2;
            asm volatile("" : "+v"(qy) :: "memory");
            Q[t] = qy.x; Y0[t] = qy.y; }
        float U0[16];
#pragma unroll
        for (int t = 0; t < 16; ++t) { X[t] = XU[t].x; U0[t] = XU[t].y; }
        asm volatile("" ::: "memory");
#pragma unroll
        for (int t = 0; t < 16; ++t) { *(LAS bf16_t*)(wl + 4096 + (t * 64 + pj) * 2) = (bf16_t)f2bf(X[t]); *(LAS bf16_t*)(wl + 6144 + (t * 64 + pj) * 2) = (bf16_t)f2bf(Q[t]); }
        asm volatile("" ::: "memory");
#pragma unroll
        for (int k = 0; k < 4; ++k) *(u32x4*)(rec + k * 1024 + lane * 16) = *(const LAS u32x4*)(wl + 4096 + k * 1024 + lane * 16);
        unsigned char* rc = rec + 8192 + g * RC_BYTES + li * 32;
#pragma unroll
        for (int hf = 0; hf < 2; ++hf) { u32x4 w;
            w.x = pk2(v[8 * hf], v[8 * hf + 1]); w.y = pk2(v[8 * hf + 2], v[8 * hf + 3]); w.z = pk2(v[8 * hf + 4], v[8 * hf + 5]); w.w = pk2(v[8 * hf + 6], v[8 * hf + 7]); *(u32x4*)(rc + hf * 16) = w;
            w.x = pk2(U0[8 * hf], U0[8 * hf + 1]); w.y = pk2(U0[8 * hf + 2], U0[8 * hf + 3]); w.z = pk2(U0[8 * hf + 4], U0[8 * hf + 5]); w.w = pk2(U0[8 * hf + 6], U0[8 * hf + 7]); *(u32x4*)(rc + 512 + hf * 16) = w;
            w.x = pk2(Y0[8 * hf], Y0[8 * hf + 1]); w.y = pk2(Y0[8 * hf + 2], Y0[8 * hf + 3]); w.z = pk2(Y0[8 * hf + 4], Y0[8 * hf + 5]); w.w = pk2(Y0[8 * hf + 6], Y0[8 * hf + 7]); *(u32x4*)(rc + 1024 + hf * 16) = w; }
        cur = nxt;
    }
}
constexpr int SC_SLOT = 10240, SC_NSLOT = 13, SC_DEPTH = 6;
__device__ __forceinline__ void scan_dma(const unsigned char* rec, int iq, LAS unsigned char* slot, int lane) {
    const unsigned char* g0 = rec + lane * 16;
#pragma unroll
    for (int k = 0; k < 8; ++k) __builtin_amdgcn_global_load_lds((const unsigned*)(g0 + k * 1024), (LAS unsigned*)(slot + k * 1024), 16, 0, 0);
    const unsigned char* g1 = rec + 8192 + iq * RC_BYTES + lane * 16;
    __builtin_amdgcn_global_load_lds((const unsigned*)g1, (LAS unsigned*)(slot + 8192), 16, 0, 0);
    if (lane < 48) __builtin_amdgcn_global_load_lds((const unsigned*)(g1 + 1024), (LAS unsigned*)(slot + 9216), 16, 0, 0);
}
__device__ __forceinline__ unsigned lds_ld(volatile LAS unsigned* q) { return *q; }
__device__ __forceinline__ void p6b_rwkv_scan(const Params& p, const Frame& F, int dir) {
    volatile LAS unsigned* ctl = (volatile LAS unsigned*)(F.lds + MISC_OFF + 1536);
    if (F.tid < 3) ctl[F.tid] = 0u;
    __syncthreads();
    if (F.wave > 2) return;
    const int lane = F.lane, g = lane >> 4, li = lane & 15;
    const int task = (F.G == 256) ? (F.bid & 7) * 32 + (F.bid >> 3) : F.bid;
    if (task >= NB * 8 * 4) return;
    const int bh = task >> 2, iq = task & 3, b = bh >> 3, h = bh & 7;
    const unsigned char* rec0 = p.ws + WS_REC2 + (size_t)bh * NCHUNK * REC_BYTES;
    if (F.wave != 0) {
        const int hh = F.wave - 1;
        if (p.dry == 1) return;
        asm volatile("s_waitcnt vmcnt(0)" ::: "memory");
#pragma unroll 1
        for (int n = 0; n < NCHUNK / 2; ++n) { const int k = 2 * n + hh;
            while ((int)lds_ld(ctl + 2) + SC_NSLOT <= k) __builtin_amdgcn_s_sleep(1);
            scan_dma(rec0 + (size_t)k * REC_BYTES, iq, F.lds + (k % SC_NSLOT) * SC_SLOT, lane);
            if (n >= 5) { asm volatile("s_waitcnt vmcnt(50)" ::: "memory"); if (lane == 0) ctl[hh] = (unsigned)(n - 4); } }
        asm volatile("s_waitcnt vmcnt(0)" ::: "memory");
        if (lane == 0) ctl[hh] = (unsigned)(NCHUNK / 2);
        return;
    }
    bf16_t* YS = WSB(p, WS_YS2) + (size_t)dir * T * 512;
    f32x4 st[4];
#pragma unroll
    for (int jt = 0; jt < 4; ++jt) st[jt] = (f32x4){0.f, 0.f, 0.f, 0.f};
    struct Ops { bf16x8 ah[2], qq[2], bk[4]; f32x4 gc[4]; u32x2 vt, u0, y0; };
#define SCAN_WAIT(c_) do { const unsigned need_ = (unsigned)((c_) >> 1) + 1u; volatile LAS unsigned* lw_ = ctl + ((c_) & 1); while (lds_ld(lw_) < need_) __builtin_amdgcn_s_sleep(1); asm volatile("" ::: "memory"); } while (0)
#define SCAN_WAIT2(c_) do { const unsigned n1_ = (unsigned)((c_) >> 1) + 1u, n0_ = ((c_) + 2 < NCHUNK) ? (unsigned)((c_) >> 1) + 2u : 0u; \
        for (;;) { const u32x2 fl_ = *(volatile LAS u32x2*)ctl; if (fl_.x >= n0_ && fl_.y >= n1_) break; __builtin_amdgcn_s_sleep(1); } asm volatile("" ::: "memory"); } while (0)
#define SCAN_LOAD(o_, c_) do { const LAS unsigned char* sl_ = F.lds + ((c_) % SC_NSLOT) * SC_SLOT; \
        _Pragma("unroll") for (int ks = 0; ks < 2; ++ks) { o_.ah[ks] = ld_frag(sl_ + (li * 64 + ks * 32 + g * 8) * 2); o_.qq[ks] = ld_frag(sl_ + 2048 + (li * 64 + ks * 32 + g * 8) * 2); } \
        _Pragma("unroll") for (int jt = 0; jt < 4; ++jt) { o_.bk[jt] = ld_frag(sl_ + 4096 + ((16 * jt + li) * 32 + g * 8) * 2); o_.gc[jt] = *(const LAS f32x4*)(sl_ + 8192 + 1536 + (16 * jt + 4 * g) * 4); } \
        o_.vt = *(const LAS u32x2*)(sl_ + 8192 + (li * 16 + 4 * g) * 2); o_.u0 = *(const LAS u32x2*)(sl_ + 8192 + 512 + (li * 16 + 4 * g) * 2); o_.y0 = *(const LAS u32x2*)(sl_ + 8192 + 1024 + (li * 16 + 4 * g) * 2); } while (0)
    const int pmode = p.dry;
    if (pmode == 2) { for (int c = 0; c < NCHUNK; ++c) { SCAN_WAIT(c); if (lane == 0) ctl[2] = (unsigned)(c + 1); } return; }
    Ops o0, o1;
    if (pmode != 1) SCAN_WAIT(0);
    SCAN_LOAD(o0, 0);
    const int rstep = dir ? -512 : 512;
#define SCAN_YPTR(c_) (YS + ((size_t)(b * NP + scan_pos(16 * (c_) + 4 * g, dir))) * 512 + h * 64 + 16 * iq + li)
#define SCAN_STEP(cur_, nxt_, c_) do { \
        const bf16x8 sb0 = pack_frag(st[0], st[1]), sb1 = pack_frag(st[2], st[3]); \
        f32x4 U = {lo16(cur_.u0.x), hi16(cur_.u0.x), lo16(cur_.u0.y), hi16(cur_.u0.y)}, Y = {lo16(cur_.y0.x), hi16(cur_.y0.x), lo16(cur_.y0.y), hi16(cur_.y0.y)}; \
        U = MFMA16(cur_.ah[0], sb0, U); Y = MFMA16(cur_.qq[0], sb0, Y); U = MFMA16(cur_.ah[1], sb1, U); Y = MFMA16(cur_.qq[1], sb1, Y); \
        asm volatile("" ::: "memory"); \
        if ((c_) + 1 < NCHUNK) { if (pmode != 1 && ((c_) & 1) == 0) SCAN_WAIT2(c_); SCAN_LOAD(nxt_, (c_) + 1); } \
        asm volatile("" ::: "memory"); \
        u32x4 uvw; uvw.x = pk2(U[0], U[1]); uvw.y = pk2(U[2], U[3]); uvw.z = cur_.vt.x; uvw.w = cur_.vt.y; \
        const bf16x8 uv = __builtin_bit_cast(bf16x8, uvw); \
        _Pragma("unroll") for (int jt = 0; jt < 4; ++jt) st[jt] = MFMA16(cur_.bk[jt], uv, st[jt] * cur_.gc[jt]); \
        if (pmode == 0) { bf16_t* yp = SCAN_YPTR(c_); _Pragma("unroll") for (int r = 0; r < 4; ++r) yp[r * rstep] = (bf16_t)f2bf(Y[r]); } \
        else if (Y[0] == 1.2345f) YS[0] = 0; \
        asm volatile("s_waitcnt lgkmcnt(0)" ::: "memory"); \
        if (lane == 0) ctl[2] = (unsigned)((c_) + 2); } while (0)
#pragma unroll 1
    for (int c = 0; c < NCHUNK; c += 2) { SCAN_STEP(o0, o1, c); SCAN_STEP(o1, o0, c + 1); }
#undef SCAN_STEP
#undef SCAN_YPTR
#undef SCAN_WAIT
#undef SCAN_WAIT2
#undef SCAN_LOAD
}

__device__ __forceinline__ void p7_rwkv_readout(const Params& p, const Frame& F, int l) {
    const bf16_t* VS = WSB(p, WS_VS2); const float* BON0 = WSF(p, WS_BON); const float* BON1 = BON0 + (size_t)T * 8;
    const bf16_t* YS0 = WSB(p, WS_H); const bf16_t* YS1 = YS0 + (size_t)T * 512;
    const bf16_t* LG = WSB(p, WS_LG); bf16_t* YW = WSB(p, WS_WU) + 1024;
    const int lane = F.lane, c0 = lane * 8;
    const float* ln_g = p.in[I_LNG] + l * 512, *ln_b = p.in[I_LNB] + l * 512;
    for (int row = F.gwave; row < T; row += F.nwave) {
        const size_t off = (size_t)row * 512 + c0;
        float y0[8], y1[8], v[8], g[8];
        unpack8(*(const u32x4*)(YS0 + off), y0); unpack8(*(const u32x4*)(YS1 + off), y1); unpack8(*(const u32x4*)(VS + off), v); unpack8(*(const u32x4*)(LG + off), g);
        const float bs = BON0[(size_t)row * 8 + (lane >> 3)] + BON1[(size_t)row * 8 + (lane >> 3)];
        float y[8], sm = 0.f;
#pragma unroll
        for (int e = 0; e < 8; ++e) { y[e] = y0[e] + y1[e]; sm += y[e]; }
        sm += shfl_xor_f(sm, 1); sm += shfl_xor_f(sm, 2); sm += shfl_xor_f(sm, 4);
        const float mean = sm * (1.f / 64.f); float vs = 0.f;
#pragma unroll
        for (int e = 0; e < 8; ++e) { const float d = y[e] - mean; vs += d * d; }
        vs += shfl_xor_f(vs, 1); vs += shfl_xor_f(vs, 2); vs += shfl_xor_f(vs, 4);
        const float rstd = rsqrtf(vs * (1.f / 64.f) + 64e-5f);
        float lg8[8], lb8[8]; *(f32x4*)lg8 = *(const f32x4*)(ln_g + c0); *(f32x4*)(lg8 + 4) = *(const f32x4*)(ln_g + c0 + 4); *(f32x4*)lb8 = *(const f32x4*)(ln_b + c0); *(f32x4*)(lb8 + 4) = *(const f32x4*)(ln_b + c0 + 4);
        float o[8];
#pragma unroll
        for (int e = 0; e < 8; ++e) o[e] = ((y[e] - mean) * rstd * lg8[e] + lb8[e] + bs * v[e]) * g[e];
        *(u32x4*)(YW + (size_t)row * 1536 + c0) = pack8(o);
    }
}
constexpr int NPHASE = 21;
constexpr int PARAMS_OFF = MISC_OFF + 2048;
__device__ __forceinline__ unsigned rfl(unsigned v) { return (unsigned)__builtin_amdgcn_readfirstlane((int)v); }
template <class Tp> __device__ __forceinline__ Tp* rfl_ptr(Tp* q) { const unsigned long long a = (unsigned long long)q; const unsigned lo = rfl((unsigned)a), hi = rfl((unsigned)(a >> 32)); return (Tp*)(((unsigned long long)hi << 32) | lo); }
__device__ __forceinline__ float rfl_f(float v) { return __builtin_bit_cast(float, rfl(__builtin_bit_cast(unsigned, v))); }
__device__ __forceinline__ Params load_params(LAS unsigned char* lds) {
    unsigned off = PARAMS_OFF; asm volatile("" : "+s"(off) :: "memory");
    const LAS Params* lp = (const LAS Params*)(lds + off);
    Params q;
#pragma unroll
    for (int i = 0; i < 33; ++i) q.in[i] = rfl_ptr(lp->in[i]);
    q.out = rfl_ptr(lp->out); q.ws = rfl_ptr(lp->ws);
#pragma unroll
    for (int i = 0; i < 16; ++i) q.invA[i] = rfl_f(lp->invA[i]);
#pragma unroll
    for (int i = 0; i < 32; ++i) q.invR[i] = rfl_f(lp->invR[i]);
    q.ph_lo = 0; q.ph_hi = 0; q.l_lo = 0; q.l_hi = 0; q.fused = 0; q.do_pro = 0; q.dry = (int)rfl((unsigned)lp->dry); q.pad2 = 0;
    return q;
}
__device__ __forceinline__ unsigned char* load_ws(LAS unsigned char* lds) {
    unsigned off = PARAMS_OFF; asm volatile("" : "+s"(off) :: "memory");
    const LAS Params* lp = (const LAS Params*)(lds + off);
    return rfl_ptr(lp->ws);
}
__device__ __forceinline__ Frame make_frame(LAS unsigned char* lds) {
    Frame F; int tid = threadIdx.x; asm volatile("" : "+v"(tid));
    int bid = blockIdx.x, G = gridDim.x; asm volatile("" : "+s"(bid), "+s"(G));
    F.lds = lds; F.tid = tid; F.lane = tid & 63; F.wave = __builtin_amdgcn_readfirstlane(tid >> 6);
    F.G = G; F.bid = bid; F.gwave = bid * NWAVES + F.wave; F.nwave = G * NWAVES;
    return F;
}
#define SEAM() do { if (fused) { XcdBarrier bar_; bar_.bar = (unsigned*)(load_ws(lds0) + WS_CTL) + CW_BAR; bar_.x = xb_xcc_id(); bar_.st = misc; xcd_barrier(bar_); } } while (0)
#ifndef MK_PHASES
#define MK_PHASES 0xFFFFFFFFu
#endif
#define IN(k) (((MK_PHASES >> (k)) & 1u) && ph_lo <= (k) && (k) < ph_hi)
#define EN(k) ((MK_PHASES >> (k)) & 1u)
#define LP() const Frame F = make_frame(lds0); const Params p = load_params(lds0)

__device__ __forceinline__ void layer_program(LAS unsigned char* const lds0, volatile LAS unsigned* misc, const int l, const int ph_lo, const int ph_hi, const int fused) {
        const bool want_ctx = l < DEPTH - 1;
        if (IN(0) && l == 0) { LP(); p1_cvt_norm1(p, F, l); SEAM(); }
        if (IN(1)) { LP();
            pg8::Gemm g{WSB(p, WS_H), WSB(p, WS_BTIN), T, 7680, 1024}; pg8::StaticOrder S; S.init(T, 7680, F.G, F.bid);
            pg8::EpiInproj E{p.ws};
            pg8::gemm_phase<pg8::EpiInproj, pg8::StaticOrder, PG8_ALIGN, PG8_SP2>(F.lds, g, S, E);
            SEAM(); }
        if (IN(2)) { LP(); p3_prep(p, F, l); SEAM(); }
        if (IN(3)) { LP();
            pg8::Gemm g{WSB(p, WS_H), WSB(p, WS_BTLORA), T, 2560, 256}; pg8::StaticOrder S; S.init(T, 2560, F.G, F.bid);
            pg8::EpiLora E{p.ws};
            pg8::gemm_phase<pg8::EpiLora, pg8::StaticOrder, PG8_ALIGN, PG8_SP2>(F.lds, g, S, E);
            SEAM(); }
        if (IN(5)) { LP(); p6c_rwkv_build<0>(p, F, l); SEAM(); }
        if (IN(6)) { LP(); p6b_rwkv_scan(p, F, 0); SEAM(); }
        if (IN(7)) { LP(); p6c_rwkv_build<1>(p, F, l); SEAM(); }
        if (IN(8)) { LP(); p6b_rwkv_scan(p, F, 1); SEAM(); }
        if (IN(9)) { LP(); p7_rwkv_readout(p, F, l); }
        if (IN(10)) { LP(); p8_ret_kv(p, F, l); SEAM(); }
        if (IN(11)) { LP(); p9_ret_scan(p, F, l); SEAM(); }
        if (IN(12)) { LP(); p10_ret_out(p, F, l, want_ctx); }
        if (IN(13)) { LP(); p11_attention(p, F, want_ctx); SEAM(); }
        if (IN(14)) { LP();
            pg8::Gemm g{WSB(p, WS_YCAT), WSB(p, WS_BTBR), T, 1024, 1536};
            pg8::EpiMergeK E{WSB(p, WS_GL), WSB(p, WS_H)};
            if (want_ctx) { pg8::StaticOrder S; S.init(T, 1024, F.G, F.bid); pg8::gemm_phase<pg8::EpiMergeK, pg8::StaticOrder, PG8_ALIGN, PG8_SP2>(F.lds, g, S, E); }
            else { pg8::LatentOrder S; S.init(1024, F.G, F.bid); pg8::gemm_phase<pg8::EpiMergeK, pg8::LatentOrder, PG8_ALIGN, PG8_SP2>(F.lds, g, S, E); }
            __syncthreads();
            cvt_run<true>(p, F, l, (LAS float*)F.lds, (want_ctx && F.G == 256) ? 32 : 0);
            SEAM(); }
        if (IN(15)) { LP();
            pg8::Gemm g{WSB(p, WS_H), WSB(p, WS_BTOUT), T, 1024, 1024};
            pg8::EpiOut E{p.out, WSF(p, WS_CTXRES), WSF(p, WS_MOD) + (size_t)l * 9 * 6144, p.dry, l == 0 ? p.in[I_X] : p.out, l == 0 ? p.in[I_CTX] : WSF(p, WS_CTXRES)};
            if (want_ctx) { pg8::StaticOrder S; S.init(T, 1024, F.G, F.bid); pg8::gemm_phase<pg8::EpiOut, pg8::StaticOrder, PG8_ALIGN, PG8_SP2>(F.lds, g, S, E); }
            else { pg8::LatentOrder S; S.init(1024, F.G, F.bid); pg8::gemm_phase<pg8::EpiOut, pg8::LatentOrder, PG8_ALIGN, PG8_SP2>(F.lds, g, S, E); }
            if (l + 1 < DEPTH && F.G == 256) { __syncthreads(); cvt_run<false>(p, F, l + 1, (LAS float*)F.lds, 32, 0, 576); }
            SEAM(); }
        if (IN(16)) { LP(); p14_norm2_router(p, F, l, want_ctx); SEAM(); }
        if (IN(17)) { LP(); p15_scatter(p, F, l, want_ctx); SEAM(); }
        if (IN(18)) { LP();
            moe_build_tab(p, F, l);
            pg8::Gemm g{WSB(p, WS_BUF), WSB(p, WS_BT1), MOE_NBLK * 256, 1024, 1024};
            typedef pg8::MoeOrder<(size_t)1024 * 1024 * 2> Ord; Ord S{F.G, F.bid, (const PG8_LAS int*)(F.lds + MISC_OFF + 64)};
            pg8::EpiSwiGLU E{WSB(p, WS_HB)};
            pg8::gemm_phase<pg8::EpiSwiGLU, Ord, PG8_ALIGN, PG8_SP2>(F.lds, g, S, E);
            SEAM(); }
        if (IN(19)) { LP();
            moe_build_tab(p, F, l);
            pg8::Gemm g{WSB(p, WS_HB), WSB(p, WS_BT2), MOE_NBLK * 256, 1024, 512};
            typedef pg8::MoeOrder<(size_t)1024 * 512 * 2> Ord; Ord S{F.G, F.bid, (const PG8_LAS int*)(F.lds + MISC_OFF + 64)};
            pg8::EpiPlainBf16 E{WSB(p, WS_YB), 1024};
            pg8::gemm_phase<pg8::EpiPlainBf16, Ord, PG8_ALIGN, PG8_SP2>(F.lds, g, S, E);
            SEAM(); }
        if (IN(20)) { LP(); p18_combine(p, F, l, want_ctx); if (l + 1 < DEPTH) { p1_weights(p, F, l + 1, F.G == 256); SEAM(); } }
    }
__global__ void __launch_bounds__(NTHREADS, 2) mk_fwd(Params kp) {
    extern __shared__ __attribute__((aligned(16))) unsigned char lds_raw[];
    LAS unsigned char* const lds0 = (LAS unsigned char*)lds_raw;
    volatile LAS unsigned* misc = (volatile LAS unsigned*)(lds0 + MISC_OFF);
    if (threadIdx.x < 4) misc[threadIdx.x] = 0u;
    if (threadIdx.x == 0) { LAS Params* lp = (LAS Params*)(lds0 + PARAMS_OFF);
#pragma unroll
        for (int i = 0; i < 33; ++i) lp->in[i] = kp.in[i];
        lp->out = kp.out; lp->ws = kp.ws;
#pragma unroll
        for (int i = 0; i < 16; ++i) lp->invA[i] = kp.invA[i];
#pragma unroll
        for (int i = 0; i < 32; ++i) lp->invR[i] = kp.invR[i];
        lp->dry = kp.dry; }
    __syncthreads();
    const int ph_lo = kp.ph_lo, ph_hi = kp.ph_hi, fused = kp.fused;
    if (fused) (void)xcd_barrier_post((unsigned*)(kp.ws + WS_CTL) + CW_BAR, misc);
    if (((MK_PHASES >> 31) & 1u) && kp.do_pro) { LP(); p0_prologue(p, F); SEAM(); }

#if MK_FUSED
    layer_program(lds0, misc, 0, ph_lo, ph_hi, fused);
    layer_program(lds0, misc, 1, ph_lo, ph_hi, fused);
    layer_program(lds0, misc, 2, ph_lo, ph_hi, fused);
    layer_program(lds0, misc, 3, ph_lo, ph_hi, fused);
#else
    if (kp.l_lo < kp.l_hi) layer_program(lds0, misc, kp.l_lo, ph_lo, ph_hi, fused);
#endif
#undef IN
#undef SEAM
}

#ifndef MK_REP_MASK
#define MK_REP_MASK 0u
#define MK_REP_N 0
#endif
#ifndef MK_DRY_MODE
#define MK_DRY_MODE 1
#endif
extern "C" void kernel_launch(void* const* d_in, const int* in_sizes, int n_in, void* d_out, int out_size, void* d_ws, size_t ws_size, hipStream_t stream) {
    static int grid = 0;
    if (grid == 0) {
        if (n_in != 33 || in_sizes[0] != NB * NLAT * D || out_size != NB * NLAT * D || ws_size < WS_NEED) {
            fprintf(stderr, "kernel_launch: unexpected shapes/workspace: n_in %d in0 %d out %d ws %zu (need %zu)\n", n_in, n_in > 0 ? in_sizes[0] : -1, out_size, ws_size, (size_t)WS_NEED); grid = -1; return; }
        int dev = 0, cus = 0, per_cu = 0;
        if (hipGetDevice(&dev) != hipSuccess || hipDeviceGetAttribute(&cus, hipDeviceAttributeMultiprocessorCount, dev) != hipSuccess) { grid = -1; return; }
        if (hipFuncSetAttribute((const void*)mk_fwd, hipFuncAttributeMaxDynamicSharedMemorySize, LDS_BYTES) != hipSuccess) { fprintf(stderr, "kernel_launch: hipFuncSetAttribute failed\n"); grid = -1; return; }
        if (hipOccupancyMaxActiveBlocksPerMultiprocessor(&per_cu, (const void*)mk_fwd, NTHREADS, LDS_BYTES) != hipSuccess || per_cu < 1)
            fprintf(stderr, "kernel_launch: occupancy query reports %d workgroups per CU\n", per_cu);
        (void)hipGetLastError();
        grid = cus;
    }
    if (grid < 0) return;
    if (hipMemsetAsync((char*)d_ws + WS_CTL, 0, CTL_BYTES, stream) != hipSuccess) { fprintf(stderr, "kernel_launch: memset failed\n"); return; }
    Params a{};
    for (int i = 0; i < 33; ++i) a.in[i] = (const float*)d_in[i];
    a.out = (float*)d_out; a.ws = (unsigned char*)d_ws;
    for (int i = 0; i < 16; ++i) a.invA[i] = (float)pow(10000.0, -(double)i / 16.0);
    for (int i = 0; i < 32; ++i) a.invR[i] = (float)pow(10000.0, -(double)i / 32.0);
#if MK_FUSED
    a.ph_lo = 0; a.ph_hi = NPHASE; a.l_lo = 0; a.l_hi = DEPTH; a.fused = 1; a.do_pro = 1;
    hipLaunchKernelGGL(mk_fwd, dim3(grid), dim3(NTHREADS), LDS_BYTES, stream, a);
    if (hipPeekAtLastError() != hipSuccess) fprintf(stderr, "kernel_launch: launch failed\n");
#else
    a.fused = 0; a.do_pro = 1; a.l_lo = 0; a.l_hi = 0; a.ph_lo = 0; a.ph_hi = 0;
    hipLaunchKernelGGL(mk_fwd, dim3(grid), dim3(NTHREADS), LDS_BYTES, stream, a);
    a.do_pro = 0;
    for (int l = 0; l < DEPTH; ++l)
        for (int ph = 0; ph < NPHASE; ++ph) { a.l_lo = l; a.l_hi = l + 1; a.ph_lo = ph; a.ph_hi = ph + 1;
            const int reps = 1 + (((MK_REP_MASK >> ph) & 1u) ? MK_REP_N : 0);
            for (int r = 0; r < reps; ++r) { a.dry = r > 0 ? MK_DRY_MODE : 0; hipLaunchKernelGGL(mk_fwd, dim3(grid), dim3(NTHREADS), LDS_BYTES, stream, a); } a.dry = 0; }
    if (hipPeekAtLastError() != hipSuccess) fprintf(stderr, "kernel_launch: launch failed\n");
#endif
}
```

```cpp
#include <hip/hip_runtime.h>
#include <cstdio>
#include <cstdint>

#ifndef MK_FUSED
#define MK_FUSED 1
#endif

constexpr int D = 1024, NB = 8, NLAT = 4096, NCTX = 256, NP = NLAT + NCTX, T = NB * NP, DEPTH = 4;
constexpr int TP = T / 256;
constexpr int NPAIR_MAX = 2 * T;
constexpr int MOE_NBLK = NPAIR_MAX / 256 + 32;
constexpr int NTHREADS = 512, NWAVES = 8;

typedef unsigned short bf16_t;
typedef short bf16x8 __attribute__((ext_vector_type(8)));
typedef short bf16x4 __attribute__((ext_vector_type(4)));
typedef float f32x4 __attribute__((ext_vector_type(4)));
typedef float f32x2 __attribute__((ext_vector_type(2)));
typedef unsigned u32x4 __attribute__((ext_vector_type(4)));
typedef unsigned u32x2 __attribute__((ext_vector_type(2)));
#define LAS __attribute__((address_space(3)))

constexpr size_t AL(size_t x) { return (x + 255) & ~(size_t)255; }
constexpr size_t WS_CTL = 0, CTL_BYTES = 65536;
constexpr int CW_BAR = 0;
constexpr int CW_CNT = 4096;
constexpr size_t WS_MOD = AL(WS_CTL + CTL_BYTES);
constexpr size_t WS_ROPE = AL(WS_MOD + (size_t)DEPTH * 9 * 6144 * 4);
constexpr size_t WS_RWT = AL(WS_ROPE + (size_t)(2 * 64 * 16 + 2 * 64 * 32) * 4);
constexpr size_t WS_RW2 = AL(WS_RWT + (size_t)DEPTH * 36 * 1024 * 4);
constexpr size_t WS_RC = AL(WS_RW2 + (size_t)DEPTH * 64 * 3 * 4 * 16 * 4 * 4);
constexpr size_t WS_CTXRES = AL(WS_RC + (size_t)DEPTH * 9 * 48 * 4);
constexpr size_t WS_BTIN = AL(WS_CTXRES + (size_t)NB * NCTX * D * 4);
constexpr size_t WS_BTBR = AL(WS_BTIN + (size_t)7680 * 1024 * 2);
constexpr size_t WS_BTOUT = AL(WS_BTBR + (size_t)3 * 1024 * 512 * 2);
constexpr size_t WS_BTLORA = AL(WS_BTOUT + (size_t)1024 * 1024 * 2);
constexpr size_t WS_H = AL(WS_BTLORA + (size_t)2560 * 256 * 2);
constexpr size_t WS_M0 = AL(WS_H + (size_t)T * 1024 * 2);
constexpr size_t SZ512 = (size_t)T * 512 * 2;
constexpr size_t WS_AQ = WS_M0;
constexpr size_t WS_AKV = AL(WS_AQ + SZ512);
constexpr size_t WS_RQ = AL(WS_AKV + (size_t)T * 256 * 2);
constexpr size_t WS_RK = AL(WS_RQ + SZ512);
constexpr size_t WS_RV = AL(WS_RK + SZ512);
constexpr size_t WS_RG = AL(WS_RV + SZ512);
constexpr size_t WS_GL = AL(WS_RG + SZ512);
constexpr size_t WS_WU = AL(WS_GL + (size_t)T * 3072 * 2);
constexpr size_t WS_LW = AL(WS_WU + (size_t)T * 1792 * 2);
constexpr size_t WS_LA = AL(WS_LW + (size_t)T * 1024 * 2);
constexpr size_t WS_LG = AL(WS_LA + (size_t)T * 1024 * 2);
constexpr size_t WS_W1 = AL(WS_LG + SZ512);
constexpr size_t WS_END_MIX = AL(WS_W1 + 9 * SZ512);
constexpr size_t WS_YS = WS_LW;
constexpr size_t WS_SF = WS_WU + 3 * SZ512;
constexpr size_t WS_SB = AL(WS_SF + (size_t)NB * 4 * 34 * 16384 * 2);
static_assert(WS_SB + (size_t)NB * 4 * 34 * 16384 * 2 <= WS_LG, "retention states fit behind YCAT inside WU|LW|LA");
constexpr size_t WS_BT1 = WS_M0;
constexpr size_t WS_BT2 = AL(WS_BT1 + (size_t)32 * 1024 * 1024 * 2);
constexpr size_t WS_BUF = AL(WS_BT2 + (size_t)32 * 1024 * 512 * 2);
constexpr size_t WS_HB = AL(WS_BUF + (size_t)MOE_NBLK * 256 * 1024 * 2);
constexpr size_t WS_YB = AL(WS_HB + (size_t)MOE_NBLK * 256 * 512 * 2);
constexpr size_t WS_PAIR = AL(WS_YB + (size_t)MOE_NBLK * 256 * 1024 * 2);
constexpr size_t WS_RSROW = AL(WS_PAIR + (size_t)4 * NPAIR_MAX * 4);
constexpr size_t WS_END_MOE = AL(WS_RSROW + (size_t)T * 4);
static_assert(WS_END_MOE <= WS_END_MIX, "moe overlay inside the mixer region");
constexpr size_t WS_NEED = WS_END_MIX;
static_assert(WS_NEED <= 1220000000ull, "workspace budget (sum of inputs = 1220.39 MB)");

constexpr int RING_BYTES = 131072;
constexpr int LDS_BYTES = 147456;
constexpr int MISC_OFF = LDS_BYTES - 4096;

struct Params {
    const float* in[33];
    float* out;
    unsigned char* ws;
    float invA[16];
    float invR[32];
    int ph_lo, ph_hi, l_lo, l_hi;
    int fused, do_pro;
    int dry, pad2;
};
enum { I_X = 0, I_C, I_CTX, I_CCTX, I_ADAW, I_ADAB, I_N1G, I_N2G, I_WIN, I_QNG, I_KNG, I_RDL, I_RGN, I_MU, I_W0, I_W2, I_A0, I_A2, I_G2, I_KK, I_KA, I_RK, I_LNG, I_LNB,
       I_WBR, I_WOUT, I_RGW, I_RGB, I_REW, I_REB, I_MG, I_MUP, I_MD };

__device__ __forceinline__ float bf2f(unsigned v) { return __builtin_bit_cast(float, v << 16); }
__device__ __forceinline__ unsigned f2bf(float f) { return (unsigned)__builtin_bit_cast(unsigned short, (__bf16)f); }
typedef __bf16 hwbf16x2 __attribute__((ext_vector_type(2)));
__device__ __forceinline__ unsigned pk2(float lo, float hi) { const f32x2 v = {lo, hi}; return __builtin_bit_cast(unsigned, __builtin_convertvector(v, hwbf16x2)); }
__device__ __forceinline__ float lo16(unsigned w) { return __builtin_bit_cast(float, w << 16); }
__device__ __forceinline__ float hi16(unsigned w) { return __builtin_bit_cast(float, w & 0xffff0000u); }
__device__ __forceinline__ void unpack8(const u32x4 v, float (&x)[8]) { x[0] = lo16(v.x); x[1] = hi16(v.x); x[2] = lo16(v.y); x[3] = hi16(v.y); x[4] = lo16(v.z); x[5] = hi16(v.z); x[6] = lo16(v.w); x[7] = hi16(v.w); }
__device__ __forceinline__ u32x4 pack8(const float (&x)[8]) { u32x4 v; v.x = pk2(x[0], x[1]); v.y = pk2(x[2], x[3]); v.z = pk2(x[4], x[5]); v.w = pk2(x[6], x[7]); return v; }
__device__ __forceinline__ float frcp(float x) { return __builtin_amdgcn_rcpf(x); }
__device__ __forceinline__ float sigmoidf_(float x) { return frcp(1.f + __expf(-x)); }
__device__ __forceinline__ float siluf_(float x) { return x * frcp(1.f + __expf(-x)); }
__device__ __forceinline__ float shfl_xor_f(float v, int m) { return __shfl_xor(v, m, 64); }
__device__ __forceinline__ float* xrow(const Params& p, int row) {
    const int b = row / NP, q = row - b * NP;
    return q < NCTX ? (float*)(p.ws + WS_CTXRES) + (size_t)(b * NCTX + q) * D : p.out + (size_t)(b * NLAT + (q - NCTX)) * D;
}
__device__ __forceinline__ bf16x8 ld_frag(const LAS unsigned char* p) { return *(const LAS bf16x8*)p; }
__device__ __forceinline__ bf16x4 tr_read(const LAS unsigned char* p) { return __builtin_amdgcn_ds_read_tr16_b64_v4i16((LAS bf16x4*)p); }
__device__ __forceinline__ bf16x8 cat44(bf16x4 a, bf16x4 b) { bf16x8 r; r[0] = a[0]; r[1] = a[1]; r[2] = a[2]; r[3] = a[3]; r[4] = b[0]; r[5] = b[1]; r[6] = b[2]; r[7] = b[3]; return r; }
__device__ __forceinline__ bf16x8 pack_frag(const f32x4 a, const f32x4 b) {
    u32x4 w; w.x = pk2(a[0], a[1]); w.y = pk2(a[2], a[3]); w.z = pk2(b[0], b[1]); w.w = pk2(b[2], b[3]); return __builtin_bit_cast(bf16x8, w);
}
#define MFMA16(a, b, c) __builtin_amdgcn_mfma_f32_16x16x32_bf16((a), (b), (c), 0, 0, 0)

#define XB_TMO      128
#define XB_XCNT(j)  (256  + 64 * (j))
#define XB_XSUB(j)  (1280 + 64 * (j))
#define XB_XGEN(j)  (2304 + 64 * (j))
#define XB_TOP      3328
#define XB_TOPGEN   3392
#define XCD_BAR_WORDS 3456
#define XB_SPIN_CAP (1u << 18)
__device__ __forceinline__ unsigned xb_ld(unsigned* p)              { return __hip_atomic_load(p, __ATOMIC_RELAXED, __HIP_MEMORY_SCOPE_AGENT); }
__device__ __forceinline__ unsigned xb_add(unsigned* p, unsigned v) { return __hip_atomic_fetch_add(p, v, __ATOMIC_RELAXED, __HIP_MEMORY_SCOPE_AGENT); }
__device__ __forceinline__ unsigned xb_xcc_id() { return (unsigned)__builtin_amdgcn_s_getreg((3 << 11) | 20) & 0xFu; }
#define XB_SPIN(cond, bar) do { unsigned _sp = 0; while (cond) { __builtin_amdgcn_s_sleep(1); \
    if ((++_sp & 255u) == 0u) { if (xb_ld(&(bar)[XB_TMO])) break; if (_sp > XB_SPIN_CAP) { atomicAdd(&(bar)[XB_TMO], 1u); break; } } } } while (0)
struct XcdBarrier { unsigned* bar; unsigned x; volatile LAS unsigned* st; };
__device__ __forceinline__ XcdBarrier xcd_barrier_post(unsigned* bar, volatile LAS unsigned* st) {
    XcdBarrier b; b.bar = bar; b.x = xb_xcc_id(); b.st = st;
    if (threadIdx.x == 0) (void)xb_add(&bar[XB_XCNT(b.x)], 1u);
    return b;
}
__device__ __forceinline__ void xcd_barrier_complete(unsigned* bar, unsigned x, unsigned& nloc, unsigned& nx) {
    const unsigned G = gridDim.x * gridDim.y * gridDim.z;
    unsigned sum, cnt, mine, sp = 0u;
    for (;;) {
        sum = 0u; cnt = 0u; mine = 0u;
#pragma unroll
        for (unsigned j = 0; j < 16; ++j) { const unsigned c = xb_ld(&bar[XB_XCNT(j)]); sum += c; cnt += (c > 0u) ? 1u : 0u; mine = (j == x) ? c : mine; }
        if (sum == G) break;
        __builtin_amdgcn_s_sleep(1);
        if ((++sp & 255u) == 0u) { if (xb_ld(&bar[XB_TMO])) break; if (sp > XB_SPIN_CAP) { atomicAdd(&bar[XB_TMO], 1u); break; } }
    }
    nloc = mine > 0u ? mine : 1u; nx = cnt > 0u ? cnt : 1u;
}
__device__ __forceinline__ void xcd_barrier(const XcdBarrier& b) {
    asm volatile("s_waitcnt vmcnt(0)" ::: "memory");
    __syncthreads();
    if (threadIdx.x == 0) {
        unsigned* bar = b.bar;
        __builtin_amdgcn_s_waitcnt(0);
        unsigned nloc = b.st[0], nx = b.st[1];
        if (nloc == 0u) { xcd_barrier_complete(bar, b.x, nloc, nx); b.st[0] = nloc; b.st[1] = nx; }
        const unsigned old = xb_add(&bar[XB_XSUB(b.x)], 1u);
        const unsigned gen = old / nloc;
        if (old + 1u == (gen + 1u) * nloc) {
            __builtin_amdgcn_fence(__ATOMIC_RELEASE, "agent");
            asm volatile("s_waitcnt vmcnt(0)" ::: "memory");
            const unsigned og = xb_add(&bar[XB_TOP], 1u);
            const unsigned tg = og / nx;
            if (og + 1u == (tg + 1u) * nx) xb_add(&bar[XB_TOPGEN], 1u);
            else XB_SPIN(xb_ld(&bar[XB_TOPGEN]) == tg, bar);
            __builtin_amdgcn_fence(__ATOMIC_ACQUIRE, "agent");
            xb_add(&bar[XB_XGEN(b.x)], 1u);
            asm volatile("s_waitcnt vmcnt(0)" ::: "memory");
        } else {
            XB_SPIN(xb_ld(&bar[XB_XGEN(b.x)]) == gen, bar);
            __builtin_amdgcn_fence(__ATOMIC_ACQUIRE, "agent");
            asm volatile("s_waitcnt vmcnt(0)" ::: "memory");
        }
    }
    __syncthreads();
}
namespace pg8 {
#define PG8_LAS __attribute__((address_space(3)))
typedef unsigned short bf16_t;
typedef short bf16x8 __attribute__((ext_vector_type(8)));
typedef float f32x4 __attribute__((ext_vector_type(4)));
typedef unsigned u32x4 __attribute__((ext_vector_type(4)));
constexpr int BM = 256, BK = 64, HALF = 128, HTB = HALF * BK * 2  , STAGE_BYTES = 8 * HTB, NXCD = 8, WGM = 8;

__host__ __device__ __forceinline__ int lds_byte(int r, int c) { const int st = (r >> 4) * 2 + (c >> 5), rr = r & 15, cc = c & 31, ob = rr * 64 + cc * 2; return st * 1024 + (ob ^ (((ob >> 9) & 1) << 5)); }
__host__ __device__ __forceinline__ void stage_rc(int b, int& R, int& C) { const int st = b / 1024, sb = b % 1024, swz = sb ^ (((sb >> 9) & 1) << 5); R = (st >> 1) * 16 + swz / 64; C = (st & 1) * 32 + (swz % 64) / 2; }
__host__ __device__ __forceinline__ int perm32(int rho) { const int n = rho >> 4, i = rho & 15; return 8 * (i >> 2) + 4 * n + (i & 3); }

struct Unit { int pm, pn; size_t bofs; };
struct Gemm { const bf16_t* A; const bf16_t* Bt; int M, N, K; };

struct StaticOrder {
    int nM, nN, nwg, G, c;
    __host__ __device__ void init(int M, int N, int G_, int c_) { nM = M / BM; nN = N / BM; nwg = nM * nN; G = G_; c = c_; }
    __host__ __device__ bool next(int i, Unit& u) const {
        const long L = (long)i * G + c; if (L >= nwg) return false;
        int wgid = (int)L; { const int q = nwg / NXCD, r = nwg % NXCD, xcd = wgid % NXCD, off = wgid / NXCD; wgid = (xcd < r ? xcd * (q + 1) : r * (q + 1) + (xcd - r) * q) + off; }
        const int nig = WGM * nN, gid = wgid / nig, fm = gid * WGM, gsz = (nM - fm) < WGM ? (nM - fm) : WGM;
        u.pm = fm + ((wgid % nig) % gsz); u.pn = (wgid % nig) / gsz; u.bofs = 0; return true;
    }
    __device__ __forceinline__ void a_ready(const Unit&) const {}
    __device__ __forceinline__ void done(const Unit&) const {}
};

__device__ __forceinline__ unsigned cvt_pk_bf16(float lo, float hi) { unsigned r; asm volatile("v_cvt_pk_bf16_f32 %0, %1, %2" : "=v"(r) : "v"(lo), "v"(hi)); return r; }
template <class Epi, class Sched, bool ALIGN_EPI = false, bool SP2 = false>
__device__ __forceinline__ void gemm_phase(PG8_LAS unsigned char* lds, const Gemm g, const Sched& S, const Epi& E) {
    int tid_ = threadIdx.x; asm volatile("" : "+v"(tid_)); const int tid = tid_, wid = __builtin_amdgcn_readfirstlane(tid >> 6), lane = tid & 63, wr = wid >> 2, wc = wid & 3, fr = lane & 15, fq = lane >> 4;
    int K = g.K; asm volatile("" : "+s"(K)); const int nt = K / BK;
    unsigned voffA[2], voffB[2];
#pragma unroll
    for (int i = 0; i < 2; ++i) { int R, C; stage_rc(tid * 16 + i * 8192, R, C); const int Rb = Epi::PERM ? ((R & ~31) + perm32(R & 31)) : R;
        voffA[i] = (unsigned)(R * K + C) * 2u; voffB[i] = (unsigned)(Rb * K + C) * 2u; }
    const size_t kstep = (size_t)(BK * 2);
    const size_t hstep = (size_t)HALF * K * 2;
    const size_t tstep = 2 * hstep;
    const unsigned ldsw = (unsigned)wid * 1024u;
    const int aoff = lds_byte(wr * 64 + fr, fq * 8), boff = lds_byte(wc * 32 + fr, fq * 8);
#define PG8_SA(b, h) (((b) * 2 + (h)) * HTB)
#define PG8_SB(b, h) ((4 + (b) * 2 + (h)) * HTB)
#define PG8_STAGE(bufoff, gbase, voff) do { _Pragma("unroll") for (int _i = 0; _i < 2; ++_i) \
        __builtin_amdgcn_global_load_lds((const unsigned*)((const char*)(gbase) + (voff)[_i]), (PG8_LAS unsigned*)(lds + (bufoff) + ldsw + _i * 8192), 16, 0, 0); } while (0)
#define PG8_LDA(dst, b, h) do { _Pragma("unroll") for (int m = 0; m < 4; ++m) _Pragma("unroll") for (int k = 0; k < 2; ++k) dst[m][k] = *(const PG8_LAS bf16x8*)(lds + PG8_SA(b, h) + aoff + m * 2048 + k * 1024); } while (0)
#define PG8_LDB(dst, b, h) do { _Pragma("unroll") for (int n = 0; n < 2; ++n) _Pragma("unroll") for (int k = 0; k < 2; ++k) dst[n][k] = *(const PG8_LAS bf16x8*)(lds + PG8_SB(b, h) + boff + n * 2048 + k * 1024); } while (0)
#define PG8_MMA(ai, bj, At, Bt) do { __builtin_amdgcn_s_setprio(1); _Pragma("unroll") for (int m = 0; m < 4; ++m) _Pragma("unroll") for (int n = 0; n < 2; ++n) _Pragma("unroll") for (int k = 0; k < 2; ++k) \
        acc[ai][bj][m][n] = __builtin_amdgcn_mfma_f32_16x16x32_bf16(Bt[n][k], At[m][k], acc[ai][bj][m][n], 0, 0, 0); __builtin_amdgcn_s_setprio(0); } while (0)
#define PG8_WAIT_V(n) asm volatile("s_waitcnt vmcnt(" #n ")" ::: "memory")
#define PG8_WAIT_L(n) asm volatile("s_waitcnt lgkmcnt(" #n ")" ::: "memory")
#define PG8_BAR __builtin_amdgcn_s_barrier()
#define PG8_SCHED __builtin_amdgcn_sched_barrier(0)
    Unit cur, nxt; int ui = 0;
    if (!S.next(0, cur)) return;
    f32x4 acc[2][2][4][2];
#pragma unroll
    for (int a = 0; a < 2; ++a)
#pragma unroll
        for (int b = 0; b < 2; ++b)
#pragma unroll
            for (int m = 0; m < 4; ++m)
#pragma unroll
                for (int n = 0; n < 2; ++n) acc[a][b][m][n] = (f32x4){0.f, 0.f, 0.f, 0.f};
    bf16x8 At[4][2], B0[2][2], B1[2][2];
    const char* cA = (const char*)g.A + (size_t)cur.pm * tstep; const char* cB = (const char*)g.Bt + cur.bofs + (size_t)cur.pn * tstep;
    S.a_ready(cur);
    if constexpr (SP2) {
        PG8_STAGE(PG8_SB(0, 0), cB, voffB); PG8_STAGE(PG8_SB(0, 1), cB + hstep, voffB); PG8_STAGE(PG8_SA(0, 0), cA, voffA); PG8_STAGE(PG8_SA(0, 1), cA + hstep, voffA);
        if (wr == 1) PG8_BAR;
        PG8_WAIT_V(2); PG8_BAR;
        PG8_STAGE(PG8_SB(1, 0), cB + kstep, voffB); PG8_STAGE(PG8_SA(1, 0), cA + kstep, voffA); PG8_STAGE(PG8_SB(1, 1), cB + hstep + kstep, voffB);
        PG8_WAIT_V(6); PG8_BAR;
    } else {
        PG8_STAGE(PG8_SB(0, 0), cB, voffB); PG8_STAGE(PG8_SA(0, 0), cA, voffA); PG8_STAGE(PG8_SB(0, 1), cB + hstep, voffB); PG8_STAGE(PG8_SA(0, 1), cA + hstep, voffA);
        if (wr == 1) PG8_BAR;
        PG8_WAIT_V(4); PG8_BAR;
        PG8_STAGE(PG8_SB(1, 0), cB + kstep, voffB); PG8_STAGE(PG8_SA(1, 0), cA + kstep, voffA); PG8_STAGE(PG8_SB(1, 1), cB + hstep + kstep, voffB);
        PG8_WAIT_V(6); PG8_BAR;
    }
    for (;;) {
        const bool has_next = S.next(ui + 1, nxt);
        const char* nA = has_next ? (const char*)g.A + (size_t)nxt.pm * tstep : cA; const char* nB = has_next ? (const char*)g.Bt + nxt.bofs + (size_t)nxt.pn * tstep : cB;
        for (int t = 0; t < nt; t += 2) {
            const bool last = (t == nt - 2);
            if constexpr (Epi::KHOOK) { if (t == 8 || t == 16) E.khook(acc, cur, wr, wc, fr, fq, t >> 3); }
            const char* a1 = cA + (size_t)(t + 1) * kstep;
            const char* a2 = last ? nA : cA + (size_t)(t + 2) * kstep; const char* b2 = last ? nB : cB + (size_t)(t + 2) * kstep;
            const char* a3 = a2 + kstep; const char* b3 = b2 + kstep;
            if (last && has_next) S.a_ready(nxt);
            if constexpr (SP2) {
            PG8_LDB(B0, 0, 0); PG8_LDB(B1, 0, 1); PG8_SCHED; PG8_LDA(At, 0, 0); PG8_STAGE(PG8_SA(1, 1), a1 + hstep, voffA);
            PG8_WAIT_V(8); PG8_WAIT_L(0); PG8_BAR; PG8_MMA(0, 0, At, B0); PG8_MMA(0, 1, At, B1); PG8_BAR; PG8_SCHED;
            PG8_LDA(At, 0, 1); PG8_STAGE(PG8_SB(0, 0), b2, voffB); PG8_STAGE(PG8_SB(0, 1), b2 + hstep, voffB); PG8_STAGE(PG8_SA(0, 0), a2, voffA);
            PG8_WAIT_V(8); PG8_WAIT_L(0); PG8_BAR; PG8_MMA(1, 0, At, B0); PG8_MMA(1, 1, At, B1); PG8_BAR; PG8_SCHED;
            PG8_LDB(B0, 1, 0); PG8_LDB(B1, 1, 1); PG8_SCHED; PG8_LDA(At, 1, 0); PG8_STAGE(PG8_SA(0, 1), a2 + hstep, voffA);
            PG8_WAIT_V(8); PG8_WAIT_L(0); PG8_BAR; PG8_MMA(0, 0, At, B0); PG8_MMA(0, 1, At, B1); PG8_BAR; PG8_SCHED;
            PG8_LDA(At, 1, 1); PG8_STAGE(PG8_SB(1, 0), b3, voffB); PG8_STAGE(PG8_SB(1, 1), b3 + hstep, voffB); PG8_STAGE(PG8_SA(1, 0), a3, voffA);
            PG8_WAIT_V(8); PG8_WAIT_L(0); PG8_BAR; PG8_MMA(1, 0, At, B0); PG8_MMA(1, 1, At, B1); PG8_BAR; PG8_SCHED;
            } else {
            PG8_LDB(B0, 0, 0); PG8_SCHED; PG8_LDA(At, 0, 0); PG8_STAGE(PG8_SA(1, 1), a1 + hstep, voffA);
            PG8_WAIT_L(8); PG8_BAR; PG8_WAIT_L(0); PG8_MMA(0, 0, At, B0); PG8_BAR; PG8_SCHED;
            PG8_LDB(B1, 0, 1); PG8_STAGE(PG8_SB(0, 0), b2, voffB);
            PG8_BAR; PG8_WAIT_L(0); PG8_MMA(0, 1, At, B1); PG8_BAR;
            PG8_LDA(At, 0, 1); PG8_STAGE(PG8_SA(0, 0), a2, voffA);
            PG8_BAR; PG8_WAIT_L(0); PG8_MMA(1, 0, At, B0); PG8_BAR; PG8_SCHED;
            PG8_STAGE(PG8_SB(0, 1), b2 + hstep, voffB);
            PG8_WAIT_V(6); PG8_BAR; PG8_MMA(1, 1, At, B1); PG8_BAR;
            PG8_LDB(B0, 1, 0); PG8_SCHED; PG8_LDA(At, 1, 0); PG8_STAGE(PG8_SA(0, 1), a2 + hstep, voffA);
            PG8_WAIT_L(8); PG8_BAR; PG8_WAIT_L(0); PG8_MMA(0, 0, At, B0); PG8_BAR; PG8_SCHED;
            PG8_LDB(B1, 1, 1); PG8_STAGE(PG8_SB(1, 0), b3, voffB);
            PG8_BAR; PG8_WAIT_L(0); PG8_MMA(0, 1, At, B1); PG8_BAR;
            PG8_LDA(At, 1, 1); PG8_STAGE(PG8_SA(1, 0), a3, voffA);
            PG8_BAR; PG8_WAIT_L(0); PG8_MMA(1, 0, At, B0); PG8_BAR; PG8_SCHED;
            PG8_STAGE(PG8_SB(1, 1), b3 + hstep, voffB);
            PG8_WAIT_V(6); PG8_BAR; PG8_MMA(1, 1, At, B1); PG8_BAR;
            }
        }
        if constexpr (ALIGN_EPI) { if (wr == 0) PG8_BAR; }
        if constexpr (!Epi::AFTER_DRAIN) { E(acc, cur, wr, wc, fr, fq); S.done(cur); }
        if (!has_next) break;
#pragma unroll
        for (int a = 0; a < 2; ++a)
#pragma unroll
            for (int b = 0; b < 2; ++b)
#pragma unroll
                for (int m = 0; m < 4; ++m)
#pragma unroll
                    for (int n = 0; n < 2; ++n) acc[a][b][m][n] = (f32x4){0.f, 0.f, 0.f, 0.f};
        cur = nxt; cA = nA; cB = nB; ++ui;
        if constexpr (ALIGN_EPI) { if (wr == 1) PG8_BAR; }
    }
    PG8_WAIT_V(0);
    if constexpr (!ALIGN_EPI) { if (wr == 0) PG8_BAR; }
    PG8_BAR;
    if constexpr (Epi::AFTER_DRAIN) { E.fused(acc, cur, wr, wc, fr, fq, lds, wid, lane); S.done(cur); }
#undef PG8_SA
#undef PG8_SB
#undef PG8_STAGE
#undef PG8_LDA
#undef PG8_LDB
#undef PG8_MMA
#undef PG8_WAIT_V
#undef PG8_WAIT_L
#undef PG8_BAR
#undef PG8_SCHED
}
template <bool EXPNEG = false> __device__ __forceinline__ void store_bf16_tile(bf16_t* O, int pitch, int colt, const f32x4 (&acc)[2][2][4][2], const Unit& u, int wr, int wc, int fr, int fq) {
    const int row0 = u.pm * BM + wr * 64 + fr; const int col0 = colt + wc * 32 + 8 * fq;
#pragma unroll
    for (int ai = 0; ai < 2; ++ai)
#pragma unroll
        for (int m = 0; m < 4; ++m) { bf16_t* rowp = O + (size_t)(row0 + ai * HALF + m * 16) * pitch + col0;
#pragma unroll
            for (int bj = 0; bj < 2; ++bj) { f32x4 v0 = acc[ai][bj][m][0], v1 = acc[ai][bj][m][1];
                if (EXPNEG) {
#pragma unroll
                    for (int e = 0; e < 4; ++e) { v0[e] = __expf(-v0[e]); v1[e] = __expf(-v1[e]); } }
                u32x4 w; w.x = cvt_pk_bf16(v0[0], v0[1]); w.y = cvt_pk_bf16(v0[2], v0[3]); w.z = cvt_pk_bf16(v1[0], v1[1]); w.w = cvt_pk_bf16(v1[2], v1[3]);
                *(u32x4*)(rowp + bj * HALF) = w; } }
}
struct EpiInproj {
    static constexpr bool PERM = true, AFTER_DRAIN = false, KHOOK = false;
    unsigned char* ws;
    __device__ __forceinline__ void operator()(const f32x4 (&acc)[2][2][4][2], const Unit& u, int wr, int wc, int fr, int fq) const {
        const int pn = u.pn; size_t base; int pitch, colt;
        if (pn < 2)       { base = WS_AQ;  pitch = 512;  colt = pn * 256; }
        else if (pn == 2) { base = WS_AKV; pitch = 256;  colt = 0; }
        else if (pn < 5)  { base = WS_RQ;  pitch = 512;  colt = (pn - 3) * 256; }
        else if (pn < 7)  { base = WS_RK;  pitch = 512;  colt = (pn - 5) * 256; }
        else if (pn < 9)  { base = WS_RV;  pitch = 512;  colt = (pn - 7) * 256; }
        else if (pn < 11) { base = WS_RG;  pitch = 512;  colt = (pn - 9) * 256; }
        else if (pn < 18) { base = WS_WU;  pitch = 1792; colt = (pn - 11) * 256; }
        else              { store_bf16_tile<true>((bf16_t*)(ws + WS_GL), 3072, (pn - 18) * 256, acc, u, wr, wc, fr, fq); return; }
        store_bf16_tile((bf16_t*)(ws + base), pitch, colt, acc, u, wr, wc, fr, fq);
    }
};
struct EpiLora {
    static constexpr bool PERM = true, AFTER_DRAIN = false, KHOOK = false;
    unsigned char* ws;
    __device__ __forceinline__ void operator()(const f32x4 (&acc)[2][2][4][2], const Unit& u, int wr, int wc, int fr, int fq) const {
        const int pn = u.pn; size_t base; int pitch, colt;
        if (pn < 4)      { base = WS_LW; pitch = 1024; colt = pn * 256; }
        else if (pn < 8) { base = WS_LA; pitch = 1024; colt = (pn - 4) * 256; }
        else             { base = WS_LG; pitch = 512;  colt = (pn - 8) * 256; }
        store_bf16_tile((bf16_t*)(ws + base), pitch, colt, acc, u, wr, wc, fr, fq);
    }
};
struct EpiPlainBf16 {
    static constexpr bool PERM = true, AFTER_DRAIN = false, KHOOK = false;
    bf16_t* O; int pitch;
    __device__ __forceinline__ void operator()(const f32x4 (&acc)[2][2][4][2], const Unit& u, int wr, int wc, int fr, int fq) const {
        store_bf16_tile(O, pitch, u.pn * BM, acc, u, wr, wc, fr, fq);
    }
};
template <int MODE> struct EpiMerge {
    static constexpr bool PERM = false, AFTER_DRAIN = false, KHOOK = false;
    const bf16_t* GL; float* MRG; bf16_t* OB; int nb;
    __device__ __forceinline__ void operator()(const f32x4 (&acc)[2][2][4][2], const Unit& u, int wr, int wc, int fr, int fq) const {
        const int row0 = u.pm * BM + wr * 64 + fr, col0 = u.pn * BM + wc * 32 + 4 * fq;
#pragma unroll
        for (int ai = 0; ai < 2; ++ai)
#pragma unroll
            for (int m = 0; m < 4; ++m) { const size_t row = (size_t)(row0 + ai * HALF + m * 16); asm volatile("" ::: "memory");
#pragma unroll
                for (int bj = 0; bj < 2; ++bj)
#pragma unroll
                    for (int n = 0; n < 2; ++n) { const int col = col0 + bj * HALF + n * 16;
                        const u32x2 gw = *(const u32x2*)(GL + row * 3072 + nb * 1024 + col);
                        f32x4 g; g[0] = __builtin_amdgcn_rcpf(1.f + __expf(-lo16(gw.x))); g[1] = __builtin_amdgcn_rcpf(1.f + __expf(-hi16(gw.x))); g[2] = __builtin_amdgcn_rcpf(1.f + __expf(-lo16(gw.y))); g[3] = __builtin_amdgcn_rcpf(1.f + __expf(-hi16(gw.y)));
                        f32x4 v = acc[ai][bj][m][n] * g;
                        float* mp = MRG + row * 1024 + col;
                        if (MODE != 0) v = v + *(const f32x4*)mp;
                        if (MODE != 2) *(f32x4*)mp = v;
                        else { u32x2 w; w.x = cvt_pk_bf16(v[0], v[1]); w.y = cvt_pk_bf16(v[2], v[3]); *(u32x2*)(OB + row * 1024 + col) = w; } } }
    }
};
struct EpiMergeK {
    static constexpr bool PERM = false, AFTER_DRAIN = false, KHOOK = true;
    const bf16_t* GL; bf16_t* OB;
    __device__ __forceinline__ void khook(f32x4 (&acc)[2][2][4][2], const Unit& u, int wr, int wc, int fr, int fq, int seg  ) const {
        const int row0 = u.pm * BM + wr * 64 + fr, col0 = u.pn * BM + wc * 32 + 4 * fq;
#pragma unroll
        for (int ai = 0; ai < 2; ++ai) {
            u32x2 ga[4][2][2], gb[4][2][2];
            asm volatile("" ::: "memory");
#pragma unroll
            for (int m = 0; m < 4; ++m) { const bf16_t* gr = GL + (size_t)(row0 + ai * HALF + m * 16) * 3072 + (seg - 1) * 1024 + col0;
#pragma unroll
                for (int bj = 0; bj < 2; ++bj)
#pragma unroll
                    for (int n = 0; n < 2; ++n) { ga[m][bj][n] = *(const u32x2*)(gr + bj * HALF + n * 16); gb[m][bj][n] = *(const u32x2*)(gr + 1024 + bj * HALF + n * 16); } }
#pragma unroll
            for (int m = 0; m < 4; ++m)
#pragma unroll
                for (int bj = 0; bj < 2; ++bj)
#pragma unroll
                    for (int n = 0; n < 2; ++n) { const u32x2 a = ga[m][bj][n], b = gb[m][bj][n];
                        f32x4 r;
                        r[0] = (1.f + lo16(b.x)) * __builtin_amdgcn_rcpf(1.f + lo16(a.x)); r[1] = (1.f + hi16(b.x)) * __builtin_amdgcn_rcpf(1.f + hi16(a.x));
                        r[2] = (1.f + lo16(b.y)) * __builtin_amdgcn_rcpf(1.f + lo16(a.y)); r[3] = (1.f + hi16(b.y)) * __builtin_amdgcn_rcpf(1.f + hi16(a.y));
                        acc[ai][bj][m][n] = acc[ai][bj][m][n] * r; } }
    }
    __device__ __forceinline__ void operator()(const f32x4 (&acc)[2][2][4][2], const Unit& u, int wr, int wc, int fr, int fq) const {
        const int row0 = u.pm * BM + wr * 64 + fr, col0 = u.pn * BM + wc * 32 + 4 * fq;
#pragma unroll
        for (int ai = 0; ai < 2; ++ai) { asm volatile("" ::: "memory");
#pragma unroll
            for (int m = 0; m < 4; ++m) { const size_t row = (size_t)(row0 + ai * HALF + m * 16);
#pragma unroll
                for (int bj = 0; bj < 2; ++bj)
#pragma unroll
                    for (int n = 0; n < 2; ++n) { const int col = col0 + bj * HALF + n * 16;
                        const u32x2 gw = *(const u32x2*)(GL + row * 3072 + 2048 + col);
                        f32x4 g; g[0] = __builtin_amdgcn_rcpf(1.f + lo16(gw.x)); g[1] = __builtin_amdgcn_rcpf(1.f + hi16(gw.x)); g[2] = __builtin_amdgcn_rcpf(1.f + lo16(gw.y)); g[3] = __builtin_amdgcn_rcpf(1.f + hi16(gw.y));
                        const f32x4 v = acc[ai][bj][m][n] * g;
                        u32x2 w; w.x = cvt_pk_bf16(v[0], v[1]); w.y = cvt_pk_bf16(v[2], v[3]); *(u32x2*)(OB + row * 1024 + col) = w; } } }
    }
};
struct EpiOut {
    static constexpr bool PERM = false, AFTER_DRAIN = false, KHOOK = false;
    float* out; float* ctxres; const float* modl; int dry; const float* xin; const float* cin;
    __device__ __forceinline__ void operator()(const f32x4 (&acc)[2][2][4][2], const Unit& u, int wr, int wc, int fr, int fq) const {
        const int row0 = u.pm * BM + wr * 64 + fr, col0 = u.pn * BM + wc * 32 + 4 * fq;
        const int b = (u.pm * BM) / NP, q0 = u.pm * BM - b * NP;
        const bool isctx = q0 < NCTX;
        const float* g1 = modl + (size_t)(isctx ? 8 : b) * 6144 + 2048;
        float* xb = isctx ? ctxres + (size_t)(b * NCTX) * D : out + ((size_t)b * NLAT + (q0 - NCTX)) * D;
        const float* xs = isctx ? cin + (size_t)(b * NCTX) * D : xin + ((size_t)b * NLAT + (q0 - NCTX)) * D;
        f32x4 gv[2][2];
#pragma unroll
        for (int bj = 0; bj < 2; ++bj)
#pragma unroll
            for (int n = 0; n < 2; ++n) gv[bj][n] = *(const f32x4*)(g1 + col0 + bj * HALF + n * 16);
#pragma unroll
        for (int ai = 0; ai < 2; ++ai) { asm volatile("" ::: "memory");
#pragma unroll
            for (int m = 0; m < 4; ++m) { const size_t ro = (size_t)(wr * 64 + fr + ai * HALF + m * 16) * D + col0; float* rowp = xb + ro; const float* srcp = xs + ro;
#pragma unroll
                for (int bj = 0; bj < 2; ++bj)
#pragma unroll
                    for (int n = 0; n < 2; ++n) { float* xp = rowp + bj * HALF + n * 16; const f32x4 nv = *(const f32x4*)(srcp + bj * HALF + n * 16) + gv[bj][n] * acc[ai][bj][m][n]; if (!dry) *(f32x4*)xp = nv; } } }
    }
};
struct EpiSwiGLU {
    static constexpr bool PERM = false, AFTER_DRAIN = false, KHOOK = false;
    bf16_t* HB;
    __device__ __forceinline__ void operator()(const f32x4 (&acc)[2][2][4][2], const Unit& u, int wr, int wc, int fr, int fq) const {
        const int row0 = u.pm * BM + wr * 64 + fr, hh0 = u.pn * 128 + wc * 16 + 4 * fq;
#pragma unroll
        for (int ai = 0; ai < 2; ++ai)
#pragma unroll
            for (int m = 0; m < 4; ++m) { bf16_t* rowp = HB + (size_t)(row0 + ai * HALF + m * 16) * 512 + hh0;
#pragma unroll
                for (int bj = 0; bj < 2; ++bj) { const f32x4 g = acc[ai][bj][m][0], up = acc[ai][bj][m][1]; f32x4 h;
#pragma unroll
                    for (int i = 0; i < 4; ++i) h[i] = g[i] * __builtin_amdgcn_rcpf(1.f + __expf(-g[i])) * up[i];
                    u32x2 w; w.x = cvt_pk_bf16(h[0], h[1]); w.y = cvt_pk_bf16(h[2], h[3]); *(u32x2*)(rowp + bj * 64) = w; } }
    }
};
struct LatentOrder {
    StaticOrder S;
    __host__ __device__ void init(int N, int G_, int c_) { S.init(128 * BM, N, G_, c_); }
    __host__ __device__ bool next(int i, Unit& u) const { if (!S.next(i, u)) return false; u.pm = (u.pm >> 4) * 17 + 1 + (u.pm & 15); return true; }
    __device__ __forceinline__ void a_ready(const Unit&) const {}
    __device__ __forceinline__ void done(const Unit&) const {}
};
template <size_t ESTRIDE> struct MoeOrder {
    int G, c; const PG8_LAS int* tab;
    __device__ __forceinline__ bool next(int i, Unit& u) const {
        const long L = (long)i * G + c; if (L >= (long)tab[32 + MOE_NBLK] * 4) return false;
        u.pm = (int)(L >> 2); u.pn = (int)(L & 3); u.bofs = (size_t)tab[32 + u.pm] * ESTRIDE; return true; }
    __device__ __forceinline__ void a_ready(const Unit&) const {}
    __device__ __forceinline__ void done(const Unit&) const {}
};
}
#define PG8_SP2 true
#define PG8_ALIGN true
struct Frame {
    LAS unsigned char* lds; int tid, lane, wave, G, bid, gwave, nwave;
};
__device__ __forceinline__ bf16_t* WSB(const Params& p, size_t off) { return (bf16_t*)(p.ws + off); }
__device__ __forceinline__ float* WSF(const Params& p, size_t off) { return (float*)(p.ws + off); }

__device__ __forceinline__ void sincos_dd(double ang, float& c, float& s) {
    const double kf = __builtin_rint(ang * 0.63661977236758134308);
    const double r = (ang - kf * 1.57079632679489655800) - kf * 6.12323399573676603587e-17;
    const int k = ((int)kf) & 3;
    const double r2 = r * r;
    const double sp = r * (1.0 + r2 * (-1.0 / 6 + r2 * (1.0 / 120 + r2 * (-1.0 / 5040 + r2 * (1.0 / 362880 + r2 * (-1.0 / 39916800 + r2 * (1.0 / 6227020800.0)))))));
    const double cp = 1.0 + r2 * (-0.5 + r2 * (1.0 / 24 + r2 * (-1.0 / 720 + r2 * (1.0 / 40320 + r2 * (-1.0 / 3628800 + r2 * (1.0 / 479001600 + r2 * (-1.0 / 87178291200.0)))))));
    const double cc = (k == 0) ? cp : (k == 1) ? -sp : (k == 2) ? -cp : sp;
    const double ss = (k == 0) ? sp : (k == 1) ? cp : (k == 2) ? -sp : -cp;
    c = (float)cc; s = (float)ss;
}
__device__ __forceinline__ void p0_prologue(const Params& p, const Frame& F) {
    const int gt = F.bid * NTHREADS + F.tid, ngt = F.G * NTHREADS;
    { float* tab = WSF(p, WS_ROPE); const LAS Params* lpar = (const LAS Params*)(F.lds + (LDS_BYTES - 4096 + 2048));
      for (int i = gt; i < 64 * 16 + 64 * 32; i += ngt) {
          if (i < 1024) { const int pos = i >> 4, k = i & 15; float c, s; sincos_dd((double)pos * (double)lpar->invA[k], c, s); tab[i] = c; tab[1024 + i] = s; }
          else { const int j = i - 1024, pos = j >> 5, k = j & 31; float c, s; sincos_dd((double)pos * (double)lpar->invR[k], c, s); tab[2048 + j] = c; tab[2048 + 2048 + j] = s; } } }
    { float* rwt = WSF(p, WS_RWT);
      for (int i = gt; i < DEPTH * 36 * 1024; i += ngt) { const int l = i / (36 * 1024), r = i - l * 36 * 1024, o = r >> 10, k = r & 1023;
          rwt[i] = o < 4 ? p.in[I_RGW][((size_t)l * 1024 + k) * 4 + o] : p.in[I_REW][((size_t)l * 1024 + k) * 32 + (o - 4)]; } }
    { float* rw2 = WSF(p, WS_RW2);
      for (int i = gt; i < DEPTH * 64 * 3 * 4 * 16 * 4; i += ngt) { const int j = i & 3, n = (i >> 2) & 15, g = (i >> 6) & 3, r = i >> 8, nt = r % 3, r2 = r / 3, kq = r2 & 63, l = r2 >> 6;
          const int ng = 16 * nt + n, k = 4 * (4 * kq + j) + g;
          rw2[i] = ng < 4 ? p.in[I_RGW][((size_t)l * 1024 + k) * 4 + ng] : (ng < 36 ? p.in[I_REW][((size_t)l * 1024 + k) * 32 + (ng - 4)] : 0.f); } }
    { LAS float* cond = (LAS float*)F.lds;
      LAS float* red = (LAS float*)(F.lds + 9 * 1024 * 4);
      for (int i = F.tid; i < 9 * 1024; i += NTHREADS) { const float v = i < 8192 ? p.in[I_C][i] : p.in[I_CCTX][i - 8192]; cond[i] = siluf_(v); }
      __syncthreads();
      float* mod = WSF(p, WS_MOD);
      for (int task = F.bid; task < DEPTH * 96; task += F.G) {
          const int l = task / 96, col0 = (task - l * 96) * 64, c = F.tid & 63, ks = F.tid >> 6;
          const float* w = p.in[I_ADAW] + ((size_t)l * 1024 + ks * 128) * 6144 + col0 + c;
          float a[9];
#pragma unroll
          for (int r = 0; r < 9; ++r) a[r] = 0.f;
          for (int k = 0; k < 128; ++k) { const float wv = w[(size_t)k * 6144];
#pragma unroll
              for (int r = 0; r < 9; ++r) a[r] += cond[r * 1024 + ks * 128 + k] * wv; }
#pragma unroll
          for (int r = 0; r < 9; ++r) red[(ks * 9 + r) * 64 + c] = a[r];
          __syncthreads();
          for (int o = F.tid; o < 9 * 64; o += NTHREADS) { const int r = o >> 6, cc = o & 63; float s = 0.f;
#pragma unroll
              for (int k2 = 0; k2 < 8; ++k2) s += red[(k2 * 9 + r) * 64 + cc];
              mod[((size_t)l * 9 + r) * 6144 + col0 + cc] = s + p.in[I_ADAB][(size_t)l * 6144 + col0 + cc]; }
          __syncthreads();
      } }
}

__device__ __forceinline__ void cvt_tile(const float* src, int ld_src, bf16_t* dst, int ld_dst, int k0, int n0, LAS float* tile  , int tid) {
#pragma unroll
    for (int ps = 0; ps < 2; ++ps) { const int k = ps * 32 + (tid >> 4), n4 = (tid & 15) * 4;
        const f32x4 v = *(const f32x4*)(src + (size_t)(k0 + k) * ld_src + n0 + n4);
        tile[k * 65 + n4] = v[0]; tile[k * 65 + n4 + 1] = v[1]; tile[k * 65 + n4 + 2] = v[2]; tile[k * 65 + n4 + 3] = v[3]; }
    __syncthreads();
    { const int n = tid >> 3, k8 = (tid & 7) * 8; float x[8];
#pragma unroll
      for (int e = 0; e < 8; ++e) x[e] = tile[(k8 + e) * 65 + n];
      *(u32x4*)(dst + (size_t)(n0 + n) * ld_dst + k0 + k8) = pack8(x); }
    __syncthreads();
}

struct CvtTask { const float* src; bf16_t* dst; int ld_src, ld_dst, k0, n0, which; };
__device__ __forceinline__ void cvt_load(f32x4 (&v)[8], const CvtTask& c, int tid) {
#pragma unroll
    for (int ps = 0; ps < 8; ++ps) v[ps] = *(const f32x4*)(c.src + (size_t)(c.k0 + ps * 8 + (tid >> 6)) * c.ld_src + c.n0 + (tid & 63) * 4);
}
__device__ __forceinline__ void cvt_store(const f32x4 (&v)[8], const CvtTask& c, LAS float* tile  , int tid) {
#pragma unroll
    for (int ps = 0; ps < 8; ++ps) *(LAS f32x4*)(tile + (ps * 8 + (tid >> 6)) * 260 + (tid & 63) * 4) = v[ps];
    __syncthreads();
    { const int n = tid >> 1, kb = (tid & 1) * 32, nn = c.n0 + n; const int row = c.which < 0 ? nn : ((nn >> 4) << 5) + (c.which << 4) + (nn & 15);
      bf16_t* d = c.dst + (size_t)row * c.ld_dst + c.k0 + kb;
#pragma unroll
      for (int q = 0; q < 4; ++q) { float x[8];
#pragma unroll
          for (int e = 0; e < 8; ++e) x[e] = tile[(kb + q * 8 + e) * 260 + n];
          *(u32x4*)(d + q * 8) = pack8(x); } }
    __syncthreads();
}
constexpr int NT_MIX = 16 * 30 + 3 * 8 * 4 + 16 * 4;
__device__ __forceinline__ CvtTask cvt_task_mix(const Params& p, int l, int t) {
    CvtTask c; c.which = -1;
    if (t < 480) { const int kt = t / 30, nt = t - kt * 30; c.src = p.in[I_WIN] + (size_t)l * 1024 * 7680; c.ld_src = 7680; c.dst = WSB(p, WS_BTIN); c.ld_dst = 1024; c.k0 = kt * 64; c.n0 = nt * 256; }
    else if (t < 576) { const int u = t - 480, nb = u >> 5, r = u & 31, kt = r >> 2, nt = r & 3;
        c.src = p.in[I_WBR] + ((size_t)l * 3 + nb) * 512 * 1024; c.ld_src = 1024; c.dst = WSB(p, WS_BTBR) + nb * 512; c.ld_dst = 1536; c.k0 = kt * 64; c.n0 = nt * 256; }
    else { const int u = t - 576, kt = u >> 2, nt = u & 3; c.src = p.in[I_WOUT] + (size_t)l * 1024 * 1024; c.ld_src = 1024; c.dst = WSB(p, WS_BTOUT); c.ld_dst = 1024; c.k0 = kt * 64; c.n0 = nt * 256; }
    return c;
}
constexpr int NT_MOE = 32 * 2 * 16 * 2 + 32 * 8 * 4;
__device__ __forceinline__ CvtTask cvt_task_moe(const Params& p, int l, int t) {
    CvtTask c;
    if (t < 2048) { const int e = t >> 6, r = t & 63, which = r >> 5, kt = (r >> 1) & 15, nt = r & 1;
        c.src = (which ? p.in[I_MUP] : p.in[I_MG]) + ((size_t)l * 32 + e) * 1024 * 512; c.ld_src = 512; c.dst = WSB(p, WS_BT1) + (size_t)e * 1024 * 1024; c.ld_dst = 1024; c.k0 = kt * 64; c.n0 = nt * 256; c.which = which; }
    else { const int u = t - 2048, e = u >> 5, r = u & 31, kt = r >> 2, nt = r & 3;
        c.src = p.in[I_MD] + ((size_t)l * 32 + e) * 512 * 1024; c.ld_src = 1024; c.dst = WSB(p, WS_BT2) + (size_t)e * 1024 * 512; c.ld_dst = 512; c.k0 = kt * 64; c.n0 = nt * 256; c.which = -1; }
    return c;
}
template <bool MOE> __device__ __forceinline__ void cvt_run(const Params& p, const Frame& F, int l, LAS float* tile, int first_blk = 0, int t_lo = 0, int t_hi = -1) {
    const int NTASK = t_hi >= 0 ? t_hi : (MOE ? NT_MOE : NT_MIX);
    if (F.bid < first_blk) return;
    const int stride = F.G - first_blk;
    int t = t_lo + F.bid - first_blk; if (t >= NTASK) return;
    CvtTask cur = MOE ? cvt_task_moe(p, l, t) : cvt_task_mix(p, l, t);
    f32x4 v[8]; cvt_load(v, cur, F.tid);
    for (;;) {
        const int tn = t + stride; const bool more = tn < NTASK;
        CvtTask nx = cur; f32x4 vn[8];
        if (more) { nx = MOE ? cvt_task_moe(p, l, tn) : cvt_task_mix(p, l, tn); cvt_load(vn, nx, F.tid); }
        cvt_store(v, cur, tile, F.tid);
        if (!more) break;
#pragma unroll
        for (int i = 0; i < 8; ++i) v[i] = vn[i];
        cur = nx; t = tn;
    }
}

__device__ __forceinline__ void rmsnorm_mod_row(const float* x, const float* g, const float* sc, const float* sh, bf16_t* o, int lane, float* keep  ) {
    f32x4 v[4]; float ss = 0.f;
#pragma unroll
    for (int j = 0; j < 4; ++j) { v[j] = *(const f32x4*)(x + j * 256 + lane * 4); ss += v[j][0] * v[j][0] + v[j][1] * v[j][1] + v[j][2] * v[j][2] + v[j][3] * v[j][3]; }
#pragma unroll
    for (int m = 1; m < 64; m <<= 1) ss += shfl_xor_f(ss, m);
    const float rs = rsqrtf(ss * (1.f / 1024.f) + 1e-6f);
#pragma unroll
    for (int j = 0; j < 4; ++j) { const int c = j * 256 + lane * 4;
        const f32x4 gg = *(const f32x4*)(g + c), s1 = *(const f32x4*)(sc + c), s0 = *(const f32x4*)(sh + c);
        f32x4 y;
#pragma unroll
        for (int e = 0; e < 4; ++e) y[e] = v[j][e] * rs * gg[e] * (1.f + s1[e]) + s0[e];
        u32x2 w; w.x = pk2(y[0], y[1]); w.y = pk2(y[2], y[3]); *(u32x2*)(o + c) = w;
        if (keep) { keep[j * 4 + 0] = y[0]; keep[j * 4 + 1] = y[1]; keep[j * 4 + 2] = y[2]; keep[j * 4 + 3] = y[3]; } }
}
__device__ __forceinline__ void p1_weights(const Params& p, const Frame& F, int l, bool early_done = false) {
    LAS float* tile = (LAS float*)F.lds;
    cvt_run<false>(p, F, l, tile, 0, early_done ? 576 : 0);
    if (F.bid < 9) { const float* sh2 = WSF(p, WS_MOD) + ((size_t)l * 9 + F.bid) * 6144 + 3072; const float* rwt = WSF(p, WS_RWT) + (size_t)l * 36 * 1024; float* rc = WSF(p, WS_RC) + ((size_t)l * 9 + F.bid) * 48;
        for (int n = F.wave; n < 48; n += NWAVES) { float a = 0.f;
            if (n < 36) {
#pragma unroll
                for (int j = 0; j < 4; ++j) { const f32x4 sv = *(const f32x4*)(sh2 + j * 256 + F.lane * 4), wv = *(const f32x4*)(rwt + n * 1024 + j * 256 + F.lane * 4); a += sv[0] * wv[0] + sv[1] * wv[1] + sv[2] * wv[2] + sv[3] * wv[3]; }
#pragma unroll
                for (int mk = 1; mk < 64; mk <<= 1) a += shfl_xor_f(a, mk);
                a += n < 4 ? p.in[I_RGB][l * 4 + n] : p.in[I_REB][l * 32 + n - 4]; }
            if (F.lane == 0) rc[n] = a; } }
    { bf16_t* bl = WSB(p, WS_BTLORA); const int gt = F.bid * NTHREADS + F.tid, ngt = F.G * NTHREADS;
      for (int i = gt; i < 2560 * 256; i += ngt) { const int k = i / 2560, row = i - k * 2560;
          float v = 0.f;
          if (row < 1024) { if (k < 64) { const int d = row >> 9, c = row & 511; v = p.in[I_W2][(((size_t)l * 2 + d) * 64 + k) * 512 + c]; } }
          else if (row < 2048) { if (k >= 64 && k < 128) { const int r2 = row - 1024, d = r2 >> 9, c = r2 & 511; v = p.in[I_A2][(((size_t)l * 2 + d) * 64 + (k - 64)) * 512 + c]; } }
          else { if (k >= 128) { const int c = row - 2048; v = p.in[I_G2][((size_t)l * 128 + (k - 128)) * 512 + c]; } }
          bl[(size_t)row * 256 + k] = (bf16_t)f2bf(v); } }
}
__device__ __forceinline__ void p1_cvt_norm1(const Params& p, const Frame& F, int l) {
    p1_weights(p, F, l);
    { const float* mod = WSF(p, WS_MOD) + (size_t)l * 9 * 6144; bf16_t* H = WSB(p, WS_H);
      for (int row = F.gwave; row < T; row += F.nwave) { const int b = row / NP, q = row - b * NP; const float* mr = mod + (size_t)(q < NCTX ? 8 : b) * 6144;
          const float* xin = q < NCTX ? p.in[I_CTX] + (size_t)(b * NCTX + q) * D : p.in[I_X] + (size_t)(b * NLAT + (q - NCTX)) * D;
          rmsnorm_mod_row(xin, p.in[I_N1G] + (size_t)l * 1024, mr + 1024, mr, H + (size_t)row * 1024, F.lane, nullptr); } }
}

__device__ __forceinline__ void p3_prep(const Params& p, const Frame& F, int l) {
    const float* tab = WSF(p, WS_ROPE);
    const float* cosA = tab, *sinA = tab + 1024, *cosR = tab + 2048, *sinR = tab + 4096;
    bf16_t* AQ = WSB(p, WS_AQ); bf16_t* AKV = WSB(p, WS_AKV); bf16_t* RQ = WSB(p, WS_RQ); bf16_t* RK = WSB(p, WS_RK);
    const bf16_t* WU = WSB(p, WS_WU); bf16_t* AL_ = WSB(p, WS_H);
    const int lane = F.lane;
    const float* qng = p.in[I_QNG] + l * 64, *kng = p.in[I_KNG] + l * 64;
    const float* mu0 = p.in[I_MU] + (size_t)l * 2 * 1792, *mu1 = mu0 + 1792;
    for (int row = F.gwave; row < T; row += F.nwave) {
        const int b = row / NP, q = row - b * NP; const bool lat = q >= NCTX; const int t = q - NCTX, prow = t >> 6, pcol = t & 63;
        const u32x4 raw_aq = *(const u32x4*)(AQ + (size_t)row * 512 + lane * 8), raw_ak = *(const u32x4*)(AKV + (size_t)row * 256 + (lane & 15) * 8);
        const u32x4 raw_rq = *(const u32x4*)(RQ + (size_t)row * 512 + lane * 8), raw_rk = *(const u32x4*)(RK + (size_t)row * 512 + lane * 8);
        const bool hasp = (q != 0) && (q != NCTX), hasn = (q != NCTX - 1) && (q != NP - 1);
        const int cw = 1536 + lane * 4;
        const u32x2 cu = *(const u32x2*)(WU + (size_t)row * 1792 + cw);
        u32x2 pu; pu.x = 0u; pu.y = 0u; u32x2 nu = pu;
        if (hasp) pu = *(const u32x2*)(WU + (size_t)(row - 1) * 1792 + cw);
        if (hasn) nu = *(const u32x2*)(WU + (size_t)(row + 1) * 1792 + cw);
        { const int sub = lane & 7, a = sub >> 2, half = (sub >> 1) & 1, ib = (sub & 1) * 8, pos = lat ? (a ? pcol : prow) : 0;
          float cA[8], sA[8];
          *(f32x4*)cA = *(const f32x4*)(cosA + pos * 16 + ib); *(f32x4*)(cA + 4) = *(const f32x4*)(cosA + pos * 16 + ib + 4);
          *(f32x4*)sA = *(const f32x4*)(sinA + pos * 16 + ib); *(f32x4*)(sA + 4) = *(const f32x4*)(sinA + pos * 16 + ib + 4);
          { float x[8]; unpack8(raw_aq, x);
            float ss = 0.f;
#pragma unroll
            for (int e = 0; e < 8; ++e) ss += x[e] * x[e];
            ss += shfl_xor_f(ss, 1); ss += shfl_xor_f(ss, 2); ss += shfl_xor_f(ss, 4);
            const float rs = rsqrtf(ss * (1.f / 64.f) + 1e-6f);
            float gq[8]; *(f32x4*)gq = *(const f32x4*)(qng + sub * 8); *(f32x4*)(gq + 4) = *(const f32x4*)(qng + sub * 8 + 4);
#pragma unroll
            for (int e = 0; e < 8; ++e) x[e] = x[e] * rs * gq[e];
            float y[8];
#pragma unroll
            for (int e = 0; e < 8; ++e) { const float o = shfl_xor_f(x[e], 2);
                if (lat) { const float c = cA[e], s = sA[e]; y[e] = half ? (x[e] * c + o * s) : (x[e] * c - o * s); } else y[e] = x[e];
                y[e] *= 0.18033688011112042f; }
            if (!p.dry) *(u32x4*)(AQ + (size_t)row * 512 + lane * 8) = pack8(y); }
          { const int lk = lane & 15; float x[8]; unpack8(raw_ak, x);
            float ss = 0.f;
#pragma unroll
            for (int e = 0; e < 8; ++e) ss += x[e] * x[e];
            ss += shfl_xor_f(ss, 1); ss += shfl_xor_f(ss, 2); ss += shfl_xor_f(ss, 4);
            const float rs = rsqrtf(ss * (1.f / 64.f) + 1e-6f);
            float gk[8]; *(f32x4*)gk = *(const f32x4*)(kng + sub * 8); *(f32x4*)(gk + 4) = *(const f32x4*)(kng + sub * 8 + 4);
#pragma unroll
            for (int e = 0; e < 8; ++e) x[e] = x[e] * rs * gk[e];
            float y[8];
#pragma unroll
            for (int e = 0; e < 8; ++e) { const float o = shfl_xor_f(x[e], 2);
                if (lat) { const float c = cA[e], s = sA[e]; y[e] = half ? (x[e] * c + o * s) : (x[e] * c - o * s); } else y[e] = x[e]; }
            if (lane < 16 && !p.dry) *(u32x4*)(AKV + (size_t)row * 256 + lk * 8) = pack8(y); } }
        { const int sub = lane & 15, a = sub >> 3, half = (sub >> 2) & 1, ib = (sub & 3) * 8, pos = lat ? (a ? pcol : prow) : 0;
          float cR[8], sR[8];
          *(f32x4*)cR = *(const f32x4*)(cosR + pos * 32 + ib); *(f32x4*)(cR + 4) = *(const f32x4*)(cosR + pos * 32 + ib + 4);
          *(f32x4*)sR = *(const f32x4*)(sinR + pos * 32 + ib); *(f32x4*)(sR + 4) = *(const f32x4*)(sinR + pos * 32 + ib + 4);
#pragma unroll
          for (int which = 0; which < 2; ++which) { bf16_t* buf = which ? RK : RQ;
            float x[8]; unpack8(which ? raw_rk : raw_rq, x); float y[8];
#pragma unroll
            for (int e = 0; e < 8; ++e) { const float o = shfl_xor_f(x[e], 4);
                if (lat) { const float c = cR[e], s = sR[e]; y[e] = half ? (x[e] * c + o * s) : (x[e] * c - o * s); } else y[e] = x[e];
                if (which) y[e] *= 0.08838834764831845f; }
            if (!p.dry) *(u32x4*)(buf + (size_t)row * 512 + lane * 8) = pack8(y); } }
        { const int c = cw;
          const float uc[4] = {lo16(cu.x), hi16(cu.x), lo16(cu.y), hi16(cu.y)}, up[4] = {lo16(pu.x), hi16(pu.x), lo16(pu.y), hi16(pu.y)}, un[4] = {lo16(nu.x), hi16(nu.x), lo16(nu.y), hi16(nu.y)};
          float y[4]; const f32x4 m0v = *(const f32x4*)(mu0 + c), m1v = *(const f32x4*)(mu1 + c);
#pragma unroll
          for (int e = 0; e < 4; ++e) { const float xs = uc[e] + (up[e] - uc[e]) * m0v[e] + (un[e] - uc[e]) * m1v[e];
              if (lane < 16) { const float ex = __expf(2.f * xs); y[e] = 1.f - 2.f * frcp(ex + 1.f); }
              else if (lane < 32) y[e] = xs;
              else y[e] = sigmoidf_(xs); }
          u32x2 w; w.x = pk2(y[0], y[1]); w.y = pk2(y[2], y[3]); *(u32x2*)(AL_ + (size_t)row * 256 + lane * 4) = w; }
    }
}

__device__ __forceinline__ void p5_rwkv_tok(const Params& p, const Frame& F, int l) {
    const bf16_t* WU = WSB(p, WS_WU); const bf16_t* LW = WSB(p, WS_LW); const bf16_t* LA = WSB(p, WS_LA);
    bf16_t* RS = WSB(p, WS_W1); bf16_t* VS = RS + (size_t)T * 512; bf16_t* KKS = VS + (size_t)T * 512;
    const int lane = F.lane, c0 = lane * 8;
    const float* mu0 = p.in[I_MU] + (size_t)l * 2 * 1792, *mu1 = mu0 + 1792;
    const float* k_k = p.in[I_KK] + l * 512, *k_a = p.in[I_KA] + l * 512;
    for (int row = F.gwave; row < T; row += F.nwave) {
        const int b = row / NP, q = row - b * NP;
        const bool hasp = (q != 0) && (q != NCTX), hasn = (q != NCTX - 1) && (q != NP - 1);
        float sh[3][8];
#pragma unroll
        for (int part = 0; part < 3; ++part) { const int c = part * 512 + c0;
            const u32x4 cu = *(const u32x4*)(WU + (size_t)row * 1792 + c);
            u32x4 pu; pu.x = pu.y = pu.z = pu.w = 0u; u32x4 nu = pu;
            if (hasp) pu = *(const u32x4*)(WU + (size_t)(row - 1) * 1792 + c);
            if (hasn) nu = *(const u32x4*)(WU + (size_t)(row + 1) * 1792 + c);
            float uc[8], up[8], un[8]; unpack8(cu, uc); unpack8(pu, up); unpack8(nu, un);
#pragma unroll
            for (int e = 0; e < 8; ++e) sh[part][e] = uc[e] + (up[e] - uc[e]) * mu0[c + e] + (un[e] - uc[e]) * mu1[c + e]; }
        float kk[8]; float ss = 0.f;
#pragma unroll
        for (int e = 0; e < 8; ++e) { kk[e] = sh[1][e] * k_k[c0 + e]; ss += kk[e] * kk[e]; }
        ss += shfl_xor_f(ss, 1); ss += shfl_xor_f(ss, 2); ss += shfl_xor_f(ss, 4);
        const float rn = rsqrtf(fmaxf(ss, 1e-12f));
#pragma unroll
        for (int e = 0; e < 8; ++e) kk[e] *= rn;
        u32x4 lw_raw[2], la_raw[2];
#pragma unroll
        for (int d = 0; d < 2; ++d) { lw_raw[d] = *(const u32x4*)(LW + (size_t)row * 1024 + d * 512 + c0); la_raw[d] = *(const u32x4*)(LA + (size_t)row * 1024 + d * 512 + c0); }
        *(u32x4*)(RS + (size_t)row * 512 + c0) = pack8(sh[0]);
        *(u32x4*)(VS + (size_t)row * 512 + c0) = pack8(sh[2]);
        *(u32x4*)(KKS + (size_t)row * 512 + c0) = pack8(kk);
#pragma unroll
        for (int d = 0; d < 2; ++d) {
            _Float16* LOGW = (_Float16*)(p.ws + WS_W1 + (size_t)(3 + 3 * d) * SZ512); bf16_t* KR = WSB(p, WS_W1 + (size_t)(4 + 3 * d) * SZ512); bf16_t* BB = WSB(p, WS_W1 + (size_t)(5 + 3 * d) * SZ512);
            const float* w0 = p.in[I_W0] + ((size_t)l * 2 + d) * 512, *a0 = p.in[I_A0] + ((size_t)l * 2 + d) * 512;
            float lw[8], la[8]; unpack8(lw_raw[d], lw); unpack8(la_raw[d], la);
            float kr[8], bb[8]; typedef _Float16 h8 __attribute__((ext_vector_type(8))); h8 lg;
#pragma unroll
            for (int e = 0; e < 8; ++e) { const float a = sigmoidf_(a0[c0 + e] + la[e]);
                lg[e] = (_Float16)(-0.6065306597126334f * sigmoidf_(w0[c0 + e] + lw[e]));
                kr[e] = sh[1][e] * (1.f + (a - 1.f) * k_a[c0 + e]); bb[e] = kk[e] * a; }
            *(h8*)(LOGW + (size_t)row * 512 + c0) = lg;
            *(u32x4*)(KR + (size_t)row * 512 + c0) = pack8(kr);
            *(u32x4*)(BB + (size_t)row * 512 + c0) = pack8(bb); }
    }
}
__device__ __forceinline__ float reduce8(float (&v)[8], int lane) {
    float a[4];
#pragma unroll
    for (int k = 0; k < 4; ++k) { const bool up = (lane & 32) != 0; const float send = up ? v[k] : v[k + 4], keep = up ? v[k + 4] : v[k]; a[k] = keep + __shfl_xor(send, 32, 64); }
    float b[2];
#pragma unroll
    for (int k = 0; k < 2; ++k) { const bool up = (lane & 16) != 0; const float send = up ? a[k] : a[k + 2], keep = up ? a[k + 2] : a[k]; b[k] = keep + __shfl_xor(send, 16, 64); }
    float c; { const bool up = (lane & 8) != 0; const float send = up ? b[0] : b[1], keep = up ? b[1] : b[0]; c = keep + __shfl_xor(send, 8, 64); }
    c += __shfl_xor(c, 4, 64); c += __shfl_xor(c, 2, 64); c += __shfl_xor(c, 1, 64);
    return c;
}
__device__ __forceinline__ void p6_rwkv_scan_naive(const Params& p, const Frame& F, int l) {
    (void)l;
    LAS float* L_r = (LAS float*)F.lds;
    LAS float* L_w = L_r + 4096; LAS float* L_k = L_w + 4096; LAS float* L_v = L_k + 4096; LAS float* L_a = L_v + 4096; LAS float* L_b = L_a + 4096; LAS float* L_y = L_b + 4096;
    const bf16_t* RS = WSB(p, WS_W1); const bf16_t* VS = RS + (size_t)T * 512; const bf16_t* KKS = VS + (size_t)T * 512;
    const int lane = F.lane, w = F.wave, tid = F.tid;
    for (int task = F.bid; task < NB * 8 * 2; task += F.G) {
        const int dir = task & 1, h = (task >> 1) & 7, b = task >> 4;
        const _Float16* LOGW = (const _Float16*)(p.ws + WS_W1 + (size_t)(3 + 3 * dir) * SZ512); const bf16_t* KR = WSB(p, WS_W1 + (size_t)(4 + 3 * dir) * SZ512); const bf16_t* BB = WSB(p, WS_W1 + (size_t)(5 + 3 * dir) * SZ512);
        bf16_t* YS = WSB(p, WS_YS) + (size_t)dir * T * 512;
        float S[8];
#pragma unroll
        for (int i = 0; i < 8; ++i) S[i] = 0.f;
        for (int s0 = 0; s0 < NP; s0 += 64) {
            { const int st = tid >> 3, c8 = (tid & 7) * 8, s = s0 + st; const int q = dir ? (s < NCTX ? NCTX - 1 - s : NP + NCTX - 1 - s) : s;
              const size_t off = ((size_t)(b * NP + q)) * 512 + h * 64 + c8;
              float x[8];
              unpack8(*(const u32x4*)(RS + off), x);
#pragma unroll
              for (int e = 0; e < 8; ++e) L_r[st * 64 + c8 + e] = x[e];
              unpack8(*(const u32x4*)(VS + off), x);
#pragma unroll
              for (int e = 0; e < 8; ++e) L_v[st * 64 + c8 + e] = x[e];
              unpack8(*(const u32x4*)(KKS + off), x);
#pragma unroll
              for (int e = 0; e < 8; ++e) L_a[st * 64 + c8 + e] = -x[e];
              unpack8(*(const u32x4*)(KR + off), x);
#pragma unroll
              for (int e = 0; e < 8; ++e) L_k[st * 64 + c8 + e] = x[e];
              unpack8(*(const u32x4*)(BB + off), x);
#pragma unroll
              for (int e = 0; e < 8; ++e) L_b[st * 64 + c8 + e] = x[e];
              typedef _Float16 h8 __attribute__((ext_vector_type(8))); const h8 lg = *(const h8*)(LOGW + off);
#pragma unroll
              for (int e = 0; e < 8; ++e) L_w[st * 64 + c8 + e] = __expf((float)lg[e]); }
            __syncthreads();
            for (int st = 0; st < 64; ++st) {
                const float rj = L_r[st * 64 + lane], wj = L_w[st * 64 + lane], kj = L_k[st * 64 + lane], aj = L_a[st * 64 + lane], bj = L_b[st * 64 + lane];
                float pa[8];
#pragma unroll
                for (int i = 0; i < 8; ++i) pa[i] = S[i] * aj;
                const float tot = reduce8(pa, lane);
                float py[8];
#pragma unroll
                for (int i = 0; i < 8; ++i) { const float sa = __shfl(tot, i * 8, 64); const float vi = L_v[st * 64 + w * 8 + i];
                    S[i] = S[i] * wj + sa * bj + vi * kj; py[i] = S[i] * rj; }
                const float ty = reduce8(py, lane);
                if ((lane & 7) == 0) L_y[st * 64 + w * 8 + (lane >> 3)] = ty;
            }
            __syncthreads();
            { const int st = tid >> 3, c8 = (tid & 7) * 8, s = s0 + st; const int q = dir ? (s < NCTX ? NCTX - 1 - s : NP + NCTX - 1 - s) : s;
              float y[8];
#pragma unroll
              for (int e = 0; e < 8; ++e) y[e] = L_y[st * 64 + c8 + e];
              *(u32x4*)(YS + ((size_t)(b * NP + q)) * 512 + h * 64 + c8) = pack8(y); }
            __syncthreads();
        }
    }
}

__device__ __forceinline__ void p7_rwkv_readout(const Params& p, const Frame& F, int l);
constexpr int RPITCH_TR = 288;
constexpr int RPITCH_ROW = 272;
__device__ __forceinline__ float log_gamma_of(const Params& p, int l, int dir, int h) {
    const float x = p.in[I_RDL][(l * 2 + dir) * 4 + h];
    return -log1pf(__expf(-x));
}
__device__ __forceinline__ void p8_ret_kv(const Params& p, const Frame& F, int l) {
    const bf16_t* RK = WSB(p, WS_RK); const bf16_t* RV = WSB(p, WS_RV);
    bf16_t* SF = WSB(p, WS_SF); bf16_t* SB = WSB(p, WS_SB);
    LAS unsigned char* Lv = F.lds; LAS unsigned char* Lkf = F.lds + 128 * RPITCH_TR; LAS unsigned char* Lkb = F.lds + 2 * 128 * RPITCH_TR;
    const int lane = F.lane, w = F.wave, tid = F.tid, g = lane >> 4, li = lane & 15, q4 = li >> 2, p4 = li & 3;
    for (int u = F.bid; u < NB * 4 * 34; u += F.G) {
        const int c = u % 34, bh = u / 34, h = bh & 3, b = bh >> 2;
        const float lgf = log_gamma_of(p, l, 0, h) * 1.4426950408889634f, lgb = log_gamma_of(p, l, 1, h) * 1.4426950408889634f;
#pragma unroll
        for (int it = 0; it < 4; ++it) { const int idx = it * NTHREADS + tid, j = idx >> 4, c8 = (idx & 15) * 8;
            const size_t off = ((size_t)(b * NP + c * 128 + j)) * 512 + h * 128 + c8;
            const u32x4 vv = *(const u32x4*)(RV + off); *(LAS u32x4*)(Lv + j * RPITCH_TR + c8 * 2) = vv;
            float x[8]; unpack8(*(const u32x4*)(RK + off), x);
            const float sf = exp2f(lgf * (float)(127 - j)), sb = exp2f(lgb * (float)j);
            float xf[8], xb[8];
#pragma unroll
            for (int e = 0; e < 8; ++e) { xf[e] = x[e] * sf; xb[e] = x[e] * sb; }
            *(LAS u32x4*)(Lkf + j * RPITCH_TR + c8 * 2) = pack8(xf); *(LAS u32x4*)(Lkb + j * RPITCH_TR + c8 * 2) = pack8(xb); }
        __syncthreads();
        const int dir = w >> 2, e0 = (w & 3) * 32;
        LAS unsigned char* Lk = dir ? Lkb : Lkf;
        f32x4 acc[2][8];
#pragma unroll
        for (int et = 0; et < 2; ++et)
#pragma unroll
            for (int dt = 0; dt < 8; ++dt) acc[et][dt] = (f32x4){0.f, 0.f, 0.f, 0.f};
        const LAS unsigned char* vbase = Lv; const LAS unsigned char* kbase = Lk;
#pragma unroll 1
        for (int ks = 0; ks < 4; ++ks) {
            const int r0 = 32 * ks + 8 * g;
            bf16x8 af[2];
#pragma unroll
            for (int et = 0; et < 2; ++et) { const int col = e0 + 16 * et + 4 * p4;
                af[et] = cat44(tr_read(vbase + (r0 + q4) * RPITCH_TR + col * 2), tr_read(vbase + (r0 + 4 + q4) * RPITCH_TR + col * 2)); }
#pragma unroll
            for (int dt = 0; dt < 8; ++dt) { const int col = 16 * dt + 4 * p4;
                const bf16x8 bfr = cat44(tr_read(kbase + (r0 + q4) * RPITCH_TR + col * 2), tr_read(kbase + (r0 + 4 + q4) * RPITCH_TR + col * 2));
#pragma unroll
                for (int et = 0; et < 2; ++et) acc[et][dt] = MFMA16(af[et], bfr, acc[et][dt]); }
        }
        bf16_t* dst = (dir ? SB : SF) + (size_t)u * 16384;
#pragma unroll
        for (int et = 0; et < 2; ++et)
#pragma unroll
            for (int dt = 0; dt < 8; ++dt)
#pragma unroll
                for (int r = 0; r < 4; ++r) dst[(size_t)(e0 + 16 * et + 4 * g + r) * 128 + 16 * dt + li] = (bf16_t)f2bf(acc[et][dt][r]);
        __syncthreads();
    }
}
__device__ __forceinline__ void p9_ret_scan(const Params& p, const Frame& F, int l) {
    unsigned* SF = (unsigned*)(p.ws + WS_SF); unsigned* SB = (unsigned*)(p.ws + WS_SB);
    const int gt = F.bid * NTHREADS + F.tid, ngt = F.G * NTHREADS;
    for (int i = gt; i < 2 * NB * 4 * 8192; i += ngt) {
        const int dir = i / (NB * 4 * 8192), r = i - dir * (NB * 4 * 8192), bh = r >> 13, el = r & 8191, h = bh & 3;
        const float gC = __expf(128.f * log_gamma_of(p, l, dir, h));
        unsigned* base = (dir ? SB : SF) + (size_t)bh * 34 * 8192 + el;
        float s0 = 0.f, s1 = 0.f;
        for (int k = 0; k < 34; ++k) { const int c = dir ? (k < 2 ? 1 - k : 35 - k) : k;
            const unsigned kv = base[(size_t)c * 8192]; if (!p.dry) base[(size_t)c * 8192] = pk2(s0, s1); s0 = gC * s0 + lo16(kv); s1 = gC * s1 + hi16(kv); }
    }
}
__device__ __forceinline__ void p10_ret_out(const Params& p, const Frame& F, int l, bool want_ctx) {
    const bf16_t* RQ = WSB(p, WS_RQ); const bf16_t* RK = WSB(p, WS_RK); const bf16_t* RV = WSB(p, WS_RV); const bf16_t* RG = WSB(p, WS_RG); bf16_t* YR = WSB(p, WS_WU) + 512;
    const bf16_t* SF = WSB(p, WS_SF); const bf16_t* SB = WSB(p, WS_SB);
    LAS unsigned char* Lq = F.lds; LAS unsigned char* Lk = Lq + 128 * RPITCH_ROW; LAS unsigned char* Lv = Lk + 128 * RPITCH_ROW; LAS unsigned char* Ls = Lv + 128 * RPITCH_TR;
    const int lane = F.lane, w = F.wave, tid = F.tid, g = lane >> 4, li = lane & 15, q4 = li >> 2, p4 = li & 3;
    const float* gn = p.in[I_RGN] + l * 512;
    for (int u = F.bid; u < NB * 4 * 34; u += F.G) {
        const int c = u % 34, bh = u / 34, h = bh & 3, b = bh >> 2;
        if (c < 2 && !want_ctx) continue;
        const float lgf = log_gamma_of(p, l, 0, h) * 1.4426950408889634f, lgb = log_gamma_of(p, l, 1, h) * 1.4426950408889634f;
        const size_t row0 = (size_t)(b * NP + c * 128);
#pragma unroll
        for (int it = 0; it < 4; ++it) { const int idx = it * NTHREADS + tid, j = idx >> 4, c8 = (idx & 15) * 8;
            const size_t off = (row0 + j) * 512 + h * 128 + c8;
            *(LAS u32x4*)(Lq + j * RPITCH_ROW + c8 * 2) = *(const u32x4*)(RQ + off);
            *(LAS u32x4*)(Lk + j * RPITCH_ROW + c8 * 2) = *(const u32x4*)(RK + off);
            *(LAS u32x4*)(Lv + j * RPITCH_TR + c8 * 2) = *(const u32x4*)(RV + off);
            *(LAS u32x4*)(Ls + j * RPITCH_ROW + c8 * 2) = *(const u32x4*)(SF + (size_t)u * 16384 + j * 128 + c8); }
        __syncthreads();
        const int il = 16 * w + li;
        bf16x8 qf[4];
#pragma unroll
        for (int ks = 0; ks < 4; ++ks) qf[ks] = ld_frag(Lq + il * RPITCH_ROW + (32 * ks + 8 * g) * 2);
        f32x4 sc[8];
#pragma unroll
        for (int jt = 0; jt < 8; ++jt) { sc[jt] = (f32x4){0.f, 0.f, 0.f, 0.f};
#pragma unroll
            for (int ks = 0; ks < 4; ++ks) sc[jt] = MFMA16(ld_frag(Lk + (16 * jt + li) * RPITCH_ROW + (32 * ks + 8 * g) * 2), qf[ks], sc[jt]); }
#pragma unroll
        for (int jt = 0; jt < 8; ++jt)
#pragma unroll
            for (int r = 0; r < 4; ++r) { const int j = 16 * jt + 4 * g + r, dl = il - j;
                const float f = dl > 0 ? __builtin_amdgcn_exp2f(lgf * (float)dl) : (dl < 0 ? __builtin_amdgcn_exp2f(lgb * (float)(-dl)) : 2.f);
                sc[jt][r] *= f; }
        f32x4 y[8];
#pragma unroll
        for (int et = 0; et < 8; ++et) y[et] = (f32x4){0.f, 0.f, 0.f, 0.f};
        const LAS unsigned char* vbase = Lv;
#pragma unroll
        for (int ks = 0; ks < 4; ++ks) {
            const bf16x8 pf = pack_frag(sc[2 * ks], sc[2 * ks + 1]);
#pragma unroll
            for (int et = 0; et < 8; ++et) { const int col = 16 * et + 4 * p4;
                const bf16x8 vf = cat44(tr_read(vbase + (32 * ks + 4 * g + q4) * RPITCH_TR + col * 2), tr_read(vbase + (32 * ks + 16 + 4 * g + q4) * RPITCH_TR + col * 2));
                y[et] = MFMA16(vf, pf, y[et]); }
        }
        { f32x4 z[8]; const float sf = exp2f(lgf * (float)(il + 1));
#pragma unroll
          for (int et = 0; et < 8; ++et) { z[et] = (f32x4){0.f, 0.f, 0.f, 0.f};
#pragma unroll
              for (int ks = 0; ks < 4; ++ks) z[et] = MFMA16(ld_frag(Ls + (16 * et + li) * RPITCH_ROW + (32 * ks + 8 * g) * 2), qf[ks], z[et]);
              y[et] = y[et] + z[et] * sf; } }
        __syncthreads();
#pragma unroll
        for (int it = 0; it < 4; ++it) { const int idx = it * NTHREADS + tid, j = idx >> 4, c8 = (idx & 15) * 8;
            *(LAS u32x4*)(Ls + j * RPITCH_ROW + c8 * 2) = *(const u32x4*)(SB + (size_t)u * 16384 + j * 128 + c8); }
        __syncthreads();
        { f32x4 z[8]; const float sb = exp2f(lgb * (float)(128 - il));
#pragma unroll
          for (int et = 0; et < 8; ++et) { z[et] = (f32x4){0.f, 0.f, 0.f, 0.f};
#pragma unroll
              for (int ks = 0; ks < 4; ++ks) z[et] = MFMA16(ld_frag(Ls + (16 * et + li) * RPITCH_ROW + (32 * ks + 8 * g) * 2), qf[ks], z[et]);
              y[et] = y[et] + z[et] * sb; } }
        float ss = 0.f;
#pragma unroll
        for (int et = 0; et < 8; ++et)
#pragma unroll
            for (int r = 0; r < 4; ++r) ss += y[et][r] * y[et][r];
        ss += shfl_xor_f(ss, 16); ss += shfl_xor_f(ss, 32);
        const float rs = rsqrtf(ss * (1.f / 128.f) + 1e-6f);
        const size_t orow = (row0 + il) * 512 + h * 128;
#pragma unroll
        for (int et = 0; et < 8; ++et) { const int e = 16 * et + 4 * g;
            const u32x2 gw = *(const u32x2*)(RG + orow + e); const f32x4 gg = *(const f32x4*)(gn + h * 128 + e);
            const float o0 = siluf_(lo16(gw.x)) * y[et][0] * rs * gg[0], o1 = siluf_(hi16(gw.x)) * y[et][1] * rs * gg[1], o2 = siluf_(lo16(gw.y)) * y[et][2] * rs * gg[2], o3 = siluf_(hi16(gw.y)) * y[et][3] * rs * gg[3];
            u32x2 ow; ow.x = pk2(o0, o1); ow.y = pk2(o2, o3); *(u32x2*)(YR + (row0 + il) * 1536 + h * 128 + e) = ow; }
        __syncthreads();
    }
}
constexpr int APITCH = 144;
__device__ __forceinline__ void p11_attention(const Params& p, const Frame& F, bool want_ctx) {
    const bf16_t* AQ = WSB(p, WS_AQ); const bf16_t* AKV = WSB(p, WS_AKV); bf16_t* YA = WSB(p, WS_WU);
    const int lane = F.lane, w = F.wave, tid = F.tid, g = lane >> 4, li = lane & 15, q4 = li >> 2, p4 = li & 3;
    LAS unsigned char* LK = F.lds; LAS unsigned char* LV = F.lds + 4 * 64 * APITCH;
    const int nunits = NB * 8 * 17;
    for (int u0 = F.bid; u0 < nunits; u0 += F.G) {
        int b, h, qb;
        int u = u0;
        if (F.G == 256 && u0 < NB * 8 * 16) { const int r = u0 >> 8, x = u0 & 7, j = (u0 & 255) >> 3, pair = x + 8 * (r >> 1), un = (r & 1) * 32 + j;
            u = (pair >> 1) * 128 + ((pair & 1) * 4 + (un >> 4)) * 16 + (un & 15); }
        if (u < NB * 8 * 16) { b = u >> 7; h = (u >> 4) & 7; qb = 1 + (u & 15); } else { const int v = u - NB * 8 * 16; b = v >> 3; h = v & 7; qb = 0; }
        if (qb == 0 && !want_ctx) continue;
        const int kvh = h >> 2, ntile = qb == 0 ? NCTX / 64 : NP / 64;
        const size_t rowbase = (size_t)b * NP + (size_t)qb * 256;
        bf16x8 qf[2][2];
#pragma unroll
        for (int it = 0; it < 2; ++it)
#pragma unroll
            for (int ks = 0; ks < 2; ++ks) qf[it][ks] = *(const bf16x8*)(AQ + (rowbase + 32 * w + 16 * it + li) * 512 + h * 64 + 32 * ks + 8 * g);
        f32x4 o[4][2]; float m[2]; f32x4 lsa[2], minit[2];
        const bf16x8 ones = {(short)0x3F80, (short)0x3F80, (short)0x3F80, (short)0x3F80, (short)0x3F80, (short)0x3F80, (short)0x3F80, (short)0x3F80};
#pragma unroll
        for (int it = 0; it < 2; ++it) { m[it] = 0.f; lsa[it] = (f32x4){0.f, 0.f, 0.f, 0.f}; minit[it] = (f32x4){0.f, 0.f, 0.f, 0.f};
#pragma unroll
            for (int et = 0; et < 4; ++et) o[et][it] = (f32x4){0.f, 0.f, 0.f, 0.f}; }
        const int sj = tid >> 3, sc8 = (tid & 7) * 8;
        const bf16_t* kvsrc = AKV + ((size_t)b * NP + sj) * 256 + kvh * 64 + sc8;
        u32x4 kreg[2], vreg[2];
#pragma unroll
        for (int sb = 0; sb < 2; ++sb) { kreg[sb] = *(const u32x4*)(kvsrc + (size_t)sb * 64 * 256); vreg[sb] = *(const u32x4*)(kvsrc + (size_t)sb * 64 * 256 + 128); }
        __syncthreads();
        for (int kp = 0; kp < ntile / 2; ++kp) {
            LAS unsigned char* lkb = LK + (kp & 1) * 128 * APITCH; LAS unsigned char* lvb = LV + (kp & 1) * 128 * APITCH;
#pragma unroll
            for (int sb = 0; sb < 2; ++sb) { *(LAS u32x4*)(lkb + (sb * 64 + sj) * APITCH + sc8 * 2) = kreg[sb]; *(LAS u32x4*)(lvb + (sb * 64 + sj) * APITCH + sc8 * 2) = vreg[sb]; }
            __syncthreads();
            if (kp + 1 < ntile / 2) {
#pragma unroll
                for (int sb = 0; sb < 2; ++sb) { const bf16_t* s2 = kvsrc + (size_t)(2 * kp + 2 + sb) * 64 * 256; kreg[sb] = *(const u32x4*)s2; vreg[sb] = *(const u32x4*)(s2 + 128); } }
#pragma unroll
            for (int sb = 0; sb < 2; ++sb) { const int kt = 2 * kp + sb; LAS unsigned char* lk = lkb + sb * 64 * APITCH; LAS unsigned char* lv = lvb + sb * 64 * APITCH;
            f32x4 sc[4][2];
#pragma unroll
            for (int jt = 0; jt < 4; ++jt) {
                const bf16x8 kf0 = ld_frag(lk + (16 * jt + li) * APITCH + (8 * g) * 2), kf1 = ld_frag(lk + (16 * jt + li) * APITCH + (32 + 8 * g) * 2);
                sc[jt][0] = MFMA16(kf0, qf[0][0], minit[0]); sc[jt][1] = MFMA16(kf0, qf[1][0], minit[1]);
                sc[jt][0] = MFMA16(kf1, qf[0][1], sc[jt][0]); sc[jt][1] = MFMA16(kf1, qf[1][1], sc[jt][1]); }
            bf16x8 pf[2][2];
            if ((kt & 7) == 0) {
                float mx[2];
#pragma unroll
                for (int it = 0; it < 2; ++it) { float t = sc[0][it][0];
#pragma unroll
                    for (int jt = 0; jt < 4; ++jt)
#pragma unroll
                        for (int r = 0; r < 4; ++r) t = fmaxf(t, sc[jt][it][r]);
                    t = fmaxf(t, shfl_xor_f(t, 16)); t = fmaxf(t, shfl_xor_f(t, 32)); mx[it] = t; }
                if (kt == 0 || __any(fmaxf(mx[0], mx[1]) > 8.f)) {
#pragma unroll
                    for (int it = 0; it < 2; ++it) { const float d = kt == 0 ? mx[it] : fmaxf(mx[it], 0.f), alpha = kt == 0 ? 1.f : __builtin_amdgcn_exp2f(-d);
                        m[it] = kt == 0 ? d : m[it] + d; lsa[it] = lsa[it] * alpha; minit[it] = (f32x4){-m[it], -m[it], -m[it], -m[it]};
#pragma unroll
                        for (int et = 0; et < 4; ++et) o[et][it] = o[et][it] * alpha;
#pragma unroll
                        for (int jt = 0; jt < 4; ++jt)
#pragma unroll
                            for (int r = 0; r < 4; ++r) sc[jt][it][r] -= d; } } }
#pragma unroll
            for (int it = 0; it < 2; ++it) {
#pragma unroll
                for (int jt = 0; jt < 4; ++jt)
#pragma unroll
                    for (int r = 0; r < 4; ++r) sc[jt][it][r] = __builtin_amdgcn_exp2f(sc[jt][it][r]);
                pf[it][0] = pack_frag(sc[0][it], sc[1][it]); pf[it][1] = pack_frag(sc[2][it], sc[3][it]);
                lsa[it] = MFMA16(ones, pf[it][0], lsa[it]); lsa[it] = MFMA16(ones, pf[it][1], lsa[it]); }
#pragma unroll
            for (int ks = 0; ks < 2; ++ks)
#pragma unroll
                for (int et = 0; et < 4; ++et) { const int col = 16 * et + 4 * p4;
                    const bf16x8 vf = cat44(tr_read(lv + (32 * ks + 4 * g + q4) * APITCH + col * 2), tr_read(lv + (32 * ks + 16 + 4 * g + q4) * APITCH + col * 2));
                    o[et][0] = MFMA16(vf, pf[0][ks], o[et][0]); o[et][1] = MFMA16(vf, pf[1][ks], o[et][1]); }
            }
        }
#pragma unroll
        for (int it = 0; it < 2; ++it) { const float inv = __builtin_amdgcn_rcpf(lsa[it][0]);
            bf16_t* op = YA + (rowbase + 32 * w + 16 * it + li) * 1536 + h * 64 + 4 * g;
#pragma unroll
            for (int et = 0; et < 4; ++et) { u32x2 ow; ow.x = pk2(o[et][it][0] * inv, o[et][it][1] * inv); ow.y = pk2(o[et][it][2] * inv, o[et][it][3] * inv); *(u32x2*)(op + 16 * et) = ow; } }
    }
    __syncthreads();
}

__device__ __forceinline__ void p14_norm2_router(const Params& p, const Frame& F, int l, bool want_ctx) {
    LAS float* tile = (LAS float*)F.lds;
    (void)tile;
    const float* mod = WSF(p, WS_MOD) + (size_t)l * 9 * 6144; bf16_t* H2 = WSB(p, WS_H);
    const float* rw2 = WSF(p, WS_RW2) + (size_t)l * 64 * 3 * 4 * 16 * 4;
    const float* rcl = WSF(p, WS_RC) + (size_t)l * 9 * 48;
    const float* n2g = p.in[I_N2G] + (size_t)l * 1024;
    unsigned* cnt = (unsigned*)(p.ws + WS_CTL) + CW_CNT + l * 32;
    int* PE = (int*)(p.ws + WS_PAIR); int* PPOS = PE + NPAIR_MAX; float* PW = (float*)(PPOS + NPAIR_MAX);
    for (int gi = F.gwave; gi < T / 16; gi += F.nwave) {
        int lane = F.lane; asm volatile("" : "+v"(lane));
        const int g = lane >> 4, li = lane & 15, half = lane >> 5, lk = lane & 31;
        const int row0 = 16 * gi, b = row0 / NP, q = row0 - b * NP; const bool isctx = q < NCTX;
        if (isctx && !want_ctx) continue;
        const int mrow = isctx ? 8 : b; const float* mr = mod + (size_t)mrow * 6144;
        LAS float* At = (LAS float*)(F.lds + F.wave * 12288);
        LAS float* LGT = At + 16 * 4 * 36;
        const float* xr[8];
#pragma unroll
        for (int r = 0; r < 8; ++r) xr[r] = xrow(p, row0 + 8 * half + r);
        f32x4 acc[3]; float ss[8];
#pragma unroll
        for (int nt = 0; nt < 3; ++nt) acc[nt] = (f32x4){0.f, 0.f, 0.f, 0.f};
#pragma unroll
        for (int r = 0; r < 8; ++r) ss[r] = 0.f;
        f32x4 xv[8];
#pragma unroll
        for (int r = 0; r < 8; ++r) xv[r] = *(const f32x4*)(xr[r] + 4 * lk);
#pragma unroll 1
        for (int ck = 0; ck < 8; ++ck) { const int kc = ck * 128 + 4 * lk;
            const f32x4 gg = *(const f32x4*)(n2g + kc), s1 = *(const f32x4*)(mr + 4096 + kc);
            f32x4 gq; gq[0] = gg[0] * (1.f + s1[0]); gq[1] = gg[1] * (1.f + s1[1]); gq[2] = gg[2] * (1.f + s1[2]); gq[3] = gg[3] * (1.f + s1[3]);
            const float* wb = rw2 + ((size_t)(ck * 8) * 3 * 4 + g) * 64 + li * 4;
            f32x4 bc[3];
#pragma unroll
            for (int nt = 0; nt < 3; ++nt) bc[nt] = *(const f32x4*)(wb + nt * 256);
#pragma unroll
            for (int r = 0; r < 8; ++r) { ss[r] += xv[r][0] * xv[r][0] + xv[r][1] * xv[r][1] + xv[r][2] * xv[r][2] + xv[r][3] * xv[r][3];
#pragma unroll
                for (int e = 0; e < 4; ++e) At[((8 * half + r) * 4 + e) * 36 + lk] = xv[r][e] * gq[e]; }
            if (ck < 7) {
#pragma unroll
                for (int r = 0; r < 8; ++r) xv[r] = *(const f32x4*)(xr[r] + kc + 128); }
            asm volatile("" ::: "memory");
#pragma unroll
            for (int kq = 0; kq < 8; ++kq) { const f32x4 av = *(const LAS f32x4*)(At + (li * 4 + g) * 36 + 4 * kq);
                f32x4 bn[3];
                if (kq < 7) {
#pragma unroll
                    for (int nt = 0; nt < 3; ++nt) bn[nt] = *(const f32x4*)(wb + ((kq + 1) * 3 + nt) * 256); }
#pragma unroll
                for (int nt = 0; nt < 3; ++nt) {
#pragma unroll
                    for (int j = 0; j < 4; ++j) acc[nt] = __builtin_amdgcn_mfma_f32_16x16x4f32(av[j], bc[nt][j], acc[nt], 0, 0, 0); }
                if (kq < 7) {
#pragma unroll
                    for (int nt = 0; nt < 3; ++nt) bc[nt] = bn[nt]; } }
            asm volatile("" ::: "memory");
        }
#pragma unroll
        for (int r = 0; r < 8; ++r) {
#pragma unroll
            for (int mk = 1; mk < 32; mk <<= 1) ss[r] += shfl_xor_f(ss[r], mk);
            ss[r] = rsqrtf(ss[r] * (1.f / 1024.f) + 1e-6f); }
#pragma unroll
        for (int r2 = 0; r2 < 4; ++r2) { float rsA = ss[r2], rsB = ss[4 + r2]; asm volatile("" : "+v"(rsA), "+v"(rsB));
            const float rs = (g & 1) ? rsB : rsA;
#pragma unroll
            for (int nt = 0; nt < 3; ++nt) LGT[(4 * g + r2) * 48 + 16 * nt + li] = acc[nt][r2] * rs + rcl[mrow * 48 + 16 * nt + li]; }
        asm volatile("" ::: "memory");
        if (lane < 16 && !p.dry) {
            const int row = row0 + lane; const LAS float* lg = LGT + lane * 48;
            int grp = 0; float gm = lg[0];
            float gl4[4]; gl4[0] = gm;
#pragma unroll
            for (int i = 1; i < 4; ++i) { gl4[i] = lg[i]; if (gl4[i] > gm) { gm = gl4[i]; grp = i; } }
            float gs = 0.f;
#pragma unroll
            for (int i = 0; i < 4; ++i) gs += __expf(gl4[i] - gm);
            const float pg = frcp(gs);
            int i1 = 0, i2 = -1; float v1 = -3.0e38f, v2 = -3.0e38f;
#pragma unroll
            for (int i = 0; i < 8; ++i) { const float v = lg[4 + grp * 8 + i];
                if (v > v1) { v2 = v1; i2 = i1; v1 = v; i1 = i; } else if (v > v2) { v2 = v; i2 = i; } }
            const float e2 = __expf(v2 - v1), w1 = pg * frcp(1.f + e2), w2 = pg * e2 * frcp(1.f + e2);
            const int ex1 = grp * 8 + i1, ex2 = grp * 8 + i2;
            const unsigned p1 = atomicAdd(&cnt[ex1], 1u), p2 = atomicAdd(&cnt[ex2], 1u);
            PE[2 * row] = ex1; PE[2 * row + 1] = ex2; PPOS[2 * row] = (int)p1; PPOS[2 * row + 1] = (int)p2; PW[2 * row] = w1; PW[2 * row + 1] = w2;
        }
        if (!p.dry && lk == 0) { float* RSR = WSF(p, WS_RSROW);
#pragma unroll
            for (int r = 0; r < 8; ++r) RSR[row0 + 8 * half + r] = ss[r]; }
    }
}
struct MoeTab { LAS int* pad_start; LAS int* blk_e; LAS int* n_used; };
__device__ __forceinline__ MoeTab moe_tab(const Frame& F) { MoeTab t; LAS int* base = (LAS int*)(F.lds + MISC_OFF + 64); t.pad_start = base; t.blk_e = base + 32; t.n_used = base + 32 + MOE_NBLK; return t; }
__device__ __forceinline__ void moe_build_tab(const Params& p, const Frame& F, int l) {
    const MoeTab t = moe_tab(F);
    const unsigned* cnt = (const unsigned*)(p.ws + WS_CTL) + CW_CNT + l * 32;
    __syncthreads();
    if (F.tid == 0) { int acc = 0;
        for (int e = 0; e < 32; ++e) { const int c = (int)__hip_atomic_load(cnt + e, __ATOMIC_RELAXED, __HIP_MEMORY_SCOPE_AGENT), nb = (c + 255) >> 8; t.pad_start[e] = acc * 256;
            for (int k = 0; k < nb; ++k) t.blk_e[acc + k] = e;
            acc += nb; }
        *t.n_used = acc; }
    __syncthreads();
}
__device__ __forceinline__ void p15_scatter(const Params& p, const Frame& F, int l, bool want_ctx) {
    moe_build_tab(p, F, l);
    const MoeTab t = moe_tab(F);
    const int* PE = (const int*)(p.ws + WS_PAIR); const int* PPOS = PE + NPAIR_MAX; int* PD = (int*)(p.ws + WS_PAIR) + 3 * NPAIR_MAX;
    const float* RSR = WSF(p, WS_RSROW); bf16_t* BUF = WSB(p, WS_BUF);
    const float* mod = WSF(p, WS_MOD) + (size_t)l * 9 * 6144; const float* n2g = p.in[I_N2G] + (size_t)l * 1024;
    const int lane = F.lane;
    for (int row = F.gwave; row < T; row += F.nwave) {
        const int b = row / NP, q = row - b * NP; const bool isctx = q < NCTX;
        if (isctx && !want_ctx) continue;
        const float* mr = mod + (size_t)(isctx ? 8 : b) * 6144; const float* x = xrow(p, row);
        const float rs = RSR[row];
        const int d0 = t.pad_start[PE[2 * row]] + PPOS[2 * row], d1 = t.pad_start[PE[2 * row + 1]] + PPOS[2 * row + 1];
        if (lane == 0) { PD[2 * row] = d0; PD[2 * row + 1] = d1; }
        f32x4 xv[4];
#pragma unroll
        for (int j = 0; j < 4; ++j) xv[j] = *(const f32x4*)(x + j * 256 + lane * 4);
#pragma unroll
        for (int j = 0; j < 4; ++j) { const int c = j * 256 + lane * 4;
            const f32x4 gg = *(const f32x4*)(n2g + c), s1 = *(const f32x4*)(mr + 4096 + c), s0 = *(const f32x4*)(mr + 3072 + c); float y[4];
#pragma unroll
            for (int e = 0; e < 4; ++e) y[e] = xv[j][e] * rs * gg[e] * (1.f + s1[e]) + s0[e];
            u32x2 w; w.x = pk2(y[0], y[1]); w.y = pk2(y[2], y[3]);
            *(u32x2*)(BUF + (size_t)d0 * 1024 + c) = w; *(u32x2*)(BUF + (size_t)d1 * 1024 + c) = w; }
    }
}
__device__ __forceinline__ void p18_combine(const Params& p, const Frame& F, int l, bool want_ctx) {
    const int* PD = (const int*)(p.ws + WS_PAIR) + 3 * NPAIR_MAX; const float* PW = (const float*)(p.ws + WS_PAIR) + 2 * NPAIR_MAX;
    const bf16_t* YB = WSB(p, WS_YB);
    const float* mod = WSF(p, WS_MOD) + (size_t)l * 9 * 6144;
    const float* modn = mod + 9 * 6144;
    const float* n1g = p.in[I_N1G] + (size_t)(l + 1) * 1024;
    bf16_t* H = WSB(p, WS_H);
    const bool donorm = (l + 1 < DEPTH);
    const int lane = F.lane;
    for (int row = F.gwave; row < T; row += F.nwave) {
        const int b = row / NP, q = row - b * NP; const bool isctx = q < NCTX;
        if (isctx && !want_ctx) continue;
        const int mrow = isctx ? 8 : b;
        const float* g2 = mod + (size_t)mrow * 6144 + 5120;
        const int d0 = PD[2 * row], d1 = PD[2 * row + 1]; const float w0 = PW[2 * row], w1 = PW[2 * row + 1];
        float* x = xrow(p, row);
        f32x4 xv[4]; float ss = 0.f;
#pragma unroll
        for (int j = 0; j < 2; ++j) { const int c = j * 512 + lane * 8;
            float ya[8], yb[8]; unpack8(*(const u32x4*)(YB + (size_t)d0 * 1024 + c), ya); unpack8(*(const u32x4*)(YB + (size_t)d1 * 1024 + c), yb);
            f32x4 x0 = *(const f32x4*)(x + c), x1 = *(const f32x4*)(x + c + 4); const f32x4 ga = *(const f32x4*)(g2 + c), gb = *(const f32x4*)(g2 + c + 4);
#pragma unroll
            for (int e = 0; e < 4; ++e) { x0[e] += ga[e] * (w0 * ya[e] + w1 * yb[e]); x1[e] += gb[e] * (w0 * ya[4 + e] + w1 * yb[4 + e]); ss += x0[e] * x0[e] + x1[e] * x1[e]; }
            if (!p.dry) { *(f32x4*)(x + c) = x0; *(f32x4*)(x + c + 4) = x1; }
            xv[2 * j] = x0; xv[2 * j + 1] = x1; }
        if (donorm) {
#pragma unroll
            for (int m = 1; m < 64; m <<= 1) ss += shfl_xor_f(ss, m);
            const float rs = rsqrtf(ss * (1.f / 1024.f) + 1e-6f);
            const float* mr = modn + (size_t)mrow * 6144;
#pragma unroll
            for (int j = 0; j < 2; ++j) { const int c = j * 512 + lane * 8; float y[8];
#pragma unroll
                for (int hf = 0; hf < 2; ++hf) { const f32x4 gg = *(const f32x4*)(n1g + c + 4 * hf), s1 = *(const f32x4*)(mr + 1024 + c + 4 * hf), s0 = *(const f32x4*)(mr + c + 4 * hf);
#pragma unroll
                    for (int e = 0; e < 4; ++e) y[4 * hf + e] = xv[2 * j + hf][e] * rs * gg[e] * (1.f + s1[e]) + s0[e]; }
                if (!p.dry) *(u32x4*)(H + (size_t)row * 1024 + c) = pack8(y); } }
    }
}
constexpr size_t WS_REC = WS_WU; constexpr int REC_BYTES = 15360, RC_BYTES = 1792;
static_assert(WS_LW == WS_WU + (size_t)T * 1792 * 2 && WS_LA == WS_LW + (size_t)T * 1024 * 2 && WS_LG == WS_LA + (size_t)T * 1024 * 2, "WU|LW|LA contiguous");
static_assert(WS_REC + (size_t)NB * 8 * (NP / 16) * REC_BYTES <= WS_LG, "chunk records fit");
constexpr size_t WS_YCAT = WS_WU;
constexpr size_t WS_YS2 = WS_H;
constexpr int NCHUNK = NP / 16;
__device__ __forceinline__ int scan_pos(int s, int dir) { return dir ? (s < NCTX ? NCTX - 1 - s : NP + NCTX - 1 - s) : s; }
constexpr size_t WS_REC2 = WS_W1;
constexpr size_t WS_VS2 = AL(WS_REC2 + (size_t)NB * 8 * (NP / 16) * REC_BYTES);
constexpr size_t WS_BON = AL(WS_VS2 + SZ512);
static_assert(WS_BON + (size_t)2 * T * 8 * 4 <= WS_END_MIX, "records + V' + bonus fit in the W1 region");
struct BuildRaw { u32x4 wu[3][2], halo[3]; };
__device__ __forceinline__ void build_load(BuildRaw& R, const Params& p, int ch, int lane) {
    const bf16_t* WU = WSB(p, WS_WU);
    const int bh = ch / NCHUNK, tb = ch - bh * NCHUNK, b = bh >> 3, h = bh & 7;
    const int q0 = 16 * tb; const size_t row0 = (size_t)b * NP + q0;
    const int lt = lane >> 2, lc = (lane & 3) * 16;
    const bool hasp = (q0 != 0) && (q0 != NCTX), hasn = (q0 + 16 != NCTX) && (q0 + 16 != NP);
#pragma unroll
    for (int part = 0; part < 3; ++part) { const bf16_t* src = WU + (row0 + lt) * 1792 + part * 512 + h * 64 + lc;
        R.wu[part][0] = *(const u32x4*)src; R.wu[part][1] = *(const u32x4*)(src + 8);
        u32x4 hv; hv.x = hv.y = hv.z = hv.w = 0u;
        if (lane < 16) { const bool nx = lane >= 8; const bool ok = nx ? hasn : hasp;
            if (ok) hv = *(const u32x4*)(WU + (nx ? row0 + 16 : row0 - 1) * 1792 + part * 512 + h * 64 + (lane & 7) * 8); }
        R.halo[part] = hv; }
}
template <int DIR> __device__ __forceinline__ void build_dir(const Params& p, int l, int lane, LAS unsigned char* wl, const float (&rr)[16], const float (&kx)[16], const float (&vx)[16], const float (&kn)[16],
                                                            const u32x4 (&lwr)[2], const u32x4 (&lar)[2], size_t row0, int h, unsigned char* rec, float* BON) {
    constexpr int dir = DIR; constexpr int TP_ = 144;
    const int g = lane >> 4, li = lane & 15, lt = lane >> 2, lc = (lane & 3) * 16, cc = h * 64 + lane;
    LAS unsigned char* Ta = wl; LAS unsigned char* Tr = wl + 2304; LAS unsigned char* Tb = wl + 4608; LAS unsigned char* Tk = wl + 6912;
    LAS float* M = (LAS float*)wl;
    const int pj = (lane & 32) + ((lane & 15) >> 2) * 8 + ((lane >> 4) & 1) * 4 + (lane & 3);
    constexpr int LO = DIR ? 11264 : 0;
    asm volatile("" ::: "memory");
    if (DIR == 0) {
        *(LAS u32x4*)(wl + lt * 128 + lc * 2) = lwr[0]; *(LAS u32x4*)(wl + lt * 128 + lc * 2 + 16) = lwr[1];
        *(LAS u32x4*)(wl + 2048 + lt * 128 + lc * 2) = lar[0]; *(LAS u32x4*)(wl + 2048 + lt * 128 + lc * 2 + 16) = lar[1]; }
    asm volatile("" ::: "memory");
        float X[16], Q[16], v[16], bhh[16], khh[16]; float Lc = 0.f;
        { const float w0c = p.in[I_W0][((size_t)l * 2 + dir) * 512 + cc], a0c = p.in[I_A0][((size_t)l * 2 + dir) * 512 + cc], kac = p.in[I_KA][l * 512 + cc], rkc = p.in[I_RK][l * 512 + cc];
          float bs0[8], bs1[8];
#pragma unroll
          for (int t = 0; t < 16; ++t) {
              constexpr int dummy_ = 0; (void)dummy_;
              const int tt = dir ? 15 - t : t; const int o = tt * 128 + lane * 2;
              const float lwv = bf2f(*(const LAS bf16_t*)(wl + LO + o)), lav = bf2f(*(const LAS bf16_t*)(wl + LO + 2048 + o));
              const float r = rr[tt], kp = kx[tt], kkn = kn[tt]; v[t] = vx[tt];
              const float asig = sigmoidf_(a0c + lav), lw = -0.6065306597126334f * sigmoidf_(w0c + lwv);
              const float k = kp * (1.f + (asig - 1.f) * kac), bb = kkn * asig, a = -kkn;
              if (t < 8) bs0[t] = r * k * rkc; else bs1[t - 8] = r * k * rkc;
              const float Lx = Lc; Lc += lw;
              const float at = a * __expf(Lx), rt = r * __expf(Lc), en = __expf(-Lc);
              X[t] = at; Q[t] = rt; bhh[t] = bb * en; khh[t] = k * en;
          }
          const float u0 = reduce8(bs0, lane), u1 = reduce8(bs1, lane);
          if ((lane & 7) == 0) { const int t = lane >> 3; const int tk0 = dir ? 15 - t : t, tk1 = dir ? 7 - t : 8 + t; BON[(row0 + tk0) * 8 + h] = u0; BON[(row0 + tk1) * 8 + h] = u1; } }
        asm volatile("" ::: "memory");
#pragma unroll
        for (int t = 0; t < 16; ++t) {
            *(LAS bf16_t*)(Ta + t * TP_ + lane * 2) = (bf16_t)f2bf(X[t]); *(LAS bf16_t*)(Tr + t * TP_ + lane * 2) = (bf16_t)f2bf(Q[t]);
            *(LAS bf16_t*)(Tb + t * TP_ + lane * 2) = (bf16_t)f2bf(bhh[t]); *(LAS bf16_t*)(Tk + t * TP_ + lane * 2) = (bf16_t)f2bf(khh[t]);
        }
        const float gC = __expf(Lc);
#pragma unroll
        for (int t = 0; t < 16; ++t) { bhh[t] *= gC; khh[t] *= gC; }
#pragma unroll
        for (int q4 = 0; q4 < 4; ++q4) *(float*)(rec + 8192 + q4 * RC_BYTES + 1536 + lane * 4) = gC;
#pragma unroll
        for (int gg = 0; gg < 4; ++gg) { u32x4 w; w.x = pk2(bhh[4 * gg], bhh[4 * gg + 1]); w.y = pk2(bhh[4 * gg + 2], bhh[4 * gg + 3]); w.z = pk2(khh[4 * gg], khh[4 * gg + 1]); w.w = pk2(khh[4 * gg + 2], khh[4 * gg + 3]);
            *(u32x4*)(rec + 4096 + (lane * 32 + gg * 8) * 2) = w; }
        f32x4 mab = {0.f, 0.f, 0.f, 0.f}, mak = mab, mrb = mab, mrk = mab;
#pragma unroll
        for (int ks = 0; ks < 2; ++ks) { const int o = li * TP_ + (32 * ks + 8 * g) * 2;
            const bf16x8 fa = ld_frag(Ta + o), fr = ld_frag(Tr + o), fb = ld_frag(Tb + o), fk = ld_frag(Tk + o);
            mab = MFMA16(fa, fb, mab); mak = MFMA16(fa, fk, mak); mrb = MFMA16(fr, fb, mrb); mrk = MFMA16(fr, fk, mrk); }
        asm volatile("" ::: "memory");
#pragma unroll
        for (int r = 0; r < 4; ++r) { const int t = 4 * g + r;
            M[t * 16 + li] = li < t ? mab[r] : 0.f; M[256 + t * 16 + li] = li < t ? mak[r] : 0.f;
            M[512 + t * 16 + li] = li <= t ? mrb[r] : 0.f; M[768 + t * 16 + li] = li <= t ? mrk[r] : 0.f; }
        f32x2 XU[16]; float Y0[16];
        XU[0] = (f32x2){X[0], 0.f};
#pragma unroll
        for (int t = 1; t < 16; ++t) { f32x2 xu = {X[t], 0.f}; float u2 = 0.f;
#pragma unroll
            for (int s4 = 0; s4 < 4; ++s4) { if (4 * s4 < t) { const f32x4 ab = *(const LAS f32x4*)(M + t * 16 + 4 * s4), ak = *(const LAS f32x4*)(M + 256 + t * 16 + 4 * s4);
#pragma unroll
                for (int e = 0; e < 4; ++e) { const int s = 4 * s4 + e; if (s < t) { xu = xu + XU[s] * ab[e]; u2 += ak[e] * v[s]; } } } }
            xu.y += u2;
            asm volatile("" : "+v"(xu) :: "memory");
            XU[t] = xu; }
#pragma unroll
        for (int t = 0; t < 16; ++t) { f32x2 qy = {Q[t], 0.f}; float y2 = 0.f;
#pragma unroll
            for (int s4 = 0; s4 < 4; ++s4) { if (4 * s4 <= t) { const f32x4 rb = *(const LAS f32x4*)(M + 512 + t * 16 + 4 * s4), rk = *(const LAS f32x4*)(M + 768 + t * 16 + 4 * s4);
#pragma unroll
                for (int e = 0; e < 4; ++e) { const int s = 4 * s4 + e; if (s <= t) { qy = qy + XU[s] * rb[e]; y2 += rk[e] * v[s]; } } } }
            qy.y += y2;
            asm volatile("" : "+v"(qy) :: "memory");
            Q[t] = qy.x; Y0[t] = qy.y; }
        float U0[16];
#pragma unroll
        for (int t = 0; t < 16; ++t) { X[t] = XU[t].x; U0[t] = XU[t].y; }
        asm volatile("" ::: "memory");
#pragma unroll
        for (int t = 0; t < 16; ++t) { *(LAS bf16_t*)(wl + 4096 + (t * 64 + pj) * 2) = (bf16_t)f2bf(X[t]); *(LAS bf16_t*)(wl + 6144 + (t * 64 + pj) * 2) = (bf16_t)f2bf(Q[t]); }
        asm volatile("" ::: "memory");
#pragma unroll
        for (int k = 0; k < 4; ++k) *(u32x4*)(rec + k * 1024 + lane * 16) = *(const LAS u32x4*)(wl + 4096 + k * 1024 + lane * 16);
        unsigned char* rc = rec + 8192 + g * RC_BYTES + li * 32;
#pragma unroll
        for (int hf = 0; hf < 2; ++hf) { u32x4 w;
            w.x = pk2(v[8 * hf], v[8 * hf + 1]); w.y = pk2(v[8 * hf + 2], v[8 * hf + 3]); w.z = pk2(v[8 * hf + 4], v[8 * hf + 5]); w.w = pk2(v[8 * hf + 6], v[8 * hf + 7]); *(u32x4*)(rc + hf * 16) = w;
            w.x = pk2(U0[8 * hf], U0[8 * hf + 1]); w.y = pk2(U0[8 * hf + 2], U0[8 * hf + 3]); w.z = pk2(U0[8 * hf + 4], U0[8 * hf + 5]); w.w = pk2(U0[8 * hf + 6], U0[8 * hf + 7]); *(u32x4*)(rc + 512 + hf * 16) = w;
            w.x = pk2(Y0[8 * hf], Y0[8 * hf + 1]); w.y = pk2(Y0[8 * hf + 2], Y0[8 * hf + 3]); w.z = pk2(Y0[8 * hf + 4], Y0[8 * hf + 5]); w.w = pk2(Y0[8 * hf + 6], Y0[8 * hf + 7]); *(u32x4*)(rc + 1024 + hf * 16) = w; }
}
__device__ __forceinline__ void p6c_rwkv_build(const Params& p, const Frame& F, int l, int half) {
    unsigned char* REC = p.ws + WS_REC2; bf16_t* VSo = WSB(p, WS_VS2); float* BON = WSF(p, WS_BON);
    constexpr int TP_ = 144;
    BuildRaw cur, nxt;
    if (F.gwave < 32 * NCHUNK) build_load(cur, p, half * 32 * NCHUNK + F.gwave, F.lane);
    for (int chl = F.gwave; chl < 32 * NCHUNK; chl += F.nwave) { const int ch = half * 32 * NCHUNK + chl;
        int lane = F.lane; asm volatile("" : "+v"(lane));
        const int g = lane >> 4, li = lane & 15;
        LAS unsigned char* wl = F.lds + F.wave * 17408;
        LAS unsigned char* Ta = wl; LAS unsigned char* Tr = wl + 2304; LAS unsigned char* Tb = wl + 4608; LAS unsigned char* Tk = wl + 6912;
        LAS float* M = (LAS float*)wl;
        LAS unsigned char* Sv = wl + 9216;
        const int pj = (lane & 32) + ((lane & 15) >> 2) * 8 + ((lane >> 4) & 1) * 4 + (lane & 3);
        const int bh = ch / NCHUNK, tb = ch - bh * NCHUNK, b = bh >> 3, h = bh & 7;
        const int q0 = 16 * tb; const size_t row0 = (size_t)b * NP + q0;
        const int lt = lane >> 2, lc = (lane & 3) * 16;
#pragma unroll
        for (int part = 0; part < 3; ++part) {
            *(LAS u32x4*)(wl + part * 2304 + (lt + 1) * 128 + lc * 2) = cur.wu[part][0]; *(LAS u32x4*)(wl + part * 2304 + (lt + 1) * 128 + lc * 2 + 16) = cur.wu[part][1];
            if (lane < 16) *(LAS u32x4*)(wl + part * 2304 + (lane >= 8 ? 17 * 128 : 0) + (lane & 7) * 16) = cur.halo[part]; }
        const int cc = h * 64 + lane;
        u32x4 lwr[2], lar[2];
        { const bf16_t* LWg = WSB(p, WS_LW); const bf16_t* LAg = WSB(p, WS_LA);
          const bf16_t* s1p = LWg + (row0 + lt) * 1024 + h * 64 + lc; const bf16_t* s2p = LAg + (row0 + lt) * 1024 + h * 64 + lc;
          lwr[0] = *(const u32x4*)s1p; lwr[1] = *(const u32x4*)(s1p + 8); lar[0] = *(const u32x4*)s2p; lar[1] = *(const u32x4*)(s2p + 8);
          *(LAS u32x4*)(wl + 11264 + lt * 128 + lc * 2) = *(const u32x4*)(s1p + 512); *(LAS u32x4*)(wl + 11264 + lt * 128 + lc * 2 + 16) = *(const u32x4*)(s1p + 520);
          *(LAS u32x4*)(wl + 13312 + lt * 128 + lc * 2) = *(const u32x4*)(s2p + 512); *(LAS u32x4*)(wl + 13312 + lt * 128 + lc * 2 + 16) = *(const u32x4*)(s2p + 520); }
        float rr[16], kx[16], vx[16], kn[16];
        { const float* mu0 = p.in[I_MU] + (size_t)l * 2 * 1792, *mu1 = mu0 + 1792;
          const float kkc = p.in[I_KK][l * 512 + cc];
#pragma unroll
          for (int part = 0; part < 3; ++part) { const float m0 = mu0[part * 512 + cc], m1 = mu1[part * 512 + cc];
              float raw[18];
#pragma unroll
              for (int t = 0; t < 18; ++t) raw[t] = bf2f(*(const LAS bf16_t*)(wl + part * 2304 + t * 128 + lane * 2));
#pragma unroll
              for (int t = 0; t < 16; ++t) { const float u = raw[t + 1], sh = u + (raw[t] - u) * m0 + (raw[t + 2] - u) * m1;
                  if (part == 0) rr[t] = sh; else if (part == 1) kx[t] = sh; else vx[t] = sh; } }
          float s0[8], s1[8];
#pragma unroll
          for (int t = 0; t < 8; ++t) { kn[t] = kx[t] * kkc; kn[t + 8] = kx[t + 8] * kkc; s0[t] = kn[t] * kn[t]; s1[t] = kn[t + 8] * kn[t + 8]; }
          const float t0 = reduce8(s0, lane), t1 = reduce8(s1, lane);
#pragma unroll
          for (int t = 0; t < 8; ++t) { kn[t] *= rsqrtf(fmaxf(__shfl(t0, t * 8, 64), 1e-12f)); kn[t + 8] *= rsqrtf(fmaxf(__shfl(t1, t * 8, 64), 1e-12f)); }
          asm volatile("" ::: "memory");
          {
#pragma unroll
              for (int t = 0; t < 16; ++t) *(LAS bf16_t*)(Sv + t * 128 + lane * 2) = (bf16_t)f2bf(vx[t]);
              asm volatile("" ::: "memory");
              bf16_t* vo = VSo + (row0 + lt) * 512 + h * 64 + lc; *(u32x4*)vo = *(const LAS u32x4*)(Sv + lt * 128 + lc * 2); *(u32x4*)(vo + 8) = *(const LAS u32x4*)(Sv + lt * 128 + lc * 2 + 16); }
          }
        { const int bhl = bh & 31;
          build_dir<0>(p, l, lane, wl, rr, kx, vx, kn, lwr, lar, row0, h, REC + ((size_t)(bhl * 2 + 0) * NCHUNK + tb) * REC_BYTES, BON);
          int lane2 = lane; asm volatile("" : "+v"(lane2) :: "memory");
          { const int chn = chl + F.nwave; if (chn < 32 * NCHUNK) build_load(nxt, p, half * 32 * NCHUNK + chn, lane2); else nxt = cur; }
          build_dir<1>(p, l, lane2, wl, rr, kx, vx, kn, lwr, lar, row0, h, REC + ((size_t)(bhl * 2 + 1) * NCHUNK + (tb < 16 ? 15 - tb : 287 - tb)) * REC_BYTES, BON + (size_t)T * 8); }
        cur = nxt;
    }
}
constexpr int SC_SLOT = 10240, SC_NSLOT = 13, SC_DEPTH = 6;
__device__ __forceinline__ void scan_dma(const unsigned char* rec, int iq, LAS unsigned char* slot, int lane) {
    const unsigned char* g0 = rec + lane * 16;
#pragma unroll
    for (int k = 0; k < 8; ++k) __builtin_amdgcn_global_load_lds((const unsigned*)(g0 + k * 1024), (LAS unsigned*)(slot + k * 1024), 16, 0, 0);
    const unsigned char* g1 = rec + 8192 + iq * RC_BYTES + lane * 16;
    __builtin_amdgcn_global_load_lds((const unsigned*)g1, (LAS unsigned*)(slot + 8192), 16, 0, 0);
    if (lane < 48) __builtin_amdgcn_global_load_lds((const unsigned*)(g1 + 1024), (LAS unsigned*)(slot + 9216), 16, 0, 0);
}
__device__ __forceinline__ unsigned lds_ld(volatile LAS unsigned* q) { return *q; }
__device__ __forceinline__ void p6b_rwkv_scan(const Params& p, const Frame& F, int half) {
    volatile LAS unsigned* ctl = (volatile LAS unsigned*)(F.lds + MISC_OFF + 1536);
    if (F.tid < 3) ctl[F.tid] = 0u;
    __syncthreads();
    if (F.wave > 2) return;
    const int lane = F.lane, g = lane >> 4, li = lane & 15;
    const int task = (F.G == 256) ? (F.bid & 7) * 32 + (F.bid >> 3) : F.bid;
    if (task >= 256) return;
    const int bhl = task >> 3, dir = (task >> 2) & 1, iq = task & 3, b = 4 * half + (bhl >> 3), h = bhl & 7;
    const unsigned char* rec0 = p.ws + WS_REC2 + (size_t)(bhl * 2 + dir) * NCHUNK * REC_BYTES;
    if (F.wave != 0) {
        const int hh = F.wave - 1;
        if (p.dry == 1) return;
        asm volatile("s_waitcnt vmcnt(0)" ::: "memory");
#pragma unroll 1
        for (int n = 0; n < NCHUNK / 2; ++n) { const int k = 2 * n + hh;
            while ((int)lds_ld(ctl + 2) + SC_NSLOT <= k) __builtin_amdgcn_s_sleep(1);
            scan_dma(rec0 + (size_t)k * REC_BYTES, iq, F.lds + (k % SC_NSLOT) * SC_SLOT, lane);
            if (n >= 5) { asm volatile("s_waitcnt vmcnt(50)" ::: "memory"); if (lane == 0) ctl[hh] = (unsigned)(n - 4); } }
        asm volatile("s_waitcnt vmcnt(0)" ::: "memory");
        if (lane == 0) ctl[hh] = (unsigned)(NCHUNK / 2);
        return;
    }
    bf16_t* YS = WSB(p, WS_YS2) + (size_t)dir * T * 512;
    f32x4 st[4];
#pragma unroll
    for (int jt = 0; jt < 4; ++jt) st[jt] = (f32x4){0.f, 0.f, 0.f, 0.f};
    struct Ops { bf16x8 ah[2], qq[2], bk[4]; f32x4 gc[4]; u32x2 vt, u0, y0; };
#define SCAN_WAIT(c_) do { const unsigned need_ = (unsigned)((c_) >> 1) + 1u; volatile LAS unsigned* lw_ = ctl + ((c_) & 1); while (lds_ld(lw_) < need_) __builtin_amdgcn_s_sleep(1); asm volatile("" ::: "memory"); } while (0)
#define SCAN_WAIT2(c_) do { const unsigned n1_ = (unsigned)((c_) >> 1) + 1u, n0_ = ((c_) + 2 < NCHUNK) ? (unsigned)((c_) >> 1) + 2u : 0u; \
        for (;;) { const u32x2 fl_ = *(volatile LAS u32x2*)ctl; if (fl_.x >= n0_ && fl_.y >= n1_) break; __builtin_amdgcn_s_sleep(1); } asm volatile("" ::: "memory"); } while (0)
#define SCAN_LOAD(o_, c_) do { const LAS unsigned char* sl_ = F.lds + ((c_) % SC_NSLOT) * SC_SLOT; \
        _Pragma("unroll") for (int ks = 0; ks < 2; ++ks) { o_.ah[ks] = ld_frag(sl_ + (li * 64 + ks * 32 + g * 8) * 2); o_.qq[ks] = ld_frag(sl_ + 2048 + (li * 64 + ks * 32 + g * 8) * 2); } \
        _Pragma("unroll") for (int jt = 0; jt < 4; ++jt) { o_.bk[jt] = ld_frag(sl_ + 4096 + ((16 * jt + li) * 32 + g * 8) * 2); o_.gc[jt] = *(const LAS f32x4*)(sl_ + 8192 + 1536 + (16 * jt + 4 * g) * 4); } \
        o_.vt = *(const LAS u32x2*)(sl_ + 8192 + (li * 16 + 4 * g) * 2); o_.u0 = *(const LAS u32x2*)(sl_ + 8192 + 512 + (li * 16 + 4 * g) * 2); o_.y0 = *(const LAS u32x2*)(sl_ + 8192 + 1024 + (li * 16 + 4 * g) * 2); } while (0)
    const int pmode = p.dry;
    if (pmode == 2) { for (int c = 0; c < NCHUNK; ++c) { SCAN_WAIT(c); if (lane == 0) ctl[2] = (unsigned)(c + 1); } return; }
    Ops o0, o1;
    if (pmode != 1) SCAN_WAIT(0);
    SCAN_LOAD(o0, 0);
    const int rstep = dir ? -512 : 512;
#define SCAN_YPTR(c_) (YS + ((size_t)(b * NP + scan_pos(16 * (c_) + 4 * g, dir))) * 512 + h * 64 + 16 * iq + li)
#define SCAN_STEP(cur_, nxt_, c_) do { \
        const bf16x8 sb0 = pack_frag(st[0], st[1]), sb1 = pack_frag(st[2], st[3]); \
        f32x4 U = {lo16(cur_.u0.x), hi16(cur_.u0.x), lo16(cur_.u0.y), hi16(cur_.u0.y)}, Y = {lo16(cur_.y0.x), hi16(cur_.y0.x), lo16(cur_.y0.y), hi16(cur_.y0.y)}; \
        U = MFMA16(cur_.ah[0], sb0, U); Y = MFMA16(cur_.qq[0], sb0, Y); U = MFMA16(cur_.ah[1], sb1, U); Y = MFMA16(cur_.qq[1], sb1, Y); \
        asm volatile("" ::: "memory"); \
        if ((c_) + 1 < NCHUNK) { if (pmode != 1 && ((c_) & 1) == 0) SCAN_WAIT2(c_); SCAN_LOAD(nxt_, (c_) + 1); } \
        asm volatile("" ::: "memory"); \
        u32x4 uvw; uvw.x = pk2(U[0], U[1]); uvw.y = pk2(U[2], U[3]); uvw.z = cur_.vt.x; uvw.w = cur_.vt.y; \
        const bf16x8 uv = __builtin_bit_cast(bf16x8, uvw); \
        _Pragma("unroll") for (int jt = 0; jt < 4; ++jt) st[jt] = MFMA16(cur_.bk[jt], uv, st[jt] * cur_.gc[jt]); \
        if (pmode == 0) { bf16_t* yp = SCAN_YPTR(c_); _Pragma("unroll") for (int r = 0; r < 4; ++r) yp[r * rstep] = (bf16_t)f2bf(Y[r]); } \
        else if (Y[0] == 1.2345f) YS[0] = 0; \
        asm volatile("s_waitcnt lgkmcnt(0)" ::: "memory"); \
        if (lane == 0) ctl[2] = (unsigned)((c_) + 2); } while (0)
#pragma unroll 1
    for (int c = 0; c < NCHUNK; c += 2) { SCAN_STEP(o0, o1, c); SCAN_STEP(o1, o0, c + 1); }
#undef SCAN_STEP
#undef SCAN_YPTR
#undef SCAN_WAIT
#undef SCAN_WAIT2
#undef SCAN_LOAD
}

__device__ __forceinline__ void p7_rwkv_readout(const Params& p, const Frame& F, int l) {
    const bf16_t* VS = WSB(p, WS_VS2); const float* BON0 = WSF(p, WS_BON); const float* BON1 = BON0 + (size_t)T * 8;
    const bf16_t* YS0 = WSB(p, WS_H); const bf16_t* YS1 = YS0 + (size_t)T * 512;
    const bf16_t* LG = WSB(p, WS_LG); bf16_t* YW = WSB(p, WS_WU) + 1024;
    const int lane = F.lane, c0 = lane * 8;
    const float* ln_g = p.in[I_LNG] + l * 512, *ln_b = p.in[I_LNB] + l * 512;
    for (int row = F.gwave; row < T; row += F.nwave) {
        const size_t off = (size_t)row * 512 + c0;
        float y0[8], y1[8], v[8], g[8];
        unpack8(*(const u32x4*)(YS0 + off), y0); unpack8(*(const u32x4*)(YS1 + off), y1); unpack8(*(const u32x4*)(VS + off), v); unpack8(*(const u32x4*)(LG + off), g);
        const float bs = BON0[(size_t)row * 8 + (lane >> 3)] + BON1[(size_t)row * 8 + (lane >> 3)];
        float y[8], sm = 0.f;
#pragma unroll
        for (int e = 0; e < 8; ++e) { y[e] = y0[e] + y1[e]; sm += y[e]; }
        sm += shfl_xor_f(sm, 1); sm += shfl_xor_f(sm, 2); sm += shfl_xor_f(sm, 4);
        const float mean = sm * (1.f / 64.f); float vs = 0.f;
#pragma unroll
        for (int e = 0; e < 8; ++e) { const float d = y[e] - mean; vs += d * d; }
        vs += shfl_xor_f(vs, 1); vs += shfl_xor_f(vs, 2); vs += shfl_xor_f(vs, 4);
        const float rstd = rsqrtf(vs * (1.f / 64.f) + 64e-5f);
        float lg8[8], lb8[8]; *(f32x4*)lg8 = *(const f32x4*)(ln_g + c0); *(f32x4*)(lg8 + 4) = *(const f32x4*)(ln_g + c0 + 4); *(f32x4*)lb8 = *(const f32x4*)(ln_b + c0); *(f32x4*)(lb8 + 4) = *(const f32x4*)(ln_b + c0 + 4);
        float o[8];
#pragma unroll
        for (int e = 0; e < 8; ++e) o[e] = ((y[e] - mean) * rstd * lg8[e] + lb8[e] + bs * v[e]) * g[e];
        *(u32x4*)(YW + (size_t)row * 1536 + c0) = pack8(o);
    }
}
constexpr int NPHASE = 21;
constexpr int PARAMS_OFF = MISC_OFF + 2048;
__device__ __forceinline__ unsigned rfl(unsigned v) { return (unsigned)__builtin_amdgcn_readfirstlane((int)v); }
template <class Tp> __device__ __forceinline__ Tp* rfl_ptr(Tp* q) { const unsigned long long a = (unsigned long long)q; const unsigned lo = rfl((unsigned)a), hi = rfl((unsigned)(a >> 32)); return (Tp*)(((unsigned long long)hi << 32) | lo); }
__device__ __forceinline__ float rfl_f(float v) { return __builtin_bit_cast(float, rfl(__builtin_bit_cast(unsigned, v))); }
__device__ __forceinline__ Params load_params(LAS unsigned char* lds) {
    unsigned off = PARAMS_OFF; asm volatile("" : "+s"(off) :: "memory");
    const LAS Params* lp = (const LAS Params*)(lds + off);
    Params q;
#pragma unroll
    for (int i = 0; i < 33; ++i) q.in[i] = rfl_ptr(lp->in[i]);
    q.out = rfl_ptr(lp->out); q.ws = rfl_ptr(lp->ws);
#pragma unroll
    for (int i = 0; i < 16; ++i) q.invA[i] = rfl_f(lp->invA[i]);
#pragma unroll
    for (int i = 0; i < 32; ++i) q.invR[i] = rfl_f(lp->invR[i]);
    q.ph_lo = 0; q.ph_hi = 0; q.l_lo = 0; q.l_hi = 0; q.fused = 0; q.do_pro = 0; q.dry = (int)rfl((unsigned)lp->dry); q.pad2 = 0;
    return q;
}
__device__ __forceinline__ unsigned char* load_ws(LAS unsigned char* lds) {
    unsigned off = PARAMS_OFF; asm volatile("" : "+s"(off) :: "memory");
    const LAS Params* lp = (const LAS Params*)(lds + off);
    return rfl_ptr(lp->ws);
}
__device__ __forceinline__ Frame make_frame(LAS unsigned char* lds) {
    Frame F; int tid = threadIdx.x; asm volatile("" : "+v"(tid));
    int bid = blockIdx.x, G = gridDim.x; asm volatile("" : "+s"(bid), "+s"(G));
    F.lds = lds; F.tid = tid; F.lane = tid & 63; F.wave = __builtin_amdgcn_readfirstlane(tid >> 6);
    F.G = G; F.bid = bid; F.gwave = bid * NWAVES + F.wave; F.nwave = G * NWAVES;
    return F;
}
#define SEAM() do { if (fused) { XcdBarrier bar_; bar_.bar = (unsigned*)(load_ws(lds0) + WS_CTL) + CW_BAR; bar_.x = xb_xcc_id(); bar_.st = misc; xcd_barrier(bar_); } } while (0)
#ifndef MK_PHASES
#define MK_PHASES 0xFFFFFFFFu
#endif
#define IN(k) (((MK_PHASES >> (k)) & 1u) && ph_lo <= (k) && (k) < ph_hi)
#define EN(k) ((MK_PHASES >> (k)) & 1u)
#define LP() const Frame F = make_frame(lds0); const Params p = load_params(lds0)

__device__ __forceinline__ void layer_program(LAS unsigned char* const lds0, volatile LAS unsigned* misc, const int l, const int ph_lo, const int ph_hi, const int fused) {
        const bool want_ctx = l < DEPTH - 1;
        if (IN(0) && l == 0) { LP(); p1_cvt_norm1(p, F, l); SEAM(); }
        if (IN(1)) { LP();
            pg8::Gemm g{WSB(p, WS_H), WSB(p, WS_BTIN), T, 7680, 1024}; pg8::StaticOrder S; S.init(T, 7680, F.G, F.bid);
            pg8::EpiInproj E{p.ws};
            pg8::gemm_phase<pg8::EpiInproj, pg8::StaticOrder, PG8_ALIGN, PG8_SP2>(F.lds, g, S, E);
            SEAM(); }
        if (IN(2)) { LP(); p3_prep(p, F, l); SEAM(); }
        if (IN(3)) { LP();
            pg8::Gemm g{WSB(p, WS_H), WSB(p, WS_BTLORA), T, 2560, 256}; pg8::StaticOrder S; S.init(T, 2560, F.G, F.bid);
            pg8::EpiLora E{p.ws};
            pg8::gemm_phase<pg8::EpiLora, pg8::StaticOrder, PG8_ALIGN, PG8_SP2>(F.lds, g, S, E);
            SEAM(); }
        if (IN(5)) { LP(); p6c_rwkv_build(p, F, l, 0); SEAM(); }
        if (IN(6)) { LP(); p6b_rwkv_scan(p, F, 0); SEAM(); }
        if (IN(7)) { LP(); p6c_rwkv_build(p, F, l, 1); SEAM(); }
        if (IN(8)) { LP(); p6b_rwkv_scan(p, F, 1); SEAM(); }
        if (IN(9)) { LP(); p7_rwkv_readout(p, F, l); }
        if (IN(10)) { LP(); p8_ret_kv(p, F, l); SEAM(); }
        if (IN(11)) { LP(); p9_ret_scan(p, F, l); SEAM(); }
        if (IN(12)) { LP(); p10_ret_out(p, F, l, want_ctx); }
        if (IN(13)) { LP(); p11_attention(p, F, want_ctx); SEAM(); }
        if (IN(14)) { LP();
            pg8::Gemm g{WSB(p, WS_YCAT), WSB(p, WS_BTBR), T, 1024, 1536};
            pg8::EpiMergeK E{WSB(p, WS_GL), WSB(p, WS_H)};
            if (want_ctx) { pg8::StaticOrder S; S.init(T, 1024, F.G, F.bid); pg8::gemm_phase<pg8::EpiMergeK, pg8::StaticOrder, PG8_ALIGN, PG8_SP2>(F.lds, g, S, E); }
            else { pg8::LatentOrder S; S.init(1024, F.G, F.bid); pg8::gemm_phase<pg8::EpiMergeK, pg8::LatentOrder, PG8_ALIGN, PG8_SP2>(F.lds, g, S, E); }
            __syncthreads();
            cvt_run<true>(p, F, l, (LAS float*)F.lds, (want_ctx && F.G == 256) ? 32 : 0);
            SEAM(); }
        if (IN(15)) { LP();
            pg8::Gemm g{WSB(p, WS_H), WSB(p, WS_BTOUT), T, 1024, 1024};
            pg8::EpiOut E{p.out, WSF(p, WS_CTXRES), WSF(p, WS_MOD) + (size_t)l * 9 * 6144, p.dry, l == 0 ? p.in[I_X] : p.out, l == 0 ? p.in[I_CTX] : WSF(p, WS_CTXRES)};
            if (want_ctx) { pg8::StaticOrder S; S.init(T, 1024, F.G, F.bid); pg8::gemm_phase<pg8::EpiOut, pg8::StaticOrder, PG8_ALIGN, PG8_SP2>(F.lds, g, S, E); }
            else { pg8::LatentOrder S; S.init(1024, F.G, F.bid); pg8::gemm_phase<pg8::EpiOut, pg8::LatentOrder, PG8_ALIGN, PG8_SP2>(F.lds, g, S, E); }
            if (l + 1 < DEPTH && F.G == 256) { __syncthreads(); cvt_run<false>(p, F, l + 1, (LAS float*)F.lds, 32, 0, 576); }
            SEAM(); }
        if (IN(16)) { LP(); p14_norm2_router(p, F, l, want_ctx); SEAM(); }
        if (IN(17)) { LP(); p15_scatter(p, F, l, want_ctx); SEAM(); }
        if (IN(18)) { LP();
            moe_build_tab(p, F, l);
            pg8::Gemm g{WSB(p, WS_BUF), WSB(p, WS_BT1), MOE_NBLK * 256, 1024, 1024};
            typedef pg8::MoeOrder<(size_t)1024 * 1024 * 2> Ord; Ord S{F.G, F.bid, (const PG8_LAS int*)(F.lds + MISC_OFF + 64)};
            pg8::EpiSwiGLU E{WSB(p, WS_HB)};
            pg8::gemm_phase<pg8::EpiSwiGLU, Ord, PG8_ALIGN, PG8_SP2>(F.lds, g, S, E);
            SEAM(); }
        if (IN(19)) { LP();
            moe_build_tab(p, F, l);
            pg8::Gemm g{WSB(p, WS_HB), WSB(p, WS_BT2), MOE_NBLK * 256, 1024, 512};
            typedef pg8::MoeOrder<(size_t)1024 * 512 * 2> Ord; Ord S{F.G, F.bid, (const PG8_LAS int*)(F.lds + MISC_OFF + 64)};
            pg8::EpiPlainBf16 E{WSB(p, WS_YB), 1024};
            pg8::gemm_phase<pg8::EpiPlainBf16, Ord, PG8_ALIGN, PG8_SP2>(F.lds, g, S, E);
            SEAM(); }
        if (IN(20)) { LP(); p18_combine(p, F, l, want_ctx); if (l + 1 < DEPTH) { p1_weights(p, F, l + 1, F.G == 256); SEAM(); } }
    }
__global__ void __launch_bounds__(NTHREADS, 2) mk_fwd(Params kp) {
    extern __shared__ __attribute__((aligned(16))) unsigned char lds_raw[];
    LAS unsigned char* const lds0 = (LAS unsigned char*)lds_raw;
    volatile LAS unsigned* misc = (volatile LAS unsigned*)(lds0 + MISC_OFF);
    if (threadIdx.x < 4) misc[threadIdx.x] = 0u;
    if (threadIdx.x == 0) { LAS Params* lp = (LAS Params*)(lds0 + PARAMS_OFF);
#pragma unroll
        for (int i = 0; i < 33; ++i) lp->in[i] = kp.in[i];
        lp->out = kp.out; lp->ws = kp.ws;
#pragma unroll
        for (int i = 0; i < 16; ++i) lp->invA[i] = kp.invA[i];
#pragma unroll
        for (int i = 0; i < 32; ++i) lp->invR[i] = kp.invR[i];
        lp->dry = kp.dry; }
    __syncthreads();
    const int ph_lo = kp.ph_lo, ph_hi = kp.ph_hi, fused = kp.fused;
    if (fused) (void)xcd_barrier_post((unsigned*)(kp.ws + WS_CTL) + CW_BAR, misc);
    if (((MK_PHASES >> 31) & 1u) && kp.do_pro) { LP(); p0_prologue(p, F); SEAM(); }

#if MK_FUSED
    layer_program(lds0, misc, 0, ph_lo, ph_hi, fused);
    layer_program(lds0, misc, 1, ph_lo, ph_hi, fused);
    layer_program(lds0, misc, 2, ph_lo, ph_hi, fused);
    layer_program(lds0, misc, 3, ph_lo, ph_hi, fused);
#else
    if (kp.l_lo < kp.l_hi) layer_program(lds0, misc, kp.l_lo, ph_lo, ph_hi, fused);
#endif
#undef IN
#undef SEAM
}

#ifndef MK_REP_MASK
#define MK_REP_MASK 0u
#define MK_REP_N 0
#endif
#ifndef MK_DRY_MODE
#define MK_DRY_MODE 1
#endif
extern "C" void kernel_launch(void* const* d_in, const int* in_sizes, int n_in, void* d_out, int out_size, void* d_ws, size_t ws_size, hipStream_t stream) {
    static int grid = 0;
    if (grid == 0) {
        if (n_in != 33 || in_sizes[0] != NB * NLAT * D || out_size != NB * NLAT * D || ws_size < WS_NEED) {
            fprintf(stderr, "kernel_launch: unexpected shapes/workspace: n_in %d in0 %d out %d ws %zu (need %zu)\n", n_in, n_in > 0 ? in_sizes[0] : -1, out_size, ws_size, (size_t)WS_NEED); grid = -1; return; }
        int dev = 0, cus = 0, per_cu = 0;
        if (hipGetDevice(&dev) != hipSuccess || hipDeviceGetAttribute(&cus, hipDeviceAttributeMultiprocessorCount, dev) != hipSuccess) { grid = -1; return; }
        if (hipFuncSetAttribute((const void*)mk_fwd, hipFuncAttributeMaxDynamicSharedMemorySize, LDS_BYTES) != hipSuccess) { fprintf(stderr, "kernel_launch: hipFuncSetAttribute failed\n"); grid = -1; return; }
        if (hipOccupancyMaxActiveBlocksPerMultiprocessor(&per_cu, (const void*)mk_fwd, NTHREADS, LDS_BYTES) != hipSuccess || per_cu < 1)
            fprintf(stderr, "kernel_launch: occupancy query reports %d workgroups per CU\n", per_cu);
        (void)hipGetLastError();
        grid = cus;
    }
    if (grid < 0) return;
    if (hipMemsetAsync((char*)d_ws + WS_CTL, 0, CTL_BYTES, stream) != hipSuccess) { fprintf(stderr, "kernel_launch: memset failed\n"); return; }
    Params a{};
    for (int i = 0; i < 33; ++i) a.in[i] = (const float*)d_in[i];
    a.out = (float*)d_out; a.ws = (unsigned char*)d_ws;
    for (int i = 0; i < 16; ++i) a.invA[i] = (float)pow(10000.0, -(double)i / 16.0);
    for (int i = 0; i < 32; ++i) a.invR[i] = (float)pow(10000.0, -(double)i / 32.0);
#if MK_FUSED
    a.ph_lo = 0; a.ph_hi = NPHASE; a.l_lo = 0; a.l_hi = DEPTH; a.fused = 1; a.do_pro = 1;
    hipLaunchKernelGGL(mk_fwd, dim3(grid), dim3(NTHREADS), LDS_BYTES, stream, a);
    if (hipPeekAtLastError() != hipSuccess) fprintf(stderr, "kernel_launch: launch failed\n");
#else
    a.fused = 0; a.do_pro = 1; a.l_lo = 0; a.l_hi = 0; a.ph_lo = 0; a.ph_hi = 0;
    hipLaunchKernelGGL(mk_fwd, dim3(grid), dim3(NTHREADS), LDS_BYTES, stream, a);
    a.do_pro = 0;
    for (int l = 0; l < DEPTH; ++l)
        for (int ph = 0; ph < NPHASE; ++ph) { a.l_lo = l; a.l_hi = l + 1; a.ph_lo = ph; a.ph_hi = ph + 1;
            const int reps = 1 + (((MK_REP_MASK >> ph) & 1u) ? MK_REP_N : 0);
            for (int r = 0; r < reps; ++r) { a.dry = r > 0 ? MK_DRY_MODE : 0; hipLaunchKernelGGL(mk_fwd, dim3(grid), dim3(NTHREADS), LDS_BYTES, stream, a); } a.dry = 0; }
    if (hipPeekAtLastError() != hipSuccess) fprintf(stderr, "kernel_launch: launch failed\n");
#endif
}
```

```cpp
#include <hip/hip_runtime.h>
#include <cstdio>
#include <cstdint>

#ifndef MK_FUSED
#define MK_FUSED 1
#endif

constexpr int D = 1024, NB = 8, NLAT = 4096, NCTX = 256, NP = NLAT + NCTX, T = NB * NP, DEPTH = 4;
constexpr int TP = T / 256;
constexpr int NPAIR_MAX = 2 * T;
constexpr int MOE_NBLK = NPAIR_MAX / 256 + 32;
constexpr int NTHREADS = 512, NWAVES = 8;

typedef unsigned short bf16_t;
typedef short bf16x8 __attribute__((ext_vector_type(8)));
typedef short bf16x4 __attribute__((ext_vector_type(4)));
typedef float f32x4 __attribute__((ext_vector_type(4)));
typedef float f32x2 __attribute__((ext_vector_type(2)));
typedef unsigned u32x4 __attribute__((ext_vector_type(4)));
typedef unsigned u32x2 __attribute__((ext_vector_type(2)));
#define LAS __attribute__((address_space(3)))

constexpr size_t AL(size_t x) { return (x + 255) & ~(size_t)255; }
constexpr size_t WS_CTL = 0, CTL_BYTES = 65536;
constexpr int CW_BAR = 0;
constexpr int CW_CNT = 4096;
constexpr size_t WS_MOD = AL(WS_CTL + CTL_BYTES);
constexpr size_t WS_ROPE = AL(WS_MOD + (size_t)DEPTH * 9 * 6144 * 4);
constexpr size_t WS_RWT = AL(WS_ROPE + (size_t)(2 * 64 * 16 + 2 * 64 * 32) * 4);
constexpr size_t WS_RW2 = AL(WS_RWT + (size_t)DEPTH * 36 * 1024 * 4);
constexpr size_t WS_RC = AL(WS_RW2 + (size_t)DEPTH * 64 * 3 * 4 * 16 * 4 * 4);
constexpr size_t WS_CTXRES = AL(WS_RC + (size_t)DEPTH * 9 * 48 * 4);
constexpr size_t WS_BTIN = AL(WS_CTXRES + (size_t)NB * NCTX * D * 4);
constexpr size_t WS_BTBR = AL(WS_BTIN + (size_t)7680 * 1024 * 2);
constexpr size_t WS_BTOUT = AL(WS_BTBR + (size_t)3 * 1024 * 512 * 2);
constexpr size_t WS_BTLORA = AL(WS_BTOUT + (size_t)1024 * 1024 * 2);
constexpr size_t WS_H = AL(WS_BTLORA + (size_t)2560 * 256 * 2);
constexpr size_t WS_M0 = AL(WS_H + (size_t)T * 1024 * 2);
constexpr size_t SZ512 = (size_t)T * 512 * 2;
constexpr size_t WS_AQ = WS_M0;
constexpr size_t WS_AKV = AL(WS_AQ + SZ512);
constexpr size_t WS_RQ = AL(WS_AKV + (size_t)T * 256 * 2);
constexpr size_t WS_RK = AL(WS_RQ + SZ512);
constexpr size_t WS_RV = AL(WS_RK + SZ512);
constexpr size_t WS_RG = AL(WS_RV + SZ512);
constexpr size_t WS_GL = AL(WS_RG + SZ512);
constexpr size_t WS_WU = AL(WS_GL + (size_t)T * 3072 * 2);
constexpr size_t WS_LW = AL(WS_WU + (size_t)T * 1792 * 2);
constexpr size_t WS_LA = AL(WS_LW + (size_t)T * 1024 * 2);
constexpr size_t WS_LG = AL(WS_LA + (size_t)T * 1024 * 2);
constexpr size_t WS_W1 = AL(WS_LG + SZ512);
constexpr size_t WS_END_MIX = AL(WS_W1 + 9 * SZ512);
constexpr size_t WS_YS = WS_LW;
constexpr size_t WS_SF = WS_WU + 3 * SZ512;
constexpr size_t WS_SB = AL(WS_SF + (size_t)NB * 4 * 34 * 16384 * 2);
static_assert(WS_SB + (size_t)NB * 4 * 34 * 16384 * 2 <= WS_LG, "retention states fit behind YCAT inside WU|LW|LA");
constexpr size_t WS_BT1 = WS_M0;
constexpr size_t WS_BT2 = AL(WS_BT1 + (size_t)32 * 1024 * 1024 * 2);
constexpr size_t WS_BUF = AL(WS_BT2 + (size_t)32 * 1024 * 512 * 2);
constexpr size_t WS_HB = AL(WS_BUF + (size_t)MOE_NBLK * 256 * 1024 * 2);
constexpr size_t WS_YB = AL(WS_HB + (size_t)MOE_NBLK * 256 * 512 * 2);
constexpr size_t WS_PAIR = AL(WS_YB + (size_t)MOE_NBLK * 256 * 1024 * 2);
constexpr size_t WS_RSROW = AL(WS_PAIR + (size_t)4 * NPAIR_MAX * 4);
constexpr size_t WS_END_MOE = AL(WS_RSROW + (size_t)T * 4);
static_assert(WS_END_MOE <= WS_END_MIX, "moe overlay inside the mixer region");
constexpr size_t WS_NEED = WS_END_MIX;
static_assert(WS_NEED <= 1220000000ull, "workspace budget (sum of inputs = 1220.39 MB)");

constexpr int RING_BYTES = 131072;
constexpr int LDS_BYTES = 147456;
constexpr int MISC_OFF = LDS_BYTES - 4096;

struct Params {
    const float* in[33];
    float* out;
    unsigned char* ws;
    float invA[16];
    float invR[32];
    int ph_lo, ph_hi, l_lo, l_hi;
    int fused, do_pro;
    int dry, pad2;
};
enum { I_X = 0, I_C, I_CTX, I_CCTX, I_ADAW, I_ADAB, I_N1G, I_N2G, I_WIN, I_QNG, I_KNG, I_RDL, I_RGN, I_MU, I_W0, I_W2, I_A0, I_A2, I_G2, I_KK, I_KA, I_RK, I_LNG, I_LNB,
       I_WBR, I_WOUT, I_RGW, I_RGB, I_REW, I_REB, I_MG, I_MUP, I_MD };

__device__ __forceinline__ float bf2f(unsigned v) { return __builtin_bit_cast(float, v << 16); }
__device__ __forceinline__ unsigned f2bf(float f) { return (unsigned)__builtin_bit_cast(unsigned short, (__bf16)f); }
typedef __bf16 hwbf16x2 __attribute__((ext_vector_type(2)));
__device__ __forceinline__ unsigned pk2(float lo, float hi) { const f32x2 v = {lo, hi}; return __builtin_bit_cast(unsigned, __builtin_convertvector(v, hwbf16x2)); }
__device__ __forceinline__ float lo16(unsigned w) { return __builtin_bit_cast(float, w << 16); }
__device__ __forceinline__ float hi16(unsigned w) { return __builtin_bit_cast(float, w & 0xffff0000u); }
__device__ __forceinline__ void unpack8(const u32x4 v, float (&x)[8]) { x[0] = lo16(v.x); x[1] = hi16(v.x); x[2] = lo16(v.y); x[3] = hi16(v.y); x[4] = lo16(v.z); x[5] = hi16(v.z); x[6] = lo16(v.w); x[7] = hi16(v.w); }
__device__ __forceinline__ u32x4 pack8(const float (&x)[8]) { u32x4 v; v.x = pk2(x[0], x[1]); v.y = pk2(x[2], x[3]); v.z = pk2(x[4], x[5]); v.w = pk2(x[6], x[7]); return v; }
__device__ __forceinline__ float frcp(float x) { return __builtin_amdgcn_rcpf(x); }
__device__ __forceinline__ float sigmoidf_(float x) { return frcp(1.f + __expf(-x)); }
__device__ __forceinline__ float siluf_(float x) { return x * frcp(1.f + __expf(-x)); }
__device__ __forceinline__ float shfl_xor_f(float v, int m) { return __shfl_xor(v, m, 64); }
__device__ __forceinline__ float* xrow(const Params& p, int row) {
    const int b = row / NP, q = row - b * NP;
    return q < NCTX ? (float*)(p.ws + WS_CTXRES) + (size_t)(b * NCTX + q) * D : p.out + (size_t)(b * NLAT + (q - NCTX)) * D;
}
__device__ __forceinline__ bf16x8 ld_frag(const LAS unsigned char* p) { return *(const LAS bf16x8*)p; }
__device__ __forceinline__ bf16x4 tr_read(const LAS unsigned char* p) { return __builtin_amdgcn_ds_read_tr16_b64_v4i16((LAS bf16x4*)p); }
__device__ __forceinline__ bf16x8 cat44(bf16x4 a, bf16x4 b) { bf16x8 r; r[0] = a[0]; r[1] = a[1]; r[2] = a[2]; r[3] = a[3]; r[4] = b[0]; r[5] = b[1]; r[6] = b[2]; r[7] = b[3]; return r; }
__device__ __forceinline__ bf16x8 pack_frag(const f32x4 a, const f32x4 b) {
    u32x4 w; w.x = pk2(a[0], a[1]); w.y = pk2(a[2], a[3]); w.z = pk2(b[0], b[1]); w.w = pk2(b[2], b[3]); return __builtin_bit_cast(bf16x8, w);
}
#define MFMA16(a, b, c) __builtin_amdgcn_mfma_f32_16x16x32_bf16((a), (b), (c), 0, 0, 0)

#define XB_TMO      128
#define XB_XCNT(j)  (256  + 64 * (j))
#define XB_XSUB(j)  (1280 + 64 * (j))
#define XB_XGEN(j)  (2304 + 64 * (j))
#define XB_TOP      3328
#define XB_TOPGEN   3392
#define XCD_BAR_WORDS 3456
#define XB_SPIN_CAP (1u << 18)
__device__ __forceinline__ unsigned xb_ld(unsigned* p)              { return __hip_atomic_load(p, __ATOMIC_RELAXED, __HIP_MEMORY_SCOPE_AGENT); }
__device__ __forceinline__ unsigned xb_add(unsigned* p, unsigned v) { return __hip_atomic_fetch_add(p, v, __ATOMIC_RELAXED, __HIP_MEMORY_SCOPE_AGENT); }
__device__ __forceinline__ unsigned xb_xcc_id() { return (unsigned)__builtin_amdgcn_s_getreg((3 << 11) | 20) & 0xFu; }
#define XB_SPIN(cond, bar) do { unsigned _sp = 0; while (cond) { __builtin_amdgcn_s_sleep(1); \
    if ((++_sp & 255u) == 0u) { if (xb_ld(&(bar)[XB_TMO])) break; if (_sp > XB_SPIN_CAP) { atomicAdd(&(bar)[XB_TMO], 1u); break; } } } } while (0)
struct XcdBarrier { unsigned* bar; unsigned x; volatile LAS unsigned* st; };
__device__ __forceinline__ XcdBarrier xcd_barrier_post(unsigned* bar, volatile LAS unsigned* st) {
    XcdBarrier b; b.bar = bar; b.x = xb_xcc_id(); b.st = st;
    if (threadIdx.x == 0) (void)xb_add(&bar[XB_XCNT(b.x)], 1u);
    return b;
}
__device__ __forceinline__ void xcd_barrier_complete(unsigned* bar, unsigned x, unsigned& nloc, unsigned& nx) {
    const unsigned G = gridDim.x * gridDim.y * gridDim.z;
    unsigned sum, cnt, mine, sp = 0u;
    for (;;) {
        sum = 0u; cnt = 0u; mine = 0u;
#pragma unroll
        for (unsigned j = 0; j < 16; ++j) { const unsigned c = xb_ld(&bar[XB_XCNT(j)]); sum += c; cnt += (c > 0u) ? 1u : 0u; mine = (j == x) ? c : mine; }
        if (sum == G) break;
        __builtin_amdgcn_s_sleep(1);
        if ((++sp & 255u) == 0u) { if (xb_ld(&bar[XB_TMO])) break; if (sp > XB_SPIN_CAP) { atomicAdd(&bar[XB_TMO], 1u); break; } }
    }
    nloc = mine > 0u ? mine : 1u; nx = cnt > 0u ? cnt : 1u;
}
__device__ __forceinline__ void xcd_barrier(const XcdBarrier& b) {
    asm volatile("s_waitcnt vmcnt(0)" ::: "memory");
    __syncthreads();
    if (threadIdx.x == 0) {
        unsigned* bar = b.bar;
        __builtin_amdgcn_s_waitcnt(0);
        unsigned nloc = b.st[0], nx = b.st[1];
        if (nloc == 0u) { xcd_barrier_complete(bar, b.x, nloc, nx); b.st[0] = nloc; b.st[1] = nx; }
        const unsigned old = xb_add(&bar[XB_XSUB(b.x)], 1u);
        const unsigned gen = old / nloc;
        if (old + 1u == (gen + 1u) * nloc) {
            __builtin_amdgcn_fence(__ATOMIC_RELEASE, "agent");
            asm volatile("s_waitcnt vmcnt(0)" ::: "memory");
            const unsigned og = xb_add(&bar[XB_TOP], 1u);
            const unsigned tg = og / nx;
            if (og + 1u == (tg + 1u) * nx) xb_add(&bar[XB_TOPGEN], 1u);
            else XB_SPIN(xb_ld(&bar[XB_TOPGEN]) == tg, bar);
            __builtin_amdgcn_fence(__ATOMIC_ACQUIRE, "agent");
            xb_add(&bar[XB_XGEN(b.x)], 1u);
            asm volatile("s_waitcnt vmcnt(0)" ::: "memory");
        } else {
            XB_SPIN(xb_ld(&bar[XB_XGEN(b.x)]) == gen, bar);
            __builtin_amdgcn_fence(__ATOMIC_ACQUIRE, "agent");
            asm volatile("s_waitcnt vmcnt(0)" ::: "memory");
        }
    }
    __syncthreads();
}
namespace pg8 {
#define PG8_LAS __attribute__((address_space(3)))
typedef unsigned short bf16_t;
typedef short bf16x8 __attribute__((ext_vector_type(8)));
typedef float f32x4 __attribute__((ext_vector_type(4)));
typedef unsigned u32x4 __attribute__((ext_vector_type(4)));
constexpr int BM = 256, BK = 64, HALF = 128, HTB = HALF * BK * 2  , STAGE_BYTES = 8 * HTB, NXCD = 8, WGM = 8;

__host__ __device__ __forceinline__ int lds_byte(int r, int c) { const int st = (r >> 4) * 2 + (c >> 5), rr = r & 15, cc = c & 31, ob = rr * 64 + cc * 2; return st * 1024 + (ob ^ (((ob >> 9) & 1) << 5)); }
__host__ __device__ __forceinline__ void stage_rc(int b, int& R, int& C) { const int st = b / 1024, sb = b % 1024, swz = sb ^ (((sb >> 9) & 1) << 5); R = (st >> 1) * 16 + swz / 64; C = (st & 1) * 32 + (swz % 64) / 2; }
__host__ __device__ __forceinline__ int perm32(int rho) { const int n = rho >> 4, i = rho & 15; return 8 * (i >> 2) + 4 * n + (i & 3); }

struct Unit { int pm, pn; size_t bofs; };
struct Gemm { const bf16_t* A; const bf16_t* Bt; int M, N, K; };

struct StaticOrder {
    int nM, nN, nwg, G, c;
    __host__ __device__ void init(int M, int N, int G_, int c_) { nM = M / BM; nN = N / BM; nwg = nM * nN; G = G_; c = c_; }
    __host__ __device__ bool next(int i, Unit& u) const {
        const long L = (long)i * G + c; if (L >= nwg) return false;
        int wgid = (int)L; { const int q = nwg / NXCD, r = nwg % NXCD, xcd = wgid % NXCD, off = wgid / NXCD; wgid = (xcd < r ? xcd * (q + 1) : r * (q + 1) + (xcd - r) * q) + off; }
        const int nig = WGM * nN, gid = wgid / nig, fm = gid * WGM, gsz = (nM - fm) < WGM ? (nM - fm) : WGM;
        u.pm = fm + ((wgid % nig) % gsz); u.pn = (wgid % nig) / gsz; u.bofs = 0; return true;
    }
    __device__ __forceinline__ void a_ready(const Unit&) const {}
    __device__ __forceinline__ void done(const Unit&) const {}
};

__device__ __forceinline__ unsigned cvt_pk_bf16(float lo, float hi) { unsigned r; asm volatile("v_cvt_pk_bf16_f32 %0, %1, %2" : "=v"(r) : "v"(lo), "v"(hi)); return r; }
template <class Epi, class Sched, bool ALIGN_EPI = false, bool SP2 = false>
__device__ __forceinline__ void gemm_phase(PG8_LAS unsigned char* lds, const Gemm g, const Sched& S, const Epi& E) {
    int tid_ = threadIdx.x; asm volatile("" : "+v"(tid_)); const int tid = tid_, wid = __builtin_amdgcn_readfirstlane(tid >> 6), lane = tid & 63, wr = wid >> 2, wc = wid & 3, fr = lane & 15, fq = lane >> 4;
    int K = g.K; asm volatile("" : "+s"(K)); const int nt = K / BK;
    unsigned voffA[2], voffB[2];
#pragma unroll
    for (int i = 0; i < 2; ++i) { int R, C; stage_rc(tid * 16 + i * 8192, R, C); const int Rb = Epi::PERM ? ((R & ~31) + perm32(R & 31)) : R;
        voffA[i] = (unsigned)(R * K + C) * 2u; voffB[i] = (unsigned)(Rb * K + C) * 2u; }
    const size_t kstep = (size_t)(BK * 2);
    const size_t hstep = (size_t)HALF * K * 2;
    const size_t tstep = 2 * hstep;
    const unsigned ldsw = (unsigned)wid * 1024u;
    const int aoff = lds_byte(wr * 64 + fr, fq * 8), boff = lds_byte(wc * 32 + fr, fq * 8);
#define PG8_SA(b, h) (((b) * 2 + (h)) * HTB)
#define PG8_SB(b, h) ((4 + (b) * 2 + (h)) * HTB)
#define PG8_STAGE(bufoff, gbase, voff) do { _Pragma("unroll") for (int _i = 0; _i < 2; ++_i) \
        __builtin_amdgcn_global_load_lds((const unsigned*)((const char*)(gbase) + (voff)[_i]), (PG8_LAS unsigned*)(lds + (bufoff) + ldsw + _i * 8192), 16, 0, 0); } while (0)
#define PG8_LDA(dst, b, h) do { _Pragma("unroll") for (int m = 0; m < 4; ++m) _Pragma("unroll") for (int k = 0; k < 2; ++k) dst[m][k] = *(const PG8_LAS bf16x8*)(lds + PG8_SA(b, h) + aoff + m * 2048 + k * 1024); } while (0)
#define PG8_LDB(dst, b, h) do { _Pragma("unroll") for (int n = 0; n < 2; ++n) _Pragma("unroll") for (int k = 0; k < 2; ++k) dst[n][k] = *(const PG8_LAS bf16x8*)(lds + PG8_SB(b, h) + boff + n * 2048 + k * 1024); } while (0)
#define PG8_MMA(ai, bj, At, Bt) do { __builtin_amdgcn_s_setprio(1); _Pragma("unroll") for (int m = 0; m < 4; ++m) _Pragma("unroll") for (int n = 0; n < 2; ++n) _Pragma("unroll") for (int k = 0; k < 2; ++k) \
        acc[ai][bj][m][n] = __builtin_amdgcn_mfma_f32_16x16x32_bf16(Bt[n][k], At[m][k], acc[ai][bj][m][n], 0, 0, 0); __builtin_amdgcn_s_setprio(0); } while (0)
#define PG8_WAIT_V(n) asm volatile("s_waitcnt vmcnt(" #n ")" ::: "memory")
#define PG8_WAIT_L(n) asm volatile("s_waitcnt lgkmcnt(" #n ")" ::: "memory")
#define PG8_BAR __builtin_amdgcn_s_barrier()
#define PG8_SCHED __builtin_amdgcn_sched_barrier(0)
    Unit cur, nxt; int ui = 0;
    if (!S.next(0, cur)) return;
    f32x4 acc[2][2][4][2];
#pragma unroll
    for (int a = 0; a < 2; ++a)
#pragma unroll
        for (int b = 0; b < 2; ++b)
#pragma unroll
            for (int m = 0; m < 4; ++m)
#pragma unroll
                for (int n = 0; n < 2; ++n) acc[a][b][m][n] = (f32x4){0.f, 0.f, 0.f, 0.f};
    bf16x8 At[4][2], B0[2][2], B1[2][2];
    const char* cA = (const char*)g.A + (size_t)cur.pm * tstep; const char* cB = (const char*)g.Bt + cur.bofs + (size_t)cur.pn * tstep;
    S.a_ready(cur);
    if constexpr (SP2) {
        PG8_STAGE(PG8_SB(0, 0), cB, voffB); PG8_STAGE(PG8_SB(0, 1), cB + hstep, voffB); PG8_STAGE(PG8_SA(0, 0), cA, voffA); PG8_STAGE(PG8_SA(0, 1), cA + hstep, voffA);
        if (wr == 1) PG8_BAR;
        PG8_WAIT_V(2); PG8_BAR;
        PG8_STAGE(PG8_SB(1, 0), cB + kstep, voffB); PG8_STAGE(PG8_SA(1, 0), cA + kstep, voffA); PG8_STAGE(PG8_SB(1, 1), cB + hstep + kstep, voffB);
        PG8_WAIT_V(6); PG8_BAR;
    } else {
        PG8_STAGE(PG8_SB(0, 0), cB, voffB); PG8_STAGE(PG8_SA(0, 0), cA, voffA); PG8_STAGE(PG8_SB(0, 1), cB + hstep, voffB); PG8_STAGE(PG8_SA(0, 1), cA + hstep, voffA);
        if (wr == 1) PG8_BAR;
        PG8_WAIT_V(4); PG8_BAR;
        PG8_STAGE(PG8_SB(1, 0), cB + kstep, voffB); PG8_STAGE(PG8_SA(1, 0), cA + kstep, voffA); PG8_STAGE(PG8_SB(1, 1), cB + hstep + kstep, voffB);
        PG8_WAIT_V(6); PG8_BAR;
    }
    for (;;) {
        const bool has_next = S.next(ui + 1, nxt);
        const char* nA = has_next ? (const char*)g.A + (size_t)nxt.pm * tstep : cA; const char* nB = has_next ? (const char*)g.Bt + nxt.bofs + (size_t)nxt.pn * tstep : cB;
        for (int t = 0; t < nt; t += 2) {
            const bool last = (t == nt - 2);
            if constexpr (Epi::KHOOK) { if (t == 8 || t == 16) E.khook(acc, cur, wr, wc, fr, fq, t >> 3); }
            const char* a1 = cA + (size_t)(t + 1) * kstep;
            const char* a2 = last ? nA : cA + (size_t)(t + 2) * kstep; const char* b2 = last ? nB : cB + (size_t)(t + 2) * kstep;
            const char* a3 = a2 + kstep; const char* b3 = b2 + kstep;
            if (last && has_next) S.a_ready(nxt);
            if constexpr (SP2) {
            PG8_LDB(B0, 0, 0); PG8_LDB(B1, 0, 1); PG8_SCHED; PG8_LDA(At, 0, 0); PG8_STAGE(PG8_SA(1, 1), a1 + hstep, voffA);
            PG8_WAIT_V(8); PG8_WAIT_L(0); PG8_BAR; PG8_MMA(0, 0, At, B0); PG8_MMA(0, 1, At, B1); PG8_BAR; PG8_SCHED;
            PG8_LDA(At, 0, 1); PG8_STAGE(PG8_SB(0, 0), b2, voffB); PG8_STAGE(PG8_SB(0, 1), b2 + hstep, voffB); PG8_STAGE(PG8_SA(0, 0), a2, voffA);
            PG8_WAIT_V(8); PG8_WAIT_L(0); PG8_BAR; PG8_MMA(1, 0, At, B0); PG8_MMA(1, 1, At, B1); PG8_BAR; PG8_SCHED;
            PG8_LDB(B0, 1, 0); PG8_LDB(B1, 1, 1); PG8_SCHED; PG8_LDA(At, 1, 0); PG8_STAGE(PG8_SA(0, 1), a2 + hstep, voffA);
            PG8_WAIT_V(8); PG8_WAIT_L(0); PG8_BAR; PG8_MMA(0, 0, At, B0); PG8_MMA(0, 1, At, B1); PG8_BAR; PG8_SCHED;
            PG8_LDA(At, 1, 1); PG8_STAGE(PG8_SB(1, 0), b3, voffB); PG8_STAGE(PG8_SB(1, 1), b3 + hstep, voffB); PG8_STAGE(PG8_SA(1, 0), a3, voffA);
            PG8_WAIT_V(8); PG8_WAIT_L(0); PG8_BAR; PG8_MMA(1, 0, At, B0); PG8_MMA(1, 1, At, B1); PG8_BAR; PG8_SCHED;
            } else {
            PG8_LDB(B0, 0, 0); PG8_SCHED; PG8_LDA(At, 0, 0); PG8_STAGE(PG8_SA(1, 1), a1 + hstep, voffA);
            PG8_WAIT_L(8); PG8_BAR; PG8_WAIT_L(0); PG8_MMA(0, 0, At, B0); PG8_BAR; PG8_SCHED;
            PG8_LDB(B1, 0, 1); PG8_STAGE(PG8_SB(0, 0), b2, voffB);
            PG8_BAR; PG8_WAIT_L(0); PG8_MMA(0, 1, At, B1); PG8_BAR;
            PG8_LDA(At, 0, 1); PG8_STAGE(PG8_SA(0, 0), a2, voffA);
            PG8_BAR; PG8_WAIT_L(0); PG8_MMA(1, 0, At, B0); PG8_BAR; PG8_SCHED;
            PG8_STAGE(PG8_SB(0, 1), b2 + hstep, voffB);
            PG8_WAIT_V(6); PG8_BAR; PG8_MMA(1, 1, At, B1); PG8_BAR;
            PG8_LDB(B0, 1, 0); PG8_SCHED; PG8_LDA(At, 1, 0); PG8_STAGE(PG8_SA(0, 1), a2 + hstep, voffA);
            PG8_WAIT_L(8); PG8_BAR; PG8_WAIT_L(0); PG8_MMA(0, 0, At, B0); PG8_BAR; PG8_SCHED;
            PG8_LDB(B1, 1, 1); PG8_STAGE(PG8_SB(1, 0), b3, voffB);
            PG8_BAR; PG8_WAIT_L(0); PG8_MMA(0, 1, At, B1); PG8_BAR;
            PG8_LDA(At, 1, 1); PG8_STAGE(PG8_SA(1, 0), a3, voffA);
            PG8_BAR; PG8_WAIT_L(0); PG8_MMA(1, 0, At, B0); PG8_BAR; PG8_SCHED;
            PG8_STAGE(PG8_SB(1, 1), b3 + hstep, voffB);
            PG8_WAIT_V(6); PG8_BAR; PG8_MMA(1, 1, At, B1); PG8_BAR;
            }
        }
        if constexpr (ALIGN_EPI) { if (wr == 0) PG8_BAR; }
        if constexpr (!Epi::AFTER_DRAIN) { E(acc, cur, wr, wc, fr, fq); S.done(cur); }
        if (!has_next) break;
#pragma unroll
        for (int a = 0; a < 2; ++a)
#pragma unroll
            for (int b = 0; b < 2; ++b)
#pragma unroll
                for (int m = 0; m < 4; ++m)
#pragma unroll
                    for (int n = 0; n < 2; ++n) acc[a][b][m][n] = (f32x4){0.f, 0.f, 0.f, 0.f};
        cur = nxt; cA = nA; cB = nB; ++ui;
        if constexpr (ALIGN_EPI) { if (wr == 1) PG8_BAR; }
    }
    PG8_WAIT_V(0);
    if constexpr (!ALIGN_EPI) { if (wr == 0) PG8_BAR; }
    PG8_BAR;
    if constexpr (Epi::AFTER_DRAIN) { E.fused(acc, cur, wr, wc, fr, fq, lds, wid, lane); S.done(cur); }
#undef PG8_SA
#undef PG8_SB
#undef PG8_STAGE
#undef PG8_LDA
#undef PG8_LDB
#undef PG8_MMA
#undef PG8_WAIT_V
#undef PG8_WAIT_L
#undef PG8_BAR
#undef PG8_SCHED
}
template <bool EXPNEG = false> __device__ __forceinline__ void store_bf16_tile(bf16_t* O, int pitch, int colt, const f32x4 (&acc)[2][2][4][2], const Unit& u, int wr, int wc, int fr, int fq) {
    const int row0 = u.pm * BM + wr * 64 + fr; const int col0 = colt + wc * 32 + 8 * fq;
#pragma unroll
    for (int ai = 0; ai < 2; ++ai)
#pragma unroll
        for (int m = 0; m < 4; ++m) { bf16_t* rowp = O + (size_t)(row0 + ai * HALF + m * 16) * pitch + col0;
#pragma unroll
            for (int bj = 0; bj < 2; ++bj) { f32x4 v0 = acc[ai][bj][m][0], v1 = acc[ai][bj][m][1];
                if (EXPNEG) {
#pragma unroll
                    for (int e = 0; e < 4; ++e) { v0[e] = __expf(-v0[e]); v1[e] = __expf(-v1[e]); } }
                u32x4 w; w.x = cvt_pk_bf16(v0[0], v0[1]); w.y = cvt_pk_bf16(v0[2], v0[3]); w.z = cvt_pk_bf16(v1[0], v1[1]); w.w = cvt_pk_bf16(v1[2], v1[3]);
                *(u32x4*)(rowp + bj * HALF) = w; } }
}
struct EpiInproj {
    static constexpr bool PERM = true, AFTER_DRAIN = false, KHOOK = false;
    unsigned char* ws;
    __device__ __forceinline__ void operator()(const f32x4 (&acc)[2][2][4][2], const Unit& u, int wr, int wc, int fr, int fq) const {
        const int pn = u.pn; size_t base; int pitch, colt;
        if (pn < 2)       { base = WS_AQ;  pitch = 512;  colt = pn * 256; }
        else if (pn == 2) { base = WS_AKV; pitch = 256;  colt = 0; }
        else if (pn < 5)  { base = WS_RQ;  pitch = 512;  colt = (pn - 3) * 256; }
        else if (pn < 7)  { base = WS_RK;  pitch = 512;  colt = (pn - 5) * 256; }
        else if (pn < 9)  { base = WS_RV;  pitch = 512;  colt = (pn - 7) * 256; }
        else if (pn < 11) { base = WS_RG;  pitch = 512;  colt = (pn - 9) * 256; }
        else if (pn < 18) { base = WS_WU;  pitch = 1792; colt = (pn - 11) * 256; }
        else              { store_bf16_tile<true>((bf16_t*)(ws + WS_GL), 3072, (pn - 18) * 256, acc, u, wr, wc, fr, fq); return; }
        store_bf16_tile((bf16_t*)(ws + base), pitch, colt, acc, u, wr, wc, fr, fq);
    }
};
struct EpiLora {
    static constexpr bool PERM = true, AFTER_DRAIN = false, KHOOK = false;
    unsigned char* ws;
    __device__ __forceinline__ void operator()(const f32x4 (&acc)[2][2][4][2], const Unit& u, int wr, int wc, int fr, int fq) const {
        const int pn = u.pn; size_t base; int pitch, colt;
        if (pn < 4)      { base = WS_LW; pitch = 1024; colt = pn * 256; }
        else if (pn < 8) { base = WS_LA; pitch = 1024; colt = (pn - 4) * 256; }
        else             { base = WS_LG; pitch = 512;  colt = (pn - 8) * 256; }
        store_bf16_tile((bf16_t*)(ws + base), pitch, colt, acc, u, wr, wc, fr, fq);
    }
};
struct EpiPlainBf16 {
    static constexpr bool PERM = true, AFTER_DRAIN = false, KHOOK = false;
    bf16_t* O; int pitch;
    __device__ __forceinline__ void operator()(const f32x4 (&acc)[2][2][4][2], const Unit& u, int wr, int wc, int fr, int fq) const {
        store_bf16_tile(O, pitch, u.pn * BM, acc, u, wr, wc, fr, fq);
    }
};
template <int MODE> struct EpiMerge {
    static constexpr bool PERM = false, AFTER_DRAIN = false, KHOOK = false;
    const bf16_t* GL; float* MRG; bf16_t* OB; int nb;
    __device__ __forceinline__ void operator()(const f32x4 (&acc)[2][2][4][2], const Unit& u, int wr, int wc, int fr, int fq) const {
        const int row0 = u.pm * BM + wr * 64 + fr, col0 = u.pn * BM + wc * 32 + 4 * fq;
#pragma unroll
        for (int ai = 0; ai < 2; ++ai)
#pragma unroll
            for (int m = 0; m < 4; ++m) { const size_t row = (size_t)(row0 + ai * HALF + m * 16); asm volatile("" ::: "memory");
#pragma unroll
                for (int bj = 0; bj < 2; ++bj)
#pragma unroll
                    for (int n = 0; n < 2; ++n) { const int col = col0 + bj * HALF + n * 16;
                        const u32x2 gw = *(const u32x2*)(GL + row * 3072 + nb * 1024 + col);
                        f32x4 g; g[0] = __builtin_amdgcn_rcpf(1.f + __expf(-lo16(gw.x))); g[1] = __builtin_amdgcn_rcpf(1.f + __expf(-hi16(gw.x))); g[2] = __builtin_amdgcn_rcpf(1.f + __expf(-lo16(gw.y))); g[3] = __builtin_amdgcn_rcpf(1.f + __expf(-hi16(gw.y)));
                        f32x4 v = acc[ai][bj][m][n] * g;
                        float* mp = MRG + row * 1024 + col;
                        if (MODE != 0) v = v + *(const f32x4*)mp;
                        if (MODE != 2) *(f32x4*)mp = v;
                        else { u32x2 w; w.x = cvt_pk_bf16(v[0], v[1]); w.y = cvt_pk_bf16(v[2], v[3]); *(u32x2*)(OB + row * 1024 + col) = w; } } }
    }
};
struct EpiMergeK {
    static constexpr bool PERM = false, AFTER_DRAIN = false, KHOOK = true;
    const bf16_t* GL; bf16_t* OB;
    __device__ __forceinline__ void khook(f32x4 (&acc)[2][2][4][2], const Unit& u, int wr, int wc, int fr, int fq, int seg  ) const {
        const int row0 = u.pm * BM + wr * 64 + fr, col0 = u.pn * BM + wc * 32 + 4 * fq;
#pragma unroll
        for (int ai = 0; ai < 2; ++ai) {
            u32x2 ga[4][2][2], gb[4][2][2];
            asm volatile("" ::: "memory");
#pragma unroll
            for (int m = 0; m < 4; ++m) { const bf16_t* gr = GL + (size_t)(row0 + ai * HALF + m * 16) * 3072 + (seg - 1) * 1024 + col0;
#pragma unroll
                for (int bj = 0; bj < 2; ++bj)
#pragma unroll
                    for (int n = 0; n < 2; ++n) { ga[m][bj][n] = *(const u32x2*)(gr + bj * HALF + n * 16); gb[m][bj][n] = *(const u32x2*)(gr + 1024 + bj * HALF + n * 16); } }
#pragma unroll
            for (int m = 0; m < 4; ++m)
#pragma unroll
                for (int bj = 0; bj < 2; ++bj)
#pragma unroll
                    for (int n = 0; n < 2; ++n) { const u32x2 a = ga[m][bj][n], b = gb[m][bj][n];
                        f32x4 r;
                        r[0] = (1.f + lo16(b.x)) * __builtin_amdgcn_rcpf(1.f + lo16(a.x)); r[1] = (1.f + hi16(b.x)) * __builtin_amdgcn_rcpf(1.f + hi16(a.x));
                        r[2] = (1.f + lo16(b.y)) * __builtin_amdgcn_rcpf(1.f + lo16(a.y)); r[3] = (1.f + hi16(b.y)) * __builtin_amdgcn_rcpf(1.f + hi16(a.y));
                        acc[ai][bj][m][n] = acc[ai][bj][m][n] * r; } }
    }
    __device__ __forceinline__ void operator()(const f32x4 (&acc)[2][2][4][2], const Unit& u, int wr, int wc, int fr, int fq) const {
        const int row0 = u.pm * BM + wr * 64 + fr, col0 = u.pn * BM + wc * 32 + 4 * fq;
#pragma unroll
        for (int ai = 0; ai < 2; ++ai) { asm volatile("" ::: "memory");
#pragma unroll
            for (int m = 0; m < 4; ++m) { const size_t row = (size_t)(row0 + ai * HALF + m * 16);
#pragma unroll
                for (int bj = 0; bj < 2; ++bj)
#pragma unroll
                    for (int n = 0; n < 2; ++n) { const int col = col0 + bj * HALF + n * 16;
                        const u32x2 gw = *(const u32x2*)(GL + row * 3072 + 2048 + col);
                        f32x4 g; g[0] = __builtin_amdgcn_rcpf(1.f + lo16(gw.x)); g[1] = __builtin_amdgcn_rcpf(1.f + hi16(gw.x)); g[2] = __builtin_amdgcn_rcpf(1.f + lo16(gw.y)); g[3] = __builtin_amdgcn_rcpf(1.f + hi16(gw.y));
                        const f32x4 v = acc[ai][bj][m][n] * g;
                        u32x2 w; w.x = cvt_pk_bf16(v[0], v[1]); w.y = cvt_pk_bf16(v[2], v[3]); *(u32x2*)(OB + row * 1024 + col) = w; } } }
    }
};
struct EpiOut {
    static constexpr bool PERM = false, AFTER_DRAIN = false, KHOOK = false;
    float* out; float* ctxres; const float* modl; int dry; const float* xin; const float* cin;
    __device__ __forceinline__ void operator()(const f32x4 (&acc)[2][2][4][2], const Unit& u, int wr, int wc, int fr, int fq) const {
        const int row0 = u.pm * BM + wr * 64 + fr, col0 = u.pn * BM + wc * 32 + 4 * fq;
        const int b = (u.pm * BM) / NP, q0 = u.pm * BM - b * NP;
        const bool isctx = q0 < NCTX;
        const float* g1 = modl + (size_t)(isctx ? 8 : b) * 6144 + 2048;
        float* xb = isctx ? ctxres + (size_t)(b * NCTX) * D : out + ((size_t)b * NLAT + (q0 - NCTX)) * D;
        const float* xs = isctx ? cin + (size_t)(b * NCTX) * D : xin + ((size_t)b * NLAT + (q0 - NCTX)) * D;
        f32x4 gv[2][2];
#pragma unroll
        for (int bj = 0; bj < 2; ++bj)
#pragma unroll
            for (int n = 0; n < 2; ++n) gv[bj][n] = *(const f32x4*)(g1 + col0 + bj * HALF + n * 16);
#pragma unroll
        for (int ai = 0; ai < 2; ++ai) { asm volatile("" ::: "memory");
#pragma unroll
            for (int m = 0; m < 4; ++m) { const size_t ro = (size_t)(wr * 64 + fr + ai * HALF + m * 16) * D + col0; float* rowp = xb + ro; const float* srcp = xs + ro;
#pragma unroll
                for (int bj = 0; bj < 2; ++bj)
#pragma unroll
                    for (int n = 0; n < 2; ++n) { float* xp = rowp + bj * HALF + n * 16; const f32x4 nv = *(const f32x4*)(srcp + bj * HALF + n * 16) + gv[bj][n] * acc[ai][bj][m][n]; if (!dry) *(f32x4*)xp = nv; } } }
    }
};
struct EpiSwiGLU {
    static constexpr bool PERM = false, AFTER_DRAIN = false, KHOOK = false;
    bf16_t* HB;
    __device__ __forceinline__ void operator()(const f32x4 (&acc)[2][2][4][2], const Unit& u, int wr, int wc, int fr, int fq) const {
        const int row0 = u.pm * BM + wr * 64 + fr, hh0 = u.pn * 128 + wc * 16 + 4 * fq;
#pragma unroll
        for (int ai = 0; ai < 2; ++ai)
#pragma unroll
            for (int m = 0; m < 4; ++m) { bf16_t* rowp = HB + (size_t)(row0 + ai * HALF + m * 16) * 512 + hh0;
#pragma unroll
                for (int bj = 0; bj < 2; ++bj) { const f32x4 g = acc[ai][bj][m][0], up = acc[ai][bj][m][1]; f32x4 h;
#pragma unroll
                    for (int i = 0; i < 4; ++i) h[i] = g[i] * __builtin_amdgcn_rcpf(1.f + __expf(-g[i])) * up[i];
                    u32x2 w; w.x = cvt_pk_bf16(h[0], h[1]); w.y = cvt_pk_bf16(h[2], h[3]); *(u32x2*)(rowp + bj * 64) = w; } }
    }
};
struct LatentOrder {
    StaticOrder S;
    __host__ __device__ void init(int N, int G_, int c_) { S.init(128 * BM, N, G_, c_); }
    __host__ __device__ bool next(int i, Unit& u) const { if (!S.next(i, u)) return false; u.pm = (u.pm >> 4) * 17 + 1 + (u.pm & 15); return true; }
    __device__ __forceinline__ void a_ready(const Unit&) const {}
    __device__ __forceinline__ void done(const Unit&) const {}
};
template <size_t ESTRIDE> struct MoeOrder {
    int G, c; const PG8_LAS int* tab;
    __device__ __forceinline__ bool next(int i, Unit& u) const {
        const long L = (long)i * G + c; if (L >= (long)tab[32 + MOE_NBLK] * 4) return false;
        u.pm = (int)(L >> 2); u.pn = (int)(L & 3); u.bofs = (size_t)tab[32 + u.pm] * ESTRIDE; return true; }
    __device__ __forceinline__ void a_ready(const Unit&) const {}
    __device__ __forceinline__ void done(const Unit&) const {}
};
}
#define PG8_SP2 true
#define PG8_ALIGN true
struct Frame {
    LAS unsigned char* lds; int tid, lane, wave, G, bid, gwave, nwave;
};
__device__ __forceinline__ bf16_t* WSB(const Params& p, size_t off) { return (bf16_t*)(p.ws + off); }
__device__ __forceinline__ float* WSF(const Params& p, size_t off) { return (float*)(p.ws + off); }

__device__ __forceinline__ void sincos_dd(double ang, float& c, float& s) {
    const double kf = __builtin_rint(ang * 0.63661977236758134308);
    const double r = (ang - kf * 1.57079632679489655800) - kf * 6.12323399573676603587e-17;
    const int k = ((int)kf) & 3;
    const double r2 = r * r;
    const double sp = r * (1.0 + r2 * (-1.0 / 6 + r2 * (1.0 / 120 + r2 * (-1.0 / 5040 + r2 * (1.0 / 362880 + r2 * (-1.0 / 39916800 + r2 * (1.0 / 6227020800.0)))))));
    const double cp = 1.0 + r2 * (-0.5 + r2 * (1.0 / 24 + r2 * (-1.0 / 720 + r2 * (1.0 / 40320 + r2 * (-1.0 / 3628800 + r2 * (1.0 / 479001600 + r2 * (-1.0 / 87178291200.0)))))));
    const double cc = (k == 0) ? cp : (k == 1) ? -sp : (k == 2) ? -cp : sp;
    const double ss = (k == 0) ? sp : (k == 1) ? cp : (k == 2) ? -sp : -cp;
    c = (float)cc; s = (float)ss;
}
__device__ __forceinline__ void p0_prologue(const Params& p, const Frame& F) {
    const int gt = F.bid * NTHREADS + F.tid, ngt = F.G * NTHREADS;
    { float* tab = WSF(p, WS_ROPE); const LAS Params* lpar = (const LAS Params*)(F.lds + (LDS_BYTES - 4096 + 2048));
      for (int i = gt; i < 64 * 16 + 64 * 32; i += ngt) {
          if (i < 1024) { const int pos = i >> 4, k = i & 15; float c, s; sincos_dd((double)pos * (double)lpar->invA[k], c, s); tab[i] = c; tab[1024 + i] = s; }
          else { const int j = i - 1024, pos = j >> 5, k = j & 31; float c, s; sincos_dd((double)pos * (double)lpar->invR[k], c, s); tab[2048 + j] = c; tab[2048 + 2048 + j] = s; } } }
    { float* rwt = WSF(p, WS_RWT);
      for (int i = gt; i < DEPTH * 36 * 1024; i += ngt) { const int l = i / (36 * 1024), r = i - l * 36 * 1024, o = r >> 10, k = r & 1023;
          rwt[i] = o < 4 ? p.in[I_RGW][((size_t)l * 1024 + k) * 4 + o] : p.in[I_REW][((size_t)l * 1024 + k) * 32 + (o - 4)]; } }
    { float* rw2 = WSF(p, WS_RW2);
      for (int i = gt; i < DEPTH * 64 * 3 * 4 * 16 * 4; i += ngt) { const int j = i & 3, n = (i >> 2) & 15, g = (i >> 6) & 3, r = i >> 8, nt = r % 3, r2 = r / 3, kq = r2 & 63, l = r2 >> 6;
          const int ng = 16 * nt + n, k = 4 * (4 * kq + j) + g;
          rw2[i] = ng < 4 ? p.in[I_RGW][((size_t)l * 1024 + k) * 4 + ng] : (ng < 36 ? p.in[I_REW][((size_t)l * 1024 + k) * 32 + (ng - 4)] : 0.f); } }
    { LAS float* cond = (LAS float*)F.lds;
      LAS float* red = (LAS float*)(F.lds + 9 * 1024 * 4);
      for (int i = F.tid; i < 9 * 1024; i += NTHREADS) { const float v = i < 8192 ? p.in[I_C][i] : p.in[I_CCTX][i - 8192]; cond[i] = siluf_(v); }
      __syncthreads();
      float* mod = WSF(p, WS_MOD);
      for (int task = F.bid; task < DEPTH * 96; task += F.G) {
          const int l = task / 96, col0 = (task - l * 96) * 64, c = F.tid & 63, ks = F.tid >> 6;
          const float* w = p.in[I_ADAW] + ((size_t)l * 1024 + ks * 128) * 6144 + col0 + c;
          float a[9];
#pragma unroll
          for (int r = 0; r < 9; ++r) a[r] = 0.f;
          for (int k = 0; k < 128; ++k) { const float wv = w[(size_t)k * 6144];
#pragma unroll
              for (int r = 0; r < 9; ++r) a[r] += cond[r * 1024 + ks * 128 + k] * wv; }
#pragma unroll
          for (int r = 0; r < 9; ++r) red[(ks * 9 + r) * 64 + c] = a[r];
          __syncthreads();
          for (int o = F.tid; o < 9 * 64; o += NTHREADS) { const int r = o >> 6, cc = o & 63; float s = 0.f;
#pragma unroll
              for (int k2 = 0; k2 < 8; ++k2) s += red[(k2 * 9 + r) * 64 + cc];
              mod[((size_t)l * 9 + r) * 6144 + col0 + cc] = s + p.in[I_ADAB][(size_t)l * 6144 + col0 + cc]; }
          __syncthreads();
      } }
}

__device__ __forceinline__ void cvt_tile(const float* src, int ld_src, bf16_t* dst, int ld_dst, int k0, int n0, LAS float* tile  , int tid) {
#pragma unroll
    for (int ps = 0; ps < 2; ++ps) { const int k = ps * 32 + (tid >> 4), n4 = (tid & 15) * 4;
        const f32x4 v = *(const f32x4*)(src + (size_t)(k0 + k) * ld_src + n0 + n4);
        tile[k * 65 + n4] = v[0]; tile[k * 65 + n4 + 1] = v[1]; tile[k * 65 + n4 + 2] = v[2]; tile[k * 65 + n4 + 3] = v[3]; }
    __syncthreads();
    { const int n = tid >> 3, k8 = (tid & 7) * 8; float x[8];
#pragma unroll
      for (int e = 0; e < 8; ++e) x[e] = tile[(k8 + e) * 65 + n];
      *(u32x4*)(dst + (size_t)(n0 + n) * ld_dst + k0 + k8) = pack8(x); }
    __syncthreads();
}

struct CvtTask { const float* src; bf16_t* dst; int ld_src, ld_dst, k0, n0, which; };
__device__ __forceinline__ void cvt_load(f32x4 (&v)[8], const CvtTask& c, int tid) {
#pragma unroll
    for (int ps = 0; ps < 8; ++ps) v[ps] = *(const f32x4*)(c.src + (size_t)(c.k0 + ps * 8 + (tid >> 6)) * c.ld_src + c.n0 + (tid & 63) * 4);
}
__device__ __forceinline__ void cvt_store(const f32x4 (&v)[8], const CvtTask& c, LAS float* tile  , int tid) {
#pragma unroll
    for (int ps = 0; ps < 8; ++ps) *(LAS f32x4*)(tile + (ps * 8 + (tid >> 6)) * 260 + (tid & 63) * 4) = v[ps];
    __syncthreads();
    { const int n = tid >> 1, kb = (tid & 1) * 32, nn = c.n0 + n; const int row = c.which < 0 ? nn : ((nn >> 4) << 5) + (c.which << 4) + (nn & 15);
      bf16_t* d = c.dst + (size_t)row * c.ld_dst + c.k0 + kb;
#pragma unroll
      for (int q = 0; q < 4; ++q) { float x[8];
#pragma unroll
          for (int e = 0; e < 8; ++e) x[e] = tile[(kb + q * 8 + e) * 260 + n];
          *(u32x4*)(d + q * 8) = pack8(x); } }
    __syncthreads();
}
constexpr int NT_MIX = 16 * 30 + 3 * 8 * 4 + 16 * 4;
__device__ __forceinline__ CvtTask cvt_task_mix(const Params& p, int l, int t) {
    CvtTask c; c.which = -1;
    if (t < 480) { const int kt = t / 30, nt = t - kt * 30; c.src = p.in[I_WIN] + (size_t)l * 1024 * 7680; c.ld_src = 7680; c.dst = WSB(p, WS_BTIN); c.ld_dst = 1024; c.k0 = kt * 64; c.n0 = nt * 256; }
    else if (t < 576) { const int u = t - 480, nb = u >> 5, r = u & 31, kt = r >> 2, nt = r & 3;
        c.src = p.in[I_WBR] + ((size_t)l * 3 + nb) * 512 * 1024; c.ld_src = 1024; c.dst = WSB(p, WS_BTBR) + nb * 512; c.ld_dst = 1536; c.k0 = kt * 64; c.n0 = nt * 256; }
    else { const int u = t - 576, kt = u >> 2, nt = u & 3; c.src = p.in[I_WOUT] + (size_t)l * 1024 * 1024; c.ld_src = 1024; c.dst = WSB(p, WS_BTOUT); c.ld_dst = 1024; c.k0 = kt * 64; c.n0 = nt * 256; }
    return c;
}
constexpr int NT_MOE = 32 * 2 * 16 * 2 + 32 * 8 * 4;
__device__ __forceinline__ CvtTask cvt_task_moe(const Params& p, int l, int t) {
    CvtTask c;
    if (t < 2048) { const int e = t >> 6, r = t & 63, which = r >> 5, kt = (r >> 1) & 15, nt = r & 1;
        c.src = (which ? p.in[I_MUP] : p.in[I_MG]) + ((size_t)l * 32 + e) * 1024 * 512; c.ld_src = 512; c.dst = WSB(p, WS_BT1) + (size_t)e * 1024 * 1024; c.ld_dst = 1024; c.k0 = kt * 64; c.n0 = nt * 256; c.which = which; }
    else { const int u = t - 2048, e = u >> 5, r = u & 31, kt = r >> 2, nt = r & 3;
        c.src = p.in[I_MD] + ((size_t)l * 32 + e) * 512 * 1024; c.ld_src = 1024; c.dst = WSB(p, WS_BT2) + (size_t)e * 1024 * 512; c.ld_dst = 512; c.k0 = kt * 64; c.n0 = nt * 256; c.which = -1; }
    return c;
}
template <bool MOE> __device__ __forceinline__ void cvt_run(const Params& p, const Frame& F, int l, LAS float* tile, int first_blk = 0, int t_lo = 0, int t_hi = -1) {
    const int NTASK = t_hi >= 0 ? t_hi : (MOE ? NT_MOE : NT_MIX);
    if (F.bid < first_blk) return;
    const int stride = F.G - first_blk;
    int t = t_lo + F.bid - first_blk; if (t >= NTASK) return;
    CvtTask cur = MOE ? cvt_task_moe(p, l, t) : cvt_task_mix(p, l, t);
    f32x4 v[8]; cvt_load(v, cur, F.tid);
    for (;;) {
        const int tn = t + stride; const bool more = tn < NTASK;
        CvtTask nx = cur; f32x4 vn[8];
        if (more) { nx = MOE ? cvt_task_moe(p, l, tn) : cvt_task_mix(p, l, tn); cvt_load(vn, nx, F.tid); }
        cvt_store(v, cur, tile, F.tid);
        if (!more) break;
#pragma unroll
        for (int i = 0; i < 8; ++i) v[i] = vn[i];
        cur = nx; t = tn;
    }
}

__device__ __forceinline__ void rmsnorm_mod_row(const float* x, const float* g, const float* sc, const float* sh, bf16_t* o, int lane, float* keep  ) {
    f32x4 v[4]; float ss = 0.f;
#pragma unroll
    for (int j = 0; j < 4; ++j) { v[j] = *(const f32x4*)(x + j * 256 + lane * 4); ss += v[j][0] * v[j][0] + v[j][1] * v[j][1] + v[j][2] * v[j][2] + v[j][3] * v[j][3]; }
#pragma unroll
    for (int m = 1; m < 64; m <<= 1) ss += shfl_xor_f(ss, m);
    const float rs = rsqrtf(ss * (1.f / 1024.f) + 1e-6f);
#pragma unroll
    for (int j = 0; j < 4; ++j) { const int c = j * 256 + lane * 4;
        const f32x4 gg = *(const f32x4*)(g + c), s1 = *(const f32x4*)(sc + c), s0 = *(const f32x4*)(sh + c);
        f32x4 y;
#pragma unroll
        for (int e = 0; e < 4; ++e) y[e] = v[j][e] * rs * gg[e] * (1.f + s1[e]) + s0[e];
        u32x2 w; w.x = pk2(y[0], y[1]); w.y = pk2(y[2], y[3]); *(u32x2*)(o + c) = w;
        if (keep) { keep[j * 4 + 0] = y[0]; keep[j * 4 + 1] = y[1]; keep[j * 4 + 2] = y[2]; keep[j * 4 + 3] = y[3]; } }
}
__device__ __forceinline__ void p1_weights(const Params& p, const Frame& F, int l, bool early_done = false) {
    LAS float* tile = (LAS float*)F.lds;
    cvt_run<false>(p, F, l, tile, 0, early_done ? 576 : 0);
    if (F.bid < 9) { const float* sh2 = WSF(p, WS_MOD) + ((size_t)l * 9 + F.bid) * 6144 + 3072; const float* rwt = WSF(p, WS_RWT) + (size_t)l * 36 * 1024; float* rc = WSF(p, WS_RC) + ((size_t)l * 9 + F.bid) * 48;
        for (int n = F.wave; n < 48; n += NWAVES) { float a = 0.f;
            if (n < 36) {
#pragma unroll
                for (int j = 0; j < 4; ++j) { const f32x4 sv = *(const f32x4*)(sh2 + j * 256 + F.lane * 4), wv = *(const f32x4*)(rwt + n * 1024 + j * 256 + F.lane * 4); a += sv[0] * wv[0] + sv[1] * wv[1] + sv[2] * wv[2] + sv[3] * wv[3]; }
#pragma unroll
                for (int mk = 1; mk < 64; mk <<= 1) a += shfl_xor_f(a, mk);
                a += n < 4 ? p.in[I_RGB][l * 4 + n] : p.in[I_REB][l * 32 + n - 4]; }
            if (F.lane == 0) rc[n] = a; } }
    { bf16_t* bl = WSB(p, WS_BTLORA); const int gt = F.bid * NTHREADS + F.tid, ngt = F.G * NTHREADS;
      for (int i = gt; i < 2560 * 256; i += ngt) { const int k = i / 2560, row = i - k * 2560;
          float v = 0.f;
          if (row < 1024) { if (k < 64) { const int d = row >> 9, c = row & 511; v = p.in[I_W2][(((size_t)l * 2 + d) * 64 + k) * 512 + c]; } }
          else if (row < 2048) { if (k >= 64 && k < 128) { const int r2 = row - 1024, d = r2 >> 9, c = r2 & 511; v = p.in[I_A2][(((size_t)l * 2 + d) * 64 + (k - 64)) * 512 + c]; } }
          else { if (k >= 128) { const int c = row - 2048; v = p.in[I_G2][((size_t)l * 128 + (k - 128)) * 512 + c]; } }
          bl[(size_t)row * 256 + k] = (bf16_t)f2bf(v); } }
}
__device__ __forceinline__ void p1_cvt_norm1(const Params& p, const Frame& F, int l) {
    p1_weights(p, F, l);
    { const float* mod = WSF(p, WS_MOD) + (size_t)l * 9 * 6144; bf16_t* H = WSB(p, WS_H);
      for (int row = F.gwave; row < T; row += F.nwave) { const int b = row / NP, q = row - b * NP; const float* mr = mod + (size_t)(q < NCTX ? 8 : b) * 6144;
          const float* xin = q < NCTX ? p.in[I_CTX] + (size_t)(b * NCTX + q) * D : p.in[I_X] + (size_t)(b * NLAT + (q - NCTX)) * D;
          rmsnorm_mod_row(xin, p.in[I_N1G] + (size_t)l * 1024, mr + 1024, mr, H + (size_t)row * 1024, F.lane, nullptr); } }
}

__device__ __forceinline__ void p3_prep(const Params& p, const Frame& F, int l) {
    const float* tab = WSF(p, WS_ROPE);
    const float* cosA = tab, *sinA = tab + 1024, *cosR = tab + 2048, *sinR = tab + 4096;
    bf16_t* AQ = WSB(p, WS_AQ); bf16_t* AKV = WSB(p, WS_AKV); bf16_t* RQ = WSB(p, WS_RQ); bf16_t* RK = WSB(p, WS_RK);
    const bf16_t* WU = WSB(p, WS_WU); bf16_t* AL_ = WSB(p, WS_H);
    const int lane = F.lane;
    const float* qng = p.in[I_QNG] + l * 64, *kng = p.in[I_KNG] + l * 64;
    const float* mu0 = p.in[I_MU] + (size_t)l * 2 * 1792, *mu1 = mu0 + 1792;
    for (int row = F.gwave; row < T; row += F.nwave) {
        const int b = row / NP, q = row - b * NP; const bool lat = q >= NCTX; const int t = q - NCTX, prow = t >> 6, pcol = t & 63;
        const u32x4 raw_aq = *(const u32x4*)(AQ + (size_t)row * 512 + lane * 8), raw_ak = *(const u32x4*)(AKV + (size_t)row * 256 + (lane & 15) * 8);
        const u32x4 raw_rq = *(const u32x4*)(RQ + (size_t)row * 512 + lane * 8), raw_rk = *(const u32x4*)(RK + (size_t)row * 512 + lane * 8);
        const bool hasp = (q != 0) && (q != NCTX), hasn = (q != NCTX - 1) && (q != NP - 1);
        const int cw = 1536 + lane * 4;
        const u32x2 cu = *(const u32x2*)(WU + (size_t)row * 1792 + cw);
        u32x2 pu; pu.x = 0u; pu.y = 0u; u32x2 nu = pu;
        if (hasp) pu = *(const u32x2*)(WU + (size_t)(row - 1) * 1792 + cw);
        if (hasn) nu = *(const u32x2*)(WU + (size_t)(row + 1) * 1792 + cw);
        { const int sub = lane & 7, a = sub >> 2, half = (sub >> 1) & 1, ib = (sub & 1) * 8, pos = lat ? (a ? pcol : prow) : 0;
          float cA[8], sA[8];
          *(f32x4*)cA = *(const f32x4*)(cosA + pos * 16 + ib); *(f32x4*)(cA + 4) = *(const f32x4*)(cosA + pos * 16 + ib + 4);
          *(f32x4*)sA = *(const f32x4*)(sinA + pos * 16 + ib); *(f32x4*)(sA + 4) = *(const f32x4*)(sinA + pos * 16 + ib + 4);
          { float x[8]; unpack8(raw_aq, x);
            float ss = 0.f;
#pragma unroll
            for (int e = 0; e < 8; ++e) ss += x[e] * x[e];
            ss += shfl_xor_f(ss, 1); ss += shfl_xor_f(ss, 2); ss += shfl_xor_f(ss, 4);
            const float rs = rsqrtf(ss * (1.f / 64.f) + 1e-6f);
            float gq[8]; *(f32x4*)gq = *(const f32x4*)(qng + sub * 8); *(f32x4*)(gq + 4) = *(const f32x4*)(qng + sub * 8 + 4);
#pragma unroll
            for (int e = 0; e < 8; ++e) x[e] = x[e] * rs * gq[e];
            float y[8];
#pragma unroll
            for (int e = 0; e < 8; ++e) { const float o = shfl_xor_f(x[e], 2);
                if (lat) { const float c = cA[e], s = sA[e]; y[e] = half ? (x[e] * c + o * s) : (x[e] * c - o * s); } else y[e] = x[e];
                y[e] *= 0.18033688011112042f; }
            if (!p.dry) *(u32x4*)(AQ + (size_t)row * 512 + lane * 8) = pack8(y); }
          { const int lk = lane & 15; float x[8]; unpack8(raw_ak, x);
            float ss = 0.f;
#pragma unroll
            for (int e = 0; e < 8; ++e) ss += x[e] * x[e];
            ss += shfl_xor_f(ss, 1); ss += shfl_xor_f(ss, 2); ss += shfl_xor_f(ss, 4);
            const float rs = rsqrtf(ss * (1.f / 64.f) + 1e-6f);
            float gk[8]; *(f32x4*)gk = *(const f32x4*)(kng + sub * 8); *(f32x4*)(gk + 4) = *(const f32x4*)(kng + sub * 8 + 4);
#pragma unroll
            for (int e = 0; e < 8; ++e) x[e] = x[e] * rs * gk[e];
            float y[8];
#pragma unroll
            for (int e = 0; e < 8; ++e) { const float o = shfl_xor_f(x[e], 2);
                if (lat) { const float c = cA[e], s = sA[e]; y[e] = half ? (x[e] * c + o * s) : (x[e] * c - o * s); } else y[e] = x[e]; }
            if (lane < 16 && !p.dry) *(u32x4*)(AKV + (size_t)row * 256 + lk * 8) = pack8(y); } }
        { const int sub = lane & 15, a = sub >> 3, half = (sub >> 2) & 1, ib = (sub & 3) * 8, pos = lat ? (a ? pcol : prow) : 0;
          float cR[8], sR[8];
          *(f32x4*)cR = *(const f32x4*)(cosR + pos * 32 + ib); *(f32x4*)(cR + 4) = *(const f32x4*)(cosR + pos * 32 + ib + 4);
          *(f32x4*)sR = *(const f32x4*)(sinR + pos * 32 + ib); *(f32x4*)(sR + 4) = *(const f32x4*)(sinR + pos * 32 + ib + 4);
#pragma unroll
          for (int which = 0; which < 2; ++which) { bf16_t* buf = which ? RK : RQ;
            float x[8]; unpack8(which ? raw_rk : raw_rq, x); float y[8];
#pragma unroll
            for (int e = 0; e < 8; ++e) { const float o = shfl_xor_f(x[e], 4);
                if (lat) { const float c = cR[e], s = sR[e]; y[e] = half ? (x[e] * c + o * s) : (x[e] * c - o * s); } else y[e] = x[e];
                if (which) y[e] *= 0.08838834764831845f; }
            if (!p.dry) *(u32x4*)(buf + (size_t)row * 512 + lane * 8) = pack8(y); } }
        { const int c = cw;
          const float uc[4] = {lo16(cu.x), hi16(cu.x), lo16(cu.y), hi16(cu.y)}, up[4] = {lo16(pu.x), hi16(pu.x), lo16(pu.y), hi16(pu.y)}, un[4] = {lo16(nu.x), hi16(nu.x), lo16(nu.y), hi16(nu.y)};
          float y[4]; const f32x4 m0v = *(const f32x4*)(mu0 + c), m1v = *(const f32x4*)(mu1 + c);
#pragma unroll
          for (int e = 0; e < 4; ++e) { const float xs = uc[e] + (up[e] - uc[e]) * m0v[e] + (un[e] - uc[e]) * m1v[e];
              if (lane < 16) { const float ex = __expf(2.f * xs); y[e] = 1.f - 2.f * frcp(ex + 1.f); }
              else if (lane < 32) y[e] = xs;
              else y[e] = sigmoidf_(xs); }
          u32x2 w; w.x = pk2(y[0], y[1]); w.y = pk2(y[2], y[3]); *(u32x2*)(AL_ + (size_t)row * 256 + lane * 4) = w; }
    }
}

__device__ __forceinline__ void p5_rwkv_tok(const Params& p, const Frame& F, int l) {
    const bf16_t* WU = WSB(p, WS_WU); const bf16_t* LW = WSB(p, WS_LW); const bf16_t* LA = WSB(p, WS_LA);
    bf16_t* RS = WSB(p, WS_W1); bf16_t* VS = RS + (size_t)T * 512; bf16_t* KKS = VS + (size_t)T * 512;
    const int lane = F.lane, c0 = lane * 8;
    const float* mu0 = p.in[I_MU] + (size_t)l * 2 * 1792, *mu1 = mu0 + 1792;
    const float* k_k = p.in[I_KK] + l * 512, *k_a = p.in[I_KA] + l * 512;
    for (int row = F.gwave; row < T; row += F.nwave) {
        const int b = row / NP, q = row - b * NP;
        const bool hasp = (q != 0) && (q != NCTX), hasn = (q != NCTX - 1) && (q != NP - 1);
        float sh[3][8];
#pragma unroll
        for (int part = 0; part < 3; ++part) { const int c = part * 512 + c0;
            const u32x4 cu = *(const u32x4*)(WU + (size_t)row * 1792 + c);
            u32x4 pu; pu.x = pu.y = pu.z = pu.w = 0u; u32x4 nu = pu;
            if (hasp) pu = *(const u32x4*)(WU + (size_t)(row - 1) * 1792 + c);
            if (hasn) nu = *(const u32x4*)(WU + (size_t)(row + 1) * 1792 + c);
            float uc[8], up[8], un[8]; unpack8(cu, uc); unpack8(pu, up); unpack8(nu, un);
#pragma unroll
            for (int e = 0; e < 8; ++e) sh[part][e] = uc[e] + (up[e] - uc[e]) * mu0[c + e] + (un[e] - uc[e]) * mu1[c + e]; }
        float kk[8]; float ss = 0.f;
#pragma unroll
        for (int e = 0; e < 8; ++e) { kk[e] = sh[1][e] * k_k[c0 + e]; ss += kk[e] * kk[e]; }
        ss += shfl_xor_f(ss, 1); ss += shfl_xor_f(ss, 2); ss += shfl_xor_f(ss, 4);
        const float rn = rsqrtf(fmaxf(ss, 1e-12f));
#pragma unroll
        for (int e = 0; e < 8; ++e) kk[e] *= rn;
        u32x4 lw_raw[2], la_raw[2];
#pragma unroll
        for (int d = 0; d < 2; ++d) { lw_raw[d] = *(const u32x4*)(LW + (size_t)row * 1024 + d * 512 + c0); la_raw[d] = *(const u32x4*)(LA + (size_t)row * 1024 + d * 512 + c0); }
        *(u32x4*)(RS + (size_t)row * 512 + c0) = pack8(sh[0]);
        *(u32x4*)(VS + (size_t)row * 512 + c0) = pack8(sh[2]);
        *(u32x4*)(KKS + (size_t)row * 512 + c0) = pack8(kk);
#pragma unroll
        for (int d = 0; d < 2; ++d) {
            _Float16* LOGW = (_Float16*)(p.ws + WS_W1 + (size_t)(3 + 3 * d) * SZ512); bf16_t* KR = WSB(p, WS_W1 + (size_t)(4 + 3 * d) * SZ512); bf16_t* BB = WSB(p, WS_W1 + (size_t)(5 + 3 * d) * SZ512);
            const float* w0 = p.in[I_W0] + ((size_t)l * 2 + d) * 512, *a0 = p.in[I_A0] + ((size_t)l * 2 + d) * 512;
            float lw[8], la[8]; unpack8(lw_raw[d], lw); unpack8(la_raw[d], la);
            float kr[8], bb[8]; typedef _Float16 h8 __attribute__((ext_vector_type(8))); h8 lg;
#pragma unroll
            for (int e = 0; e < 8; ++e) { const float a = sigmoidf_(a0[c0 + e] + la[e]);
                lg[e] = (_Float16)(-0.6065306597126334f * sigmoidf_(w0[c0 + e] + lw[e]));
                kr[e] = sh[1][e] * (1.f + (a - 1.f) * k_a[c0 + e]); bb[e] = kk[e] * a; }
            *(h8*)(LOGW + (size_t)row * 512 + c0) = lg;
            *(u32x4*)(KR + (size_t)row * 512 + c0) = pack8(kr);
            *(u32x4*)(BB + (size_t)row * 512 + c0) = pack8(bb); }
    }
}
__device__ __forceinline__ float reduce8(float (&v)[8], int lane) {
    float a[4];
#pragma unroll
    for (int k = 0; k < 4; ++k) { const bool up = (lane & 32) != 0; const float send = up ? v[k] : v[k + 4], keep = up ? v[k + 4] : v[k]; a[k] = keep + __shfl_xor(send, 32, 64); }
    float b[2];
#pragma unroll
    for (int k = 0; k < 2; ++k) { const bool up = (lane & 16) != 0; const float send = up ? a[k] : a[k + 2], keep = up ? a[k + 2] : a[k]; b[k] = keep + __shfl_xor(send, 16, 64); }
    float c; { const bool up = (lane & 8) != 0; const float send = up ? b[0] : b[1], keep = up ? b[1] : b[0]; c = keep + __shfl_xor(send, 8, 64); }
    c += __shfl_xor(c, 4, 64); c += __shfl_xor(c, 2, 64); c += __shfl_xor(c, 1, 64);
    return c;
}
__device__ __forceinline__ void p6_rwkv_scan_naive(const Params& p, const Frame& F, int l) {
    (void)l;
    LAS float* L_r = (LAS float*)F.lds;
    LAS float* L_w = L_r + 4096; LAS float* L_k = L_w + 4096; LAS float* L_v = L_k + 4096; LAS float* L_a = L_v + 4096; LAS float* L_b = L_a + 4096; LAS float* L_y = L_b + 4096;
    const bf16_t* RS = WSB(p, WS_W1); const bf16_t* VS = RS + (size_t)T * 512; const bf16_t* KKS = VS + (size_t)T * 512;
    const int lane = F.lane, w = F.wave, tid = F.tid;
    for (int task = F.bid; task < NB * 8 * 2; task += F.G) {
        const int dir = task & 1, h = (task >> 1) & 7, b = task >> 4;
        const _Float16* LOGW = (const _Float16*)(p.ws + WS_W1 + (size_t)(3 + 3 * dir) * SZ512); const bf16_t* KR = WSB(p, WS_W1 + (size_t)(4 + 3 * dir) * SZ512); const bf16_t* BB = WSB(p, WS_W1 + (size_t)(5 + 3 * dir) * SZ512);
        bf16_t* YS = WSB(p, WS_YS) + (size_t)dir * T * 512;
        float S[8];
#pragma unroll
        for (int i = 0; i < 8; ++i) S[i] = 0.f;
        for (int s0 = 0; s0 < NP; s0 += 64) {
            { const int st = tid >> 3, c8 = (tid & 7) * 8, s = s0 + st; const int q = dir ? (s < NCTX ? NCTX - 1 - s : NP + NCTX - 1 - s) : s;
              const size_t off = ((size_t)(b * NP + q)) * 512 + h * 64 + c8;
              float x[8];
              unpack8(*(const u32x4*)(RS + off), x);
#pragma unroll
              for (int e = 0; e < 8; ++e) L_r[st * 64 + c8 + e] = x[e];
              unpack8(*(const u32x4*)(VS + off), x);
#pragma unroll
              for (int e = 0; e < 8; ++e) L_v[st * 64 + c8 + e] = x[e];
              unpack8(*(const u32x4*)(KKS + off), x);
#pragma unroll
              for (int e = 0; e < 8; ++e) L_a[st * 64 + c8 + e] = -x[e];
              unpack8(*(const u32x4*)(KR + off), x);
#pragma unroll
              for (int e = 0; e < 8; ++e) L_k[st * 64 + c8 + e] = x[e];
              unpack8(*(const u32x4*)(BB + off), x);
#pragma unroll
              for (int e = 0; e < 8; ++e) L_b[st * 64 + c8 + e] = x[e];
              typedef _Float16 h8 __attribute__((ext_vector_type(8))); const h8 lg = *(const h8*)(LOGW + off);
#pragma unroll
              for (int e = 0; e < 8; ++e) L_w[st * 64 + c8 + e] = __expf((float)lg[e]); }
            __syncthreads();
            for (int st = 0; st < 64; ++st) {
                const float rj = L_r[st * 64 + lane], wj = L_w[st * 64 + lane], kj = L_k[st * 64 + lane], aj = L_a[st * 64 + lane], bj = L_b[st * 64 + lane];
                float pa[8];
#pragma unroll
                for (int i = 0; i < 8; ++i) pa[i] = S[i] * aj;
                const float tot = reduce8(pa, lane);
                float py[8];
#pragma unroll
                for (int i = 0; i < 8; ++i) { const float sa = __shfl(tot, i * 8, 64); const float vi = L_v[st * 64 + w * 8 + i];
                    S[i] = S[i] * wj + sa * bj + vi * kj; py[i] = S[i] * rj; }
                const float ty = reduce8(py, lane);
                if ((lane & 7) == 0) L_y[st * 64 + w * 8 + (lane >> 3)] = ty;
            }
            __syncthreads();
            { const int st = tid >> 3, c8 = (tid & 7) * 8, s = s0 + st; const int q = dir ? (s < NCTX ? NCTX - 1 - s : NP + NCTX - 1 - s) : s;
              float y[8];
#pragma unroll
              for (int e = 0; e < 8; ++e) y[e] = L_y[st * 64 + c8 + e];
              *(u32x4*)(YS + ((size_t)(b * NP + q)) * 512 + h * 64 + c8) = pack8(y); }
            __syncthreads();
        }
    }
}

__device__ __forceinline__ void p7_rwkv_readout(const Params& p, const Frame& F, int l);
constexpr int RPITCH_TR = 288;
constexpr int RPITCH_ROW = 272;
__device__ __forceinline__ float log_gamma_of(const Params& p, int l, int dir, int h) {
    const float x = p.in[I_RDL][(l * 2 + dir) * 4 + h];
    return -log1pf(__expf(-x));
}
__device__ __forceinline__ void p8_ret_kv(const Params& p, const Frame& F, int l) {
    const bf16_t* RK = WSB(p, WS_RK); const bf16_t* RV = WSB(p, WS_RV);
    bf16_t* SF = WSB(p, WS_SF); bf16_t* SB = WSB(p, WS_SB);
    LAS unsigned char* Lv = F.lds; LAS unsigned char* Lkf = F.lds + 128 * RPITCH_TR; LAS unsigned char* Lkb = F.lds + 2 * 128 * RPITCH_TR;
    const int lane = F.lane, w = F.wave, tid = F.tid, g = lane >> 4, li = lane & 15, q4 = li >> 2, p4 = li & 3;
    for (int u = F.bid; u < NB * 4 * 34; u += F.G) {
        const int c = u % 34, bh = u / 34, h = bh & 3, b = bh >> 2;
        const float lgf = log_gamma_of(p, l, 0, h) * 1.4426950408889634f, lgb = log_gamma_of(p, l, 1, h) * 1.4426950408889634f;
#pragma unroll
        for (int it = 0; it < 4; ++it) { const int idx = it * NTHREADS + tid, j = idx >> 4, c8 = (idx & 15) * 8;
            const size_t off = ((size_t)(b * NP + c * 128 + j)) * 512 + h * 128 + c8;
            const u32x4 vv = *(const u32x4*)(RV + off); *(LAS u32x4*)(Lv + j * RPITCH_TR + c8 * 2) = vv;
            float x[8]; unpack8(*(const u32x4*)(RK + off), x);
            const float sf = exp2f(lgf * (float)(127 - j)), sb = exp2f(lgb * (float)j);
            float xf[8], xb[8];
#pragma unroll
            for (int e = 0; e < 8; ++e) { xf[e] = x[e] * sf; xb[e] = x[e] * sb; }
            *(LAS u32x4*)(Lkf + j * RPITCH_TR + c8 * 2) = pack8(xf); *(LAS u32x4*)(Lkb + j * RPITCH_TR + c8 * 2) = pack8(xb); }
        __syncthreads();
        const int dir = w >> 2, e0 = (w & 3) * 32;
        LAS unsigned char* Lk = dir ? Lkb : Lkf;
        f32x4 acc[2][8];
#pragma unroll
        for (int et = 0; et < 2; ++et)
#pragma unroll
            for (int dt = 0; dt < 8; ++dt) acc[et][dt] = (f32x4){0.f, 0.f, 0.f, 0.f};
        const LAS unsigned char* vbase = Lv; const LAS unsigned char* kbase = Lk;
#pragma unroll 1
        for (int ks = 0; ks < 4; ++ks) {
            const int r0 = 32 * ks + 8 * g;
            bf16x8 af[2];
#pragma unroll
            for (int et = 0; et < 2; ++et) { const int col = e0 + 16 * et + 4 * p4;
                af[et] = cat44(tr_read(vbase + (r0 + q4) * RPITCH_TR + col * 2), tr_read(vbase + (r0 + 4 + q4) * RPITCH_TR + col * 2)); }
#pragma unroll
            for (int dt = 0; dt < 8; ++dt) { const int col = 16 * dt + 4 * p4;
                const bf16x8 bfr = cat44(tr_read(kbase + (r0 + q4) * RPITCH_TR + col * 2), tr_read(kbase + (r0 + 4 + q4) * RPITCH_TR + col * 2));
#pragma unroll
                for (int et = 0; et < 2; ++et) acc[et][dt] = MFMA16(af[et], bfr, acc[et][dt]); }
        }
        bf16_t* dst = (dir ? SB : SF) + (size_t)u * 16384;
#pragma unroll
        for (int et = 0; et < 2; ++et)
#pragma unroll
            for (int dt = 0; dt < 8; ++dt)
#pragma unroll
                for (int r = 0; r < 4; ++r) dst[(size_t)(e0 + 16 * et + 4 * g + r) * 128 + 16 * dt + li] = (bf16_t)f2bf(acc[et][dt][r]);
        __syncthreads();
    }
}
__device__ __forceinline__ void p9_ret_scan(const Params& p, const Frame& F, int l) {
    unsigned* SF = (unsigned*)(p.ws + WS_SF); unsigned* SB = (unsigned*)(p.ws + WS_SB);
    const int gt = F.bid * NTHREADS + F.tid, ngt = F.G * NTHREADS;
    for (int i = gt; i < 2 * NB * 4 * 8192; i += ngt) {
        const int dir = i / (NB * 4 * 8192), r = i - dir * (NB * 4 * 8192), bh = r >> 13, el = r & 8191, h = bh & 3;
        const float gC = __expf(128.f * log_gamma_of(p, l, dir, h));
        unsigned* base = (dir ? SB : SF) + (size_t)bh * 34 * 8192 + el;
        float s0 = 0.f, s1 = 0.f;
        for (int k = 0; k < 34; ++k) { const int c = dir ? (k < 2 ? 1 - k : 35 - k) : k;
            const unsigned kv = base[(size_t)c * 8192]; if (!p.dry) base[(size_t)c * 8192] = pk2(s0, s1); s0 = gC * s0 + lo16(kv); s1 = gC * s1 + hi16(kv); }
    }
}
__device__ __forceinline__ void p10_ret_out(const Params& p, const Frame& F, int l, bool want_ctx) {
    const bf16_t* RQ = WSB(p, WS_RQ); const bf16_t* RK = WSB(p, WS_RK); const bf16_t* RV = WSB(p, WS_RV); const bf16_t* RG = WSB(p, WS_RG); bf16_t* YR = WSB(p, WS_WU) + 512;
    const bf16_t* SF = WSB(p, WS_SF); const bf16_t* SB = WSB(p, WS_SB);
    LAS unsigned char* Lq = F.lds; LAS unsigned char* Lk = Lq + 128 * RPITCH_ROW; LAS unsigned char* Lv = Lk + 128 * RPITCH_ROW; LAS unsigned char* Ls = Lv + 128 * RPITCH_TR;
    const int lane = F.lane, w = F.wave, tid = F.tid, g = lane >> 4, li = lane & 15, q4 = li >> 2, p4 = li & 3;
    const float* gn = p.in[I_RGN] + l * 512;
    for (int u = F.bid; u < NB * 4 * 34; u += F.G) {
        const int c = u % 34, bh = u / 34, h = bh & 3, b = bh >> 2;
        if (c < 2 && !want_ctx) continue;
        const float lgf = log_gamma_of(p, l, 0, h) * 1.4426950408889634f, lgb = log_gamma_of(p, l, 1, h) * 1.4426950408889634f;
        const size_t row0 = (size_t)(b * NP + c * 128);
#pragma unroll
        for (int it = 0; it < 4; ++it) { const int idx = it * NTHREADS + tid, j = idx >> 4, c8 = (idx & 15) * 8;
            const size_t off = (row0 + j) * 512 + h * 128 + c8;
            *(LAS u32x4*)(Lq + j * RPITCH_ROW + c8 * 2) = *(const u32x4*)(RQ + off);
            *(LAS u32x4*)(Lk + j * RPITCH_ROW + c8 * 2) = *(const u32x4*)(RK + off);
            *(LAS u32x4*)(Lv + j * RPITCH_TR + c8 * 2) = *(const u32x4*)(RV + off);
            *(LAS u32x4*)(Ls + j * RPITCH_ROW + c8 * 2) = *(const u32x4*)(SF + (size_t)u * 16384 + j * 128 + c8); }
        __syncthreads();
        const int il = 16 * w + li;
        bf16x8 qf[4];
#pragma unroll
        for (int ks = 0; ks < 4; ++ks) qf[ks] = ld_frag(Lq + il * RPITCH_ROW + (32 * ks + 8 * g) * 2);
        f32x4 sc[8];
#pragma unroll
        for (int jt = 0; jt < 8; ++jt) { sc[jt] = (f32x4){0.f, 0.f, 0.f, 0.f};
#pragma unroll
            for (int ks = 0; ks < 4; ++ks) sc[jt] = MFMA16(ld_frag(Lk + (16 * jt + li) * RPITCH_ROW + (32 * ks + 8 * g) * 2), qf[ks], sc[jt]); }
#pragma unroll
        for (int jt = 0; jt < 8; ++jt)
#pragma unroll
            for (int r = 0; r < 4; ++r) { const int j = 16 * jt + 4 * g + r, dl = il - j;
                const float f = dl > 0 ? __builtin_amdgcn_exp2f(lgf * (float)dl) : (dl < 0 ? __builtin_amdgcn_exp2f(lgb * (float)(-dl)) : 2.f);
                sc[jt][r] *= f; }
        f32x4 y[8];
#pragma unroll
        for (int et = 0; et < 8; ++et) y[et] = (f32x4){0.f, 0.f, 0.f, 0.f};
        const LAS unsigned char* vbase = Lv;
#pragma unroll
        for (int ks = 0; ks < 4; ++ks) {
            const bf16x8 pf = pack_frag(sc[2 * ks], sc[2 * ks + 1]);
#pragma unroll
            for (int et = 0; et < 8; ++et) { const int col = 16 * et + 4 * p4;
                const bf16x8 vf = cat44(tr_read(vbase + (32 * ks + 4 * g + q4) * RPITCH_TR + col * 2), tr_read(vbase + (32 * ks + 16 + 4 * g + q4) * RPITCH_TR + col * 2));
                y[et] = MFMA16(vf, pf, y[et]); }
        }
        { f32x4 z[8]; const float sf = exp2f(lgf * (float)(il + 1));
#pragma unroll
          for (int et = 0; et < 8; ++et) { z[et] = (f32x4){0.f, 0.f, 0.f, 0.f};
#pragma unroll
              for (int ks = 0; ks < 4; ++ks) z[et] = MFMA16(ld_frag(Ls + (16 * et + li) * RPITCH_ROW + (32 * ks + 8 * g) * 2), qf[ks], z[et]);
              y[et] = y[et] + z[et] * sf; } }
        __syncthreads();
#pragma unroll
        for (int it = 0; it < 4; ++it) { const int idx = it * NTHREADS + tid, j = idx >> 4, c8 = (idx & 15) * 8;
            *(LAS u32x4*)(Ls + j * RPITCH_ROW + c8 * 2) = *(const u32x4*)(SB + (size_t)u * 16384 + j * 128 + c8); }
        __syncthreads();
        { f32x4 z[8]; const float sb = exp2f(lgb * (float)(128 - il));
#pragma unroll
          for (int et = 0; et < 8; ++et) { z[et] = (f32x4){0.f, 0.f, 0.f, 0.f};
#pragma unroll
              for (int ks = 0; ks < 4; ++ks) z[et] = MFMA16(ld_frag(Ls + (16 * et + li) * RPITCH_ROW + (32 * ks + 8 * g) * 2), qf[ks], z[et]);
              y[et] = y[et] + z[et] * sb; } }
        float ss = 0.f;
#pragma unroll
        for (int et = 0; et < 8; ++et)
#pragma unroll
            for (int r = 0; r < 4; ++r) ss += y[et][r] * y[et][r];
        ss += shfl_xor_f(ss, 16); ss += shfl_xor_f(ss, 32);
        const float rs = rsqrtf(ss * (1.f / 128.f) + 1e-6f);
        const size_t orow = (row0 + il) * 512 + h * 128;
#pragma unroll
        for (int et = 0; et < 8; ++et) { const int e = 16 * et + 4 * g;
            const u32x2 gw = *(const u32x2*)(RG + orow + e); const f32x4 gg = *(const f32x4*)(gn + h * 128 + e);
            const float o0 = siluf_(lo16(gw.x)) * y[et][0] * rs * gg[0], o1 = siluf_(hi16(gw.x)) * y[et][1] * rs * gg[1], o2 = siluf_(lo16(gw.y)) * y[et][2] * rs * gg[2], o3 = siluf_(hi16(gw.y)) * y[et][3] * rs * gg[3];
            u32x2 ow; ow.x = pk2(o0, o1); ow.y = pk2(o2, o3); *(u32x2*)(YR + (row0 + il) * 1536 + h * 128 + e) = ow; }
        __syncthreads();
    }
}
constexpr int APITCH = 144;
__device__ __forceinline__ void p11_attention(const Params& p, const Frame& F, bool want_ctx) {
    const bf16_t* AQ = WSB(p, WS_AQ); const bf16_t* AKV = WSB(p, WS_AKV); bf16_t* YA = WSB(p, WS_WU);
    const int lane = F.lane, w = F.wave, tid = F.tid, g = lane >> 4, li = lane & 15, q4 = li >> 2, p4 = li & 3;
    LAS unsigned char* LK = F.lds; LAS unsigned char* LV = F.lds + 4 * 64 * APITCH;
    const int nunits = NB * 8 * 17;
    for (int u0 = F.bid; u0 < nunits; u0 += F.G) {
        int b, h, qb;
        int u = u0;
        if (F.G == 256 && u0 < NB * 8 * 16) { const int r = u0 >> 8, x = u0 & 7, j = (u0 & 255) >> 3, pair = x + 8 * (r >> 1), un = (r & 1) * 32 + j;
            u = (pair >> 1) * 128 + ((pair & 1) * 4 + (un >> 4)) * 16 + (un & 15); }
        if (u < NB * 8 * 16) { b = u >> 7; h = (u >> 4) & 7; qb = 1 + (u & 15); } else { const int v = u - NB * 8 * 16; b = v >> 3; h = v & 7; qb = 0; }
        if (qb == 0 && !want_ctx) continue;
        const int kvh = h >> 2, ntile = qb == 0 ? NCTX / 64 : NP / 64;
        const size_t rowbase = (size_t)b * NP + (size_t)qb * 256;
        bf16x8 qf[2][2];
#pragma unroll
        for (int it = 0; it < 2; ++it)
#pragma unroll
            for (int ks = 0; ks < 2; ++ks) qf[it][ks] = *(const bf16x8*)(AQ + (rowbase + 32 * w + 16 * it + li) * 512 + h * 64 + 32 * ks + 8 * g);
        f32x4 o[4][2]; float m[2]; f32x4 lsa[2], minit[2];
        const bf16x8 ones = {(short)0x3F80, (short)0x3F80, (short)0x3F80, (short)0x3F80, (short)0x3F80, (short)0x3F80, (short)0x3F80, (short)0x3F80};
#pragma unroll
        for (int it = 0; it < 2; ++it) { m[it] = 0.f; lsa[it] = (f32x4){0.f, 0.f, 0.f, 0.f}; minit[it] = (f32x4){0.f, 0.f, 0.f, 0.f};
#pragma unroll
            for (int et = 0; et < 4; ++et) o[et][it] = (f32x4){0.f, 0.f, 0.f, 0.f}; }
        const int sj = tid >> 3, sc8 = (tid & 7) * 8;
        const bf16_t* kvsrc = AKV + ((size_t)b * NP + sj) * 256 + kvh * 64 + sc8;
        u32x4 kreg[2], vreg[2];
#pragma unroll
        for (int sb = 0; sb < 2; ++sb) { kreg[sb] = *(const u32x4*)(kvsrc + (size_t)sb * 64 * 256); vreg[sb] = *(const u32x4*)(kvsrc + (size_t)sb * 64 * 256 + 128); }
        __syncthreads();
        for (int kp = 0; kp < ntile / 2; ++kp) {
            LAS unsigned char* lkb = LK + (kp & 1) * 128 * APITCH; LAS unsigned char* lvb = LV + (kp & 1) * 128 * APITCH;
#pragma unroll
            for (int sb = 0; sb < 2; ++sb) { *(LAS u32x4*)(lkb + (sb * 64 + sj) * APITCH + sc8 * 2) = kreg[sb]; *(LAS u32x4*)(lvb + (sb * 64 + sj) * APITCH + sc8 * 2) = vreg[sb]; }
            __syncthreads();
            if (kp + 1 < ntile / 2) {
#pragma unroll
                for (int sb = 0; sb < 2; ++sb) { const bf16_t* s2 = kvsrc + (size_t)(2 * kp + 2 + sb) * 64 * 256; kreg[sb] = *(const u32x4*)s2; vreg[sb] = *(const u32x4*)(s2 + 128); } }
#pragma unroll
            for (int sb = 0; sb < 2; ++sb) { const int kt = 2 * kp + sb; LAS unsigned char* lk = lkb + sb * 64 * APITCH; LAS unsigned char* lv = lvb + sb * 64 * APITCH;
            f32x4 sc[4][2];
#pragma unroll
            for (int jt = 0; jt < 4; ++jt) {
                const bf16x8 kf0 = ld_frag(lk + (16 * jt + li) * APITCH + (8 * g) * 2), kf1 = ld_frag(lk + (16 * jt + li) * APITCH + (32 + 8 * g) * 2);
                sc[jt][0] = MFMA16(kf0, qf[0][0], minit[0]); sc[jt][1] = MFMA16(kf0, qf[1][0], minit[1]);
                sc[jt][0] = MFMA16(kf1, qf[0][1], sc[jt][0]); sc[jt][1] = MFMA16(kf1, qf[1][1], sc[jt][1]); }
            bf16x8 pf[2][2];
            if ((kt & 7) == 0) {
                float mx[2];
#pragma unroll
                for (int it = 0; it < 2; ++it) { float t = sc[0][it][0];
#pragma unroll
                    for (int jt = 0; jt < 4; ++jt)
#pragma unroll
                        for (int r = 0; r < 4; ++r) t = fmaxf(t, sc[jt][it][r]);
                    t = fmaxf(t, shfl_xor_f(t, 16)); t = fmaxf(t, shfl_xor_f(t, 32)); mx[it] = t; }
                if (kt == 0 || __any(fmaxf(mx[0], mx[1]) > 8.f)) {
#pragma unroll
                    for (int it = 0; it < 2; ++it) { const float d = kt == 0 ? mx[it] : fmaxf(mx[it], 0.f), alpha = kt == 0 ? 1.f : __builtin_amdgcn_exp2f(-d);
                        m[it] = kt == 0 ? d : m[it] + d; lsa[it] = lsa[it] * alpha; minit[it] = (f32x4){-m[it], -m[it], -m[it], -m[it]};
#pragma unroll
                        for (int et = 0; et < 4; ++et) o[et][it] = o[et][it] * alpha;
#pragma unroll
                        for (int jt = 0; jt < 4; ++jt)
#pragma unroll
                            for (int r = 0; r < 4; ++r) sc[jt][it][r] -= d; } } }
#pragma unroll
            for (int it = 0; it < 2; ++it) {
#pragma unroll
                for (int jt = 0; jt < 4; ++jt)
#pragma unroll
                    for (int r = 0; r < 4; ++r) sc[jt][it][r] = __builtin_amdgcn_exp2f(sc[jt][it][r]);
                pf[it][0] = pack_frag(sc[0][it], sc[1][it]); pf[it][1] = pack_frag(sc[2][it], sc[3][it]);
                lsa[it] = MFMA16(ones, pf[it][0], lsa[it]); lsa[it] = MFMA16(ones, pf[it][1], lsa[it]); }
#pragma unroll
            for (int ks = 0; ks < 2; ++ks)
#pragma unroll
                for (int et = 0; et < 4; ++et) { const int col = 16 * et + 4 * p4;
                    const bf16x8 vf = cat44(tr_read(lv + (32 * ks + 4 * g + q4) * APITCH + col * 2), tr_read(lv + (32 * ks + 16 + 4 * g + q4) * APITCH + col * 2));
                    o[et][0] = MFMA16(vf, pf[0][ks], o[et][0]); o[et][1] = MFMA16(vf, pf[1][ks], o[et][1]); }
            }
        }
#pragma unroll
        for (int it = 0; it < 2; ++it) { const float inv = __builtin_amdgcn_rcpf(lsa[it][0]);
            bf16_t* op = YA + (rowbase + 32 * w + 16 * it + li) * 1536 + h * 64 + 4 * g;
#pragma unroll
            for (int et = 0; et < 4; ++et) { u32x2 ow; ow.x = pk2(o[et][it][0] * inv, o[et][it][1] * inv); ow.y = pk2(o[et][it][2] * inv, o[et][it][3] * inv); *(u32x2*)(op + 16 * et) = ow; } }
    }
    __syncthreads();
}

__device__ __forceinline__ void p14_norm2_router(const Params& p, const Frame& F, int l, bool want_ctx) {
    LAS float* tile = (LAS float*)F.lds;
    (void)tile;
    const float* mod = WSF(p, WS_MOD) + (size_t)l * 9 * 6144; bf16_t* H2 = WSB(p, WS_H);
    const float* rw2 = WSF(p, WS_RW2) + (size_t)l * 64 * 3 * 4 * 16 * 4;
    const float* rcl = WSF(p, WS_RC) + (size_t)l * 9 * 48;
    const float* n2g = p.in[I_N2G] + (size_t)l * 1024;
    unsigned* cnt = (unsigned*)(p.ws + WS_CTL) + CW_CNT + l * 32;
    int* PE = (int*)(p.ws + WS_PAIR); int* PPOS = PE + NPAIR_MAX; float* PW = (float*)(PPOS + NPAIR_MAX);
    for (int gi = F.gwave; gi < T / 16; gi += F.nwave) {
        int lane = F.lane; asm volatile("" : "+v"(lane));
        const int g = lane >> 4, li = lane & 15, half = lane >> 5, lk = lane & 31;
        const int row0 = 16 * gi, b = row0 / NP, q = row0 - b * NP; const bool isctx = q < NCTX;
        if (isctx && !want_ctx) continue;
        const int mrow = isctx ? 8 : b; const float* mr = mod + (size_t)mrow * 6144;
        LAS float* At = (LAS float*)(F.lds + F.wave * 12288);
        LAS float* LGT = At + 16 * 4 * 36;
        const float* xr[8];
#pragma unroll
        for (int r = 0; r < 8; ++r) xr[r] = xrow(p, row0 + 8 * half + r);
        f32x4 acc[3]; float ss[8];
#pragma unroll
        for (int nt = 0; nt < 3; ++nt) acc[nt] = (f32x4){0.f, 0.f, 0.f, 0.f};
#pragma unroll
        for (int r = 0; r < 8; ++r) ss[r] = 0.f;
        f32x4 xv[8];
#pragma unroll
        for (int r = 0; r < 8; ++r) xv[r] = *(const f32x4*)(xr[r] + 4 * lk);
#pragma unroll 1
        for (int ck = 0; ck < 8; ++ck) { const int kc = ck * 128 + 4 * lk;
            const f32x4 gg = *(const f32x4*)(n2g + kc), s1 = *(const f32x4*)(mr + 4096 + kc);
            f32x4 gq; gq[0] = gg[0] * (1.f + s1[0]); gq[1] = gg[1] * (1.f + s1[1]); gq[2] = gg[2] * (1.f + s1[2]); gq[3] = gg[3] * (1.f + s1[3]);
            const float* wb = rw2 + ((size_t)(ck * 8) * 3 * 4 + g) * 64 + li * 4;
            f32x4 bc[3];
#pragma unroll
            for (int nt = 0; nt < 3; ++nt) bc[nt] = *(const f32x4*)(wb + nt * 256);
#pragma unroll
            for (int r = 0; r < 8; ++r) { ss[r] += xv[r][0] * xv[r][0] + xv[r][1] * xv[r][1] + xv[r][2] * xv[r][2] + xv[r][3] * xv[r][3];
#pragma unroll
                for (int e = 0; e < 4; ++e) At[((8 * half + r) * 4 + e) * 36 + lk] = xv[r][e] * gq[e]; }
            if (ck < 7) {
#pragma unroll
                for (int r = 0; r < 8; ++r) xv[r] = *(const f32x4*)(xr[r] + kc + 128); }
            asm volatile("" ::: "memory");
#pragma unroll
            for (int kq = 0; kq < 8; ++kq) { const f32x4 av = *(const LAS f32x4*)(At + (li * 4 + g) * 36 + 4 * kq);
                f32x4 bn[3];
                if (kq < 7) {
#pragma unroll
                    for (int nt = 0; nt < 3; ++nt) bn[nt] = *(const f32x4*)(wb + ((kq + 1) * 3 + nt) * 256); }
#pragma unroll
                for (int nt = 0; nt < 3; ++nt) {
#pragma unroll
                    for (int j = 0; j < 4; ++j) acc[nt] = __builtin_amdgcn_mfma_f32_16x16x4f32(av[j], bc[nt][j], acc[nt], 0, 0, 0); }
                if (kq < 7) {
#pragma unroll
                    for (int nt = 0; nt < 3; ++nt) bc[nt] = bn[nt]; } }
            asm volatile("" ::: "memory");
        }
#pragma unroll
        for (int r = 0; r < 8; ++r) {
#pragma unroll
            for (int mk = 1; mk < 32; mk <<= 1) ss[r] += shfl_xor_f(ss[r], mk);
            ss[r] = rsqrtf(ss[r] * (1.f / 1024.f) + 1e-6f); }
#pragma unroll
        for (int r2 = 0; r2 < 4; ++r2) { float rsA = ss[r2], rsB = ss[4 + r2]; asm volatile("" : "+v"(rsA), "+v"(rsB));
            const float rs = (g & 1) ? rsB : rsA;
#pragma unroll
            for (int nt = 0; nt < 3; ++nt) LGT[(4 * g + r2) * 48 + 16 * nt + li] = acc[nt][r2] * rs + rcl[mrow * 48 + 16 * nt + li]; }
        asm volatile("" ::: "memory");
        if (lane < 16 && !p.dry) {
            const int row = row0 + lane; const LAS float* lg = LGT + lane * 48;
            int grp = 0; float gm = lg[0];
            float gl4[4]; gl4[0] = gm;
#pragma unroll
            for (int i = 1; i < 4; ++i) { gl4[i] = lg[i]; if (gl4[i] > gm) { gm = gl4[i]; grp = i; } }
            float gs = 0.f;
#pragma unroll
            for (int i = 0; i < 4; ++i) gs += __expf(gl4[i] - gm);
            const float pg = frcp(gs);
            int i1 = 0, i2 = -1; float v1 = -3.0e38f, v2 = -3.0e38f;
#pragma unroll
            for (int i = 0; i < 8; ++i) { const float v = lg[4 + grp * 8 + i];
                if (v > v1) { v2 = v1; i2 = i1; v1 = v; i1 = i; } else if (v > v2) { v2 = v; i2 = i; } }
            const float e2 = __expf(v2 - v1), w1 = pg * frcp(1.f + e2), w2 = pg * e2 * frcp(1.f + e2);
            const int ex1 = grp * 8 + i1, ex2 = grp * 8 + i2;
            const unsigned p1 = atomicAdd(&cnt[ex1], 1u), p2 = atomicAdd(&cnt[ex2], 1u);
            PE[2 * row] = ex1; PE[2 * row + 1] = ex2; PPOS[2 * row] = (int)p1; PPOS[2 * row + 1] = (int)p2; PW[2 * row] = w1; PW[2 * row + 1] = w2;
        }
        if (!p.dry && lk == 0) { float* RSR = WSF(p, WS_RSROW);
#pragma unroll
            for (int r = 0; r < 8; ++r) RSR[row0 + 8 * half + r] = ss[r]; }
    }
}
struct MoeTab { LAS int* pad_start; LAS int* blk_e; LAS int* n_used; };
__device__ __forceinline__ MoeTab moe_tab(const Frame& F) { MoeTab t; LAS int* base = (LAS int*)(F.lds + MISC_OFF + 64); t.pad_start = base; t.blk_e = base + 32; t.n_used = base + 32 + MOE_NBLK; return t; }
__device__ __forceinline__ void moe_build_tab(const Params& p, const Frame& F, int l) {
    const MoeTab t = moe_tab(F);
    const unsigned* cnt = (const unsigned*)(p.ws + WS_CTL) + CW_CNT + l * 32;
    __syncthreads();
    if (F.tid == 0) { int acc = 0;
        for (int e = 0; e < 32; ++e) { const int c = (int)__hip_atomic_load(cnt + e, __ATOMIC_RELAXED, __HIP_MEMORY_SCOPE_AGENT), nb = (c + 255) >> 8; t.pad_start[e] = acc * 256;
            for (int k = 0; k < nb; ++k) t.blk_e[acc + k] = e;
            acc += nb; }
        *t.n_used = acc; }
    __syncthreads();
}
__device__ __forceinline__ void p15_scatter(const Params& p, const Frame& F, int l, bool want_ctx) {
    moe_build_tab(p, F, l);
    const MoeTab t = moe_tab(F);
    const int* PE = (const int*)(p.ws + WS_PAIR); const int* PPOS = PE + NPAIR_MAX; int* PD = (int*)(p.ws + WS_PAIR) + 3 * NPAIR_MAX;
    const float* RSR = WSF(p, WS_RSROW); bf16_t* BUF = WSB(p, WS_BUF);
    const float* mod = WSF(p, WS_MOD) + (size_t)l * 9 * 6144; const float* n2g = p.in[I_N2G] + (size_t)l * 1024;
    const int lane = F.lane;
    for (int row = F.gwave; row < T; row += F.nwave) {
        const int b = row / NP, q = row - b * NP; const bool isctx = q < NCTX;
        if (isctx && !want_ctx) continue;
        const float* mr = mod + (size_t)(isctx ? 8 : b) * 6144; const float* x = xrow(p, row);
        const float rs = RSR[row];
        const int d0 = t.pad_start[PE[2 * row]] + PPOS[2 * row], d1 = t.pad_start[PE[2 * row + 1]] + PPOS[2 * row + 1];
        if (lane == 0) { PD[2 * row] = d0; PD[2 * row + 1] = d1; }
        f32x4 xv[4];
#pragma unroll
        for (int j = 0; j < 4; ++j) xv[j] = *(const f32x4*)(x + j * 256 + lane * 4);
#pragma unroll
        for (int j = 0; j < 4; ++j) { const int c = j * 256 + lane * 4;
            const f32x4 gg = *(const f32x4*)(n2g + c), s1 = *(const f32x4*)(mr + 4096 + c), s0 = *(const f32x4*)(mr + 3072 + c); float y[4];
#pragma unroll
            for (int e = 0; e < 4; ++e) y[e] = xv[j][e] * rs * gg[e] * (1.f + s1[e]) + s0[e];
            u32x2 w; w.x = pk2(y[0], y[1]); w.y = pk2(y[2], y[3]);
            *(u32x2*)(BUF + (size_t)d0 * 1024 + c) = w; *(u32x2*)(BUF + (size_t)d1 * 1024 + c) = w; }
    }
}
__device__ __forceinline__ void p18_combine(const Params& p, const Frame& F, int l, bool want_ctx) {
    const int* PD = (const int*)(p.ws + WS_PAIR) + 3 * NPAIR_MAX; const float* PW = (const float*)(p.ws + WS_PAIR) + 2 * NPAIR_MAX;
    const bf16_t* YB = WSB(p, WS_YB);
    const float* mod = WSF(p, WS_MOD) + (size_t)l * 9 * 6144;
    const float* modn = mod + 9 * 6144;
    const float* n1g = p.in[I_N1G] + (size_t)(l + 1) * 1024;
    bf16_t* H = WSB(p, WS_H);
    const bool donorm = (l + 1 < DEPTH);
    const int lane = F.lane;
    for (int row = F.gwave; row < T; row += F.nwave) {
        const int b = row / NP, q = row - b * NP; const bool isctx = q < NCTX;
        if (isctx && !want_ctx) continue;
        const int mrow = isctx ? 8 : b;
        const float* g2 = mod + (size_t)mrow * 6144 + 5120;
        const int d0 = PD[2 * row], d1 = PD[2 * row + 1]; const float w0 = PW[2 * row], w1 = PW[2 * row + 1];
        float* x = xrow(p, row);
        f32x4 xv[4]; float ss = 0.f;
#pragma unroll
        for (int j = 0; j < 2; ++j) { const int c = j * 512 + lane * 8;
            float ya[8], yb[8]; unpack8(*(const u32x4*)(YB + (size_t)d0 * 1024 + c), ya); unpack8(*(const u32x4*)(YB + (size_t)d1 * 1024 + c), yb);
            f32x4 x0 = *(const f32x4*)(x + c), x1 = *(const f32x4*)(x + c + 4); const f32x4 ga = *(const f32x4*)(g2 + c), gb = *(const f32x4*)(g2 + c + 4);
#pragma unroll
            for (int e = 0; e < 4; ++e) { x0[e] += ga[e] * (w0 * ya[e] + w1 * yb[e]); x1[e] += gb[e] * (w0 * ya[4 + e] + w1 * yb[4 + e]); ss += x0[e] * x0[e] + x1[e] * x1[e]; }
            if (!p.dry) { *(f32x4*)(x + c) = x0; *(f32x4*)(x + c + 4) = x1; }
            xv[2 * j] = x0; xv[2 * j + 1] = x1; }
        if (donorm) {
#pragma unroll
            for (int m = 1; m < 64; m <<= 1) ss += shfl_xor_f(ss, m);
            const float rs = rsqrtf(ss * (1.f / 1024.f) + 1e-6f);
            const float* mr = modn + (size_t)mrow * 6144;
#pragma unroll
            for (int j = 0; j < 2; ++j) { const int c = j * 512 + lane * 8; float y[8];
#pragma unroll
                for (int hf = 0; hf < 2; ++hf) { const f32x4 gg = *(const f32x4*)(n1g + c + 4 * hf), s1 = *(const f32x4*)(mr + 1024 + c + 4 * hf), s0 = *(const f32x4*)(mr + c + 4 * hf);
#pragma unroll
                    for (int e = 0; e < 4; ++e) y[4 * hf + e] = xv[2 * j + hf][e] * rs * gg[e] * (1.f + s1[e]) + s0[e]; }
                if (!p.dry) *(u32x4*)(H + (size_t)row * 1024 + c) = pack8(y); } }
    }
}
constexpr size_t WS_REC = WS_WU; constexpr int REC_BYTES = 15360, RC_BYTES = 1792;
static_assert(WS_LW == WS_WU + (size_t)T * 1792 * 2 && WS_LA == WS_LW + (size_t)T * 1024 * 2 && WS_LG == WS_LA + (size_t)T * 1024 * 2, "WU|LW|LA contiguous");
static_assert(WS_REC + (size_t)NB * 8 * (NP / 16) * REC_BYTES <= WS_LG, "chunk records fit");
constexpr size_t WS_YCAT = WS_WU;
constexpr size_t WS_YS2 = WS_H;
constexpr int NCHUNK = NP / 16;
__device__ __forceinline__ int scan_pos(int s, int dir) { return dir ? (s < NCTX ? NCTX - 1 - s : NP + NCTX - 1 - s) : s; }
constexpr size_t WS_REC2 = WS_W1;
constexpr size_t WS_VS2 = AL(WS_REC2 + (size_t)NB * 8 * (NP / 16) * REC_BYTES);
constexpr size_t WS_BON = AL(WS_VS2 + SZ512);
static_assert(WS_BON + (size_t)2 * T * 8 * 4 <= WS_END_MIX, "records + V' + bonus fit in the W1 region");
struct BuildRaw { u32x4 wu[3][2], halo[3]; };
__device__ __forceinline__ void build_load(BuildRaw& R, const Params& p, int ch, int lane) {
    const bf16_t* WU = WSB(p, WS_WU);
    const int bh = ch / NCHUNK, tb = ch - bh * NCHUNK, b = bh >> 3, h = bh & 7;
    const int q0 = 16 * tb; const size_t row0 = (size_t)b * NP + q0;
    const int lt = lane >> 2, lc = (lane & 3) * 16;
    const bool hasp = (q0 != 0) && (q0 != NCTX), hasn = (q0 + 16 != NCTX) && (q0 + 16 != NP);
#pragma unroll
    for (int part = 0; part < 3; ++part) { const bf16_t* src = WU + (row0 + lt) * 1792 + part * 512 + h * 64 + lc;
        R.wu[part][0] = *(const u32x4*)src; R.wu[part][1] = *(const u32x4*)(src + 8);
        u32x4 hv; hv.x = hv.y = hv.z = hv.w = 0u;
        if (lane < 16) { const bool nx = lane >= 8; const bool ok = nx ? hasn : hasp;
            if (ok) hv = *(const u32x4*)(WU + (nx ? row0 + 16 : row0 - 1) * 1792 + part * 512 + h * 64 + (lane & 7) * 8); }
        R.halo[part] = hv; }
}
template <int DIR> __device__ __forceinline__ void build_dir(const Params& p, int l, int lane, LAS unsigned char* wl, const float (&rr)[16], const float (&kx)[16], const float (&vx)[16], const float (&kn)[16],
                                                            const u32x4 (&lwr)[2], const u32x4 (&lar)[2], size_t row0, int h, unsigned char* rec, float* BON) {
    constexpr int dir = DIR; constexpr int TP_ = 144;
    const int g = lane >> 4, li = lane & 15, lt = lane >> 2, lc = (lane & 3) * 16, cc = h * 64 + lane;
    LAS unsigned char* Ta = wl; LAS unsigned char* Tr = wl + 2304; LAS unsigned char* Tb = wl + 4608; LAS unsigned char* Tk = wl + 6912;
    LAS float* M = (LAS float*)wl;
    const int pj = (lane & 32) + ((lane & 15) >> 2) * 8 + ((lane >> 4) & 1) * 4 + (lane & 3);
    constexpr int LO = DIR ? 11264 : 0;
    asm volatile("" ::: "memory");
    if (DIR == 0) {
        *(LAS u32x4*)(wl + lt * 128 + lc * 2) = lwr[0]; *(LAS u32x4*)(wl + lt * 128 + lc * 2 + 16) = lwr[1];
        *(LAS u32x4*)(wl + 2048 + lt * 128 + lc * 2) = lar[0]; *(LAS u32x4*)(wl + 2048 + lt * 128 + lc * 2 + 16) = lar[1]; }
    asm volatile("" ::: "memory");
        float X[16], Q[16], v[16], bhh[16], khh[16]; float Lc = 0.f;
        { const float w0c = p.in[I_W0][((size_t)l * 2 + dir) * 512 + cc], a0c = p.in[I_A0][((size_t)l * 2 + dir) * 512 + cc], kac = p.in[I_KA][l * 512 + cc], rkc = p.in[I_RK][l * 512 + cc];
          float bs0[8], bs1[8];
#pragma unroll
          for (int t = 0; t < 16; ++t) {
              constexpr int dummy_ = 0; (void)dummy_;
              const int tt = dir ? 15 - t : t; const int o = tt * 128 + lane * 2;
              const float lwv = bf2f(*(const LAS bf16_t*)(wl + LO + o)), lav = bf2f(*(const LAS bf16_t*)(wl + LO + 2048 + o));
              const float r = rr[tt], kp = kx[tt], kkn = kn[tt]; v[t] = vx[tt];
              const float asig = sigmoidf_(a0c + lav), lw = -0.6065306597126334f * sigmoidf_(w0c + lwv);
              const float k = kp * (1.f + (asig - 1.f) * kac), bb = kkn * asig, a = -kkn;
              if (t < 8) bs0[t] = r * k * rkc; else bs1[t - 8] = r * k * rkc;
              const float Lx = Lc; Lc += lw;
              const float at = a * __expf(Lx), rt = r * __expf(Lc), en = __expf(-Lc);
              X[t] = at; Q[t] = rt; bhh[t] = bb * en; khh[t] = k * en;
          }
          const float u0 = reduce8(bs0, lane), u1 = reduce8(bs1, lane);
          if ((lane & 7) == 0) { const int t = lane >> 3; const int tk0 = dir ? 15 - t : t, tk1 = dir ? 7 - t : 8 + t; BON[(row0 + tk0) * 8 + h] = u0; BON[(row0 + tk1) * 8 + h] = u1; } }
        asm volatile("" ::: "memory");
#pragma unroll
        for (int t = 0; t < 16; ++t) {
            *(LAS bf16_t*)(Ta + t * TP_ + lane * 2) = (bf16_t)f2bf(X[t]); *(LAS bf16_t*)(Tr + t * TP_ + lane * 2) = (bf16_t)f2bf(Q[t]);
            *(LAS bf16_t*)(Tb + t * TP_ + lane * 2) = (bf16_t)f2bf(bhh[t]); *(LAS bf16_t*)(Tk + t * TP_ + lane * 2) = (bf16_t)f2bf(khh[t]);
        }
        const float gC = __expf(Lc);
#pragma unroll
        for (int t = 0; t < 16; ++t) { bhh[t] *= gC; khh[t] *= gC; }
#pragma unroll
        for (int q4 = 0; q4 < 4; ++q4) *(float*)(rec + 8192 + q4 * RC_BYTES + 1536 + lane * 4) = gC;
#pragma unroll
        for (int gg = 0; gg < 4; ++gg) { u32x4 w; w.x = pk2(bhh[4 * gg], bhh[4 * gg + 1]); w.y = pk2(bhh[4 * gg + 2], bhh[4 * gg + 3]); w.z = pk2(khh[4 * gg], khh[4 * gg + 1]); w.w = pk2(khh[4 * gg + 2], khh[4 * gg + 3]);
            *(u32x4*)(rec + 4096 + (lane * 32 + gg * 8) * 2) = w; }
        f32x4 mab = {0.f, 0.f, 0.f, 0.f}, mak = mab, mrb = mab, mrk = mab;
#pragma unroll
        for (int ks = 0; ks < 2; ++ks) { const int o = li * TP_ + (32 * ks + 8 * g) * 2;
            const bf16x8 fa = ld_frag(Ta + o), fr = ld_frag(Tr + o), fb = ld_frag(Tb + o), fk = ld_frag(Tk + o);
            mab = MFMA16(fa, fb, mab); mak = MFMA16(fa, fk, mak); mrb = MFMA16(fr, fb, mrb); mrk = MFMA16(fr, fk, mrk); }
        asm volatile("" ::: "memory");
#pragma unroll
        for (int r = 0; r < 4; ++r) { const int t = 4 * g + r;
            M[t * 16 + li] = li < t ? mab[r] : 0.f; M[256 + t * 16 + li] = li < t ? mak[r] : 0.f;
            M[512 + t * 16 + li] = li <= t ? mrb[r] : 0.f; M[768 + t * 16 + li] = li <= t ? mrk[r] : 0.f; }
        f32x2 XU[16]; float Y0[16];
        XU[0] = (f32x2){X[0], 0.f};
#pragma unroll
        for (int t = 1; t < 16; ++t) { f32x2 xu = {X[t], 0.f}; float u2 = 0.f;
#pragma unroll
            for (int s4 = 0; s4 < 4; ++s4) { if (4 * s4 < t) { const f32x4 ab = *(const LAS f32x4*)(M + t * 16 + 4 * s4), ak = *(const LAS f32x4*)(M + 256 + t * 16 + 4 * s4);
#pragma unroll
                for (int e = 0; e < 4; ++e) { const int s = 4 * s4 + e; if (s < t) { xu = xu + XU[s] * ab[e]; u2 += ak[e] * v[s]; } } } }
            xu.y += u2;
            asm volatile("" : "+v"(xu) :: "memory");
            XU[t] = xu; }
#pragma unroll
        for (int t = 0; t < 16; ++t) { f32x2 qy = {Q[t], 0.f}; float y2 = 0.f;
#pragma unroll
            for (int s4 = 0; s4 < 4; ++s4) { if (4 * s4 <= t) { const f32x4 rb = *(const LAS f32x4*)(M + 512 + t * 16 + 4 * s4), rk = *(const LAS f32x4*)(M + 768 + t * 16 + 4 * s4);
#pragma unroll
                for (int e = 0; e < 4; ++e) { const int s = 4 * s4 + e; if (s <= t) { qy = qy + XU[s] * rb[e]; y2 += rk[e] * v[s]; } } } }
            qy.y += y2;
            asm volatile("" : "+v"(qy) :: "memory");
            Q[t] = qy.x; Y0[t] = qy.y; }
        float U0[16];
#pragma unroll
        for (int t = 0; t < 16; ++t) { X[t] = XU[t].x; U0[t] = XU[t].y; }
        asm volatile("" ::: "memory");
#pragma unroll
        for (int t = 0; t < 16; ++t) { *(LAS bf16_t*)(wl + 4096 + (t * 64 + pj) * 2) = (bf16_t)f2bf(X[t]); *(LAS bf16_t*)(wl + 6144 + (t * 64 + pj) * 2) = (bf16_t)f2bf(Q[t]); }
        asm volatile("" ::: "memory");
#pragma unroll
        for (int k = 0; k < 4; ++k) *(u32x4*)(rec + k * 1024 + lane * 16) = *(const LAS u32x4*)(wl + 4096 + k * 1024 + lane * 16);
        unsigned char* rc = rec + 8192 + g * RC_BYTES + li * 32;
#pragma unroll
        for (int hf = 0; hf < 2; ++hf) { u32x4 w;
            w.x = pk2(v[8 * hf], v[8 * hf + 1]); w.y = pk2(v[8 * hf + 2], v[8 * hf + 3]); w.z = pk2(v[8 * hf + 4], v[8 * hf + 5]); w.w = pk2(v[8 * hf + 6], v[8 * hf + 7]); *(u32x4*)(rc + hf * 16) = w;
            w.x = pk2(U0[8 * hf], U0[8 * hf + 1]); w.y = pk2(U0[8 * hf + 2], U0[8 * hf + 3]); w.z = pk2(U0[8 * hf + 4], U0[8 * hf + 5]); w.w = pk2(U0[8 * hf + 6], U0[8 * hf + 7]); *(u32x4*)(rc + 512 + hf * 16) = w;
            w.x = pk2(Y0[8 * hf], Y0[8 * hf + 1]); w.y = pk2(Y0[8 * hf + 2], Y0[8 * hf + 3]); w.z = pk2(Y0[8 * hf + 4], Y0[8 * hf + 5]); w.w = pk2(Y0[8 * hf + 6], Y0[8 * hf + 7]); *(u32x4*)(rc + 1024 + hf * 16) = w; }
}
__device__ __forceinline__ void p6c_rwkv_build(const Params& p, const Frame& F, int l, int half) {
    unsigned char* REC = p.ws + WS_REC2; bf16_t* VSo = WSB(p, WS_VS2); float* BON = WSF(p, WS_BON);
    constexpr int TP_ = 144;
    BuildRaw cur, nxt;
    if (F.gwave < 32 * NCHUNK) build_load(cur, p, half * 32 * NCHUNK + F.gwave, F.lane);
    for (int chl = F.gwave; chl < 32 * NCHUNK; chl += F.nwave) { const int ch = half * 32 * NCHUNK + chl;
        int lane = F.lane; asm volatile("" : "+v"(lane));
        const int g = lane >> 4, li = lane & 15;
        LAS unsigned char* wl = F.lds + F.wave * 17408;
        LAS unsigned char* Ta = wl; LAS unsigned char* Tr = wl + 2304; LAS unsigned char* Tb = wl + 4608; LAS unsigned char* Tk = wl + 6912;
        LAS float* M = (LAS float*)wl;
        LAS unsigned char* Sv = wl + 9216;
        const int pj = (lane & 32) + ((lane & 15) >> 2) * 8 + ((lane >> 4) & 1) * 4 + (lane & 3);
        const int bh = ch / NCHUNK, tb = ch - bh * NCHUNK, b = bh >> 3, h = bh & 7;
        const int q0 = 16 * tb; const size_t row0 = (size_t)b * NP + q0;
        const int lt = lane >> 2, lc = (lane & 3) * 16;
#pragma unroll
        for (int part = 0; part < 3; ++part) {
            *(LAS u32x4*)(wl + part * 2304 + (lt + 1) * 128 + lc * 2) = cur.wu[part][0]; *(LAS u32x4*)(wl + part * 2304 + (lt + 1) * 128 + lc * 2 + 16) = cur.wu[part][1];
            if (lane < 16) *(LAS u32x4*)(wl + part * 2304 + (lane >= 8 ? 17 * 128 : 0) + (lane & 7) * 16) = cur.halo[part]; }
        const int cc = h * 64 + lane;
        u32x4 lwr[2], lar[2];
        { const bf16_t* LWg = WSB(p, WS_LW); const bf16_t* LAg = WSB(p, WS_LA);
          const bf16_t* s1p = LWg + (row0 + lt) * 1024 + h * 64 + lc; const bf16_t* s2p = LAg + (row0 + lt) * 1024 + h * 64 + lc;
          lwr[0] = *(const u32x4*)s1p; lwr[1] = *(const u32x4*)(s1p + 8); lar[0] = *(const u32x4*)s2p; lar[1] = *(const u32x4*)(s2p + 8);
          *(LAS u32x4*)(wl + 11264 + lt * 128 + lc * 2) = *(const u32x4*)(s1p + 512); *(LAS u32x4*)(wl + 11264 + lt * 128 + lc * 2 + 16) = *(const u32x4*)(s1p + 520);
          *(LAS u32x4*)(wl + 13312 + lt * 128 + lc * 2) = *(const u32x4*)(s2p + 512); *(LAS u32x4*)(wl + 13312 + lt * 128 + lc * 2 + 16) = *(const u32x4*)(s2p + 520); }
        float rr[16], kx[16], vx[16], kn[16];
        { const float* mu0 = p.in[I_MU] + (size_t)l * 2 * 1792, *mu1 = mu0 + 1792;
          const float kkc = p.in[I_KK][l * 512 + cc];
#pragma unroll
          for (int part = 0; part < 3; ++part) { const float m0 = mu0[part * 512 + cc], m1 = mu1[part * 512 + cc];
              float raw[18];
#pragma unroll
              for (int t = 0; t < 18; ++t) raw[t] = bf2f(*(const LAS bf16_t*)(wl + part * 2304 + t * 128 + lane * 2));
#pragma unroll
              for (int t = 0; t < 16; ++t) { const float u = raw[t + 1], sh = u + (raw[t] - u) * m0 + (raw[t + 2] - u) * m1;
                  if (part == 0) rr[t] = sh; else if (part == 1) kx[t] = sh; else vx[t] = sh; } }
          float s0[8], s1[8];
#pragma unroll
          for (int t = 0; t < 8; ++t) { kn[t] = kx[t] * kkc; kn[t + 8] = kx[t + 8] * kkc; s0[t] = kn[t] * kn[t]; s1[t] = kn[t + 8] * kn[t + 8]; }
          const float t0 = reduce8(s0, lane), t1 = reduce8(s1, lane);
#pragma unroll
          for (int t = 0; t < 8; ++t) { kn[t] *= rsqrtf(fmaxf(__shfl(t0, t * 8, 64), 1e-12f)); kn[t + 8] *= rsqrtf(fmaxf(__shfl(t1, t * 8, 64), 1e-12f)); }
          asm volatile("" ::: "memory");
          {
#pragma unroll
              for (int t = 0; t < 16; ++t) *(LAS bf16_t*)(Sv + t * 128 + lane * 2) = (bf16_t)f2bf(vx[t]);
              asm volatile("" ::: "memory");
              bf16_t* vo = VSo + (row0 + lt) * 512 + h * 64 + lc; *(u32x4*)vo = *(const LAS u32x4*)(Sv + lt * 128 + lc * 2); *(u32x4*)(vo + 8) = *(const LAS u32x4*)(Sv + lt * 128 + lc * 2 + 16); }
          }
        { const int bhl = bh & 31;
          build_dir<0>(p, l, lane, wl, rr, kx, vx, kn, lwr, lar, row0, h, REC + ((size_t)(bhl * 2 + 0) * NCHUNK + tb) * REC_BYTES, BON);
          int lane2 = lane; asm volatile("" : "+v"(lane2) :: "memory");
          { const int chn = chl + F.nwave; if (chn < 32 * NCHUNK) build_load(nxt, p, half * 32 * NCHUNK + chn, lane2); else nxt = cur; }
          build_dir<1>(p, l, lane2, wl, rr, kx, vx, kn, lwr, lar, row0, h, REC + ((size_t)(bhl * 2 + 1) * NCHUNK + (tb < 16 ? 15 - tb : 287 - tb)) * REC_BYTES, BON + (size_t)T * 8); }
        cur = nxt;
    }
}
constexpr int SC_SLOT = 10240, SC_NSLOT = 13, SC_DEPTH = 6;
__device__ __forceinline__ void scan_dma(const unsigned char* rec, int iq, LAS unsigned char* slot, int lane) {
    const unsigned char* g0 = rec + lane * 16;
#pragma unroll
    for (int k = 0; k < 8; ++k) __builtin_amdgcn_global_load_lds((const unsigned*)(g0 + k * 1024), (LAS unsigned*)(slot + k * 1024), 16, 0, 0);
    const unsigned char* g1 = rec + 8192 + iq * RC_BYTES + lane * 16;
    __builtin_amdgcn_global_load_lds((const unsigned*)g1, (LAS unsigned*)(slot + 8192), 16, 0, 0);
    if (lane < 48) __builtin_amdgcn_global_load_lds((const unsigned*)(g1 + 1024), (LAS unsigned*)(slot + 9216), 16, 0, 0);
}
__device__ __forceinline__ unsigned lds_ld(volatile LAS unsigned* q) { return *q; }
__device__ __forceinline__ void p6b_rwkv_scan(const Params& p, const Frame& F, int half) {
    volatile LAS unsigned* ctl = (volatile LAS unsigned*)(F.lds + MISC_OFF + 1536);
    if (F.tid < 4) ctl[F.tid] = 0u;
    __syncthreads();
    if (F.wave > 3) return;
    const int lane = F.lane, g = lane >> 4, li = lane & 15;
    const int task = (F.G == 256) ? (F.bid & 7) * 32 + (F.bid >> 3) : F.bid;
    if (task >= 256) return;
    const int bhl = task >> 3, dir = (task >> 2) & 1, iq = task & 3, b = 4 * half + (bhl >> 3), h = bhl & 7;
    const unsigned char* rec0 = p.ws + WS_REC2 + (size_t)(bhl * 2 + dir) * NCHUNK * REC_BYTES;
    LAS unsigned char* SBUF = F.lds + SC_NSLOT * SC_SLOT;
    if (F.wave == 1 || F.wave == 2) {
        const int hh = F.wave - 1;
        asm volatile("s_waitcnt vmcnt(0)" ::: "memory");
#pragma unroll 1
        for (int n = 0; n < NCHUNK / 2; ++n) { const int k = 2 * n + hh;
            while ((int)lds_ld(ctl + 2) + SC_NSLOT <= k) __builtin_amdgcn_s_sleep(1);
            scan_dma(rec0 + (size_t)k * REC_BYTES, iq, F.lds + (k % SC_NSLOT) * SC_SLOT, lane);
            if (n >= 4) { asm volatile("s_waitcnt vmcnt(40)" ::: "memory"); if (lane == 0) ctl[hh] = (unsigned)(n - 3); } }
        asm volatile("s_waitcnt vmcnt(0)" ::: "memory");
        if (lane == 0) ctl[hh] = (unsigned)(NCHUNK / 2);
        return;
    }
    if (F.wave == 3) {
        bf16_t* YS = WSB(p, WS_YS2) + (size_t)dir * T * 512;
        const int rstep = dir ? -512 : 512;
#pragma unroll 1
        for (int c = 0; c < NCHUNK; ++c) {
            while (lds_ld(ctl + 3) <= (unsigned)c) __builtin_amdgcn_s_sleep(1);
            asm volatile("" ::: "memory");
            const LAS unsigned char* sl = F.lds + (c % SC_NSLOT) * SC_SLOT; const LAS unsigned char* sp = SBUF + (c & 3) * 2048 + lane * 16;
            const bf16x8 sb0 = ld_frag(sp), sb1 = ld_frag(sp + 1024);
            const bf16x8 q0 = ld_frag(sl + 2048 + (li * 64 + g * 8) * 2), q1 = ld_frag(sl + 2048 + (li * 64 + 32 + g * 8) * 2);
            const u32x2 y0 = *(const LAS u32x2*)(sl + 8192 + 1024 + (li * 16 + 4 * g) * 2);
            f32x4 Y = {lo16(y0.x), hi16(y0.x), lo16(y0.y), hi16(y0.y)};
            Y = MFMA16(q0, sb0, Y); Y = MFMA16(q1, sb1, Y);
            asm volatile("s_waitcnt lgkmcnt(0)" ::: "memory");
            if (lane == 0) ctl[2] = (unsigned)(c + 1);
            bf16_t* yp = YS + ((size_t)(b * NP + scan_pos(16 * c + 4 * g, dir))) * 512 + h * 64 + 16 * iq + li;
#pragma unroll
            for (int r = 0; r < 4; ++r) yp[r * rstep] = (bf16_t)f2bf(Y[r]);
        }
        return;
    }
    f32x4 st[4];
#pragma unroll
    for (int jt = 0; jt < 4; ++jt) st[jt] = (f32x4){0.f, 0.f, 0.f, 0.f};
    struct Ops { bf16x8 ah[2], bk[4]; f32x4 gc[4]; u32x2 vt, u0; };
#define SCAN_WAIT(c_) do { const unsigned need_ = (unsigned)((c_) >> 1) + 1u; volatile LAS unsigned* lw_ = ctl + ((c_) & 1); while (lds_ld(lw_) < need_) __builtin_amdgcn_s_sleep(1); asm volatile("" ::: "memory"); } while (0)
#define SCAN_WAIT2(c_) do { const unsigned n1_ = (unsigned)((c_) >> 1) + 1u, n0_ = ((c_) + 2 < NCHUNK) ? (unsigned)((c_) >> 1) + 2u : 0u; \
        for (;;) { const u32x4 fl_ = *(volatile LAS u32x4*)ctl; if (fl_.x >= n0_ && fl_.y >= n1_ && (int)fl_.z + 1 >= (c_)) break; __builtin_amdgcn_s_sleep(1); } asm volatile("" ::: "memory"); } while (0)
#define SCAN_LOAD(o_, c_) do { const LAS unsigned char* sl_ = F.lds + ((c_) % SC_NSLOT) * SC_SLOT; \
        _Pragma("unroll") for (int ks = 0; ks < 2; ++ks) o_.ah[ks] = ld_frag(sl_ + (li * 64 + ks * 32 + g * 8) * 2); \
        _Pragma("unroll") for (int jt = 0; jt < 4; ++jt) { o_.bk[jt] = ld_frag(sl_ + 4096 + ((16 * jt + li) * 32 + g * 8) * 2); o_.gc[jt] = *(const LAS f32x4*)(sl_ + 8192 + 1536 + (16 * jt + 4 * g) * 4); } \
        o_.vt = *(const LAS u32x2*)(sl_ + 8192 + (li * 16 + 4 * g) * 2); o_.u0 = *(const LAS u32x2*)(sl_ + 8192 + 512 + (li * 16 + 4 * g) * 2); } while (0)
    Ops o0, o1;
    SCAN_WAIT(0);
    SCAN_LOAD(o0, 0);
#define SCAN_STEP(cur_, nxt_, c_) do { \
        const bf16x8 sb0 = pack_frag(st[0], st[1]), sb1 = pack_frag(st[2], st[3]); \
        { LAS unsigned char* sp_ = SBUF + ((c_) & 3) * 2048 + lane * 16; *(LAS bf16x8*)sp_ = sb0; *(LAS bf16x8*)(sp_ + 1024) = sb1; } \
        if (lane == 0) ctl[3] = (unsigned)((c_) + 1); \
        f32x4 U = {lo16(cur_.u0.x), hi16(cur_.u0.x), lo16(cur_.u0.y), hi16(cur_.u0.y)}; \
        U = MFMA16(cur_.ah[0], sb0, U); U = MFMA16(cur_.ah[1], sb1, U); \
        asm volatile("" ::: "memory"); \
        if ((c_) + 1 < NCHUNK) { if (((c_) & 1) == 0) SCAN_WAIT2(c_); SCAN_LOAD(nxt_, (c_) + 1); } \
        asm volatile("" ::: "memory"); \
        u32x4 uvw; uvw.x = pk2(U[0], U[1]); uvw.y = pk2(U[2], U[3]); uvw.z = cur_.vt.x; uvw.w = cur_.vt.y; \
        const bf16x8 uv = __builtin_bit_cast(bf16x8, uvw); \
        _Pragma("unroll") for (int jt = 0; jt < 4; ++jt) st[jt] = MFMA16(cur_.bk[jt], uv, st[jt] * cur_.gc[jt]); \
        asm volatile("s_waitcnt lgkmcnt(0)" ::: "memory"); } while (0)
#pragma unroll 1
    for (int c = 0; c < NCHUNK; c += 2) { SCAN_STEP(o0, o1, c); SCAN_STEP(o1, o0, c + 1); }
#undef SCAN_STEP
#undef SCAN_WAIT
#undef SCAN_WAIT2
#undef SCAN_LOAD
}

__device__ __forceinline__ void p7_rwkv_readout(const Params& p, const Frame& F, int l) {
    const bf16_t* VS = WSB(p, WS_VS2); const float* BON0 = WSF(p, WS_BON); const float* BON1 = BON0 + (size_t)T * 8;
    const bf16_t* YS0 = WSB(p, WS_H); const bf16_t* YS1 = YS0 + (size_t)T * 512;
    const bf16_t* LG = WSB(p, WS_LG); bf16_t* YW = WSB(p, WS_WU) + 1024;
    const int lane = F.lane, c0 = lane * 8;
    const float* ln_g = p.in[I_LNG] + l * 512, *ln_b = p.in[I_LNB] + l * 512;
    for (int row = F.gwave; row < T; row += F.nwave) {
        const size_t off = (size_t)row * 512 + c0;
        float y0[8], y1[8], v[8], g[8];
        unpack8(*(const u32x4*)(YS0 + off), y0); unpack8(*(const u32x4*)(YS1 + off), y1); unpack8(*(const u32x4*)(VS + off), v); unpack8(*(const u32x4*)(LG + off), g);
        const float bs = BON0[(size_t)row * 8 + (lane >> 3)] + BON1[(size_t)row * 8 + (lane >> 3)];
        float y[8], sm = 0.f;
#pragma unroll
        for (int e = 0; e < 8; ++e) { y[e] = y0[e] + y1[e]; sm += y[e]; }
        sm += shfl_xor_f(sm, 1); sm += shfl_xor_f(sm, 2); sm += shfl_xor_f(sm, 4);
        const float mean = sm * (1.f / 64.f); float vs = 0.f;
#pragma unroll
        for (int e = 0; e < 8; ++e) { const float d = y[e] - mean; vs += d * d; }
        vs += shfl_xor_f(vs, 1); vs += shfl_xor_f(vs, 2); vs += shfl_xor_f(vs, 4);
        const float rstd = rsqrtf(vs * (1.f / 64.f) + 64e-5f);
        float lg8[8], lb8[8]; *(f32x4*)lg8 = *(const f32x4*)(ln_g + c0); *(f32x4*)(lg8 + 4) = *(const f32x4*)(ln_g + c0 + 4); *(f32x4*)lb8 = *(const f32x4*)(ln_b + c0); *(f32x4*)(lb8 + 4) = *(const f32x4*)(ln_b + c0 + 4);
        float o[8];
#pragma unroll
        for (int e = 0; e < 8; ++e) o[e] = ((y[e] - mean) * rstd * lg8[e] + lb8[e] + bs * v[e]) * g[e];
        *(u32x4*)(YW + (size_t)row * 1536 + c0) = pack8(o);
    }
}
constexpr int NPHASE = 21;
constexpr int PARAMS_OFF = MISC_OFF + 2048;
__device__ __forceinline__ unsigned rfl(unsigned v) { return (unsigned)__builtin_amdgcn_readfirstlane((int)v); }
template <class Tp> __device__ __forceinline__ Tp* rfl_ptr(Tp* q) { const unsigned long long a = (unsigned long long)q; const unsigned lo = rfl((unsigned)a), hi = rfl((unsigned)(a >> 32)); return (Tp*)(((unsigned long long)hi << 32) | lo); }
__device__ __forceinline__ float rfl_f(float v) { return __builtin_bit_cast(float, rfl(__builtin_bit_cast(unsigned, v))); }
__device__ __forceinline__ Params load_params(LAS unsigned char* lds) {
    unsigned off = PARAMS_OFF; asm volatile("" : "+s"(off) :: "memory");
    const LAS Params* lp = (const LAS Params*)(lds + off);
    Params q;
#pragma unroll
    for (int i = 0; i < 33; ++i) q.in[i] = rfl_ptr(lp->in[i]);
    q.out = rfl_ptr(lp->out); q.ws = rfl_ptr(lp->ws);
#pragma unroll
    for (int i = 0; i < 16; ++i) q.invA[i] = rfl_f(lp->invA[i]);
#pragma unroll
    for (int i = 0; i < 32; ++i) q.invR[i] = rfl_f(lp->invR[i]);
    q.ph_lo = 0; q.ph_hi = 0; q.l_lo = 0; q.l_hi = 0; q.fused = 0; q.do_pro = 0; q.dry = (int)rfl((unsigned)lp->dry); q.pad2 = 0;
    return q;
}
__device__ __forceinline__ unsigned char* load_ws(LAS unsigned char* lds) {
    unsigned off = PARAMS_OFF; asm volatile("" : "+s"(off) :: "memory");
    const LAS Params* lp = (const LAS Params*)(lds + off);
    return rfl_ptr(lp->ws);
}
__device__ __forceinline__ Frame make_frame(LAS unsigned char* lds) {
    Frame F; int tid = threadIdx.x; asm volatile("" : "+v"(tid));
    int bid = blockIdx.x, G = gridDim.x; asm volatile("" : "+s"(bid), "+s"(G));
    F.lds = lds; F.tid = tid; F.lane = tid & 63; F.wave = __builtin_amdgcn_readfirstlane(tid >> 6);
    F.G = G; F.bid = bid; F.gwave = bid * NWAVES + F.wave; F.nwave = G * NWAVES;
    return F;
}
#define SEAM() do { if (fused) { XcdBarrier bar_; bar_.bar = (unsigned*)(load_ws(lds0) + WS_CTL) + CW_BAR; bar_.x = xb_xcc_id(); bar_.st = misc; xcd_barrier(bar_); } } while (0)
#ifndef MK_PHASES
#define MK_PHASES 0xFFFFFFFFu
#endif
#define IN(k) (((MK_PHASES >> (k)) & 1u) && ph_lo <= (k) && (k) < ph_hi)
#define EN(k) ((MK_PHASES >> (k)) & 1u)
#define LP() const Frame F = make_frame(lds0); const Params p = load_params(lds0)

__device__ __forceinline__ void layer_program(LAS unsigned char* const lds0, volatile LAS unsigned* misc, const int l, const int ph_lo, const int ph_hi, const int fused) {
        const bool want_ctx = l < DEPTH - 1;
        if (IN(0) && l == 0) { LP(); p1_cvt_norm1(p, F, l); SEAM(); }
        if (IN(1)) { LP();
            pg8::Gemm g{WSB(p, WS_H), WSB(p, WS_BTIN), T, 7680, 1024}; pg8::StaticOrder S; S.init(T, 7680, F.G, F.bid);
            pg8::EpiInproj E{p.ws};
            pg8::gemm_phase<pg8::EpiInproj, pg8::StaticOrder, PG8_ALIGN, PG8_SP2>(F.lds, g, S, E);
            SEAM(); }
        if (IN(2)) { LP(); p3_prep(p, F, l); SEAM(); }
        if (IN(3)) { LP();
            pg8::Gemm g{WSB(p, WS_H), WSB(p, WS_BTLORA), T, 2560, 256}; pg8::StaticOrder S; S.init(T, 2560, F.G, F.bid);
            pg8::EpiLora E{p.ws};
            pg8::gemm_phase<pg8::EpiLora, pg8::StaticOrder, PG8_ALIGN, PG8_SP2>(F.lds, g, S, E);
            SEAM(); }
        if (IN(5)) { LP(); p6c_rwkv_build(p, F, l, 0); SEAM(); }
        if (IN(6)) { LP(); p6b_rwkv_scan(p, F, 0); SEAM(); }
        if (IN(7)) { LP(); p6c_rwkv_build(p, F, l, 1); SEAM(); }
        if (IN(8)) { LP(); p6b_rwkv_scan(p, F, 1); SEAM(); }
        if (IN(9)) { LP(); p7_rwkv_readout(p, F, l); }
        if (IN(10)) { LP(); p8_ret_kv(p, F, l); SEAM(); }
        if (IN(11)) { LP(); p9_ret_scan(p, F, l); SEAM(); }
        if (IN(12)) { LP(); p10_ret_out(p, F, l, want_ctx); }
        if (IN(13)) { LP(); p11_attention(p, F, want_ctx); SEAM(); }
        if (IN(14)) { LP();
            pg8::Gemm g{WSB(p, WS_YCAT), WSB(p, WS_BTBR), T, 1024, 1536};
            pg8::EpiMergeK E{WSB(p, WS_GL), WSB(p, WS_H)};
            if (want_ctx) { pg8::StaticOrder S; S.init(T, 1024, F.G, F.bid); pg8::gemm_phase<pg8::EpiMergeK, pg8::StaticOrder, PG8_ALIGN, PG8_SP2>(F.lds, g, S, E); }
            else { pg8::LatentOrder S; S.init(1024, F.G, F.bid); pg8::gemm_phase<pg8::EpiMergeK, pg8::LatentOrder, PG8_ALIGN, PG8_SP2>(F.lds, g, S, E); }
            __syncthreads();
            cvt_run<true>(p, F, l, (LAS float*)F.lds, (want_ctx && F.G == 256) ? 32 : 0);
            SEAM(); }
        if (IN(15)) { LP();
            pg8::Gemm g{WSB(p, WS_H), WSB(p, WS_BTOUT), T, 1024, 1024};
            pg8::EpiOut E{p.out, WSF(p, WS_CTXRES), WSF(p, WS_MOD) + (size_t)l * 9 * 6144, p.dry, l == 0 ? p.in[I_X] : p.out, l == 0 ? p.in[I_CTX] : WSF(p, WS_CTXRES)};
            if (want_ctx) { pg8::StaticOrder S; S.init(T, 1024, F.G, F.bid); pg8::gemm_phase<pg8::EpiOut, pg8::StaticOrder, PG8_ALIGN, PG8_SP2>(F.lds, g, S, E); }
            else { pg8::LatentOrder S; S.init(1024, F.G, F.bid); pg8::gemm_phase<pg8::EpiOut, pg8::LatentOrder, PG8_ALIGN, PG8_SP2>(F.lds, g, S, E); }
            if (l + 1 < DEPTH && F.G == 256) { __syncthreads(); cvt_run<false>(p, F, l + 1, (LAS float*)F.lds, 32, 0, 576); }
            SEAM(); }
        if (IN(16)) { LP(); p14_norm2_router(p, F, l, want_ctx); SEAM(); }
        if (IN(17)) { LP(); p15_scatter(p, F, l, want_ctx); SEAM(); }
        if (IN(18)) { LP();
            moe_build_tab(p, F, l);
            pg8::Gemm g{WSB(p, WS_BUF), WSB(p, WS_BT1), MOE_NBLK * 256, 1024, 1024};
            typedef pg8::MoeOrder<(size_t)1024 * 1024 * 2> Ord; Ord S{F.G, F.bid, (const PG8_LAS int*)(F.lds + MISC_OFF + 64)};
            pg8::EpiSwiGLU E{WSB(p, WS_HB)};
            pg8::gemm_phase<pg8::EpiSwiGLU, Ord, PG8_ALIGN, PG8_SP2>(F.lds, g, S, E);
            SEAM(); }
        if (IN(19)) { LP();
            moe_build_tab(p, F, l);
            pg8::Gemm g{WSB(p, WS_HB), WSB(p, WS_BT2), MOE_NBLK * 256, 1024, 512};
            typedef pg8::MoeOrder<(size_t)1024 * 512 * 2> Ord; Ord S{F.G, F.bid, (const PG8_LAS int*)(F.lds + MISC_OFF + 64)};
            pg8::EpiPlainBf16 E{WSB(p, WS_YB), 1024};
            pg8::gemm_phase<pg8::EpiPlainBf16, Ord, PG8_ALIGN, PG8_SP2>(F.lds, g, S, E);
            SEAM(); }
        if (IN(20)) { LP(); p18_combine(p, F, l, want_ctx); if (l + 1 < DEPTH) { p1_weights(p, F, l + 1, F.G == 256); SEAM(); } }
    }
__global__ void __launch_bounds__(NTHREADS, 2) mk_fwd(Params kp) {
    extern __shared__ __attribute__((aligned(16))) unsigned char lds_raw[];
    LAS unsigned char* const lds0 = (LAS unsigned char*)lds_raw;
    volatile LAS unsigned* misc = (volatile LAS unsigned*)(lds0 + MISC_OFF);
    if (threadIdx.x < 4) misc[threadIdx.x] = 0u;
    if (threadIdx.x == 0) { LAS Params* lp = (LAS Params*)(lds0 + PARAMS_OFF);
#pragma unroll
        for (int i = 0; i < 33; ++i) lp->in[i] = kp.in[i];
        lp->out = kp.out; lp->ws = kp.ws;
#pragma unroll
        for (int i = 0; i < 16; ++i) lp->invA[i] = kp.invA[i];
#pragma unroll
        for (int i = 0; i < 32; ++i) lp->invR[i] = kp.invR[i];
        lp->dry = kp.dry; }
    __syncthreads();
    const int ph_lo = kp.ph_lo, ph_hi = kp.ph_hi, fused = kp.fused;
    if (fused) (void)xcd_barrier_post((unsigned*)(kp.ws + WS_CTL) + CW_BAR, misc);
    if (((MK_PHASES >> 31) & 1u) && kp.do_pro) { LP(); p0_prologue(p, F); SEAM(); }

#if MK_FUSED
    layer_program(lds0, misc, 0, ph_lo, ph_hi, fused);
    layer_program(lds0, misc, 1, ph_lo, ph_hi, fused);
    layer_program(lds0, misc, 2, ph_lo, ph_hi, fused);
    layer_program(lds0, misc, 3, ph_lo, ph_hi, fused);
#else
    if (kp.l_lo < kp.l_hi) layer_program(lds0, misc, kp.l_lo, ph_lo, ph_hi, fused);
#endif
#undef IN
#undef SEAM
}

#ifndef MK_REP_MASK
#define MK_REP_MASK 0u
#define MK_REP_N 0
#endif
#ifndef MK_DRY_MODE
#define MK_DRY_MODE 1
#endif
extern "C" void kernel_launch(void* const* d_in, const int* in_sizes, int n_in, void* d_out, int out_size, void* d_ws, size_t ws_size, hipStream_t stream) {
    static int grid = 0;
    if (grid == 0) {
        if (n_in != 33 || in_sizes[0] != NB * NLAT * D || out_size != NB * NLAT * D || ws_size < WS_NEED) {
            fprintf(stderr, "kernel_launch: unexpected shapes/workspace: n_in %d in0 %d out %d ws %zu (need %zu)\n", n_in, n_in > 0 ? in_sizes[0] : -1, out_size, ws_size, (size_t)WS_NEED); grid = -1; return; }
        int dev = 0, cus = 0, per_cu = 0;
        if (hipGetDevice(&dev) != hipSuccess || hipDeviceGetAttribute(&cus, hipDeviceAttributeMultiprocessorCount, dev) != hipSuccess) { grid = -1; return; }
        if (hipFuncSetAttribute((const void*)mk_fwd, hipFuncAttributeMaxDynamicSharedMemorySize, LDS_BYTES) != hipSuccess) { fprintf(stderr, "kernel_launch: hipFuncSetAttribute failed\n"); grid = -1; return; }
        if (hipOccupancyMaxActiveBlocksPerMultiprocessor(&per_cu, (const void*)mk_fwd, NTHREADS, LDS_BYTES) != hipSuccess || per_cu < 1)
            fprintf(stderr, "kernel_launch: occupancy query reports %d workgroups per CU\n", per_cu);
        (void)hipGetLastError();
        grid = cus;
    }
    if (grid < 0) return;
    if (hipMemsetAsync((char*)d_ws + WS_CTL, 0, CTL_BYTES, stream) != hipSuccess) { fprintf(stderr, "kernel_launch: memset failed\n"); return; }
    Params a{};
    for (int i = 0; i < 33; ++i) a.in[i] = (const float*)d_in[i];
    a.out = (float*)d_out; a.ws = (unsigned char*)d_ws;
    for (int i = 0; i < 16; ++i) a.invA[i] = (float)pow(10000.0, -(double)i / 16.0);
    for (int i = 0; i < 32; ++i) a.invR[i] = (float)pow(10000.0, -(double)i / 32.0);
#if MK_FUSED
    a.ph_lo = 0; a.ph_hi = NPHASE; a.l_lo = 0; a.l_hi = DEPTH; a.fused = 1; a.do_pro = 1;
    hipLaunchKernelGGL(mk_fwd, dim3(grid), dim3(NTHREADS), LDS_BYTES, stream, a);
    if (hipPeekAtLastError() != hipSuccess) fprintf(stderr, "kernel_launch: launch failed\n");
#else
    a.fused = 0; a.do_pro = 1; a.l_lo = 0; a.l_hi = 0; a.ph_lo = 0; a.ph_hi = 0;
    hipLaunchKernelGGL(mk_fwd, dim3(grid), dim3(NTHREADS), LDS_BYTES, stream, a);
    a.do_pro = 0;
    for (int l = 0; l < DEPTH; ++l)
        for (int ph = 0; ph < NPHASE; ++ph) { a.l_lo = l; a.l_hi = l + 1; a.ph_lo = ph; a.ph_hi = ph + 1;
            const int reps = 1 + (((MK_REP_MASK >> ph) & 1u) ? MK_REP_N : 0);
            for (int r = 0; r < reps; ++r) { a.dry = r > 0 ? MK_DRY_MODE : 0; hipLaunchKernelGGL(mk_fwd, dim3(grid), dim3(NTHREADS), LDS_BYTES, stream, a); } a.dry = 0; }
    if (hipPeekAtLastError() != hipSuccess) fprintf(stderr, "kernel_launch: launch failed\n");
#endif
}
```

```cpp
#include <hip/hip_runtime.h>
#include <cstdio>
#include <cstdint>

#ifndef MK_FUSED
#define MK_FUSED 1
#endif

constexpr int D = 1024, NB = 8, NLAT = 4096, NCTX = 256, NP = NLAT + NCTX, T = NB * NP, DEPTH = 4;
constexpr int TP = T / 256;
constexpr int NPAIR_MAX = 2 * T;
constexpr int MOE_NBLK = NPAIR_MAX / 256 + 32;
constexpr int NTHREADS = 512, NWAVES = 8;

typedef unsigned short bf16_t;
typedef short bf16x8 __attribute__((ext_vector_type(8)));
typedef short bf16x4 __attribute__((ext_vector_type(4)));
typedef float f32x4 __attribute__((ext_vector_type(4)));
typedef float f32x2 __attribute__((ext_vector_type(2)));
typedef unsigned u32x4 __attribute__((ext_vector_type(4)));
typedef unsigned u32x2 __attribute__((ext_vector_type(2)));
#define LAS __attribute__((address_space(3)))
#define GAS __attribute__((address_space(1)))

constexpr size_t AL(size_t x) { return (x + 255) & ~(size_t)255; }
constexpr size_t WS_CTL = 0, CTL_BYTES = 65536;
constexpr int CW_BAR = 0;
constexpr int CW_CNT = 4096;
constexpr size_t WS_MOD = AL(WS_CTL + CTL_BYTES);
constexpr size_t WS_ROPE = AL(WS_MOD + (size_t)DEPTH * 9 * 6144 * 4);
constexpr size_t WS_RWT = AL(WS_ROPE + (size_t)(2 * 64 * 16 + 2 * 64 * 32) * 4);
constexpr size_t WS_RW2 = AL(WS_RWT + (size_t)DEPTH * 36 * 1024 * 4);
constexpr size_t WS_RC = AL(WS_RW2 + (size_t)DEPTH * 64 * 3 * 4 * 16 * 4 * 4);
constexpr size_t WS_CTXRES = AL(WS_RC + (size_t)DEPTH * 9 * 48 * 4);
constexpr size_t WS_BTIN = AL(WS_CTXRES + (size_t)NB * NCTX * D * 4);
constexpr size_t WS_BTBR = AL(WS_BTIN + (size_t)7680 * 1024 * 2);
constexpr size_t WS_BTOUT = AL(WS_BTBR + (size_t)3 * 1024 * 512 * 2);
constexpr size_t WS_BTLORA = AL(WS_BTOUT + (size_t)1024 * 1024 * 2);
constexpr size_t WS_H = AL(WS_BTLORA + (size_t)2560 * 256 * 2);
constexpr size_t WS_M0 = AL(WS_H + (size_t)T * 1024 * 2);
constexpr size_t SZ512 = (size_t)T * 512 * 2;
constexpr size_t WS_AQ = WS_M0;
constexpr size_t WS_AKV = AL(WS_AQ + SZ512);
constexpr size_t WS_RQ = AL(WS_AKV + (size_t)T * 256 * 2);
constexpr size_t WS_RK = AL(WS_RQ + SZ512);
constexpr size_t WS_RV = AL(WS_RK + SZ512);
constexpr size_t WS_RG = AL(WS_RV + SZ512);
constexpr size_t WS_GL = AL(WS_RG + SZ512);
constexpr size_t WS_WU = AL(WS_GL + (size_t)T * 3072 * 2);
constexpr size_t WS_LW = AL(WS_WU + (size_t)T * 1792 * 2);
constexpr size_t WS_LA = AL(WS_LW + (size_t)T * 1024 * 2);
constexpr size_t WS_LG = AL(WS_LA + (size_t)T * 1024 * 2);
constexpr size_t WS_W1 = AL(WS_LG + SZ512);
constexpr size_t WS_END_MIX = AL(WS_W1 + 9 * SZ512);
constexpr size_t WS_YS = WS_LW;
constexpr size_t WS_SF = WS_WU + 3 * SZ512;
constexpr size_t WS_SB = AL(WS_SF + (size_t)NB * 4 * 34 * 16384 * 2);
static_assert(WS_SB + (size_t)NB * 4 * 34 * 16384 * 2 <= WS_LG, "retention states fit behind YCAT inside WU|LW|LA");
constexpr size_t WS_BT1 = WS_M0;
constexpr size_t WS_BT2 = AL(WS_BT1 + (size_t)32 * 1024 * 1024 * 2);
constexpr size_t WS_BUF = AL(WS_BT2 + (size_t)32 * 1024 * 512 * 2);
constexpr size_t WS_HB = AL(WS_BUF + (size_t)MOE_NBLK * 256 * 1024 * 2);
constexpr size_t WS_YB = AL(WS_HB + (size_t)MOE_NBLK * 256 * 512 * 2);
constexpr size_t WS_PAIR = AL(WS_YB + (size_t)MOE_NBLK * 256 * 1024 * 2);
constexpr size_t WS_RSROW = AL(WS_PAIR + (size_t)4 * NPAIR_MAX * 4);
constexpr size_t WS_END_MOE = AL(WS_RSROW + (size_t)T * 4);
static_assert(WS_END_MOE <= WS_END_MIX, "moe overlay inside the mixer region");
constexpr size_t WS_NEED = WS_END_MIX;
static_assert(WS_NEED <= 1220000000ull, "workspace budget (sum of inputs = 1220.39 MB)");

constexpr int RING_BYTES = 131072;
constexpr int LDS_BYTES = 147456;
constexpr int MISC_OFF = LDS_BYTES - 4096;

struct Params {
    const float* in[33];
    float* out;
    unsigned char* ws;
    float invA[16];
    float invR[32];
    int ph_lo, ph_hi, l_lo, l_hi;
    int fused, do_pro;
    int dry, pad2;
};
enum { I_X = 0, I_C, I_CTX, I_CCTX, I_ADAW, I_ADAB, I_N1G, I_N2G, I_WIN, I_QNG, I_KNG, I_RDL, I_RGN, I_MU, I_W0, I_W2, I_A0, I_A2, I_G2, I_KK, I_KA, I_RK, I_LNG, I_LNB,
       I_WBR, I_WOUT, I_RGW, I_RGB, I_REW, I_REB, I_MG, I_MUP, I_MD };

__device__ __forceinline__ float bf2f(unsigned v) { return __builtin_bit_cast(float, v << 16); }
__device__ __forceinline__ unsigned f2bf(float f) { return (unsigned)__builtin_bit_cast(unsigned short, (__bf16)f); }
typedef __bf16 hwbf16x2 __attribute__((ext_vector_type(2)));
__device__ __forceinline__ unsigned pk2(float lo, float hi) { const f32x2 v = {lo, hi}; return __builtin_bit_cast(unsigned, __builtin_convertvector(v, hwbf16x2)); }
__device__ __forceinline__ float lo16(unsigned w) { return __builtin_bit_cast(float, w << 16); }
__device__ __forceinline__ float hi16(unsigned w) { return __builtin_bit_cast(float, w & 0xffff0000u); }
__device__ __forceinline__ void unpack8(const u32x4 v, float (&x)[8]) { x[0] = lo16(v.x); x[1] = hi16(v.x); x[2] = lo16(v.y); x[3] = hi16(v.y); x[4] = lo16(v.z); x[5] = hi16(v.z); x[6] = lo16(v.w); x[7] = hi16(v.w); }
__device__ __forceinline__ u32x4 pack8(const float (&x)[8]) { u32x4 v; v.x = pk2(x[0], x[1]); v.y = pk2(x[2], x[3]); v.z = pk2(x[4], x[5]); v.w = pk2(x[6], x[7]); return v; }
__device__ __forceinline__ float frcp(float x) { return __builtin_amdgcn_rcpf(x); }
__device__ __forceinline__ float sigmoidf_(float x) { return frcp(1.f + __expf(-x)); }
__device__ __forceinline__ float siluf_(float x) { return x * frcp(1.f + __expf(-x)); }
__device__ __forceinline__ float shfl_xor_f(float v, int m) { return __shfl_xor(v, m, 64); }
__device__ __forceinline__ float* xrow(const Params& p, int row) {
    const int b = row / NP, q = row - b * NP;
    return q < NCTX ? (float*)(p.ws + WS_CTXRES) + (size_t)(b * NCTX + q) * D : p.out + (size_t)(b * NLAT + (q - NCTX)) * D;
}
__device__ __forceinline__ bf16x8 ld_frag(const LAS unsigned char* p) { return *(const LAS bf16x8*)p; }
__device__ __forceinline__ bf16x4 tr_read(const LAS unsigned char* p) { return __builtin_amdgcn_ds_read_tr16_b64_v4i16((LAS bf16x4*)p); }
__device__ __forceinline__ bf16x8 cat44(bf16x4 a, bf16x4 b) { bf16x8 r; r[0] = a[0]; r[1] = a[1]; r[2] = a[2]; r[3] = a[3]; r[4] = b[0]; r[5] = b[1]; r[6] = b[2]; r[7] = b[3]; return r; }
__device__ __forceinline__ bf16x8 pack_frag(const f32x4 a, const f32x4 b) {
    u32x4 w; w.x = pk2(a[0], a[1]); w.y = pk2(a[2], a[3]); w.z = pk2(b[0], b[1]); w.w = pk2(b[2], b[3]); return __builtin_bit_cast(bf16x8, w);
}
#define MFMA16(a, b, c) __builtin_amdgcn_mfma_f32_16x16x32_bf16((a), (b), (c), 0, 0, 0)

#define XB_TMO      128
#define XB_XCNT(j)  (256  + 64 * (j))
#define XB_XSUB(j)  (1280 + 64 * (j))
#define XB_XGEN(j)  (2304 + 64 * (j))
#define XB_TOP      3328
#define XB_TOPGEN   3392
#define XCD_BAR_WORDS 3456
#define XB_SPIN_CAP (1u << 18)
__device__ __forceinline__ unsigned xb_ld(unsigned* p)              { return __hip_atomic_load(p, __ATOMIC_RELAXED, __HIP_MEMORY_SCOPE_AGENT); }
__device__ __forceinline__ unsigned xb_add(unsigned* p, unsigned v) { return __hip_atomic_fetch_add(p, v, __ATOMIC_RELAXED, __HIP_MEMORY_SCOPE_AGENT); }
__device__ __forceinline__ unsigned xb_xcc_id() { return (unsigned)__builtin_amdgcn_s_getreg((3 << 11) | 20) & 0xFu; }
#define XB_SPIN(cond, bar) do { unsigned _sp = 0; while (cond) { __builtin_amdgcn_s_sleep(1); \
    if ((++_sp & 255u) == 0u) { if (xb_ld(&(bar)[XB_TMO])) break; if (_sp > XB_SPIN_CAP) { atomicAdd(&(bar)[XB_TMO], 1u); break; } } } } while (0)
struct XcdBarrier { unsigned* bar; unsigned x; volatile LAS unsigned* st; };
__device__ __forceinline__ XcdBarrier xcd_barrier_post(unsigned* bar, volatile LAS unsigned* st) {
    XcdBarrier b; b.bar = bar; b.x = xb_xcc_id(); b.st = st;
    if (threadIdx.x == 0) (void)xb_add(&bar[XB_XCNT(b.x)], 1u);
    return b;
}
__device__ __forceinline__ void xcd_barrier_complete(unsigned* bar, unsigned x, unsigned& nloc, unsigned& nx) {
    const unsigned G = gridDim.x * gridDim.y * gridDim.z;
    unsigned sum, cnt, mine, sp = 0u;
    for (;;) {
        sum = 0u; cnt = 0u; mine = 0u;
#pragma unroll
        for (unsigned j = 0; j < 16; ++j) { const unsigned c = xb_ld(&bar[XB_XCNT(j)]); sum += c; cnt += (c > 0u) ? 1u : 0u; mine = (j == x) ? c : mine; }
        if (sum == G) break;
        __builtin_amdgcn_s_sleep(1);
        if ((++sp & 255u) == 0u) { if (xb_ld(&bar[XB_TMO])) break; if (sp > XB_SPIN_CAP) { atomicAdd(&bar[XB_TMO], 1u); break; } }
    }
    nloc = mine > 0u ? mine : 1u; nx = cnt > 0u ? cnt : 1u;
}
__device__ __forceinline__ void xcd_barrier(const XcdBarrier& b) {
    asm volatile("s_waitcnt vmcnt(0)" ::: "memory");
    __syncthreads();
    if (threadIdx.x == 0) {
        unsigned* bar = b.bar;
        __builtin_amdgcn_s_waitcnt(0);
        unsigned nloc = b.st[0], nx = b.st[1];
        if (nloc == 0u) { xcd_barrier_complete(bar, b.x, nloc, nx); b.st[0] = nloc; b.st[1] = nx; }
        const unsigned old = xb_add(&bar[XB_XSUB(b.x)], 1u);
        const unsigned gen = old / nloc;
        if (old + 1u == (gen + 1u) * nloc) {
            __builtin_amdgcn_fence(__ATOMIC_RELEASE, "agent");
            asm volatile("s_waitcnt vmcnt(0)" ::: "memory");
            const unsigned og = xb_add(&bar[XB_TOP], 1u);
            const unsigned tg = og / nx;
            if (og + 1u == (tg + 1u) * nx) xb_add(&bar[XB_TOPGEN], 1u);
            else XB_SPIN(xb_ld(&bar[XB_TOPGEN]) == tg, bar);
            __builtin_amdgcn_fence(__ATOMIC_ACQUIRE, "agent");
            xb_add(&bar[XB_XGEN(b.x)], 1u);
            asm volatile("s_waitcnt vmcnt(0)" ::: "memory");
        } else {
            XB_SPIN(xb_ld(&bar[XB_XGEN(b.x)]) == gen, bar);
            __builtin_amdgcn_fence(__ATOMIC_ACQUIRE, "agent");
            asm volatile("s_waitcnt vmcnt(0)" ::: "memory");
        }
    }
    __syncthreads();
}
namespace pg8 {
#define PG8_LAS __attribute__((address_space(3)))
typedef unsigned short bf16_t;
typedef short bf16x8 __attribute__((ext_vector_type(8)));
typedef float f32x4 __attribute__((ext_vector_type(4)));
typedef unsigned u32x4 __attribute__((ext_vector_type(4)));
constexpr int BM = 256, BK = 64, HALF = 128, HTB = HALF * BK * 2  , STAGE_BYTES = 8 * HTB, NXCD = 8, WGM = 8;

__host__ __device__ __forceinline__ int lds_byte(int r, int c) { const int st = (r >> 4) * 2 + (c >> 5), rr = r & 15, cc = c & 31, ob = rr * 64 + cc * 2; return st * 1024 + (ob ^ (((ob >> 9) & 1) << 5)); }
__host__ __device__ __forceinline__ void stage_rc(int b, int& R, int& C) { const int st = b / 1024, sb = b % 1024, swz = sb ^ (((sb >> 9) & 1) << 5); R = (st >> 1) * 16 + swz / 64; C = (st & 1) * 32 + (swz % 64) / 2; }
__host__ __device__ __forceinline__ int perm32(int rho) { const int n = rho >> 4, i = rho & 15; return 8 * (i >> 2) + 4 * n + (i & 3); }

struct Unit { int pm, pn; size_t bofs; };
struct Gemm { const bf16_t* A; const bf16_t* Bt; int M, N, K; };

struct StaticOrder {
    int nM, nN, nwg, G, c;
    __host__ __device__ void init(int M, int N, int G_, int c_) { nM = M / BM; nN = N / BM; nwg = nM * nN; G = G_; c = c_; }
    __host__ __device__ bool next(int i, Unit& u) const {
        const long L = (long)i * G + c; if (L >= nwg) return false;
        int wgid = (int)L; { const int q = nwg / NXCD, r = nwg % NXCD, xcd = wgid % NXCD, off = wgid / NXCD; wgid = (xcd < r ? xcd * (q + 1) : r * (q + 1) + (xcd - r) * q) + off; }
        const int nig = WGM * nN, gid = wgid / nig, fm = gid * WGM, gsz = (nM - fm) < WGM ? (nM - fm) : WGM;
        u.pm = fm + ((wgid % nig) % gsz); u.pn = (wgid % nig) / gsz; u.bofs = 0; return true;
    }
    __device__ __forceinline__ void a_ready(const Unit&) const {}
    __device__ __forceinline__ void done(const Unit&) const {}
};

__device__ __forceinline__ unsigned cvt_pk_bf16(float lo, float hi) { unsigned r; asm volatile("v_cvt_pk_bf16_f32 %0, %1, %2" : "=v"(r) : "v"(lo), "v"(hi)); return r; }
template <class Epi, class Sched, bool ALIGN_EPI = false, bool SP2 = false>
__device__ __forceinline__ void gemm_phase(PG8_LAS unsigned char* lds, const Gemm g, const Sched& S, const Epi& E) {
    int tid_ = threadIdx.x; asm volatile("" : "+v"(tid_)); const int tid = tid_, wid = __builtin_amdgcn_readfirstlane(tid >> 6), lane = tid & 63, wr = wid >> 2, wc = wid & 3, fr = lane & 15, fq = lane >> 4;
    int K = g.K; asm volatile("" : "+s"(K)); const int nt = K / BK;
    unsigned voffA[2], voffB[2];
#pragma unroll
    for (int i = 0; i < 2; ++i) { int R, C; stage_rc(tid * 16 + i * 8192, R, C); const int Rb = Epi::PERM ? ((R & ~31) + perm32(R & 31)) : R;
        voffA[i] = (unsigned)(R * K + C) * 2u; voffB[i] = (unsigned)(Rb * K + C) * 2u; }
    const size_t kstep = (size_t)(BK * 2);
    const size_t hstep = (size_t)HALF * K * 2;
    const size_t tstep = 2 * hstep;
    const unsigned ldsw = (unsigned)wid * 1024u;
    const int aoff = lds_byte(wr * 64 + fr, fq * 8), boff = lds_byte(wc * 32 + fr, fq * 8);
#define PG8_SA(b, h) (((b) * 2 + (h)) * HTB)
#define PG8_SB(b, h) ((4 + (b) * 2 + (h)) * HTB)
#define PG8_STAGE(bufoff, gbase, voff) do { _Pragma("unroll") for (int _i = 0; _i < 2; ++_i) \
        __builtin_amdgcn_global_load_lds((const unsigned*)((const char*)(gbase) + (voff)[_i]), (PG8_LAS unsigned*)(lds + (bufoff) + ldsw + _i * 8192), 16, 0, 0); } while (0)
#define PG8_LDA(dst, b, h) do { _Pragma("unroll") for (int m = 0; m < 4; ++m) _Pragma("unroll") for (int k = 0; k < 2; ++k) dst[m][k] = *(const PG8_LAS bf16x8*)(lds + PG8_SA(b, h) + aoff + m * 2048 + k * 1024); } while (0)
#define PG8_LDB(dst, b, h) do { _Pragma("unroll") for (int n = 0; n < 2; ++n) _Pragma("unroll") for (int k = 0; k < 2; ++k) dst[n][k] = *(const PG8_LAS bf16x8*)(lds + PG8_SB(b, h) + boff + n * 2048 + k * 1024); } while (0)
#define PG8_MMA(ai, bj, At, Bt) do { __builtin_amdgcn_s_setprio(1); _Pragma("unroll") for (int m = 0; m < 4; ++m) _Pragma("unroll") for (int n = 0; n < 2; ++n) _Pragma("unroll") for (int k = 0; k < 2; ++k) \
        acc[ai][bj][m][n] = __builtin_amdgcn_mfma_f32_16x16x32_bf16(Bt[n][k], At[m][k], acc[ai][bj][m][n], 0, 0, 0); __builtin_amdgcn_s_setprio(0); } while (0)
#define PG8_WAIT_V(n) asm volatile("s_waitcnt vmcnt(" #n ")" ::: "memory")
#define PG8_WAIT_L(n) asm volatile("s_waitcnt lgkmcnt(" #n ")" ::: "memory")
#define PG8_BAR __builtin_amdgcn_s_barrier()
#define PG8_SCHED __builtin_amdgcn_sched_barrier(0)
    Unit cur, nxt; int ui = 0;
    if (!S.next(0, cur)) return;
    f32x4 acc[2][2][4][2];
#pragma unroll
    for (int a = 0; a < 2; ++a)
#pragma unroll
        for (int b = 0; b < 2; ++b)
#pragma unroll
            for (int m = 0; m < 4; ++m)
#pragma unroll
                for (int n = 0; n < 2; ++n) acc[a][b][m][n] = (f32x4){0.f, 0.f, 0.f, 0.f};
    bf16x8 At[4][2], B0[2][2], B1[2][2];
    const char* cA = (const char*)g.A + (size_t)cur.pm * tstep; const char* cB = (const char*)g.Bt + cur.bofs + (size_t)cur.pn * tstep;
    S.a_ready(cur);
    if constexpr (SP2) {
        PG8_STAGE(PG8_SB(0, 0), cB, voffB); PG8_STAGE(PG8_SB(0, 1), cB + hstep, voffB); PG8_STAGE(PG8_SA(0, 0), cA, voffA); PG8_STAGE(PG8_SA(0, 1), cA + hstep, voffA);
        if (wr == 1) PG8_BAR;
        PG8_WAIT_V(2); PG8_BAR;
        PG8_STAGE(PG8_SB(1, 0), cB + kstep, voffB); PG8_STAGE(PG8_SA(1, 0), cA + kstep, voffA); PG8_STAGE(PG8_SB(1, 1), cB + hstep + kstep, voffB);
        PG8_WAIT_V(6); PG8_BAR;
    } else {
        PG8_STAGE(PG8_SB(0, 0), cB, voffB); PG8_STAGE(PG8_SA(0, 0), cA, voffA); PG8_STAGE(PG8_SB(0, 1), cB + hstep, voffB); PG8_STAGE(PG8_SA(0, 1), cA + hstep, voffA);
        if (wr == 1) PG8_BAR;
        PG8_WAIT_V(4); PG8_BAR;
        PG8_STAGE(PG8_SB(1, 0), cB + kstep, voffB); PG8_STAGE(PG8_SA(1, 0), cA + kstep, voffA); PG8_STAGE(PG8_SB(1, 1), cB + hstep + kstep, voffB);
        PG8_WAIT_V(6); PG8_BAR;
    }
    for (;;) {
        const bool has_next = S.next(ui + 1, nxt);
        const char* nA = has_next ? (const char*)g.A + (size_t)nxt.pm * tstep : cA; const char* nB = has_next ? (const char*)g.Bt + nxt.bofs + (size_t)nxt.pn * tstep : cB;
        for (int t = 0; t < nt; t += 2) {
            const bool last = (t == nt - 2);
            if constexpr (Epi::KHOOK) { if (t == 8 || t == 16) E.khook(acc, cur, wr, wc, fr, fq, t >> 3); }
            const char* a1 = cA + (size_t)(t + 1) * kstep;
            const char* a2 = last ? nA : cA + (size_t)(t + 2) * kstep; const char* b2 = last ? nB : cB + (size_t)(t + 2) * kstep;
            const char* a3 = a2 + kstep; const char* b3 = b2 + kstep;
            if (last && has_next) S.a_ready(nxt);
            if constexpr (SP2) {
            PG8_LDB(B0, 0, 0); PG8_LDB(B1, 0, 1); PG8_SCHED; PG8_LDA(At, 0, 0); PG8_STAGE(PG8_SA(1, 1), a1 + hstep, voffA);
            PG8_WAIT_V(8); PG8_WAIT_L(0); PG8_BAR; PG8_MMA(0, 0, At, B0); PG8_MMA(0, 1, At, B1); PG8_BAR; PG8_SCHED;
            PG8_LDA(At, 0, 1); PG8_STAGE(PG8_SB(0, 0), b2, voffB); PG8_STAGE(PG8_SB(0, 1), b2 + hstep, voffB); PG8_STAGE(PG8_SA(0, 0), a2, voffA);
            PG8_WAIT_V(8); PG8_WAIT_L(0); PG8_BAR; PG8_MMA(1, 0, At, B0); PG8_MMA(1, 1, At, B1); PG8_BAR; PG8_SCHED;
            PG8_LDB(B0, 1, 0); PG8_LDB(B1, 1, 1); PG8_SCHED; PG8_LDA(At, 1, 0); PG8_STAGE(PG8_SA(0, 1), a2 + hstep, voffA);
            PG8_WAIT_V(8); PG8_WAIT_L(0); PG8_BAR; PG8_MMA(0, 0, At, B0); PG8_MMA(0, 1, At, B1); PG8_BAR; PG8_SCHED;
            PG8_LDA(At, 1, 1); PG8_STAGE(PG8_SB(1, 0), b3, voffB); PG8_STAGE(PG8_SB(1, 1), b3 + hstep, voffB); PG8_STAGE(PG8_SA(1, 0), a3, voffA);
            PG8_WAIT_V(8); PG8_WAIT_L(0); PG8_BAR; PG8_MMA(1, 0, At, B0); PG8_MMA(1, 1, At, B1); PG8_BAR; PG8_SCHED;
            } else {
            PG8_LDB(B0, 0, 0); PG8_SCHED; PG8_LDA(At, 0, 0); PG8_STAGE(PG8_SA(1, 1), a1 + hstep, voffA);
            PG8_WAIT_L(8); PG8_BAR; PG8_WAIT_L(0); PG8_MMA(0, 0, At, B0); PG8_BAR; PG8_SCHED;
            PG8_LDB(B1, 0, 1); PG8_STAGE(PG8_SB(0, 0), b2, voffB);
            PG8_BAR; PG8_WAIT_L(0); PG8_MMA(0, 1, At, B1); PG8_BAR;
            PG8_LDA(At, 0, 1); PG8_STAGE(PG8_SA(0, 0), a2, voffA);
            PG8_BAR; PG8_WAIT_L(0); PG8_MMA(1, 0, At, B0); PG8_BAR; PG8_SCHED;
            PG8_STAGE(PG8_SB(0, 1), b2 + hstep, voffB);
            PG8_WAIT_V(6); PG8_BAR; PG8_MMA(1, 1, At, B1); PG8_BAR;
            PG8_LDB(B0, 1, 0); PG8_SCHED; PG8_LDA(At, 1, 0); PG8_STAGE(PG8_SA(0, 1), a2 + hstep, voffA);
            PG8_WAIT_L(8); PG8_BAR; PG8_WAIT_L(0); PG8_MMA(0, 0, At, B0); PG8_BAR; PG8_SCHED;
            PG8_LDB(B1, 1, 1); PG8_STAGE(PG8_SB(1, 0), b3, voffB);
            PG8_BAR; PG8_WAIT_L(0); PG8_MMA(0, 1, At, B1); PG8_BAR;
            PG8_LDA(At, 1, 1); PG8_STAGE(PG8_SA(1, 0), a3, voffA);
            PG8_BAR; PG8_WAIT_L(0); PG8_MMA(1, 0, At, B0); PG8_BAR; PG8_SCHED;
            PG8_STAGE(PG8_SB(1, 1), b3 + hstep, voffB);
            PG8_WAIT_V(6); PG8_BAR; PG8_MMA(1, 1, At, B1); PG8_BAR;
            }
        }
        if constexpr (ALIGN_EPI) { if (wr == 0) PG8_BAR; }
        if constexpr (!Epi::AFTER_DRAIN) { E(acc, cur, wr, wc, fr, fq); S.done(cur); }
        if (!has_next) break;
#pragma unroll
        for (int a = 0; a < 2; ++a)
#pragma unroll
            for (int b = 0; b < 2; ++b)
#pragma unroll
                for (int m = 0; m < 4; ++m)
#pragma unroll
                    for (int n = 0; n < 2; ++n) acc[a][b][m][n] = (f32x4){0.f, 0.f, 0.f, 0.f};
        cur = nxt; cA = nA; cB = nB; ++ui;
        if constexpr (ALIGN_EPI) { if (wr == 1) PG8_BAR; }
    }
    PG8_WAIT_V(0);
    if constexpr (!ALIGN_EPI) { if (wr == 0) PG8_BAR; }
    PG8_BAR;
    if constexpr (Epi::AFTER_DRAIN) { E.fused(acc, cur, wr, wc, fr, fq, lds, wid, lane); S.done(cur); }
#undef PG8_SA
#undef PG8_SB
#undef PG8_STAGE
#undef PG8_LDA
#undef PG8_LDB
#undef PG8_MMA
#undef PG8_WAIT_V
#undef PG8_WAIT_L
#undef PG8_BAR
#undef PG8_SCHED
}
template <bool EXPNEG = false> __device__ __forceinline__ void store_bf16_tile(bf16_t* O, int pitch, int colt, const f32x4 (&acc)[2][2][4][2], const Unit& u, int wr, int wc, int fr, int fq) {
    const int row0 = u.pm * BM + wr * 64 + fr; const int col0 = colt + wc * 32 + 8 * fq;
#pragma unroll
    for (int ai = 0; ai < 2; ++ai)
#pragma unroll
        for (int m = 0; m < 4; ++m) { bf16_t* rowp = O + (size_t)(row0 + ai * HALF + m * 16) * pitch + col0;
#pragma unroll
            for (int bj = 0; bj < 2; ++bj) { f32x4 v0 = acc[ai][bj][m][0], v1 = acc[ai][bj][m][1];
                if (EXPNEG) {
#pragma unroll
                    for (int e = 0; e < 4; ++e) { v0[e] = __expf(-v0[e]); v1[e] = __expf(-v1[e]); } }
                u32x4 w; w.x = cvt_pk_bf16(v0[0], v0[1]); w.y = cvt_pk_bf16(v0[2], v0[3]); w.z = cvt_pk_bf16(v1[0], v1[1]); w.w = cvt_pk_bf16(v1[2], v1[3]);
                *(GAS u32x4*)(rowp + bj * HALF) = w; } }
}
struct EpiInproj {
    static constexpr bool PERM = true, AFTER_DRAIN = false, KHOOK = false;
    unsigned char* ws;
    __device__ __forceinline__ void operator()(const f32x4 (&acc)[2][2][4][2], const Unit& u, int wr, int wc, int fr, int fq) const {
        const int pn = u.pn; size_t base; int pitch, colt;
        if (pn < 2)       { base = WS_AQ;  pitch = 512;  colt = pn * 256; }
        else if (pn == 2) { base = WS_AKV; pitch = 256;  colt = 0; }
        else if (pn < 5)  { base = WS_RQ;  pitch = 512;  colt = (pn - 3) * 256; }
        else if (pn < 7)  { base = WS_RK;  pitch = 512;  colt = (pn - 5) * 256; }
        else if (pn < 9)  { base = WS_RV;  pitch = 512;  colt = (pn - 7) * 256; }
        else if (pn < 11) { base = WS_RG;  pitch = 512;  colt = (pn - 9) * 256; }
        else if (pn < 18) { base = WS_WU;  pitch = 1792; colt = (pn - 11) * 256; }
        else              { store_bf16_tile<true>((bf16_t*)(ws + WS_GL), 3072, (pn - 18) * 256, acc, u, wr, wc, fr, fq); return; }
        store_bf16_tile((bf16_t*)(ws + base), pitch, colt, acc, u, wr, wc, fr, fq);
    }
};
struct EpiLora {
    static constexpr bool PERM = true, AFTER_DRAIN = false, KHOOK = false;
    unsigned char* ws;
    __device__ __forceinline__ void operator()(const f32x4 (&acc)[2][2][4][2], const Unit& u, int wr, int wc, int fr, int fq) const {
        const int pn = u.pn; size_t base; int pitch, colt;
        if (pn < 4)      { base = WS_LW; pitch = 1024; colt = pn * 256; }
        else if (pn < 8) { base = WS_LA; pitch = 1024; colt = (pn - 4) * 256; }
        else             { base = WS_LG; pitch = 512;  colt = (pn - 8) * 256; }
        store_bf16_tile((bf16_t*)(ws + base), pitch, colt, acc, u, wr, wc, fr, fq);
    }
};
struct EpiPlainBf16 {
    static constexpr bool PERM = true, AFTER_DRAIN = false, KHOOK = false;
    bf16_t* O; int pitch;
    __device__ __forceinline__ void operator()(const f32x4 (&acc)[2][2][4][2], const Unit& u, int wr, int wc, int fr, int fq) const {
        store_bf16_tile(O, pitch, u.pn * BM, acc, u, wr, wc, fr, fq);
    }
};
template <int MODE> struct EpiMerge {
    static constexpr bool PERM = false, AFTER_DRAIN = false, KHOOK = false;
    const bf16_t* GL; float* MRG; bf16_t* OB; int nb;
    __device__ __forceinline__ void operator()(const f32x4 (&acc)[2][2][4][2], const Unit& u, int wr, int wc, int fr, int fq) const {
        const int row0 = u.pm * BM + wr * 64 + fr, col0 = u.pn * BM + wc * 32 + 4 * fq;
#pragma unroll
        for (int ai = 0; ai < 2; ++ai)
#pragma unroll
            for (int m = 0; m < 4; ++m) { const size_t row = (size_t)(row0 + ai * HALF + m * 16); asm volatile("" ::: "memory");
#pragma unroll
                for (int bj = 0; bj < 2; ++bj)
#pragma unroll
                    for (int n = 0; n < 2; ++n) { const int col = col0 + bj * HALF + n * 16;
                        const u32x2 gw = *(const GAS u32x2*)(GL + row * 3072 + nb * 1024 + col);
                        f32x4 g; g[0] = __builtin_amdgcn_rcpf(1.f + __expf(-lo16(gw.x))); g[1] = __builtin_amdgcn_rcpf(1.f + __expf(-hi16(gw.x))); g[2] = __builtin_amdgcn_rcpf(1.f + __expf(-lo16(gw.y))); g[3] = __builtin_amdgcn_rcpf(1.f + __expf(-hi16(gw.y)));
                        f32x4 v = acc[ai][bj][m][n] * g;
                        float* mp = MRG + row * 1024 + col;
                        if (MODE != 0) v = v + *(const GAS f32x4*)mp;
                        if (MODE != 2) *(GAS f32x4*)mp = v;
                        else { u32x2 w; w.x = cvt_pk_bf16(v[0], v[1]); w.y = cvt_pk_bf16(v[2], v[3]); *(GAS u32x2*)(OB + row * 1024 + col) = w; } } }
    }
};
struct EpiMergeK {
    static constexpr bool PERM = false, AFTER_DRAIN = false, KHOOK = true;
    const bf16_t* GL; bf16_t* OB;
    __device__ __forceinline__ void khook(f32x4 (&acc)[2][2][4][2], const Unit& u, int wr, int wc, int fr, int fq, int seg  ) const {
        const int row0 = u.pm * BM + wr * 64 + fr, col0 = u.pn * BM + wc * 32 + 4 * fq;
#pragma unroll
        for (int ai = 0; ai < 2; ++ai) {
            u32x2 ga[4][2][2], gb[4][2][2];
            asm volatile("" ::: "memory");
#pragma unroll
            for (int m = 0; m < 4; ++m) { const bf16_t* gr = GL + (size_t)(row0 + ai * HALF + m * 16) * 3072 + (seg - 1) * 1024 + col0;
#pragma unroll
                for (int bj = 0; bj < 2; ++bj)
#pragma unroll
                    for (int n = 0; n < 2; ++n) { ga[m][bj][n] = *(const GAS u32x2*)(gr + bj * HALF + n * 16); gb[m][bj][n] = *(const GAS u32x2*)(gr + 1024 + bj * HALF + n * 16); } }
#pragma unroll
            for (int m = 0; m < 4; ++m)
#pragma unroll
                for (int bj = 0; bj < 2; ++bj)
#pragma unroll
                    for (int n = 0; n < 2; ++n) { const u32x2 a = ga[m][bj][n], b = gb[m][bj][n];
                        f32x4 r;
                        r[0] = (1.f + lo16(b.x)) * __builtin_amdgcn_rcpf(1.f + lo16(a.x)); r[1] = (1.f + hi16(b.x)) * __builtin_amdgcn_rcpf(1.f + hi16(a.x));
                        r[2] = (1.f + lo16(b.y)) * __builtin_amdgcn_rcpf(1.f + lo16(a.y)); r[3] = (1.f + hi16(b.y)) * __builtin_amdgcn_rcpf(1.f + hi16(a.y));
                        acc[ai][bj][m][n] = acc[ai][bj][m][n] * r; } }
    }
    __device__ __forceinline__ void operator()(const f32x4 (&acc)[2][2][4][2], const Unit& u, int wr, int wc, int fr, int fq) const {
        const int row0 = u.pm * BM + wr * 64 + fr, col0 = u.pn * BM + wc * 32 + 4 * fq;
#pragma unroll
        for (int ai = 0; ai < 2; ++ai) { asm volatile("" ::: "memory");
#pragma unroll
            for (int m = 0; m < 4; ++m) { const size_t row = (size_t)(row0 + ai * HALF + m * 16);
#pragma unroll
                for (int bj = 0; bj < 2; ++bj)
#pragma unroll
                    for (int n = 0; n < 2; ++n) { const int col = col0 + bj * HALF + n * 16;
                        const u32x2 gw = *(const GAS u32x2*)(GL + row * 3072 + 2048 + col);
                        f32x4 g; g[0] = __builtin_amdgcn_rcpf(1.f + lo16(gw.x)); g[1] = __builtin_amdgcn_rcpf(1.f + hi16(gw.x)); g[2] = __builtin_amdgcn_rcpf(1.f + lo16(gw.y)); g[3] = __builtin_amdgcn_rcpf(1.f + hi16(gw.y));
                        const f32x4 v = acc[ai][bj][m][n] * g;
                        u32x2 w; w.x = cvt_pk_bf16(v[0], v[1]); w.y = cvt_pk_bf16(v[2], v[3]); *(GAS u32x2*)(OB + row * 1024 + col) = w; } } }
    }
};
struct EpiOut {
    static constexpr bool PERM = false, AFTER_DRAIN = false, KHOOK = false;
    float* out; float* ctxres; const float* modl; int dry; const float* xin; const float* cin;
    __device__ __forceinline__ void operator()(const f32x4 (&acc)[2][2][4][2], const Unit& u, int wr, int wc, int fr, int fq) const {
        const int row0 = u.pm * BM + wr * 64 + fr, col0 = u.pn * BM + wc * 32 + 4 * fq;
        const int b = (u.pm * BM) / NP, q0 = u.pm * BM - b * NP;
        const bool isctx = q0 < NCTX;
        const float* g1 = modl + (size_t)(isctx ? 8 : b) * 6144 + 2048;
        float* xb = isctx ? ctxres + (size_t)(b * NCTX) * D : out + ((size_t)b * NLAT + (q0 - NCTX)) * D;
        const float* xs = isctx ? cin + (size_t)(b * NCTX) * D : xin + ((size_t)b * NLAT + (q0 - NCTX)) * D;
        f32x4 gv[2][2];
#pragma unroll
        for (int bj = 0; bj < 2; ++bj)
#pragma unroll
            for (int n = 0; n < 2; ++n) gv[bj][n] = *(const GAS f32x4*)(g1 + col0 + bj * HALF + n * 16);
#pragma unroll
        for (int ai = 0; ai < 2; ++ai) { asm volatile("" ::: "memory");
#pragma unroll
            for (int m = 0; m < 4; ++m) { const size_t ro = (size_t)(wr * 64 + fr + ai * HALF + m * 16) * D + col0; float* rowp = xb + ro; const float* srcp = xs + ro;
#pragma unroll
                for (int bj = 0; bj < 2; ++bj)
#pragma unroll
                    for (int n = 0; n < 2; ++n) { float* xp = rowp + bj * HALF + n * 16; const f32x4 nv = *(const GAS f32x4*)(srcp + bj * HALF + n * 16) + gv[bj][n] * acc[ai][bj][m][n]; if (!dry) *(GAS f32x4*)xp = nv; } } }
    }
};
struct EpiSwiGLU {
    static constexpr bool PERM = false, AFTER_DRAIN = false, KHOOK = false;
    bf16_t* HB;
    __device__ __forceinline__ void operator()(const f32x4 (&acc)[2][2][4][2], const Unit& u, int wr, int wc, int fr, int fq) const {
        const int row0 = u.pm * BM + wr * 64 + fr, hh0 = u.pn * 128 + wc * 16 + 4 * fq;
#pragma unroll
        for (int ai = 0; ai < 2; ++ai)
#pragma unroll
            for (int m = 0; m < 4; ++m) { bf16_t* rowp = HB + (size_t)(row0 + ai * HALF + m * 16) * 512 + hh0;
#pragma unroll
                for (int bj = 0; bj < 2; ++bj) { const f32x4 g = acc[ai][bj][m][0], up = acc[ai][bj][m][1]; f32x4 h;
#pragma unroll
                    for (int i = 0; i < 4; ++i) h[i] = g[i] * __builtin_amdgcn_rcpf(1.f + __expf(-g[i])) * up[i];
                    u32x2 w; w.x = cvt_pk_bf16(h[0], h[1]); w.y = cvt_pk_bf16(h[2], h[3]); *(GAS u32x2*)(rowp + bj * 64) = w; } }
    }
};
struct LatentOrder {
    StaticOrder S;
    __host__ __device__ void init(int N, int G_, int c_) { S.init(128 * BM, N, G_, c_); }
    __host__ __device__ bool next(int i, Unit& u) const { if (!S.next(i, u)) return false; u.pm = (u.pm >> 4) * 17 + 1 + (u.pm & 15); return true; }
    __device__ __forceinline__ void a_ready(const Unit&) const {}
    __device__ __forceinline__ void done(const Unit&) const {}
};
template <size_t ESTRIDE> struct MoeOrder {
    int G, c; const PG8_LAS int* tab;
    __device__ __forceinline__ bool next(int i, Unit& u) const {
        const long L = (long)i * G + c; if (L >= (long)tab[32 + MOE_NBLK] * 4) return false;
        u.pm = (int)(L >> 2); u.pn = (int)(L & 3); u.bofs = (size_t)tab[32 + u.pm] * ESTRIDE; return true; }
    __device__ __forceinline__ void a_ready(const Unit&) const {}
    __device__ __forceinline__ void done(const Unit&) const {}
};
}
#define PG8_SP2 true
#define PG8_ALIGN true
struct Frame {
    LAS unsigned char* lds; int tid, lane, wave, G, bid, gwave, nwave;
};
__device__ __forceinline__ bf16_t* WSB(const Params& p, size_t off) { return (bf16_t*)(p.ws + off); }
__device__ __forceinline__ float* WSF(const Params& p, size_t off) { return (float*)(p.ws + off); }

__device__ __forceinline__ void sincos_dd(double ang, float& c, float& s) {
    const double kf = __builtin_rint(ang * 0.63661977236758134308);
    const double r = (ang - kf * 1.57079632679489655800) - kf * 6.12323399573676603587e-17;
    const int k = ((int)kf) & 3;
    const double r2 = r * r;
    const double sp = r * (1.0 + r2 * (-1.0 / 6 + r2 * (1.0 / 120 + r2 * (-1.0 / 5040 + r2 * (1.0 / 362880 + r2 * (-1.0 / 39916800 + r2 * (1.0 / 6227020800.0)))))));
    const double cp = 1.0 + r2 * (-0.5 + r2 * (1.0 / 24 + r2 * (-1.0 / 720 + r2 * (1.0 / 40320 + r2 * (-1.0 / 3628800 + r2 * (1.0 / 479001600 + r2 * (-1.0 / 87178291200.0)))))));
    const double cc = (k == 0) ? cp : (k == 1) ? -sp : (k == 2) ? -cp : sp;
    const double ss = (k == 0) ? sp : (k == 1) ? cp : (k == 2) ? -sp : -cp;
    c = (float)cc; s = (float)ss;
}
__device__ __forceinline__ void p0_prologue(const Params& p, const Frame& F) {
    const int gt = F.bid * NTHREADS + F.tid, ngt = F.G * NTHREADS;
    { float* tab = WSF(p, WS_ROPE); const LAS Params* lpar = (const LAS Params*)(F.lds + (LDS_BYTES - 4096 + 2048));
      for (int i = gt; i < 64 * 16 + 64 * 32; i += ngt) {
          if (i < 1024) { const int pos = i >> 4, k = i & 15; float c, s; sincos_dd((double)pos * (double)lpar->invA[k], c, s); tab[i] = c; tab[1024 + i] = s; }
          else { const int j = i - 1024, pos = j >> 5, k = j & 31; float c, s; sincos_dd((double)pos * (double)lpar->invR[k], c, s); tab[2048 + j] = c; tab[2048 + 2048 + j] = s; } } }
    { float* rwt = WSF(p, WS_RWT);
      for (int i = gt; i < DEPTH * 36 * 1024; i += ngt) { const int l = i / (36 * 1024), r = i - l * 36 * 1024, o = r >> 10, k = r & 1023;
          rwt[i] = o < 4 ? ((const GAS float*)p.in[I_RGW])[((size_t)l * 1024 + k) * 4 + o] : ((const GAS float*)p.in[I_REW])[((size_t)l * 1024 + k) * 32 + (o - 4)]; } }
    { float* rw2 = WSF(p, WS_RW2);
      for (int i = gt; i < DEPTH * 64 * 3 * 4 * 16 * 4; i += ngt) { const int j = i & 3, n = (i >> 2) & 15, g = (i >> 6) & 3, r = i >> 8, nt = r % 3, r2 = r / 3, kq = r2 & 63, l = r2 >> 6;
          const int ng = 16 * nt + n, k = 4 * (4 * kq + j) + g;
          rw2[i] = ng < 4 ? ((const GAS float*)p.in[I_RGW])[((size_t)l * 1024 + k) * 4 + ng] : (ng < 36 ? ((const GAS float*)p.in[I_REW])[((size_t)l * 1024 + k) * 32 + (ng - 4)] : 0.f); } }
    { LAS float* cond = (LAS float*)F.lds;
      LAS float* red = (LAS float*)(F.lds + 9 * 1024 * 4);
      for (int i = F.tid; i < 9 * 1024; i += NTHREADS) { const float v = i < 8192 ? ((const GAS float*)p.in[I_C])[i] : ((const GAS float*)p.in[I_CCTX])[i - 8192]; cond[i] = siluf_(v); }
      __syncthreads();
      float* mod = WSF(p, WS_MOD);
      for (int task = F.bid; task < DEPTH * 96; task += F.G) {
          const int l = task / 96, col0 = (task - l * 96) * 64, c = F.tid & 63, ks = F.tid >> 6;
          const GAS float* w = (const GAS float*)p.in[I_ADAW] + ((size_t)l * 1024 + ks * 128) * 6144 + col0 + c;
          float a[9];
#pragma unroll
          for (int r = 0; r < 9; ++r) a[r] = 0.f;
          for (int k0 = 0; k0 < 128; k0 += 16) { float wv[16];
#pragma unroll
              for (int j = 0; j < 16; ++j) wv[j] = w[(size_t)(k0 + j) * 6144];
#pragma unroll
              for (int j = 0; j < 16; ++j)
#pragma unroll
                  for (int r = 0; r < 9; ++r) a[r] += cond[r * 1024 + ks * 128 + k0 + j] * wv[j]; }
#pragma unroll
          for (int r = 0; r < 9; ++r) red[(ks * 9 + r) * 64 + c] = a[r];
          __syncthreads();
          for (int o = F.tid; o < 9 * 64; o += NTHREADS) { const int r = o >> 6, cc = o & 63; float s = 0.f;
#pragma unroll
              for (int k2 = 0; k2 < 8; ++k2) s += red[(k2 * 9 + r) * 64 + cc];
              mod[((size_t)l * 9 + r) * 6144 + col0 + cc] = s + ((const GAS float*)p.in[I_ADAB])[(size_t)l * 6144 + col0 + cc]; }
          __syncthreads();
      } }
}

__device__ __forceinline__ void cvt_tile(const float* src, int ld_src, bf16_t* dst, int ld_dst, int k0, int n0, LAS float* tile  , int tid) {
#pragma unroll
    for (int ps = 0; ps < 2; ++ps) { const int k = ps * 32 + (tid >> 4), n4 = (tid & 15) * 4;
        const f32x4 v = *(const GAS f32x4*)(src + (size_t)(k0 + k) * ld_src + n0 + n4);
        tile[k * 65 + n4] = v[0]; tile[k * 65 + n4 + 1] = v[1]; tile[k * 65 + n4 + 2] = v[2]; tile[k * 65 + n4 + 3] = v[3]; }
    __syncthreads();
    { const int n = tid >> 3, k8 = (tid & 7) * 8; float x[8];
#pragma unroll
      for (int e = 0; e < 8; ++e) x[e] = tile[(k8 + e) * 65 + n];
      *(GAS u32x4*)(dst + (size_t)(n0 + n) * ld_dst + k0 + k8) = pack8(x); }
    __syncthreads();
}

struct CvtTask { const float* src; bf16_t* dst; int ld_src, ld_dst, k0, n0, which; };
__device__ __forceinline__ void cvt_load(f32x4 (&v)[8], const CvtTask& c, int tid) {
#pragma unroll
    for (int ps = 0; ps < 8; ++ps) v[ps] = *(const GAS f32x4*)(c.src + (size_t)(c.k0 + ps * 8 + (tid >> 6)) * c.ld_src + c.n0 + (tid & 63) * 4);
}
__device__ __forceinline__ void cvt_store(const f32x4 (&v)[8], const CvtTask& c, LAS float* tile  , int tid) {
#pragma unroll
    for (int ps = 0; ps < 8; ++ps) *(LAS f32x4*)(tile + (ps * 8 + (tid >> 6)) * 260 + (tid & 63) * 4) = v[ps];
    asm volatile("s_waitcnt lgkmcnt(0)" ::: "memory"); __builtin_amdgcn_s_barrier(); asm volatile("" ::: "memory");
    { const int n = tid >> 1, kb = (tid & 1) * 32, nn = c.n0 + n; const int row = c.which < 0 ? nn : ((nn >> 4) << 5) + (c.which << 4) + (nn & 15);
      bf16_t* d = c.dst + (size_t)row * c.ld_dst + c.k0 + kb;
#pragma unroll
      for (int q = 0; q < 4; ++q) { float x[8];
#pragma unroll
          for (int e = 0; e < 8; ++e) x[e] = tile[(kb + q * 8 + e) * 260 + n];
          *(GAS u32x4*)(d + q * 8) = pack8(x); } }
    asm volatile("s_waitcnt lgkmcnt(0)" ::: "memory"); __builtin_amdgcn_s_barrier(); asm volatile("" ::: "memory");
}
constexpr int NT_MIX = 16 * 30 + 3 * 8 * 4 + 16 * 4;
__device__ __forceinline__ CvtTask cvt_task_mix(const Params& p, int l, int t) {
    CvtTask c; c.which = -1;
    if (t < 480) { const int kt = t / 30, nt = t - kt * 30; c.src = p.in[I_WIN] + (size_t)l * 1024 * 7680; c.ld_src = 7680; c.dst = WSB(p, WS_BTIN); c.ld_dst = 1024; c.k0 = kt * 64; c.n0 = nt * 256; }
    else if (t < 576) { const int u = t - 480, nb = u >> 5, r = u & 31, kt = r >> 2, nt = r & 3;
        c.src = p.in[I_WBR] + ((size_t)l * 3 + nb) * 512 * 1024; c.ld_src = 1024; c.dst = WSB(p, WS_BTBR) + nb * 512; c.ld_dst = 1536; c.k0 = kt * 64; c.n0 = nt * 256; }
    else { const int u = t - 576, kt = u >> 2, nt = u & 3; c.src = p.in[I_WOUT] + (size_t)l * 1024 * 1024; c.ld_src = 1024; c.dst = WSB(p, WS_BTOUT); c.ld_dst = 1024; c.k0 = kt * 64; c.n0 = nt * 256; }
    return c;
}
constexpr int NT_MOE = 32 * 2 * 16 * 2 + 32 * 8 * 4;
__device__ __forceinline__ CvtTask cvt_task_moe(const Params& p, int l, int t) {
    CvtTask c;
    if (t < 2048) { const int e = t >> 6, r = t & 63, which = r >> 5, kt = (r >> 1) & 15, nt = r & 1;
        c.src = (which ? p.in[I_MUP] : p.in[I_MG]) + ((size_t)l * 32 + e) * 1024 * 512; c.ld_src = 512; c.dst = WSB(p, WS_BT1) + (size_t)e * 1024 * 1024; c.ld_dst = 1024; c.k0 = kt * 64; c.n0 = nt * 256; c.which = which; }
    else { const int u = t - 2048, e = u >> 5, r = u & 31, kt = r >> 2, nt = r & 3;
        c.src = p.in[I_MD] + ((size_t)l * 32 + e) * 512 * 1024; c.ld_src = 1024; c.dst = WSB(p, WS_BT2) + (size_t)e * 1024 * 512; c.ld_dst = 512; c.k0 = kt * 64; c.n0 = nt * 256; c.which = -1; }
    return c;
}
template <bool MOE> __device__ __forceinline__ void cvt_run(const Params& p, const Frame& F, int l, LAS float* tile, int first_blk = 0, int t_lo = 0, int t_hi = -1) {
    const int NTASK = t_hi >= 0 ? t_hi : (MOE ? NT_MOE : NT_MIX);
    if (F.bid < first_blk) return;
    const int stride = F.G - first_blk;
    int t = t_lo + F.bid - first_blk; if (t >= NTASK) return;
    CvtTask cur = MOE ? cvt_task_moe(p, l, t) : cvt_task_mix(p, l, t);
    f32x4 v[8], vn[8]; cvt_load(v, cur, F.tid);
    for (;;) {
        const int tn = t + stride; const bool more = tn < NTASK;
        CvtTask nx = cur;
        if (more) { nx = MOE ? cvt_task_moe(p, l, tn) : cvt_task_mix(p, l, tn); cvt_load(vn, nx, F.tid); }
        cvt_store(v, cur, tile, F.tid);
        if (!more) break;
        const int t2 = tn + stride; const bool more2 = t2 < NTASK;
        if (more2) { cur = MOE ? cvt_task_moe(p, l, t2) : cvt_task_mix(p, l, t2); cvt_load(v, cur, F.tid); }
        cvt_store(vn, nx, tile, F.tid);
        if (!more2) break;
        t = t2;
    }
    __syncthreads();
}

__device__ __forceinline__ void rmsnorm_mod_row(const float* x, const float* g, const float* sc, const float* sh, bf16_t* o, int lane, float* keep  ) {
    f32x4 v[4]; float ss = 0.f;
#pragma unroll
    for (int j = 0; j < 4; ++j) { v[j] = *(const GAS f32x4*)(x + j * 256 + lane * 4); ss += v[j][0] * v[j][0] + v[j][1] * v[j][1] + v[j][2] * v[j][2] + v[j][3] * v[j][3]; }
#pragma unroll
    for (int m = 1; m < 64; m <<= 1) ss += shfl_xor_f(ss, m);
    const float rs = rsqrtf(ss * (1.f / 1024.f) + 1e-6f);
#pragma unroll
    for (int j = 0; j < 4; ++j) { const int c = j * 256 + lane * 4;
        const f32x4 gg = *(const GAS f32x4*)(g + c), s1 = *(const GAS f32x4*)(sc + c), s0 = *(const GAS f32x4*)(sh + c);
        f32x4 y;
#pragma unroll
        for (int e = 0; e < 4; ++e) y[e] = v[j][e] * rs * gg[e] * (1.f + s1[e]) + s0[e];
        u32x2 w; w.x = pk2(y[0], y[1]); w.y = pk2(y[2], y[3]); *(GAS u32x2*)(o + c) = w;
        if (keep) { keep[j * 4 + 0] = y[0]; keep[j * 4 + 1] = y[1]; keep[j * 4 + 2] = y[2]; keep[j * 4 + 3] = y[3]; } }
}
__device__ __forceinline__ void p1_weights(const Params& p, const Frame& F, int l, bool early_done = false) {
    LAS float* tile = (LAS float*)F.lds;
    cvt_run<false>(p, F, l, tile, 0, early_done ? 576 : 0);
    for (int idx = F.gwave; idx < 9 * 48; idx += F.nwave) { const int mrow = idx / 48, n = idx - mrow * 48;
        const float* sh2 = WSF(p, WS_MOD) + ((size_t)l * 9 + mrow) * 6144 + 3072; const float* rwt = WSF(p, WS_RWT) + (size_t)l * 36 * 1024; float* rc = WSF(p, WS_RC) + ((size_t)l * 9 + mrow) * 48;
        float a = 0.f;
        if (n < 36) {
#pragma unroll
            for (int j = 0; j < 4; ++j) { const f32x4 sv = *(const GAS f32x4*)(sh2 + j * 256 + F.lane * 4), wv = *(const GAS f32x4*)(rwt + n * 1024 + j * 256 + F.lane * 4); a += sv[0] * wv[0] + sv[1] * wv[1] + sv[2] * wv[2] + sv[3] * wv[3]; }
#pragma unroll
            for (int mk = 1; mk < 64; mk <<= 1) a += shfl_xor_f(a, mk);
            a += n < 4 ? ((const GAS float*)p.in[I_RGB])[l * 4 + n] : ((const GAS float*)p.in[I_REB])[l * 32 + n - 4]; }
        if (F.lane == 0) rc[n] = a; }
    { bf16_t* bl = WSB(p, WS_BTLORA); const int gt = F.bid * NTHREADS + F.tid, ngt = F.G * NTHREADS;
      for (int i = gt; i < 2560 * 256; i += ngt) { const int k = i / 2560, row = i - k * 2560;
          float v = 0.f;
          if (row < 1024) { if (k < 64) { const int d = row >> 9, c = row & 511; v = ((const GAS float*)p.in[I_W2])[(((size_t)l * 2 + d) * 64 + k) * 512 + c]; } }
          else if (row < 2048) { if (k >= 64 && k < 128) { const int r2 = row - 1024, d = r2 >> 9, c = r2 & 511; v = ((const GAS float*)p.in[I_A2])[(((size_t)l * 2 + d) * 64 + (k - 64)) * 512 + c]; } }
          else { if (k >= 128) { const int c = row - 2048; v = ((const GAS float*)p.in[I_G2])[((size_t)l * 128 + (k - 128)) * 512 + c]; } }
          bl[(size_t)row * 256 + k] = (bf16_t)f2bf(v); } }
}
__device__ __forceinline__ void p1_cvt_norm1(const Params& p, const Frame& F, int l) {
    p1_weights(p, F, l);
    { const float* mod = WSF(p, WS_MOD) + (size_t)l * 9 * 6144; bf16_t* H = WSB(p, WS_H);
      for (int row = F.gwave; row < T; row += F.nwave) { const int b = row / NP, q = row - b * NP; const float* mr = mod + (size_t)(q < NCTX ? 8 : b) * 6144;
          const float* xin = q < NCTX ? p.in[I_CTX] + (size_t)(b * NCTX + q) * D : p.in[I_X] + (size_t)(b * NLAT + (q - NCTX)) * D;
          rmsnorm_mod_row(xin, p.in[I_N1G] + (size_t)l * 1024, mr + 1024, mr, H + (size_t)row * 1024, F.lane, nullptr); } }
}

__device__ __forceinline__ void p3_prep(const Params& p, const Frame& F, int l) {
    const float* tab = WSF(p, WS_ROPE);
    const float* cosA = tab, *sinA = tab + 1024, *cosR = tab + 2048, *sinR = tab + 4096;
    bf16_t* AQ = WSB(p, WS_AQ); bf16_t* AKV = WSB(p, WS_AKV); bf16_t* RQ = WSB(p, WS_RQ); bf16_t* RK = WSB(p, WS_RK);
    const bf16_t* WU = WSB(p, WS_WU); bf16_t* AL_ = WSB(p, WS_H);
    const int lane = F.lane;
    const float* qng = p.in[I_QNG] + l * 64, *kng = p.in[I_KNG] + l * 64;
    const float* mu0 = p.in[I_MU] + (size_t)l * 2 * 1792, *mu1 = mu0 + 1792;
    for (int row = F.gwave; row < T; row += F.nwave) {
        const int b = row / NP, q = row - b * NP; const bool lat = q >= NCTX; const int t = q - NCTX, prow = t >> 6, pcol = t & 63;
        const u32x4 raw_aq = *(const GAS u32x4*)(AQ + (size_t)row * 512 + lane * 8), raw_ak = *(const GAS u32x4*)(AKV + (size_t)row * 256 + (lane & 15) * 8);
        const u32x4 raw_rq = *(const GAS u32x4*)(RQ + (size_t)row * 512 + lane * 8), raw_rk = *(const GAS u32x4*)(RK + (size_t)row * 512 + lane * 8);
        const bool hasp = (q != 0) && (q != NCTX), hasn = (q != NCTX - 1) && (q != NP - 1);
        const int cw = 1536 + lane * 4;
        const u32x2 cu = *(const GAS u32x2*)(WU + (size_t)row * 1792 + cw);
        u32x2 pu; pu.x = 0u; pu.y = 0u; u32x2 nu = pu;
        if (hasp) pu = *(const GAS u32x2*)(WU + (size_t)(row - 1) * 1792 + cw);
        if (hasn) nu = *(const GAS u32x2*)(WU + (size_t)(row + 1) * 1792 + cw);
        { const int sub = lane & 7, a = sub >> 2, half = (sub >> 1) & 1, ib = (sub & 1) * 8, pos = lat ? (a ? pcol : prow) : 0;
          float cA[8], sA[8];
          *(f32x4*)cA = *(const GAS f32x4*)(cosA + pos * 16 + ib); *(f32x4*)(cA + 4) = *(const GAS f32x4*)(cosA + pos * 16 + ib + 4);
          *(f32x4*)sA = *(const GAS f32x4*)(sinA + pos * 16 + ib); *(f32x4*)(sA + 4) = *(const GAS f32x4*)(sinA + pos * 16 + ib + 4);
          { float x[8]; unpack8(raw_aq, x);
            float ss = 0.f;
#pragma unroll
            for (int e = 0; e < 8; ++e) ss += x[e] * x[e];
            ss += shfl_xor_f(ss, 1); ss += shfl_xor_f(ss, 2); ss += shfl_xor_f(ss, 4);
            const float rs = rsqrtf(ss * (1.f / 64.f) + 1e-6f);
            float gq[8]; *(f32x4*)gq = *(const GAS f32x4*)(qng + sub * 8); *(f32x4*)(gq + 4) = *(const GAS f32x4*)(qng + sub * 8 + 4);
#pragma unroll
            for (int e = 0; e < 8; ++e) x[e] = x[e] * rs * gq[e];
            float y[8];
#pragma unroll
            for (int e = 0; e < 8; ++e) { const float o = shfl_xor_f(x[e], 2);
                if (lat) { const float c = cA[e], s = sA[e]; y[e] = half ? (x[e] * c + o * s) : (x[e] * c - o * s); } else y[e] = x[e];
                y[e] *= 0.18033688011112042f; }
            if (!p.dry) *(GAS u32x4*)(AQ + (size_t)row * 512 + lane * 8) = pack8(y); }
          { const int lk = lane & 15; float x[8]; unpack8(raw_ak, x);
            float ss = 0.f;
#pragma unroll
            for (int e = 0; e < 8; ++e) ss += x[e] * x[e];
            ss += shfl_xor_f(ss, 1); ss += shfl_xor_f(ss, 2); ss += shfl_xor_f(ss, 4);
            const float rs = rsqrtf(ss * (1.f / 64.f) + 1e-6f);
            float gk[8]; *(f32x4*)gk = *(const GAS f32x4*)(kng + sub * 8); *(f32x4*)(gk + 4) = *(const GAS f32x4*)(kng + sub * 8 + 4);
#pragma unroll
            for (int e = 0; e < 8; ++e) x[e] = x[e] * rs * gk[e];
            float y[8];
#pragma unroll
            for (int e = 0; e < 8; ++e) { const float o = shfl_xor_f(x[e], 2);
                if (lat) { const float c = cA[e], s = sA[e]; y[e] = half ? (x[e] * c + o * s) : (x[e] * c - o * s); } else y[e] = x[e]; }
            if (lane < 16 && !p.dry) *(GAS u32x4*)(AKV + (size_t)row * 256 + lk * 8) = pack8(y); } }
        { const int sub = lane & 15, a = sub >> 3, half = (sub >> 2) & 1, ib = (sub & 3) * 8, pos = lat ? (a ? pcol : prow) : 0;
          float cR[8], sR[8];
          *(f32x4*)cR = *(const GAS f32x4*)(cosR + pos * 32 + ib); *(f32x4*)(cR + 4) = *(const GAS f32x4*)(cosR + pos * 32 + ib + 4);
          *(f32x4*)sR = *(const GAS f32x4*)(sinR + pos * 32 + ib); *(f32x4*)(sR + 4) = *(const GAS f32x4*)(sinR + pos * 32 + ib + 4);
#pragma unroll
          for (int which = 0; which < 2; ++which) { bf16_t* buf = which ? RK : RQ;
            float x[8]; unpack8(which ? raw_rk : raw_rq, x); float y[8];
#pragma unroll
            for (int e = 0; e < 8; ++e) { const float o = shfl_xor_f(x[e], 4);
                if (lat) { const float c = cR[e], s = sR[e]; y[e] = half ? (x[e] * c + o * s) : (x[e] * c - o * s); } else y[e] = x[e];
                if (which) y[e] *= 0.08838834764831845f; }
            if (!p.dry) *(GAS u32x4*)(buf + (size_t)row * 512 + lane * 8) = pack8(y); } }
        { const int c = cw;
          const float uc[4] = {lo16(cu.x), hi16(cu.x), lo16(cu.y), hi16(cu.y)}, up[4] = {lo16(pu.x), hi16(pu.x), lo16(pu.y), hi16(pu.y)}, un[4] = {lo16(nu.x), hi16(nu.x), lo16(nu.y), hi16(nu.y)};
          float y[4]; const f32x4 m0v = *(const GAS f32x4*)(mu0 + c), m1v = *(const GAS f32x4*)(mu1 + c);
#pragma unroll
          for (int e = 0; e < 4; ++e) { const float xs = uc[e] + (up[e] - uc[e]) * m0v[e] + (un[e] - uc[e]) * m1v[e];
              if (lane < 16) { const float ex = __expf(2.f * xs); y[e] = 1.f - 2.f * frcp(ex + 1.f); }
              else if (lane < 32) y[e] = xs;
              else y[e] = sigmoidf_(xs); }
          u32x2 w; w.x = pk2(y[0], y[1]); w.y = pk2(y[2], y[3]); *(GAS u32x2*)(AL_ + (size_t)row * 256 + lane * 4) = w; }
    }
}

__device__ __forceinline__ void p5_rwkv_tok(const Params& p, const Frame& F, int l) {
    const bf16_t* WU = WSB(p, WS_WU); const bf16_t* LW = WSB(p, WS_LW); const bf16_t* LA = WSB(p, WS_LA);
    bf16_t* RS = WSB(p, WS_W1); bf16_t* VS = RS + (size_t)T * 512; bf16_t* KKS = VS + (size_t)T * 512;
    const int lane = F.lane, c0 = lane * 8;
    const float* mu0 = p.in[I_MU] + (size_t)l * 2 * 1792, *mu1 = mu0 + 1792;
    const float* k_k = p.in[I_KK] + l * 512, *k_a = p.in[I_KA] + l * 512;
    for (int row = F.gwave; row < T; row += F.nwave) {
        const int b = row / NP, q = row - b * NP;
        const bool hasp = (q != 0) && (q != NCTX), hasn = (q != NCTX - 1) && (q != NP - 1);
        float sh[3][8];
#pragma unroll
        for (int part = 0; part < 3; ++part) { const int c = part * 512 + c0;
            const u32x4 cu = *(const GAS u32x4*)(WU + (size_t)row * 1792 + c);
            u32x4 pu; pu.x = pu.y = pu.z = pu.w = 0u; u32x4 nu = pu;
            if (hasp) pu = *(const GAS u32x4*)(WU + (size_t)(row - 1) * 1792 + c);
            if (hasn) nu = *(const GAS u32x4*)(WU + (size_t)(row + 1) * 1792 + c);
            float uc[8], up[8], un[8]; unpack8(cu, uc); unpack8(pu, up); unpack8(nu, un);
#pragma unroll
            for (int e = 0; e < 8; ++e) sh[part][e] = uc[e] + (up[e] - uc[e]) * mu0[c + e] + (un[e] - uc[e]) * mu1[c + e]; }
        float kk[8]; float ss = 0.f;
#pragma unroll
        for (int e = 0; e < 8; ++e) { kk[e] = sh[1][e] * k_k[c0 + e]; ss += kk[e] * kk[e]; }
        ss += shfl_xor_f(ss, 1); ss += shfl_xor_f(ss, 2); ss += shfl_xor_f(ss, 4);
        const float rn = rsqrtf(fmaxf(ss, 1e-12f));
#pragma unroll
        for (int e = 0; e < 8; ++e) kk[e] *= rn;
        u32x4 lw_raw[2], la_raw[2];
#pragma unroll
        for (int d = 0; d < 2; ++d) { lw_raw[d] = *(const GAS u32x4*)(LW + (size_t)row * 1024 + d * 512 + c0); la_raw[d] = *(const GAS u32x4*)(LA + (size_t)row * 1024 + d * 512 + c0); }
        *(GAS u32x4*)(RS + (size_t)row * 512 + c0) = pack8(sh[0]);
        *(GAS u32x4*)(VS + (size_t)row * 512 + c0) = pack8(sh[2]);
        *(GAS u32x4*)(KKS + (size_t)row * 512 + c0) = pack8(kk);
#pragma unroll
        for (int d = 0; d < 2; ++d) {
            _Float16* LOGW = (_Float16*)(p.ws + WS_W1 + (size_t)(3 + 3 * d) * SZ512); bf16_t* KR = WSB(p, WS_W1 + (size_t)(4 + 3 * d) * SZ512); bf16_t* BB = WSB(p, WS_W1 + (size_t)(5 + 3 * d) * SZ512);
            const float* w0 = p.in[I_W0] + ((size_t)l * 2 + d) * 512, *a0 = p.in[I_A0] + ((size_t)l * 2 + d) * 512;
            float lw[8], la[8]; unpack8(lw_raw[d], lw); unpack8(la_raw[d], la);
            float kr[8], bb[8]; typedef _Float16 h8 __attribute__((ext_vector_type(8))); h8 lg;
#pragma unroll
            for (int e = 0; e < 8; ++e) { const float a = sigmoidf_(a0[c0 + e] + la[e]);
                lg[e] = (_Float16)(-0.6065306597126334f * sigmoidf_(w0[c0 + e] + lw[e]));
                kr[e] = sh[1][e] * (1.f + (a - 1.f) * k_a[c0 + e]); bb[e] = kk[e] * a; }
            *(h8*)(LOGW + (size_t)row * 512 + c0) = lg;
            *(GAS u32x4*)(KR + (size_t)row * 512 + c0) = pack8(kr);
            *(GAS u32x4*)(BB + (size_t)row * 512 + c0) = pack8(bb); }
    }
}
__device__ __forceinline__ float reduce8(float (&v)[8], int lane) {
    float a[4];
#pragma unroll
    for (int k = 0; k < 4; ++k) { const bool up = (lane & 32) != 0; const float send = up ? v[k] : v[k + 4], keep = up ? v[k + 4] : v[k]; a[k] = keep + __shfl_xor(send, 32, 64); }
    float b[2];
#pragma unroll
    for (int k = 0; k < 2; ++k) { const bool up = (lane & 16) != 0; const float send = up ? a[k] : a[k + 2], keep = up ? a[k + 2] : a[k]; b[k] = keep + __shfl_xor(send, 16, 64); }
    float c; { const bool up = (lane & 8) != 0; const float send = up ? b[0] : b[1], keep = up ? b[1] : b[0]; c = keep + __shfl_xor(send, 8, 64); }
    c += __shfl_xor(c, 4, 64); c += __shfl_xor(c, 2, 64); c += __shfl_xor(c, 1, 64);
    return c;
}
__device__ __forceinline__ void p6_rwkv_scan_naive(const Params& p, const Frame& F, int l) {
    (void)l;
    LAS float* L_r = (LAS float*)F.lds;
    LAS float* L_w = L_r + 4096; LAS float* L_k = L_w + 4096; LAS float* L_v = L_k + 4096; LAS float* L_a = L_v + 4096; LAS float* L_b = L_a + 4096; LAS float* L_y = L_b + 4096;
    const bf16_t* RS = WSB(p, WS_W1); const bf16_t* VS = RS + (size_t)T * 512; const bf16_t* KKS = VS + (size_t)T * 512;
    const int lane = F.lane, w = F.wave, tid = F.tid;
    for (int task = F.bid; task < NB * 8 * 2; task += F.G) {
        const int dir = task & 1, h = (task >> 1) & 7, b = task >> 4;
        const _Float16* LOGW = (const _Float16*)(p.ws + WS_W1 + (size_t)(3 + 3 * dir) * SZ512); const bf16_t* KR = WSB(p, WS_W1 + (size_t)(4 + 3 * dir) * SZ512); const bf16_t* BB = WSB(p, WS_W1 + (size_t)(5 + 3 * dir) * SZ512);
        bf16_t* YS = WSB(p, WS_YS) + (size_t)dir * T * 512;
        float S[8];
#pragma unroll
        for (int i = 0; i < 8; ++i) S[i] = 0.f;
        for (int s0 = 0; s0 < NP; s0 += 64) {
            { const int st = tid >> 3, c8 = (tid & 7) * 8, s = s0 + st; const int q = dir ? (s < NCTX ? NCTX - 1 - s : NP + NCTX - 1 - s) : s;
              const size_t off = ((size_t)(b * NP + q)) * 512 + h * 64 + c8;
              float x[8];
              unpack8(*(const GAS u32x4*)(RS + off), x);
#pragma unroll
              for (int e = 0; e < 8; ++e) L_r[st * 64 + c8 + e] = x[e];
              unpack8(*(const GAS u32x4*)(VS + off), x);
#pragma unroll
              for (int e = 0; e < 8; ++e) L_v[st * 64 + c8 + e] = x[e];
              unpack8(*(const GAS u32x4*)(KKS + off), x);
#pragma unroll
              for (int e = 0; e < 8; ++e) L_a[st * 64 + c8 + e] = -x[e];
              unpack8(*(const GAS u32x4*)(KR + off), x);
#pragma unroll
              for (int e = 0; e < 8; ++e) L_k[st * 64 + c8 + e] = x[e];
              unpack8(*(const GAS u32x4*)(BB + off), x);
#pragma unroll
              for (int e = 0; e < 8; ++e) L_b[st * 64 + c8 + e] = x[e];
              typedef _Float16 h8 __attribute__((ext_vector_type(8))); const h8 lg = *(const h8*)(LOGW + off);
#pragma unroll
              for (int e = 0; e < 8; ++e) L_w[st * 64 + c8 + e] = __expf((float)lg[e]); }
            __syncthreads();
            for (int st = 0; st < 64; ++st) {
                const float rj = L_r[st * 64 + lane], wj = L_w[st * 64 + lane], kj = L_k[st * 64 + lane], aj = L_a[st * 64 + lane], bj = L_b[st * 64 + lane];
                float pa[8];
#pragma unroll
                for (int i = 0; i < 8; ++i) pa[i] = S[i] * aj;
                const float tot = reduce8(pa, lane);
                float py[8];
#pragma unroll
                for (int i = 0; i < 8; ++i) { const float sa = __shfl(tot, i * 8, 64); const float vi = L_v[st * 64 + w * 8 + i];
                    S[i] = S[i] * wj + sa * bj + vi * kj; py[i] = S[i] * rj; }
                const float ty = reduce8(py, lane);
                if ((lane & 7) == 0) L_y[st * 64 + w * 8 + (lane >> 3)] = ty;
            }
            __syncthreads();
            { const int st = tid >> 3, c8 = (tid & 7) * 8, s = s0 + st; const int q = dir ? (s < NCTX ? NCTX - 1 - s : NP + NCTX - 1 - s) : s;
              float y[8];
#pragma unroll
              for (int e = 0; e < 8; ++e) y[e] = L_y[st * 64 + c8 + e];
              *(GAS u32x4*)(YS + ((size_t)(b * NP + q)) * 512 + h * 64 + c8) = pack8(y); }
            __syncthreads();
        }
    }
}

__device__ __forceinline__ void p7_rwkv_readout(const Params& p, const Frame& F, int l);
constexpr int RPITCH_TR = 288;
constexpr int RPITCH_ROW = 272;
__device__ __forceinline__ float log_gamma_of(const Params& p, int l, int dir, int h) {
    const float x = ((const GAS float*)p.in[I_RDL])[(l * 2 + dir) * 4 + h];
    return -log1pf(__expf(-x));
}
__device__ __forceinline__ void p8_ret_kv(const Params& p, const Frame& F, int l) {
    const bf16_t* RK = WSB(p, WS_RK); const bf16_t* RV = WSB(p, WS_RV);
    bf16_t* SF = WSB(p, WS_SF); bf16_t* SB = WSB(p, WS_SB);
    LAS unsigned char* Lv = F.lds; LAS unsigned char* Lkf = F.lds + 128 * RPITCH_TR; LAS unsigned char* Lkb = F.lds + 2 * 128 * RPITCH_TR;
    const int lane = F.lane, w = F.wave, tid = F.tid, g = lane >> 4, li = lane & 15, q4 = li >> 2, p4 = li & 3;
    for (int u = F.bid; u < NB * 4 * 34; u += F.G) {
        const int c = u % 34, bh = u / 34, h = bh & 3, b = bh >> 2;
        const float lgf = log_gamma_of(p, l, 0, h) * 1.4426950408889634f, lgb = log_gamma_of(p, l, 1, h) * 1.4426950408889634f;
#pragma unroll
        for (int it = 0; it < 4; ++it) { const int idx = it * NTHREADS + tid, j = idx >> 4, c8 = (idx & 15) * 8;
            const size_t off = ((size_t)(b * NP + c * 128 + j)) * 512 + h * 128 + c8;
            const u32x4 vv = *(const GAS u32x4*)(RV + off); *(LAS u32x4*)(Lv + j * RPITCH_TR + c8 * 2) = vv;
            float x[8]; unpack8(*(const GAS u32x4*)(RK + off), x);
            const float sf = exp2f(lgf * (float)(127 - j)), sb = exp2f(lgb * (float)j);
            float xf[8], xb[8];
#pragma unroll
            for (int e = 0; e < 8; ++e) { xf[e] = x[e] * sf; xb[e] = x[e] * sb; }
            *(LAS u32x4*)(Lkf + j * RPITCH_TR + c8 * 2) = pack8(xf); *(LAS u32x4*)(Lkb + j * RPITCH_TR + c8 * 2) = pack8(xb); }
        __syncthreads();
        const int dir = w >> 2, e0 = (w & 3) * 32;
        LAS unsigned char* Lk = dir ? Lkb : Lkf;
        f32x4 acc[2][8];
#pragma unroll
        for (int et = 0; et < 2; ++et)
#pragma unroll
            for (int dt = 0; dt < 8; ++dt) acc[et][dt] = (f32x4){0.f, 0.f, 0.f, 0.f};
        const LAS unsigned char* vbase = Lv; const LAS unsigned char* kbase = Lk;
#pragma unroll 1
        for (int ks = 0; ks < 4; ++ks) {
            const int r0 = 32 * ks + 8 * g;
            bf16x8 af[2];
#pragma unroll
            for (int et = 0; et < 2; ++et) { const int col = e0 + 16 * et + 4 * p4;
                af[et] = cat44(tr_read(vbase + (r0 + q4) * RPITCH_TR + col * 2), tr_read(vbase + (r0 + 4 + q4) * RPITCH_TR + col * 2)); }
#pragma unroll
            for (int dt = 0; dt < 8; ++dt) { const int col = 16 * dt + 4 * p4;
                const bf16x8 bfr = cat44(tr_read(kbase + (r0 + q4) * RPITCH_TR + col * 2), tr_read(kbase + (r0 + 4 + q4) * RPITCH_TR + col * 2));
#pragma unroll
                for (int et = 0; et < 2; ++et) acc[et][dt] = MFMA16(af[et], bfr, acc[et][dt]); }
        }
        bf16_t* dst = (dir ? SB : SF) + (size_t)u * 16384;
#pragma unroll
        for (int et = 0; et < 2; ++et)
#pragma unroll
            for (int dt = 0; dt < 8; ++dt)
#pragma unroll
                for (int r = 0; r < 4; ++r) dst[(size_t)(e0 + 16 * et + 4 * g + r) * 128 + 16 * dt + li] = (bf16_t)f2bf(acc[et][dt][r]);
        __syncthreads();
    }
}
__device__ __forceinline__ void p9_ret_scan(const Params& p, const Frame& F, int l) {
    unsigned* SF = (unsigned*)(p.ws + WS_SF); unsigned* SB = (unsigned*)(p.ws + WS_SB);
    const int gt = F.bid * NTHREADS + F.tid, ngt = F.G * NTHREADS;
    for (int i = gt; i < 2 * NB * 4 * 8192; i += ngt) {
        const int dir = i / (NB * 4 * 8192), r = i - dir * (NB * 4 * 8192), bh = r >> 13, el = r & 8191, h = bh & 3;
        const float gC = __expf(128.f * log_gamma_of(p, l, dir, h));
        unsigned* base = (dir ? SB : SF) + (size_t)bh * 34 * 8192 + el;
        float s0 = 0.f, s1 = 0.f;
        for (int k = 0; k < 34; ++k) { const int c = dir ? (k < 2 ? 1 - k : 35 - k) : k;
            const unsigned kv = base[(size_t)c * 8192]; if (!p.dry) base[(size_t)c * 8192] = pk2(s0, s1); s0 = gC * s0 + lo16(kv); s1 = gC * s1 + hi16(kv); }
    }
}
__device__ __forceinline__ bf16x8 frag22(u32x2 a, u32x2 b) { u32x4 w; w.x = a.x; w.y = a.y; w.z = b.x; w.w = b.y; return __builtin_bit_cast(bf16x8, w); }
__device__ __forceinline__ void kv_reads(unsigned ka, unsigned va, u32x2 (&ra)[8], u32x2 (&rb)[16]) {
    asm volatile("ds_read_b64_tr_b16 %0, %24 offset:0\n\t"
        "ds_read_b64_tr_b16 %1, %24 offset:1152\n\t"
        "ds_read_b64_tr_b16 %2, %24 offset:9216\n\t"
        "ds_read_b64_tr_b16 %3, %24 offset:10368\n\t"
        "ds_read_b64_tr_b16 %4, %24 offset:18432\n\t"
        "ds_read_b64_tr_b16 %5, %24 offset:19584\n\t"
        "ds_read_b64_tr_b16 %6, %24 offset:27648\n\t"
        "ds_read_b64_tr_b16 %7, %24 offset:28800\n\t"
        "ds_read_b64_tr_b16 %8, %25 offset:0\n\t"
        "ds_read_b64_tr_b16 %9, %25 offset:256\n\t"
        "ds_read_b64_tr_b16 %10, %25 offset:32\n\t"
        "ds_read_b64_tr_b16 %11, %25 offset:288\n\t"
        "ds_read_b64_tr_b16 %12, %25 offset:2048\n\t"
        "ds_read_b64_tr_b16 %13, %25 offset:2304\n\t"
        "ds_read_b64_tr_b16 %14, %25 offset:2080\n\t"
        "ds_read_b64_tr_b16 %15, %25 offset:2336\n\t"
        "ds_read_b64_tr_b16 %16, %25 offset:4096\n\t"
        "ds_read_b64_tr_b16 %17, %25 offset:4352\n\t"
        "ds_read_b64_tr_b16 %18, %25 offset:4128\n\t"
        "ds_read_b64_tr_b16 %19, %25 offset:4384\n\t"
        "ds_read_b64_tr_b16 %20, %25 offset:6144\n\t"
        "ds_read_b64_tr_b16 %21, %25 offset:6400\n\t"
        "ds_read_b64_tr_b16 %22, %25 offset:6176\n\t"
        "ds_read_b64_tr_b16 %23, %25 offset:6432\n\t"
        "s_waitcnt lgkmcnt(0)"
        : "=&v"(ra[0]), "=&v"(ra[1]), "=&v"(ra[2]), "=&v"(ra[3]), "=&v"(ra[4]), "=&v"(ra[5]), "=&v"(ra[6]), "=&v"(ra[7]), "=&v"(rb[0]), "=&v"(rb[1]), "=&v"(rb[2]), "=&v"(rb[3]), "=&v"(rb[4]), "=&v"(rb[5]), "=&v"(rb[6]), "=&v"(rb[7]), "=&v"(rb[8]), "=&v"(rb[9]), "=&v"(rb[10]), "=&v"(rb[11]), "=&v"(rb[12]), "=&v"(rb[13]), "=&v"(rb[14]), "=&v"(rb[15]) : "v"(ka), "v"(va) : "memory");
}
__device__ __forceinline__ void p8f_ret_kvscan(const Params& p, const Frame& F, int l) {
    const bf16_t* RK = WSB(p, WS_RK); const bf16_t* RV = WSB(p, WS_RV);
    bf16_t* SF = WSB(p, WS_SF); bf16_t* SB = WSB(p, WS_SB);
    constexpr int VP = 64;
    static_assert(RPITCH_TR == 288, "the operand-read offsets above are spelled out for these pitches");
    LAS unsigned char* LK0 = F.lds; LAS unsigned char* LV0 = F.lds + 3 * 128 * RPITCH_TR;
    const int lane = F.lane, w = F.wave, tid = F.tid, g = lane >> 4, li = lane & 15, q4 = li >> 2, p4 = li & 3;
    for (int unit = F.bid; unit < NB * 4 * 8; unit += F.G) {
        const int x = unit & 7, slot = unit >> 3, bh = x * 4 + (slot >> 3), sub = slot & 7, dir = sub >> 2, e0 = (sub & 3) * 32;
        const int h = bh & 3, b = bh >> 2;
        const float lg = log_gamma_of(p, l, dir, h), lg2 = lg * 1.4426950408889634f; const float gC = __expf(128.f * lg);
        const int vj = tid >> 2, vc8 = (tid & 3) * 8;
        const float vs = dir ? exp2f(lg2 * (float)vj) : exp2f(lg2 * (float)(127 - vj));
        __attribute__((address_space(1))) bf16_t* dstb = (__attribute__((address_space(1))) bf16_t*)((dir ? SB : SF) + (size_t)bh * 34 * 16384 + (size_t)(e0 + li) * 128 + 16 * w + 4 * g);
        const bf16_t* kq = RK + ((size_t)b * NP + 16 * w) * 512 + h * 128 + 2 * lane;
        const bf16_t* vq = RV + ((size_t)b * NP + 16 * w + (lane >> 4)) * 512 + h * 128 + e0 + 2 * (lane & 15);
        const unsigned ka0 = (unsigned)(unsigned long long)(LK0 + (8 * g + q4) * RPITCH_TR + (16 * w + 4 * p4) * 2), va0 = (unsigned)(unsigned long long)(LV0 + (8 * g + q4) * VP + (4 * p4) * 2);
        f32x4 acc[2]; acc[0] = (f32x4){0.f, 0.f, 0.f, 0.f}; acc[1] = acc[0];
#define KV_ORD(k_) (dir ? ((k_) < 2 ? 1 - (k_) : 35 - (k_)) : (k_))
#define KV_FETCH(k_) do { const int c_ = KV_ORD(k_); LAS unsigned char* d_ = LK0 + ((k_) % 3) * 128 * RPITCH_TR + (16 * w) * RPITCH_TR; LAS unsigned char* e_ = LV0 + ((k_) % 3) * 128 * VP + (16 * w) * VP; \
            _Pragma("unroll") for (int i_ = 0; i_ < 16; ++i_) __builtin_amdgcn_global_load_lds((const unsigned*)(kq + ((size_t)c_ * 128 + i_) * 512), (LAS unsigned*)(d_ + i_ * RPITCH_TR), 4, 0, 0); \
            _Pragma("unroll") for (int i_ = 0; i_ < 4; ++i_) __builtin_amdgcn_global_load_lds((const unsigned*)(vq + ((size_t)c_ * 128 + 4 * i_) * 512), (LAS unsigned*)(e_ + 4 * i_ * VP), 4, 0, 0); } while (0)
        KV_FETCH(0); KV_FETCH(1);
        for (int k = 0; k < 34; ++k) { const int bi = k % 3;
            if (k < 33) asm volatile("s_waitcnt vmcnt(20)" ::: "memory"); else asm volatile("s_waitcnt vmcnt(0)" ::: "memory");
            { LAS u32x4* vp = (LAS u32x4*)(LV0 + bi * 128 * VP + vj * VP + vc8 * 2); float x8[8]; unpack8(*vp, x8);
#pragma unroll
              for (int e = 0; e < 8; ++e) x8[e] *= vs;
              *vp = pack8(x8); }
            asm volatile("s_waitcnt lgkmcnt(0)" ::: "memory"); __builtin_amdgcn_s_barrier(); asm volatile("" ::: "memory");
            if (k + 2 < 34) KV_FETCH(k + 2);
            { const int c = KV_ORD(k);
#pragma unroll
              for (int et = 0; et < 2; ++et) { u32x2 ow; ow.x = pk2(acc[et][0], acc[et][1]); ow.y = pk2(acc[et][2], acc[et][3]);
                  *(__attribute__((address_space(1))) u32x2*)(dstb + (size_t)c * 16384 + (size_t)(16 * et) * 128) = ow; acc[et] = acc[et] * gC; } }
            { u32x2 ra[8], rb[16]; const unsigned ka = ka0 + bi * 128 * RPITCH_TR, va = va0 + bi * 128 * VP;
              kv_reads(ka, va, ra, rb);
#pragma unroll
              for (int ks = 0; ks < 4; ++ks) { const bf16x8 af = frag22(ra[2 * ks], ra[2 * ks + 1]);
#pragma unroll
                  for (int et = 0; et < 2; ++et) acc[et] = MFMA16(af, frag22(rb[(ks * 2 + et) * 2], rb[(ks * 2 + et) * 2 + 1]), acc[et]); } }
        }
        asm volatile("s_waitcnt vmcnt(0) lgkmcnt(0)" ::: "memory");
        __syncthreads();
#undef KV_ORD
#undef KV_FETCH
    }
}
__device__ __forceinline__ void p10_ret_out(const Params& p, const Frame& F, int l, bool want_ctx) {
    const bf16_t* RQ = WSB(p, WS_RQ); const bf16_t* RK = WSB(p, WS_RK); const bf16_t* RV = WSB(p, WS_RV); const bf16_t* RG = WSB(p, WS_RG); bf16_t* YR = WSB(p, WS_WU) + 512;
    const bf16_t* SF = WSB(p, WS_SF); const bf16_t* SB = WSB(p, WS_SB);
    LAS unsigned char* Lq = F.lds; LAS unsigned char* Lk = Lq + 128 * RPITCH_ROW; LAS unsigned char* Lv = Lk + 128 * RPITCH_ROW; LAS unsigned char* Ls = Lv + 128 * RPITCH_TR;
    const int lane = F.lane, w = F.wave, g = lane >> 4, li = lane & 15, q4 = li >> 2, p4 = li & 3;
    const float* gn = p.in[I_RGN] + l * 512;
    const int nun = want_ctx ? NB * 4 * 34 : NB * 4 * 32;
    const int bj = 16 * w + (lane >> 4), bc8 = (lane & 15) * 8;
    u32x4 rq[4];
    int k = F.bid;
#define RO_UNIT(k_, bh_, c_) const int bh_ = (k_) < NB * 4 * 32 ? (k_) >> 5 : ((k_) - NB * 4 * 32) >> 1, c_ = (k_) < NB * 4 * 32 ? 2 + ((k_) & 31) : ((k_) & 1)
#define RO_FETCH(bh_, c_) do { const int h_ = (bh_) & 3, b_ = (bh_) >> 2; const size_t r_ = (size_t)(b_ * NP + (c_) * 128) + 16 * w; \
        const bf16_t* kq_ = RK + r_ * 512 + h_ * 128 + 2 * lane; const bf16_t* vq_ = RV + r_ * 512 + h_ * 128 + 2 * lane; const bf16_t* sq_ = SF + ((size_t)(bh_) * 34 + (c_)) * 16384 + (16 * w) * 128 + 2 * lane; \
        _Pragma("unroll") for (int i_ = 0; i_ < 16; ++i_) { \
            __builtin_amdgcn_global_load_lds((const unsigned*)(kq_ + i_ * 512), (LAS unsigned*)(Lk + (16 * w + i_) * RPITCH_ROW), 4, 0, 0); \
            __builtin_amdgcn_global_load_lds((const unsigned*)(vq_ + i_ * 512), (LAS unsigned*)(Lv + (16 * w + i_) * RPITCH_TR), 4, 0, 0); \
            __builtin_amdgcn_global_load_lds((const unsigned*)(sq_ + i_ * 128), (LAS unsigned*)(Ls + (16 * w + i_) * RPITCH_ROW), 4, 0, 0); } \
        _Pragma("unroll") for (int it_ = 0; it_ < 4; ++it_) rq[it_] = *(const GAS u32x4*)(RQ + ((size_t)(b_ * NP + (c_) * 128) + bj + 4 * it_) * 512 + h_ * 128 + bc8); } while (0)
    if (k < nun) { RO_UNIT(k, bh0, c0); RO_FETCH(bh0, c0); }
    for (; k < nun; k += F.G) {
        RO_UNIT(k, bh, c); const int h = bh & 3, b = bh >> 2; const size_t u = (size_t)bh * 34 + c;
        const float lgf = log_gamma_of(p, l, 0, h) * 1.4426950408889634f, lgb = log_gamma_of(p, l, 1, h) * 1.4426950408889634f;
        const size_t row0 = (size_t)(b * NP + c * 128);
#pragma unroll
        for (int it = 0; it < 4; ++it) *(LAS u32x4*)(Lq + (bj + 4 * it) * RPITCH_ROW + bc8 * 2) = rq[it];
        asm volatile("s_waitcnt vmcnt(0)" ::: "memory");
        __syncthreads();
        const int il = 16 * w + li;
        bf16x8 qf[4];
#pragma unroll
        for (int ks = 0; ks < 4; ++ks) qf[ks] = ld_frag(Lq + il * RPITCH_ROW + (32 * ks + 8 * g) * 2);
        u32x4 sbr[4];
#pragma unroll
        for (int it = 0; it < 4; ++it) sbr[it] = *(const GAS u32x4*)(SB + u * 16384 + (bj + 4 * it) * 128 + bc8);
        f32x4 sc[8];
#pragma unroll
        for (int jt = 0; jt < 8; ++jt) { sc[jt] = (f32x4){0.f, 0.f, 0.f, 0.f};
#pragma unroll
            for (int ks = 0; ks < 4; ++ks) sc[jt] = MFMA16(ld_frag(Lk + (16 * jt + li) * RPITCH_ROW + (32 * ks + 8 * g) * 2), qf[ks], sc[jt]); }
#pragma unroll
        for (int jt = 0; jt < 8; ++jt)
#pragma unroll
            for (int r = 0; r < 4; ++r) { const int j = 16 * jt + 4 * g + r, dl = il - j;
                const float f = dl > 0 ? __builtin_amdgcn_exp2f(lgf * (float)dl) : (dl < 0 ? __builtin_amdgcn_exp2f(lgb * (float)(-dl)) : 2.f);
                sc[jt][r] *= f; }
        f32x4 y[8];
#pragma unroll
        for (int et = 0; et < 8; ++et) y[et] = (f32x4){0.f, 0.f, 0.f, 0.f};
        const LAS unsigned char* vbase = Lv;
#pragma unroll
        for (int ks = 0; ks < 4; ++ks) {
            const bf16x8 pf = pack_frag(sc[2 * ks], sc[2 * ks + 1]);
#pragma unroll
            for (int et = 0; et < 8; ++et) { const int col = 16 * et + 4 * p4;
                const bf16x8 vf = cat44(tr_read(vbase + (32 * ks + 4 * g + q4) * RPITCH_TR + col * 2), tr_read(vbase + (32 * ks + 16 + 4 * g + q4) * RPITCH_TR + col * 2));
                y[et] = MFMA16(vf, pf, y[et]); }
        }
        { f32x4 z[8]; const float sf = exp2f(lgf * (float)(il + 1));
#pragma unroll
          for (int et = 0; et < 8; ++et) { z[et] = (f32x4){0.f, 0.f, 0.f, 0.f};
#pragma unroll
              for (int ks = 0; ks < 4; ++ks) z[et] = MFMA16(ld_frag(Ls + (16 * et + li) * RPITCH_ROW + (32 * ks + 8 * g) * 2), qf[ks], z[et]);
              y[et] = y[et] + z[et] * sf; } }
#pragma unroll
        for (int it = 0; it < 4; ++it) *(LAS u32x4*)(Lq + (bj + 4 * it) * RPITCH_ROW + bc8 * 2) = sbr[it];
        __syncthreads();
        { const int kn = k + F.G; if (kn < nun) { RO_UNIT(kn, bhn, cn); RO_FETCH(bhn, cn); } }
        const size_t orow = (row0 + il) * 512 + h * 128;
        u32x2 gw[8];
#pragma unroll
        for (int et = 0; et < 8; ++et) gw[et] = *(const GAS u32x2*)(RG + orow + 16 * et + 4 * g);
        { f32x4 z[8]; const float sb = exp2f(lgb * (float)(128 - il));
#pragma unroll
          for (int et = 0; et < 8; ++et) { z[et] = (f32x4){0.f, 0.f, 0.f, 0.f};
#pragma unroll
              for (int ks = 0; ks < 4; ++ks) z[et] = MFMA16(ld_frag(Lq + (16 * et + li) * RPITCH_ROW + (32 * ks + 8 * g) * 2), qf[ks], z[et]);
              y[et] = y[et] + z[et] * sb; } }
        float ss = 0.f;
#pragma unroll
        for (int et = 0; et < 8; ++et)
#pragma unroll
            for (int r = 0; r < 4; ++r) ss += y[et][r] * y[et][r];
        ss += shfl_xor_f(ss, 16); ss += shfl_xor_f(ss, 32);
        const float rs_ = rsqrtf(ss * (1.f / 128.f) + 1e-6f);
#pragma unroll
        for (int et = 0; et < 8; ++et) { const int e = 16 * et + 4 * g;
            const f32x4 gg = *(const GAS f32x4*)(gn + h * 128 + e);
            const float o0 = siluf_(lo16(gw[et].x)) * y[et][0] * rs_ * gg[0], o1 = siluf_(hi16(gw[et].x)) * y[et][1] * rs_ * gg[1], o2 = siluf_(lo16(gw[et].y)) * y[et][2] * rs_ * gg[2], o3 = siluf_(hi16(gw[et].y)) * y[et][3] * rs_ * gg[3];
            u32x2 ow; ow.x = pk2(o0, o1); ow.y = pk2(o2, o3); *(GAS u32x2*)(YR + (row0 + il) * 1536 + h * 128 + e) = ow; }
        __syncthreads();
    }
#undef RO_UNIT
#undef RO_FETCH
}
constexpr int APITCH = 144;
__device__ __forceinline__ void p11_attention(const Params& p, const Frame& F, bool want_ctx) {
    const bf16_t* AQ = WSB(p, WS_AQ); const bf16_t* AKV = WSB(p, WS_AKV); bf16_t* YA = WSB(p, WS_WU);
    const int lane = F.lane, w = F.wave, tid = F.tid, g = lane >> 4, li = lane & 15, q4 = li >> 2, p4 = li & 3;
    LAS unsigned char* LK = F.lds; LAS unsigned char* LV = F.lds + 4 * 64 * APITCH;
    const int nunits = NB * 8 * 17;
    for (int uit = 0;; ++uit) { int u0;
        if (F.G == 256) { if (uit < 4) u0 = F.bid + 256 * uit; else if (uit == 4 && F.bid >= 192) u0 = NB * 8 * 16 + (F.bid - 192); else break; }
        else { u0 = F.bid + uit * F.G; if (u0 >= nunits) break; }
        int b, h, qb;
        int u = u0;
        if (F.G == 256 && u0 < NB * 8 * 16) { const int r = u0 >> 8, x = u0 & 7, j = (u0 & 255) >> 3, pair = x + 8 * (r >> 1), un = (r & 1) * 32 + j;
            u = (pair >> 1) * 128 + ((pair & 1) * 4 + (un >> 4)) * 16 + (un & 15); }
        if (u < NB * 8 * 16) { b = u >> 7; h = (u >> 4) & 7; qb = 1 + (u & 15); } else { const int v = u - NB * 8 * 16; b = v >> 3; h = v & 7; qb = 0; }
        if (qb == 0 && !want_ctx) continue;
        const int kvh = h >> 2, ntile = qb == 0 ? NCTX / 64 : NP / 64;
        const size_t rowbase = (size_t)b * NP + (size_t)qb * 256;
        bf16x8 qf[2][2];
#pragma unroll
        for (int it = 0; it < 2; ++it)
#pragma unroll
            for (int ks = 0; ks < 2; ++ks) qf[it][ks] = *(const GAS bf16x8*)(AQ + (rowbase + 32 * w + 16 * it + li) * 512 + h * 64 + 32 * ks + 8 * g);
        f32x4 o[4][2]; float m[2]; f32x4 lsa[2], minit[2];
        const bf16x8 ones = {(short)0x3F80, (short)0x3F80, (short)0x3F80, (short)0x3F80, (short)0x3F80, (short)0x3F80, (short)0x3F80, (short)0x3F80};
#pragma unroll
        for (int it = 0; it < 2; ++it) { m[it] = 0.f; lsa[it] = (f32x4){0.f, 0.f, 0.f, 0.f}; minit[it] = (f32x4){0.f, 0.f, 0.f, 0.f};
#pragma unroll
            for (int et = 0; et < 4; ++et) o[et][it] = (f32x4){0.f, 0.f, 0.f, 0.f}; }
        const int sj = tid >> 3, sc8 = (tid & 7) * 8;
        const bf16_t* kvsrc = AKV + ((size_t)b * NP + sj) * 256 + kvh * 64 + sc8;
        u32x4 kreg[2], vreg[2];
#pragma unroll
        for (int sb = 0; sb < 2; ++sb) { kreg[sb] = *(const GAS u32x4*)(kvsrc + (size_t)sb * 64 * 256); vreg[sb] = *(const GAS u32x4*)(kvsrc + (size_t)sb * 64 * 256 + 128); }
        __syncthreads();
        for (int kp = 0; kp < ntile / 2; ++kp) {
            LAS unsigned char* lkb = LK + (kp & 1) * 128 * APITCH; LAS unsigned char* lvb = LV + (kp & 1) * 128 * APITCH;
#pragma unroll
            for (int sb = 0; sb < 2; ++sb) { *(LAS u32x4*)(lkb + (sb * 64 + sj) * APITCH + sc8 * 2) = kreg[sb]; *(LAS u32x4*)(lvb + (sb * 64 + sj) * APITCH + sc8 * 2) = vreg[sb]; }
            __syncthreads();
            if (kp + 1 < ntile / 2) {
#pragma unroll
                for (int sb = 0; sb < 2; ++sb) { const bf16_t* s2 = kvsrc + (size_t)(2 * kp + 2 + sb) * 64 * 256; kreg[sb] = *(const GAS u32x4*)s2; vreg[sb] = *(const GAS u32x4*)(s2 + 128); } }
#pragma unroll
            for (int sb = 0; sb < 2; ++sb) { const int kt = 2 * kp + sb; LAS unsigned char* lk = lkb + sb * 64 * APITCH; LAS unsigned char* lv = lvb + sb * 64 * APITCH;
            f32x4 sc[4][2];
#pragma unroll
            for (int jt = 0; jt < 4; ++jt) {
                const bf16x8 kf0 = ld_frag(lk + (16 * jt + li) * APITCH + (8 * g) * 2), kf1 = ld_frag(lk + (16 * jt + li) * APITCH + (32 + 8 * g) * 2);
                sc[jt][0] = MFMA16(kf0, qf[0][0], minit[0]); sc[jt][1] = MFMA16(kf0, qf[1][0], minit[1]);
                sc[jt][0] = MFMA16(kf1, qf[0][1], sc[jt][0]); sc[jt][1] = MFMA16(kf1, qf[1][1], sc[jt][1]); }
            bf16x8 pf[2][2];
            if ((kt & 7) == 0) {
                float mx[2];
#pragma unroll
                for (int it = 0; it < 2; ++it) { float t = sc[0][it][0];
#pragma unroll
                    for (int jt = 0; jt < 4; ++jt)
#pragma unroll
                        for (int r = 0; r < 4; ++r) t = fmaxf(t, sc[jt][it][r]);
                    t = fmaxf(t, shfl_xor_f(t, 16)); t = fmaxf(t, shfl_xor_f(t, 32)); mx[it] = t; }
                if (kt == 0 || __any(fmaxf(mx[0], mx[1]) > 8.f)) {
#pragma unroll
                    for (int it = 0; it < 2; ++it) { const float d = kt == 0 ? mx[it] : fmaxf(mx[it], 0.f), alpha = kt == 0 ? 1.f : __builtin_amdgcn_exp2f(-d);
                        m[it] = kt == 0 ? d : m[it] + d; lsa[it] = lsa[it] * alpha; minit[it] = (f32x4){-m[it], -m[it], -m[it], -m[it]};
#pragma unroll
                        for (int et = 0; et < 4; ++et) o[et][it] = o[et][it] * alpha;
#pragma unroll
                        for (int jt = 0; jt < 4; ++jt)
#pragma unroll
                            for (int r = 0; r < 4; ++r) sc[jt][it][r] -= d; } } }
#pragma unroll
            for (int it = 0; it < 2; ++it) {
#pragma unroll
                for (int jt = 0; jt < 4; ++jt)
#pragma unroll
                    for (int r = 0; r < 4; ++r) sc[jt][it][r] = __builtin_amdgcn_exp2f(sc[jt][it][r]);
                pf[it][0] = pack_frag(sc[0][it], sc[1][it]); pf[it][1] = pack_frag(sc[2][it], sc[3][it]);
                lsa[it] = MFMA16(ones, pf[it][0], lsa[it]); lsa[it] = MFMA16(ones, pf[it][1], lsa[it]); }
#pragma unroll
            for (int ks = 0; ks < 2; ++ks)
#pragma unroll
                for (int et = 0; et < 4; ++et) { const int col = 16 * et + 4 * p4;
                    const bf16x8 vf = cat44(tr_read(lv + (32 * ks + 4 * g + q4) * APITCH + col * 2), tr_read(lv + (32 * ks + 16 + 4 * g + q4) * APITCH + col * 2));
                    o[et][0] = MFMA16(vf, pf[0][ks], o[et][0]); o[et][1] = MFMA16(vf, pf[1][ks], o[et][1]); }
            }
        }
#pragma unroll
        for (int it = 0; it < 2; ++it) { const float inv = __builtin_amdgcn_rcpf(lsa[it][0]);
            bf16_t* op = YA + (rowbase + 32 * w + 16 * it + li) * 1536 + h * 64 + 4 * g;
#pragma unroll
            for (int et = 0; et < 4; ++et) { u32x2 ow; ow.x = pk2(o[et][it][0] * inv, o[et][it][1] * inv); ow.y = pk2(o[et][it][2] * inv, o[et][it][3] * inv); *(GAS u32x2*)(op + 16 * et) = ow; } }
    }
    __syncthreads();
}

__device__ __forceinline__ void p14_norm2_router(const Params& p, const Frame& F, int l, bool want_ctx) {
    LAS float* tile = (LAS float*)F.lds;
    (void)tile;
    const float* mod = WSF(p, WS_MOD) + (size_t)l * 9 * 6144; bf16_t* H2 = WSB(p, WS_H);
    const float* rw2 = WSF(p, WS_RW2) + (size_t)l * 64 * 3 * 4 * 16 * 4;
    const float* rcl = WSF(p, WS_RC) + (size_t)l * 9 * 48;
    const float* n2g = p.in[I_N2G] + (size_t)l * 1024;
    unsigned* cnt = (unsigned*)(p.ws + WS_CTL) + CW_CNT + l * 32;
    int* PE = (int*)(p.ws + WS_PAIR); int* PPOS = PE + NPAIR_MAX; float* PW = (float*)(PPOS + NPAIR_MAX);
    const bool spread = F.G == 256;
    for (int it = 0;; ++it) { int gi;
        if (spread) { if (it == 0) gi = (F.gwave >> 8) * (NP / 16) + NCTX / 16 + (F.gwave & 255);
                      else if (it == 1 && want_ctx && !(F.bid & 1) && F.wave == ((F.bid >> 1) & 7)) { const int j = F.bid >> 1; gi = (j >> 4) * (NP / 16) + (j & 15); }
                      else break; }
        else { gi = F.gwave + it * F.nwave; if (gi >= T / 16) break; }
        int lane = F.lane; asm volatile("" : "+v"(lane));
        const int g = lane >> 4, li = lane & 15, half = lane >> 5, lk = lane & 31;
        const int row0 = 16 * gi, b = row0 / NP, q = row0 - b * NP; const bool isctx = q < NCTX;
        if (isctx && !want_ctx) continue;
        const int mrow = isctx ? 8 : b; const float* mr = mod + (size_t)mrow * 6144;
        LAS float* At = (LAS float*)(F.lds + F.wave * 12288);
        LAS float* LGT = At + 16 * 4 * 36;
        const float* xr[8];
#pragma unroll
        for (int r = 0; r < 8; ++r) xr[r] = xrow(p, row0 + 8 * half + r);
        f32x4 acc[3]; float ss[8];
#pragma unroll
        for (int nt = 0; nt < 3; ++nt) acc[nt] = (f32x4){0.f, 0.f, 0.f, 0.f};
#pragma unroll
        for (int r = 0; r < 8; ++r) ss[r] = 0.f;
        f32x4 xv[8];
#pragma unroll
        for (int r = 0; r < 8; ++r) xv[r] = *(const GAS f32x4*)(xr[r] + 4 * lk);
#pragma unroll 1
        for (int ck = 0; ck < 8; ++ck) { const int kc = ck * 128 + 4 * lk;
            const f32x4 gg = *(const GAS f32x4*)(n2g + kc), s1 = *(const GAS f32x4*)(mr + 4096 + kc);
            f32x4 gq; gq[0] = gg[0] * (1.f + s1[0]); gq[1] = gg[1] * (1.f + s1[1]); gq[2] = gg[2] * (1.f + s1[2]); gq[3] = gg[3] * (1.f + s1[3]);
            const float* wb = rw2 + ((size_t)(ck * 8) * 3 * 4 + g) * 64 + li * 4;
            f32x4 bc[3];
#pragma unroll
            for (int nt = 0; nt < 3; ++nt) bc[nt] = *(const GAS f32x4*)(wb + nt * 256);
#pragma unroll
            for (int r = 0; r < 8; ++r) { ss[r] += xv[r][0] * xv[r][0] + xv[r][1] * xv[r][1] + xv[r][2] * xv[r][2] + xv[r][3] * xv[r][3];
#pragma unroll
                for (int e = 0; e < 4; ++e) At[((8 * half + r) * 4 + e) * 36 + lk] = xv[r][e] * gq[e]; }
            if (ck < 7) {
#pragma unroll
                for (int r = 0; r < 8; ++r) xv[r] = *(const GAS f32x4*)(xr[r] + kc + 128); }
            asm volatile("" ::: "memory");
#pragma unroll
            for (int kq = 0; kq < 8; ++kq) { const f32x4 av = *(const LAS f32x4*)(At + (li * 4 + g) * 36 + 4 * kq);
                f32x4 bn[3];
                if (kq < 7) {
#pragma unroll
                    for (int nt = 0; nt < 3; ++nt) bn[nt] = *(const GAS f32x4*)(wb + ((kq + 1) * 3 + nt) * 256); }
#pragma unroll
                for (int nt = 0; nt < 3; ++nt) {
#pragma unroll
                    for (int j = 0; j < 4; ++j) acc[nt] = __builtin_amdgcn_mfma_f32_16x16x4f32(av[j], bc[nt][j], acc[nt], 0, 0, 0); }
                if (kq < 7) {
#pragma unroll
                    for (int nt = 0; nt < 3; ++nt) bc[nt] = bn[nt]; } }
            asm volatile("" ::: "memory");
        }
#pragma unroll
        for (int r = 0; r < 8; ++r) {
#pragma unroll
            for (int mk = 1; mk < 32; mk <<= 1) ss[r] += shfl_xor_f(ss[r], mk);
            ss[r] = rsqrtf(ss[r] * (1.f / 1024.f) + 1e-6f); }
#pragma unroll
        for (int r2 = 0; r2 < 4; ++r2) { float rsA = ss[r2], rsB = ss[4 + r2]; asm volatile("" : "+v"(rsA), "+v"(rsB));
            const float rs = (g & 1) ? rsB : rsA;
#pragma unroll
            for (int nt = 0; nt < 3; ++nt) LGT[(4 * g + r2) * 48 + 16 * nt + li] = acc[nt][r2] * rs + rcl[mrow * 48 + 16 * nt + li]; }
        asm volatile("" ::: "memory");
        if (lane < 16 && !p.dry) {
            const int row = row0 + lane; const LAS float* lg = LGT + lane * 48;
            int grp = 0; float gm = lg[0];
            float gl4[4]; gl4[0] = gm;
#pragma unroll
            for (int i = 1; i < 4; ++i) { gl4[i] = lg[i]; if (gl4[i] > gm) { gm = gl4[i]; grp = i; } }
            float gs = 0.f;
#pragma unroll
            for (int i = 0; i < 4; ++i) gs += __expf(gl4[i] - gm);
            const float pg = frcp(gs);
            int i1 = 0, i2 = -1; float v1 = -3.0e38f, v2 = -3.0e38f;
#pragma unroll
            for (int i = 0; i < 8; ++i) { const float v = lg[4 + grp * 8 + i];
                if (v > v1) { v2 = v1; i2 = i1; v1 = v; i1 = i; } else if (v > v2) { v2 = v; i2 = i; } }
            const float e2 = __expf(v2 - v1), w1 = pg * frcp(1.f + e2), w2 = pg * e2 * frcp(1.f + e2);
            const int ex1 = grp * 8 + i1, ex2 = grp * 8 + i2;
            const unsigned p1 = atomicAdd(&cnt[ex1], 1u), p2 = atomicAdd(&cnt[ex2], 1u);
            PE[2 * row] = ex1; PE[2 * row + 1] = ex2; PPOS[2 * row] = (int)p1; PPOS[2 * row + 1] = (int)p2; PW[2 * row] = w1; PW[2 * row + 1] = w2;
        }
        if (!p.dry && lk == 0) { float* RSR = WSF(p, WS_RSROW);
#pragma unroll
            for (int r = 0; r < 8; ++r) RSR[row0 + 8 * half + r] = ss[r]; }
    }
}
struct MoeTab { LAS int* pad_start; LAS int* blk_e; LAS int* n_used; };
__device__ __forceinline__ MoeTab moe_tab(const Frame& F) { MoeTab t; LAS int* base = (LAS int*)(F.lds + MISC_OFF + 64); t.pad_start = base; t.blk_e = base + 32; t.n_used = base + 32 + MOE_NBLK; return t; }
__device__ __forceinline__ void moe_build_tab(const Params& p, const Frame& F, int l) {
    const MoeTab t = moe_tab(F);
    const unsigned* cnt = (const unsigned*)(p.ws + WS_CTL) + CW_CNT + l * 32;
    __syncthreads();
    if (F.wave == 0) {
        const int e = F.lane & 31; const int c = (int)__hip_atomic_load(cnt + e, __ATOMIC_RELAXED, __HIP_MEMORY_SCOPE_AGENT), nb = (c + 255) >> 8;
        int incl = nb;
#pragma unroll
        for (int d = 1; d < 32; d <<= 1) { const int v = __shfl_up(incl, d, 64); if (e >= d) incl += v; }
        if (F.lane < 32) { const int excl = incl - nb; t.pad_start[e] = excl * 256;
            for (int k = 0; k < nb; ++k) t.blk_e[excl + k] = e;
            if (e == 31) *t.n_used = incl; } }
    __syncthreads();
}
__device__ __forceinline__ void p15_scatter(const Params& p, const Frame& F, int l, bool want_ctx) {
    moe_build_tab(p, F, l);
    const MoeTab t = moe_tab(F);
    const int* PE = (const int*)(p.ws + WS_PAIR); const int* PPOS = PE + NPAIR_MAX; int* PD = (int*)(p.ws + WS_PAIR) + 3 * NPAIR_MAX;
    const float* RSR = WSF(p, WS_RSROW); bf16_t* BUF = WSB(p, WS_BUF);
    const float* mod = WSF(p, WS_MOD) + (size_t)l * 9 * 6144; const float* n2g = p.in[I_N2G] + (size_t)l * 1024;
    const int lane = F.lane;
    for (int row = F.gwave; row < T; row += F.nwave) {
        const int b = row / NP, q = row - b * NP; const bool isctx = q < NCTX;
        if (isctx && !want_ctx) continue;
        const float* mr = mod + (size_t)(isctx ? 8 : b) * 6144; const float* x = xrow(p, row);
        const float rs = RSR[row];
        const int d0 = t.pad_start[PE[2 * row]] + PPOS[2 * row], d1 = t.pad_start[PE[2 * row + 1]] + PPOS[2 * row + 1];
        if (lane == 0) { PD[2 * row] = d0; PD[2 * row + 1] = d1; }
        f32x4 xv[4];
#pragma unroll
        for (int j = 0; j < 4; ++j) xv[j] = *(const GAS f32x4*)(x + j * 256 + lane * 4);
#pragma unroll
        for (int j = 0; j < 4; ++j) { const int c = j * 256 + lane * 4;
            const f32x4 gg = *(const GAS f32x4*)(n2g + c), s1 = *(const GAS f32x4*)(mr + 4096 + c), s0 = *(const GAS f32x4*)(mr + 3072 + c); float y[4];
#pragma unroll
            for (int e = 0; e < 4; ++e) y[e] = xv[j][e] * rs * gg[e] * (1.f + s1[e]) + s0[e];
            u32x2 w; w.x = pk2(y[0], y[1]); w.y = pk2(y[2], y[3]);
            *(GAS u32x2*)(BUF + (size_t)d0 * 1024 + c) = w; *(GAS u32x2*)(BUF + (size_t)d1 * 1024 + c) = w; }
    }
}
__device__ __forceinline__ void p18_combine(const Params& p, const Frame& F, int l, bool want_ctx) {
    const int* PD = (const int*)(p.ws + WS_PAIR) + 3 * NPAIR_MAX; const float* PW = (const float*)(p.ws + WS_PAIR) + 2 * NPAIR_MAX;
    const bf16_t* YB = WSB(p, WS_YB);
    const float* mod = WSF(p, WS_MOD) + (size_t)l * 9 * 6144;
    const float* modn = mod + 9 * 6144;
    const float* n1g = p.in[I_N1G] + (size_t)(l + 1) * 1024;
    bf16_t* H = WSB(p, WS_H);
    const bool donorm = (l + 1 < DEPTH);
    const int lane = F.lane;
    for (int row = F.gwave; row < T; row += F.nwave) {
        const int b = row / NP, q = row - b * NP; const bool isctx = q < NCTX;
        if (isctx && !want_ctx) continue;
        const int mrow = isctx ? 8 : b;
        const float* g2 = mod + (size_t)mrow * 6144 + 5120;
        const int d0 = PD[2 * row], d1 = PD[2 * row + 1]; const float w0 = PW[2 * row], w1 = PW[2 * row + 1];
        float* x = xrow(p, row);
        f32x4 xv[4]; float ss = 0.f;
#pragma unroll
        for (int j = 0; j < 2; ++j) { const int c = j * 512 + lane * 8;
            float ya[8], yb[8]; unpack8(*(const GAS u32x4*)(YB + (size_t)d0 * 1024 + c), ya); unpack8(*(const GAS u32x4*)(YB + (size_t)d1 * 1024 + c), yb);
            f32x4 x0 = *(const GAS f32x4*)(x + c), x1 = *(const GAS f32x4*)(x + c + 4); const f32x4 ga = *(const GAS f32x4*)(g2 + c), gb = *(const GAS f32x4*)(g2 + c + 4);
#pragma unroll
            for (int e = 0; e < 4; ++e) { x0[e] += ga[e] * (w0 * ya[e] + w1 * yb[e]); x1[e] += gb[e] * (w0 * ya[4 + e] + w1 * yb[4 + e]); ss += x0[e] * x0[e] + x1[e] * x1[e]; }
            if (!p.dry) { *(GAS f32x4*)(x + c) = x0; *(GAS f32x4*)(x + c + 4) = x1; }
            xv[2 * j] = x0; xv[2 * j + 1] = x1; }
        if (donorm) {
#pragma unroll
            for (int m = 1; m < 64; m <<= 1) ss += shfl_xor_f(ss, m);
            const float rs = rsqrtf(ss * (1.f / 1024.f) + 1e-6f);
            const float* mr = modn + (size_t)mrow * 6144;
#pragma unroll
            for (int j = 0; j < 2; ++j) { const int c = j * 512 + lane * 8; float y[8];
#pragma unroll
                for (int hf = 0; hf < 2; ++hf) { const f32x4 gg = *(const GAS f32x4*)(n1g + c + 4 * hf), s1 = *(const GAS f32x4*)(mr + 1024 + c + 4 * hf), s0 = *(const GAS f32x4*)(mr + c + 4 * hf);
#pragma unroll
                    for (int e = 0; e < 4; ++e) y[4 * hf + e] = xv[2 * j + hf][e] * rs * gg[e] * (1.f + s1[e]) + s0[e]; }
                if (!p.dry) *(GAS u32x4*)(H + (size_t)row * 1024 + c) = pack8(y); } }
    }
}
constexpr size_t WS_REC = WS_WU; constexpr int REC_BYTES = 15360, RC_BYTES = 1792;
static_assert(WS_LW == WS_WU + (size_t)T * 1792 * 2 && WS_LA == WS_LW + (size_t)T * 1024 * 2 && WS_LG == WS_LA + (size_t)T * 1024 * 2, "WU|LW|LA contiguous");
static_assert(WS_REC + (size_t)NB * 8 * (NP / 16) * REC_BYTES <= WS_LG, "chunk records fit");
constexpr size_t WS_YCAT = WS_WU;
constexpr size_t WS_YS2 = WS_H;
constexpr int NCHUNK = NP / 16;
__device__ __forceinline__ int scan_pos(int s, int dir) { return dir ? (s < NCTX ? NCTX - 1 - s : NP + NCTX - 1 - s) : s; }
constexpr size_t WS_REC2 = WS_W1;
constexpr size_t WS_VS2 = AL(WS_REC2 + (size_t)NB * 8 * (NP / 16) * REC_BYTES);
constexpr size_t WS_BON = AL(WS_VS2 + SZ512);
static_assert(WS_BON + (size_t)2 * T * 8 * 4 <= WS_END_MIX, "records + V' + bonus fit in the W1 region");
__device__ __forceinline__ bf16x8 frag4(unsigned a, unsigned b, unsigned c, unsigned d) { u32x4 w; w.x = a; w.y = b; w.z = c; w.w = d; return __builtin_bit_cast(bf16x8, w); }
struct BuildRaw { u32x4 wu[3][2], halo[3]; };
__device__ __forceinline__ void build_load(BuildRaw& R, const Params& p, int ch, int lane) {
    const bf16_t* WU = WSB(p, WS_WU);
    const int bh = ch / NCHUNK, tb = ch - bh * NCHUNK, b = bh >> 3, h = bh & 7;
    const int q0 = 16 * tb; const size_t row0 = (size_t)b * NP + q0;
    const int lt = lane >> 2, lc = (lane & 3) * 16;
    const bool hasp = (q0 != 0) && (q0 != NCTX), hasn = (q0 + 16 != NCTX) && (q0 + 16 != NP);
#pragma unroll
    for (int part = 0; part < 3; ++part) { const bf16_t* src = WU + (row0 + lt) * 1792 + part * 512 + h * 64 + lc;
        R.wu[part][0] = *(const GAS u32x4*)src; R.wu[part][1] = *(const GAS u32x4*)(src + 8);
        u32x4 hv; hv.x = hv.y = hv.z = hv.w = 0u;
        if (lane < 16) { const bool nx = lane >= 8; const bool ok = nx ? hasn : hasp;
            if (ok) hv = *(const GAS u32x4*)(WU + (nx ? row0 + 16 : row0 - 1) * 1792 + part * 512 + h * 64 + (lane & 7) * 8); }
        R.halo[part] = hv; }
}
template <int DIR> __device__ __forceinline__ void build_dir(const Params& p, int l, int lane, LAS unsigned char* wl, const float (&rr)[16], const float (&kx)[16], const float (&vx)[16], const float (&kn)[16],
                                                            const u32x4 (&lwr)[2], const u32x4 (&lar)[2], size_t row0, int h, unsigned char* rec, float* BON) {
    constexpr int dir = DIR; constexpr int TP_ = 144;
    const int g = lane >> 4, li = lane & 15, lt = lane >> 2, lc = (lane & 3) * 16, cc = h * 64 + lane;
    LAS unsigned char* Ta = wl; LAS unsigned char* Tr = wl + 2304; LAS unsigned char* Tb = wl + 4608; LAS unsigned char* Tk = wl + 6912;
    constexpr int LO = DIR ? 11264 : 0;
    asm volatile("" ::: "memory");
    if (DIR == 0) {
        *(LAS u32x4*)(wl + lt * 128 + lc * 2) = lwr[0]; *(LAS u32x4*)(wl + lt * 128 + lc * 2 + 16) = lwr[1];
        *(LAS u32x4*)(wl + 2048 + lt * 128 + lc * 2) = lar[0]; *(LAS u32x4*)(wl + 2048 + lt * 128 + lc * 2 + 16) = lar[1]; }
    asm volatile("" ::: "memory");
        float X[16], Q[16], bhh[16], khh[16]; float Lc = 0.f;
        { const float w0c = ((const GAS float*)p.in[I_W0])[((size_t)l * 2 + dir) * 512 + cc], a0c = ((const GAS float*)p.in[I_A0])[((size_t)l * 2 + dir) * 512 + cc], kac = ((const GAS float*)p.in[I_KA])[l * 512 + cc], rkc = ((const GAS float*)p.in[I_RK])[l * 512 + cc];
          float bs0[8], bs1[8];
#pragma unroll
          for (int t = 0; t < 16; ++t) {
              constexpr int dummy_ = 0; (void)dummy_;
              const int tt = dir ? 15 - t : t; const int o = tt * 128 + lane * 2;
              const float lwv = bf2f(*(const LAS bf16_t*)(wl + LO + o)), lav = bf2f(*(const LAS bf16_t*)(wl + LO + 2048 + o));
              const float r = rr[tt], kp = kx[tt], kkn = kn[tt];
              const float asig = sigmoidf_(a0c + lav), lw = -0.6065306597126334f * sigmoidf_(w0c + lwv);
              const float k = kp * (1.f + (asig - 1.f) * kac), bb = kkn * asig, a = -kkn;
              if (t < 8) bs0[t] = r * k * rkc; else bs1[t - 8] = r * k * rkc;
              const float Lx = Lc; Lc += lw;
              const float at = a * __expf(Lx), rt = r * __expf(Lc), en = __expf(-Lc);
              X[t] = at; Q[t] = rt; bhh[t] = bb * en; khh[t] = k * en;
          }
          const float u0 = reduce8(bs0, lane), u1 = reduce8(bs1, lane);
          if ((lane & 7) == 0) { const int t = lane >> 3; const int tk0 = dir ? 15 - t : t, tk1 = dir ? 7 - t : 8 + t; ((GAS float*)BON)[(row0 + tk0) * 8 + h] = u0; ((GAS float*)BON)[(row0 + tk1) * 8 + h] = u1; } }
        asm volatile("" ::: "memory");
#pragma unroll
        for (int t = 0; t < 16; ++t) {
            *(LAS bf16_t*)(Ta + t * TP_ + lane * 2) = (bf16_t)f2bf(X[t]); *(LAS bf16_t*)(Tr + t * TP_ + lane * 2) = (bf16_t)f2bf(Q[t]);
            *(LAS bf16_t*)(Tb + t * TP_ + lane * 2) = (bf16_t)f2bf(bhh[t]); *(LAS bf16_t*)(Tk + t * TP_ + lane * 2) = (bf16_t)f2bf(khh[t]);
        }
        const float gC = __expf(Lc);
#pragma unroll
        for (int t = 0; t < 16; ++t) { bhh[t] *= gC; khh[t] *= gC; }
#pragma unroll
        for (int q4 = 0; q4 < 4; ++q4) *(GAS float*)(rec + 8192 + q4 * RC_BYTES + 1536 + lane * 4) = gC;
#pragma unroll
        for (int gg = 0; gg < 4; ++gg) { u32x4 w; w.x = pk2(bhh[4 * gg], bhh[4 * gg + 1]); w.y = pk2(bhh[4 * gg + 2], bhh[4 * gg + 3]); w.z = pk2(khh[4 * gg], khh[4 * gg + 1]); w.w = pk2(khh[4 * gg + 2], khh[4 * gg + 3]);
            *(GAS u32x4*)(rec + 4096 + (lane * 32 + gg * 8) * 2) = w; }
        f32x4 mab = {0.f, 0.f, 0.f, 0.f}, makT = mab, mrbT = mab, mrkT = mab;
#pragma unroll
        for (int ks = 0; ks < 2; ++ks) { const int o = li * TP_ + (32 * ks + 8 * g) * 2;
            const bf16x8 fa = ld_frag(Ta + o), fr = ld_frag(Tr + o), fb = ld_frag(Tb + o), fk = ld_frag(Tk + o);
            mab = MFMA16(fa, fb, mab); makT = MFMA16(fk, fa, makT); mrbT = MFMA16(fb, fr, mrbT); mrkT = MFMA16(fk, fr, mrkT); }
        LAS float* MT = (LAS float*)(wl + 15360);
        { f32x4 m;
#pragma unroll
          for (int r = 0; r < 4; ++r) { const int s = 4 * g + r; m[r] = li < s ? mab[r] : 0.f; makT[r] = s < li ? makT[r] : 0.f; mrbT[r] = s <= li ? mrbT[r] : 0.f; mrkT[r] = s <= li ? mrkT[r] : 0.f; }
          *(LAS f32x4*)(MT + li * 16 + 4 * g) = m; }
        asm volatile("" ::: "memory");
        float TI[16];
        TI[15] = li == 15 ? 1.f : 0.f;
        { f32x4 nb[4];
          nb[3] = *(const LAS f32x4*)(MT + 14 * 16 + 12); nb[0] = nb[1] = nb[2] = nb[3];
#pragma unroll
          for (int c = 14; c >= 0; --c) { f32x4 na[4];
#pragma unroll
              for (int s4 = 0; s4 < 4; ++s4) na[s4] = nb[s4];
              if (c > 0) {
#pragma unroll
                  for (int s4 = 0; s4 < 4; ++s4) if (4 * s4 + 3 > c - 1) nb[s4] = *(const LAS f32x4*)(MT + (c - 1) * 16 + 4 * s4); }
              float acc = li == c ? 1.f : 0.f;
#pragma unroll
              for (int s4 = 0; s4 < 4; ++s4)
#pragma unroll
                  for (int e = 0; e < 4; ++e) { const int s = 4 * s4 + e; if (s > c) acc = __builtin_fmaf(TI[s], na[s4][e], acc); }
              asm volatile("" : "+v"(acc) :: "memory");
              TI[c] = acc; } }
        unsigned tw0, tw1;
        { float te[4];
#pragma unroll
          for (int e = 0; e < 4; ++e) { float a0 = TI[e], a1 = TI[4 + e], a2 = TI[8 + e], a3 = TI[12 + e]; asm volatile("" : "+v"(a0), "+v"(a1), "+v"(a2), "+v"(a3));
              te[e] = g == 0 ? a0 : (g == 1 ? a1 : (g == 2 ? a2 : a3)); }
          tw0 = pk2(te[0], te[1]); tw1 = pk2(te[2], te[3]); }
        const unsigned ak0 = DIR ? pk2(makT[3], makT[2]) : pk2(makT[0], makT[1]), ak1 = DIR ? pk2(makT[1], makT[0]) : pk2(makT[2], makT[3]);
        const unsigned rk0 = DIR ? pk2(mrkT[3], mrkT[2]) : pk2(mrkT[0], mrkT[1]), rk1 = DIR ? pk2(mrkT[1], mrkT[0]) : pk2(mrkT[2], mrkT[3]);
        const unsigned rb0 = pk2(mrbT[0], mrbT[1]), rb1 = pk2(mrbT[2], mrbT[3]);
        const unsigned id0 = (li == 4 * g ? 0x3F80u : 0u) | (li == 4 * g + 1 ? 0x3F800000u : 0u), id1 = (li == 4 * g + 2 ? 0x3F80u : 0u) | (li == 4 * g + 3 ? 0x3F800000u : 0u);
        const bf16x8 aT = frag4(tw0, tw1, 0u, 0u), aAK = frag4(ak0, ak1, 0u, 0u), aRBI = frag4(rb0, rb1, id0, id1), aRBK = frag4(rb0, rb1, rk0, rk1);
        const int q4 = li >> 2, p4 = li & 3;
        const f32x4 zero4 = {0.f, 0.f, 0.f, 0.f};
        const LAS unsigned char* Svr = wl + 9216 + ((DIR ? 12 - 4 * g : 4 * g) + q4) * 128 + p4 * 8;
        unsigned char* rcu = rec + 8192 + 512 + li * 32 + g * 8;
#pragma unroll
        for (int it = 0; it < 4; ++it) {
            const u32x2 tv = __builtin_bit_cast(u32x2, tr_read(Svr + it * 32));
            const f32x4 W = MFMA16(aAK, frag4(tv.x, tv.y, 0u, 0u), zero4);
            const f32x4 U = MFMA16(aT, frag4(pk2(W[0], W[1]), pk2(W[2], W[3]), 0u, 0u), zero4);
            u32x2 uw; uw.x = pk2(U[0], U[1]); uw.y = pk2(U[2], U[3]);
            const f32x4 Y = MFMA16(aRBK, frag4(uw.x, uw.y, tv.x, tv.y), zero4);
            u32x2 yw; yw.x = pk2(Y[0], Y[1]); yw.y = pk2(Y[2], Y[3]);
            *(GAS u32x2*)(rcu + it * RC_BYTES) = uw; *(GAS u32x2*)(rcu + it * RC_BYTES + 512) = yw; }
        u32x2 ahw[4], qw[4];
        { const LAS unsigned char* Tar = Ta + (4 * g + q4) * TP_ + p4 * 8; const LAS unsigned char* Trr = Tr + (4 * g + q4) * TP_ + p4 * 8;
#pragma unroll
          for (int jt = 0; jt < 4; ++jt) {
              const u32x2 ta = __builtin_bit_cast(u32x2, tr_read(Tar + jt * 32)), tr = __builtin_bit_cast(u32x2, tr_read(Trr + jt * 32));
              const f32x4 A = MFMA16(aT, frag4(ta.x, ta.y, 0u, 0u), zero4);
              ahw[jt].x = pk2(A[0], A[1]); ahw[jt].y = pk2(A[2], A[3]);
              const f32x4 Qv = MFMA16(aRBI, frag4(ahw[jt].x, ahw[jt].y, tr.x, tr.y), zero4);
              qw[jt].x = pk2(Qv[0], Qv[1]); qw[jt].y = pk2(Qv[2], Qv[3]); } }
        asm volatile("" ::: "memory");
#pragma unroll
        for (int jt = 0; jt < 4; ++jt) { const int pjv = 32 * (jt >> 1) + q4 * 8 + (jt & 1) * 4 + p4;
            LAS unsigned char* da = wl + 4096 + ((4 * g) * 64 + pjv) * 2; LAS unsigned char* dq = da + 2048;
            *(LAS bf16_t*)(da) = (bf16_t)(ahw[jt].x & 0xffffu); *(LAS bf16_t*)(da + 128) = (bf16_t)(ahw[jt].x >> 16); *(LAS bf16_t*)(da + 256) = (bf16_t)(ahw[jt].y & 0xffffu); *(LAS bf16_t*)(da + 384) = (bf16_t)(ahw[jt].y >> 16);
            *(LAS bf16_t*)(dq) = (bf16_t)(qw[jt].x & 0xffffu); *(LAS bf16_t*)(dq + 128) = (bf16_t)(qw[jt].x >> 16); *(LAS bf16_t*)(dq + 256) = (bf16_t)(qw[jt].y & 0xffffu); *(LAS bf16_t*)(dq + 384) = (bf16_t)(qw[jt].y >> 16); }
        asm volatile("" ::: "memory");
#pragma unroll
        for (int k = 0; k < 4; ++k) *(GAS u32x4*)(rec + k * 1024 + lane * 16) = *(const LAS u32x4*)(wl + 4096 + k * 1024 + lane * 16);
        unsigned char* rc = rec + 8192 + g * RC_BYTES + li * 32;
#pragma unroll
        for (int hf = 0; hf < 2; ++hf) { u32x4 w;
#define VS_(t_) vx[DIR ? 15 - (t_) : (t_)]
            w.x = pk2(VS_(8 * hf), VS_(8 * hf + 1)); w.y = pk2(VS_(8 * hf + 2), VS_(8 * hf + 3)); w.z = pk2(VS_(8 * hf + 4), VS_(8 * hf + 5)); w.w = pk2(VS_(8 * hf + 6), VS_(8 * hf + 7)); *(GAS u32x4*)(rc + hf * 16) = w;
#undef VS_
        }
}
__device__ __forceinline__ void p6c_rwkv_build(const Params& p, const Frame& F, int l, int half) {
    unsigned char* REC = p.ws + WS_REC2; bf16_t* VSo = WSB(p, WS_VS2); float* BON = WSF(p, WS_BON);
    constexpr int TP_ = 144;
    BuildRaw cur, nxt;
    if (F.gwave < 32 * NCHUNK) build_load(cur, p, half * 32 * NCHUNK + F.gwave, F.lane);
    const bool spread = F.G == 256; int rnd = 0;
    for (int chl = F.gwave; chl >= 0 && chl < 32 * NCHUNK; ++rnd) { const int ch = half * 32 * NCHUNK + chl;
        const int chn = spread ? (rnd < 3 ? chl + 2048 : (rnd == 3 && F.wave < 2 ? 8192 + 2 * F.bid + F.wave : -1)) : (chl + F.nwave < 32 * NCHUNK ? chl + F.nwave : -1);
        int lane = F.lane; asm volatile("" : "+v"(lane));
        const int g = lane >> 4, li = lane & 15;
        LAS unsigned char* wl = F.lds + F.wave * 17408;
        LAS unsigned char* Ta = wl; LAS unsigned char* Tr = wl + 2304; LAS unsigned char* Tb = wl + 4608; LAS unsigned char* Tk = wl + 6912;
        LAS float* M = (LAS float*)wl;
        LAS unsigned char* Sv = wl + 9216;
        const int pj = (lane & 32) + ((lane & 15) >> 2) * 8 + ((lane >> 4) & 1) * 4 + (lane & 3);
        const int bh = ch / NCHUNK, tb = ch - bh * NCHUNK, b = bh >> 3, h = bh & 7;
        const int q0 = 16 * tb; const size_t row0 = (size_t)b * NP + q0;
        const int lt = lane >> 2, lc = (lane & 3) * 16;
#pragma unroll
        for (int part = 0; part < 3; ++part) {
            *(LAS u32x4*)(wl + part * 2304 + (lt + 1) * 128 + lc * 2) = cur.wu[part][0]; *(LAS u32x4*)(wl + part * 2304 + (lt + 1) * 128 + lc * 2 + 16) = cur.wu[part][1];
            if (lane < 16) *(LAS u32x4*)(wl + part * 2304 + (lane >= 8 ? 17 * 128 : 0) + (lane & 7) * 16) = cur.halo[part]; }
        const int cc = h * 64 + lane;
        u32x4 lwr[2], lar[2];
        { const bf16_t* LWg = WSB(p, WS_LW); const bf16_t* LAg = WSB(p, WS_LA);
          const bf16_t* s1p = LWg + (row0 + lt) * 1024 + h * 64 + lc; const bf16_t* s2p = LAg + (row0 + lt) * 1024 + h * 64 + lc;
          lwr[0] = *(const GAS u32x4*)s1p; lwr[1] = *(const GAS u32x4*)(s1p + 8); lar[0] = *(const GAS u32x4*)s2p; lar[1] = *(const GAS u32x4*)(s2p + 8);
          *(LAS u32x4*)(wl + 11264 + lt * 128 + lc * 2) = *(const GAS u32x4*)(s1p + 512); *(LAS u32x4*)(wl + 11264 + lt * 128 + lc * 2 + 16) = *(const GAS u32x4*)(s1p + 520);
          *(LAS u32x4*)(wl + 13312 + lt * 128 + lc * 2) = *(const GAS u32x4*)(s2p + 512); *(LAS u32x4*)(wl + 13312 + lt * 128 + lc * 2 + 16) = *(const GAS u32x4*)(s2p + 520); }
        float rr[16], kx[16], vx[16], kn[16];
        { const float* mu0 = p.in[I_MU] + (size_t)l * 2 * 1792, *mu1 = mu0 + 1792;
          const float kkc = ((const GAS float*)p.in[I_KK])[l * 512 + cc];
#pragma unroll
          for (int part = 0; part < 3; ++part) { const float m0 = ((const GAS float*)mu0)[part * 512 + cc], m1 = ((const GAS float*)mu1)[part * 512 + cc];
              float raw[18];
#pragma unroll
              for (int t = 0; t < 18; ++t) raw[t] = bf2f(*(const LAS bf16_t*)(wl + part * 2304 + t * 128 + lane * 2));
#pragma unroll
              for (int t = 0; t < 16; ++t) { const float u = raw[t + 1], sh = u + (raw[t] - u) * m0 + (raw[t + 2] - u) * m1;
                  if (part == 0) rr[t] = sh; else if (part == 1) kx[t] = sh; else vx[t] = sh; } }
          float s0[8], s1[8];
#pragma unroll
          for (int t = 0; t < 8; ++t) { kn[t] = kx[t] * kkc; kn[t + 8] = kx[t + 8] * kkc; s0[t] = kn[t] * kn[t]; s1[t] = kn[t + 8] * kn[t + 8]; }
          const float t0 = reduce8(s0, lane), t1 = reduce8(s1, lane);
#pragma unroll
          for (int t = 0; t < 8; ++t) { kn[t] *= rsqrtf(fmaxf(__shfl(t0, t * 8, 64), 1e-12f)); kn[t + 8] *= rsqrtf(fmaxf(__shfl(t1, t * 8, 64), 1e-12f)); }
          asm volatile("" ::: "memory");
          {
#pragma unroll
              for (int t = 0; t < 16; ++t) *(LAS bf16_t*)(Sv + t * 128 + lane * 2) = (bf16_t)f2bf(vx[t]);
              asm volatile("" ::: "memory");
              bf16_t* vo = VSo + (row0 + lt) * 512 + h * 64 + lc; *(GAS u32x4*)vo = *(const LAS u32x4*)(Sv + lt * 128 + lc * 2); *(GAS u32x4*)(vo + 8) = *(const LAS u32x4*)(Sv + lt * 128 + lc * 2 + 16); }
          }
        { const int bhl = bh & 31;
          build_dir<0>(p, l, lane, wl, rr, kx, vx, kn, lwr, lar, row0, h, REC + ((size_t)(bhl * 2 + 0) * NCHUNK + tb) * REC_BYTES, BON);
          int lane2 = lane; asm volatile("" : "+v"(lane2) :: "memory");
          { if (chn >= 0) build_load(nxt, p, half * 32 * NCHUNK + chn, lane2); else nxt = cur; }
          build_dir<1>(p, l, lane2, wl, rr, kx, vx, kn, lwr, lar, row0, h, REC + ((size_t)(bhl * 2 + 1) * NCHUNK + (tb < 16 ? 15 - tb : 287 - tb)) * REC_BYTES, BON + (size_t)T * 8); }
        cur = nxt; chl = chn;
    }
}
constexpr int SC_SLOT = 10240, SC_NSLOT = 13, SC_DEPTH = 6;
__device__ __forceinline__ void scan_dma(const unsigned char* rec, int iq, LAS unsigned char* slot, int lane) {
    const unsigned char* g0 = rec + lane * 16;
#pragma unroll
    for (int k = 0; k < 8; ++k) __builtin_amdgcn_global_load_lds((const unsigned*)(g0 + k * 1024), (LAS unsigned*)(slot + k * 1024), 16, 0, 0);
    const unsigned char* g1 = rec + 8192 + iq * RC_BYTES + lane * 16;
    __builtin_amdgcn_global_load_lds((const unsigned*)g1, (LAS unsigned*)(slot + 8192), 16, 0, 0);
    if (lane < 48) __builtin_amdgcn_global_load_lds((const unsigned*)(g1 + 1024), (LAS unsigned*)(slot + 9216), 16, 0, 0);
}
__device__ __forceinline__ unsigned lds_ld(volatile LAS unsigned* q) { return *q; }
__device__ __forceinline__ void p6b_rwkv_scan(const Params& p, const Frame& F, int half) {
    volatile LAS unsigned* ctl = (volatile LAS unsigned*)(F.lds + MISC_OFF + 1536);
    if (F.tid < 4) ctl[F.tid] = 0u;
    __syncthreads();
    if (F.wave > 3) return;
    const int lane = F.lane, g = lane >> 4, li = lane & 15;
    const int task = (F.G == 256) ? (F.bid & 7) * 32 + (F.bid >> 3) : F.bid;
    if (task >= 256) return;
    const int bhl = task >> 3, dir = (task >> 2) & 1, iq = task & 3, b = 4 * half + (bhl >> 3), h = bhl & 7;
    const unsigned char* rec0 = p.ws + WS_REC2 + (size_t)(bhl * 2 + dir) * NCHUNK * REC_BYTES;
    LAS unsigned char* SBUF = F.lds + SC_NSLOT * SC_SLOT;
    if (F.wave == 1 || F.wave == 2) {
        const int hh = F.wave - 1;
        asm volatile("s_waitcnt vmcnt(0)" ::: "memory");
#pragma unroll 1
        for (int n = 0; n < NCHUNK / 2; ++n) { const int k = 2 * n + hh;
            while ((int)lds_ld(ctl + 2) + SC_NSLOT <= k) __builtin_amdgcn_s_sleep(1);
            scan_dma(rec0 + (size_t)k * REC_BYTES, iq, F.lds + (k % SC_NSLOT) * SC_SLOT, lane);
            if (n >= 4) { asm volatile("s_waitcnt vmcnt(40)" ::: "memory"); if (lane == 0) ctl[hh] = (unsigned)(n - 3); } }
        asm volatile("s_waitcnt vmcnt(0)" ::: "memory");
        if (lane == 0) ctl[hh] = (unsigned)(NCHUNK / 2);
        return;
    }
    if (F.wave == 3) {
        bf16_t* YS = WSB(p, WS_YS2) + (size_t)dir * T * 512;
        const int rstep = dir ? -512 : 512;
#pragma unroll 1
        for (int c = 0; c < NCHUNK; ++c) {
            while (lds_ld(ctl + 3) <= (unsigned)c) __builtin_amdgcn_s_sleep(1);
            asm volatile("" ::: "memory");
            const LAS unsigned char* sl = F.lds + (c % SC_NSLOT) * SC_SLOT; const LAS unsigned char* sp = SBUF + (c & 3) * 2048 + lane * 16;
            const bf16x8 sb0 = ld_frag(sp), sb1 = ld_frag(sp + 1024);
            const bf16x8 q0 = ld_frag(sl + 2048 + (li * 64 + g * 8) * 2), q1 = ld_frag(sl + 2048 + (li * 64 + 32 + g * 8) * 2);
            const u32x2 y0 = *(const LAS u32x2*)(sl + 8192 + 1024 + (li * 16 + 4 * g) * 2);
            f32x4 Y = {lo16(y0.x), hi16(y0.x), lo16(y0.y), hi16(y0.y)};
            Y = MFMA16(q0, sb0, Y); Y = MFMA16(q1, sb1, Y);
            asm volatile("s_waitcnt lgkmcnt(0)" ::: "memory");
            if (lane == 0) ctl[2] = (unsigned)(c + 1);
            bf16_t* yp = YS + ((size_t)(b * NP + scan_pos(16 * c + 4 * g, dir))) * 512 + h * 64 + 16 * iq + li;
#pragma unroll
            for (int r = 0; r < 4; ++r) ((GAS bf16_t*)yp)[r * rstep] = (bf16_t)f2bf(Y[r]);
        }
        return;
    }
    f32x4 st[4];
#pragma unroll
    for (int jt = 0; jt < 4; ++jt) st[jt] = (f32x4){0.f, 0.f, 0.f, 0.f};
    struct Ops { bf16x8 ah[2], bk[4]; f32x4 gc[4]; u32x2 vt, u0; };
#define SCAN_WAIT(c_) do { const unsigned need_ = (unsigned)((c_) >> 1) + 1u; volatile LAS unsigned* lw_ = ctl + ((c_) & 1); while (lds_ld(lw_) < need_) __builtin_amdgcn_s_sleep(1); asm volatile("" ::: "memory"); } while (0)
#define SCAN_WAIT2(c_) do { const unsigned n1_ = (unsigned)((c_) >> 1) + 1u, n0_ = ((c_) + 2 < NCHUNK) ? (unsigned)((c_) >> 1) + 2u : 0u; \
        for (;;) { const u32x4 fl_ = *(volatile LAS u32x4*)ctl; if (fl_.x >= n0_ && fl_.y >= n1_ && (int)fl_.z + 1 >= (c_)) break; __builtin_amdgcn_s_sleep(1); } asm volatile("" ::: "memory"); } while (0)
#define SCAN_LOAD(o_, c_) do { const LAS unsigned char* sl_ = F.lds + ((c_) % SC_NSLOT) * SC_SLOT; \
        _Pragma("unroll") for (int ks = 0; ks < 2; ++ks) o_.ah[ks] = ld_frag(sl_ + (li * 64 + ks * 32 + g * 8) * 2); \
        _Pragma("unroll") for (int jt = 0; jt < 4; ++jt) { o_.bk[jt] = ld_frag(sl_ + 4096 + ((16 * jt + li) * 32 + g * 8) * 2); o_.gc[jt] = *(const LAS f32x4*)(sl_ + 8192 + 1536 + (16 * jt + 4 * g) * 4); } \
        o_.vt = *(const LAS u32x2*)(sl_ + 8192 + (li * 16 + 4 * g) * 2); o_.u0 = *(const LAS u32x2*)(sl_ + 8192 + 512 + (li * 16 + 4 * g) * 2); } while (0)
    Ops o0, o1;
    SCAN_WAIT(0);
    SCAN_LOAD(o0, 0);
#define SCAN_STEP(cur_, nxt_, c_) do { \
        const bf16x8 sb0 = pack_frag(st[0], st[1]), sb1 = pack_frag(st[2], st[3]); \
        { LAS unsigned char* sp_ = SBUF + ((c_) & 3) * 2048 + lane * 16; *(LAS bf16x8*)sp_ = sb0; *(LAS bf16x8*)(sp_ + 1024) = sb1; } \
        if (lane == 0) ctl[3] = (unsigned)((c_) + 1); \
        f32x4 U = {lo16(cur_.u0.x), hi16(cur_.u0.x), lo16(cur_.u0.y), hi16(cur_.u0.y)}; \
        U = MFMA16(cur_.ah[0], sb0, U); U = MFMA16(cur_.ah[1], sb1, U); \
        asm volatile("" ::: "memory"); \
        if ((c_) + 1 < NCHUNK) { if (((c_) & 1) == 0) SCAN_WAIT2(c_); SCAN_LOAD(nxt_, (c_) + 1); } \
        asm volatile("" ::: "memory"); \
        u32x4 uvw; uvw.x = pk2(U[0], U[1]); uvw.y = pk2(U[2], U[3]); uvw.z = cur_.vt.x; uvw.w = cur_.vt.y; \
        const bf16x8 uv = __builtin_bit_cast(bf16x8, uvw); \
        _Pragma("unroll") for (int jt = 0; jt < 4; ++jt) st[jt] = MFMA16(cur_.bk[jt], uv, st[jt] * cur_.gc[jt]); \
        asm volatile("s_waitcnt lgkmcnt(0)" ::: "memory"); } while (0)
#pragma unroll 1
    for (int c = 0; c < NCHUNK; c += 2) { SCAN_STEP(o0, o1, c); SCAN_STEP(o1, o0, c + 1); }
#undef SCAN_STEP
#undef SCAN_WAIT
#undef SCAN_WAIT2
#undef SCAN_LOAD
}

__device__ __forceinline__ void p7_rwkv_readout(const Params& p, const Frame& F, int l) {
    const bf16_t* VS = WSB(p, WS_VS2); const float* BON0 = WSF(p, WS_BON); const float* BON1 = BON0 + (size_t)T * 8;
    const bf16_t* YS0 = WSB(p, WS_H); const bf16_t* YS1 = YS0 + (size_t)T * 512;
    const bf16_t* LG = WSB(p, WS_LG); bf16_t* YW = WSB(p, WS_WU) + 1024;
    const int lane = F.lane, c0 = lane * 8;
    const float* ln_g = p.in[I_LNG] + l * 512, *ln_b = p.in[I_LNB] + l * 512;
    for (int row = F.gwave; row < T; row += F.nwave) {
        const size_t off = (size_t)row * 512 + c0;
        float y0[8], y1[8], v[8], g[8];
        unpack8(*(const GAS u32x4*)(YS0 + off), y0); unpack8(*(const GAS u32x4*)(YS1 + off), y1); unpack8(*(const GAS u32x4*)(VS + off), v); unpack8(*(const GAS u32x4*)(LG + off), g);
        const float bs = BON0[(size_t)row * 8 + (lane >> 3)] + BON1[(size_t)row * 8 + (lane >> 3)];
        float y[8], sm = 0.f;
#pragma unroll
        for (int e = 0; e < 8; ++e) { y[e] = y0[e] + y1[e]; sm += y[e]; }
        sm += shfl_xor_f(sm, 1); sm += shfl_xor_f(sm, 2); sm += shfl_xor_f(sm, 4);
        const float mean = sm * (1.f / 64.f); float vs = 0.f;
#pragma unroll
        for (int e = 0; e < 8; ++e) { const float d = y[e] - mean; vs += d * d; }
        vs += shfl_xor_f(vs, 1); vs += shfl_xor_f(vs, 2); vs += shfl_xor_f(vs, 4);
        const float rstd = rsqrtf(vs * (1.f / 64.f) + 64e-5f);
        float lg8[8], lb8[8]; *(f32x4*)lg8 = *(const GAS f32x4*)(ln_g + c0); *(f32x4*)(lg8 + 4) = *(const GAS f32x4*)(ln_g + c0 + 4); *(f32x4*)lb8 = *(const GAS f32x4*)(ln_b + c0); *(f32x4*)(lb8 + 4) = *(const GAS f32x4*)(ln_b + c0 + 4);
        float o[8];
#pragma unroll
        for (int e = 0; e < 8; ++e) o[e] = ((y[e] - mean) * rstd * lg8[e] + lb8[e] + bs * v[e]) * g[e];
        *(GAS u32x4*)(YW + (size_t)row * 1536 + c0) = pack8(o);
    }
}
constexpr int NPHASE = 21;
constexpr int PARAMS_OFF = MISC_OFF + 2048;
__device__ __forceinline__ unsigned rfl(unsigned v) { return (unsigned)__builtin_amdgcn_readfirstlane((int)v); }
template <class Tp> __device__ __forceinline__ Tp* rfl_ptr(Tp* q) { const unsigned long long a = (unsigned long long)q; const unsigned lo = rfl((unsigned)a), hi = rfl((unsigned)(a >> 32)); return (Tp*)(((unsigned long long)hi << 32) | lo); }
__device__ __forceinline__ float rfl_f(float v) { return __builtin_bit_cast(float, rfl(__builtin_bit_cast(unsigned, v))); }
__device__ __forceinline__ Params load_params(LAS unsigned char* lds) {
    unsigned off = PARAMS_OFF; asm volatile("" : "+s"(off) :: "memory");
    const LAS Params* lp = (const LAS Params*)(lds + off);
    Params q;
#pragma unroll
    for (int i = 0; i < 33; ++i) q.in[i] = rfl_ptr(lp->in[i]);
    q.out = rfl_ptr(lp->out); q.ws = rfl_ptr(lp->ws);
#pragma unroll
    for (int i = 0; i < 16; ++i) q.invA[i] = rfl_f(lp->invA[i]);
#pragma unroll
    for (int i = 0; i < 32; ++i) q.invR[i] = rfl_f(lp->invR[i]);
    q.ph_lo = 0; q.ph_hi = 0; q.l_lo = 0; q.l_hi = 0; q.fused = 0; q.do_pro = 0; q.dry = (int)rfl((unsigned)lp->dry); q.pad2 = 0;
    return q;
}
__device__ __forceinline__ unsigned char* load_ws(LAS unsigned char* lds) {
    unsigned off = PARAMS_OFF; asm volatile("" : "+s"(off) :: "memory");
    const LAS Params* lp = (const LAS Params*)(lds + off);
    return rfl_ptr(lp->ws);
}
__device__ __forceinline__ Frame make_frame(LAS unsigned char* lds) {
    Frame F; int tid = threadIdx.x; asm volatile("" : "+v"(tid));
    int bid = blockIdx.x, G = gridDim.x; asm volatile("" : "+s"(bid), "+s"(G));
    F.lds = lds; F.tid = tid; F.lane = tid & 63; F.wave = __builtin_amdgcn_readfirstlane(tid >> 6);
    F.G = G; F.bid = bid; F.gwave = bid * NWAVES + F.wave; F.nwave = G * NWAVES;
    return F;
}
#define SEAM() do { if (fused) { XcdBarrier bar_; bar_.bar = (unsigned*)(load_ws(lds0) + WS_CTL) + CW_BAR; bar_.x = xb_xcc_id(); bar_.st = misc; xcd_barrier(bar_); } } while (0)
#ifndef MK_PHASES
#define MK_PHASES 0xFFFFFFFFu
#endif
#define IN(k) (((MK_PHASES >> (k)) & 1u) && ph_lo <= (k) && (k) < ph_hi)
#define EN(k) ((MK_PHASES >> (k)) & 1u)
#define LP() const Frame F = make_frame(lds0); const Params p = load_params(lds0)

__device__ __forceinline__ void layer_program(LAS unsigned char* const lds0, volatile LAS unsigned* misc, const int l, const int ph_lo, const int ph_hi, const int fused) {
        const bool want_ctx = l < DEPTH - 1;
        if (IN(0) && l == 0) { LP(); p1_cvt_norm1(p, F, l); SEAM(); }
        if (IN(1)) { LP();
            pg8::Gemm g{WSB(p, WS_H), WSB(p, WS_BTIN), T, 7680, 1024}; pg8::StaticOrder S; S.init(T, 7680, F.G, F.bid);
            pg8::EpiInproj E{p.ws};
            pg8::gemm_phase<pg8::EpiInproj, pg8::StaticOrder, PG8_ALIGN, PG8_SP2>(F.lds, g, S, E);
            SEAM(); }
        if (IN(2)) { LP(); p3_prep(p, F, l); SEAM(); }
        if (IN(3)) { LP();
            pg8::Gemm g{WSB(p, WS_H), WSB(p, WS_BTLORA), T, 2560, 256}; pg8::StaticOrder S; S.init(T, 2560, F.G, F.bid);
            pg8::EpiLora E{p.ws};
            pg8::gemm_phase<pg8::EpiLora, pg8::StaticOrder, PG8_ALIGN, PG8_SP2>(F.lds, g, S, E);
            SEAM(); }
        if (IN(5)) { LP(); p6c_rwkv_build(p, F, l, 0); SEAM(); }
        if (IN(6)) { LP(); p6b_rwkv_scan(p, F, 0); SEAM(); }
        if (IN(7)) { LP(); p6c_rwkv_build(p, F, l, 1); SEAM(); }
        if (IN(8)) { LP(); p6b_rwkv_scan(p, F, 1); SEAM(); }
        if (IN(9)) { LP(); p7_rwkv_readout(p, F, l); }
        if (IN(10)) { LP(); p8f_ret_kvscan(p, F, l); SEAM(); }
        if (IN(12)) { LP(); p10_ret_out(p, F, l, want_ctx); }
        if (IN(13)) { LP(); p11_attention(p, F, want_ctx); SEAM(); }
        if (IN(14)) { LP();
            pg8::Gemm g{WSB(p, WS_YCAT), WSB(p, WS_BTBR), T, 1024, 1536};
            pg8::EpiMergeK E{WSB(p, WS_GL), WSB(p, WS_H)};
            if (want_ctx) { pg8::StaticOrder S; S.init(T, 1024, F.G, F.bid); pg8::gemm_phase<pg8::EpiMergeK, pg8::StaticOrder, PG8_ALIGN, PG8_SP2>(F.lds, g, S, E); }
            else { pg8::LatentOrder S; S.init(1024, F.G, F.bid); pg8::gemm_phase<pg8::EpiMergeK, pg8::LatentOrder, PG8_ALIGN, PG8_SP2>(F.lds, g, S, E); }
            __syncthreads();
            cvt_run<true>(p, F, l, (LAS float*)F.lds, (want_ctx && F.G == 256) ? 32 : 0);
            SEAM(); }
        if (IN(15)) { LP();
            pg8::Gemm g{WSB(p, WS_H), WSB(p, WS_BTOUT), T, 1024, 1024};
            pg8::EpiOut E{p.out, WSF(p, WS_CTXRES), WSF(p, WS_MOD) + (size_t)l * 9 * 6144, p.dry, l == 0 ? p.in[I_X] : p.out, l == 0 ? p.in[I_CTX] : WSF(p, WS_CTXRES)};
            if (want_ctx) { pg8::StaticOrder S; S.init(T, 1024, F.G, F.bid); pg8::gemm_phase<pg8::EpiOut, pg8::StaticOrder, PG8_ALIGN, PG8_SP2>(F.lds, g, S, E); }
            else { pg8::LatentOrder S; S.init(1024, F.G, F.bid); pg8::gemm_phase<pg8::EpiOut, pg8::LatentOrder, PG8_ALIGN, PG8_SP2>(F.lds, g, S, E); }
            if (l + 1 < DEPTH && F.G == 256) { __syncthreads(); cvt_run<false>(p, F, l + 1, (LAS float*)F.lds, 32, 0, 576); }
            SEAM(); }
        if (IN(16)) { LP(); p14_norm2_router(p, F, l, want_ctx); SEAM(); }
        if (IN(17)) { LP(); p15_scatter(p, F, l, want_ctx); SEAM(); }
        if (IN(18)) { LP();
            moe_build_tab(p, F, l);
            pg8::Gemm g{WSB(p, WS_BUF), WSB(p, WS_BT1), MOE_NBLK * 256, 1024, 1024};
            typedef pg8::MoeOrder<(size_t)1024 * 1024 * 2> Ord; Ord S{F.G, F.bid, (const PG8_LAS int*)(F.lds + MISC_OFF + 64)};
            pg8::EpiSwiGLU E{WSB(p, WS_HB)};
            pg8::gemm_phase<pg8::EpiSwiGLU, Ord, PG8_ALIGN, PG8_SP2>(F.lds, g, S, E);
            SEAM(); }
        if (IN(19)) { LP();
            moe_build_tab(p, F, l);
            pg8::Gemm g{WSB(p, WS_HB), WSB(p, WS_BT2), MOE_NBLK * 256, 1024, 512};
            typedef pg8::MoeOrder<(size_t)1024 * 512 * 2> Ord; Ord S{F.G, F.bid, (const PG8_LAS int*)(F.lds + MISC_OFF + 64)};
            pg8::EpiPlainBf16 E{WSB(p, WS_YB), 1024};
            pg8::gemm_phase<pg8::EpiPlainBf16, Ord, PG8_ALIGN, PG8_SP2>(F.lds, g, S, E);
            SEAM(); }
        if (IN(20)) { LP(); p18_combine(p, F, l, want_ctx); if (l + 1 < DEPTH) { p1_weights(p, F, l + 1, F.G == 256); SEAM(); } }
    }
__global__ void __launch_bounds__(NTHREADS, 2) mk_fwd(Params kp) {
    extern __shared__ __attribute__((aligned(16))) unsigned char lds_raw[];
    LAS unsigned char* const lds0 = (LAS unsigned char*)lds_raw;
    volatile LAS unsigned* misc = (volatile LAS unsigned*)(lds0 + MISC_OFF);
    if (threadIdx.x < 4) misc[threadIdx.x] = 0u;
    if (threadIdx.x == 0) { LAS Params* lp = (LAS Params*)(lds0 + PARAMS_OFF);
#pragma unroll
        for (int i = 0; i < 33; ++i) lp->in[i] = kp.in[i];
        lp->out = kp.out; lp->ws = kp.ws;
#pragma unroll
        for (int i = 0; i < 16; ++i) lp->invA[i] = kp.invA[i];
#pragma unroll
        for (int i = 0; i < 32; ++i) lp->invR[i] = kp.invR[i];
        lp->dry = kp.dry; }
    __syncthreads();
    const int ph_lo = kp.ph_lo, ph_hi = kp.ph_hi, fused = kp.fused;
    if (fused) (void)xcd_barrier_post((unsigned*)(kp.ws + WS_CTL) + CW_BAR, misc);
    if (((MK_PHASES >> 31) & 1u) && kp.do_pro) { LP(); p0_prologue(p, F); SEAM(); }

#if MK_FUSED
    layer_program(lds0, misc, 0, ph_lo, ph_hi, fused);
    layer_program(lds0, misc, 1, ph_lo, ph_hi, fused);
    layer_program(lds0, misc, 2, ph_lo, ph_hi, fused);
    layer_program(lds0, misc, 3, ph_lo, ph_hi, fused);
#else
    if (kp.l_lo < kp.l_hi) layer_program(lds0, misc, kp.l_lo, ph_lo, ph_hi, fused);
#endif
#undef IN
#undef SEAM
}

#ifndef MK_REP_MASK
#define MK_REP_MASK 0u
#define MK_REP_N 0
#endif
#ifndef MK_DRY_MODE
#define MK_DRY_MODE 1
#endif
extern "C" void kernel_launch(void* const* d_in, const int* in_sizes, int n_in, void* d_out, int out_size, void* d_ws, size_t ws_size, hipStream_t stream) {
    static int grid = 0;
    if (grid == 0) {
        if (n_in != 33 || in_sizes[0] != NB * NLAT * D || out_size != NB * NLAT * D || ws_size < WS_NEED) {
            fprintf(stderr, "kernel_launch: unexpected shapes/workspace: n_in %d in0 %d out %d ws %zu (need %zu)\n", n_in, n_in > 0 ? in_sizes[0] : -1, out_size, ws_size, (size_t)WS_NEED); grid = -1; return; }
        int dev = 0, cus = 0, per_cu = 0;
        if (hipGetDevice(&dev) != hipSuccess || hipDeviceGetAttribute(&cus, hipDeviceAttributeMultiprocessorCount, dev) != hipSuccess) { grid = -1; return; }
        if (hipFuncSetAttribute((const void*)mk_fwd, hipFuncAttributeMaxDynamicSharedMemorySize, LDS_BYTES) != hipSuccess) { fprintf(stderr, "kernel_launch: hipFuncSetAttribute failed\n"); grid = -1; return; }
        if (hipOccupancyMaxActiveBlocksPerMultiprocessor(&per_cu, (const void*)mk_fwd, NTHREADS, LDS_BYTES) != hipSuccess || per_cu < 1)
            fprintf(stderr, "kernel_launch: occupancy query reports %d workgroups per CU\n", per_cu);
        (void)hipGetLastError();
        grid = cus;
    }
    if (grid < 0) return;
    if (hipMemsetAsync((char*)d_ws + WS_CTL, 0, CTL_BYTES, stream) != hipSuccess) { fprintf(stderr, "kernel_launch: memset failed\n"); return; }
    Params a{};
    for (int i = 0; i < 33; ++i) a.in[i] = (const float*)d_in[i];
    a.out = (float*)d_out; a.ws = (unsigned char*)d_ws;
    for (int i = 0; i < 16; ++i) a.invA[i] = (float)pow(10000.0, -(double)i / 16.0);
    for (int i = 0; i < 32; ++i) a.invR[i] = (float)pow(10000.0, -(double)i / 32.0);
#if MK_FUSED
    a.ph_lo = 0; a.ph_hi = NPHASE; a.l_lo = 0; a.l_hi = DEPTH; a.fused = 1; a.do_pro = 1;
    hipLaunchKernelGGL(mk_fwd, dim3(grid), dim3(NTHREADS), LDS_BYTES, stream, a);
    if (hipPeekAtLastError() != hipSuccess) fprintf(stderr, "kernel_launch: launch failed\n");
#else
    a.fused = 0; a.do_pro = 1; a.l_lo = 0; a.l_hi = 0; a.ph_lo = 0; a.ph_hi = 0;
    hipLaunchKernelGGL(mk_fwd, dim3(grid), dim3(NTHREADS), LDS_BYTES, stream, a);
    a.do_pro = 0;
    for (int l = 0; l < DEPTH; ++l)
        for (int ph = 0; ph < NPHASE; ++ph) { a.l_lo = l; a.l_hi = l + 1; a.ph_lo = ph; a.ph_hi = ph + 1;
            const int reps = 1 + (((MK_REP_MASK >> ph) & 1u) ? MK_REP_N : 0);
            for (int r = 0; r < reps; ++r) { a.dry = r > 0 ? MK_DRY_MODE : 0; hipLaunchKernelGGL(mk_fwd, dim3(grid), dim3(NTHREADS), LDS_BYTES, stream, a); } a.dry = 0; }
    if (hipPeekAtLastError() != hipSuccess) fprintf(stderr, "kernel_launch: launch failed\n");
#endif
}
```
